# Optimizing an MI355X kernel written in HIP

```python
import jax, jax.numpy as jnp
from jax import lax
import numpy as np

D_MODEL = 1024
BATCH = 16
SEQ = 2048
DEPTH = 1

CHUNK = 64
Q_BLOCK = 128
MEM_LEN = 256
D_MIX = D_MODEL
MLA_HEADS = 8
MLA_NOPE = 64
MLA_ROPE = 32
MLA_V = 64
MLA_WIDTH = MLA_HEADS * MLA_V
Q_LORA = 256
KV_LORA = 128
ROPE_THETA = 10000.0
CONV_CH = D_MIX - MLA_WIDTH
CONV_WIDTH = 31
IN_COLS = Q_LORA + KV_LORA + MLA_ROPE + 2 * CONV_CH
X_HEADS = 4
X_HEAD_DIM = D_MODEL // X_HEADS
N_EXPERTS = 32
TOP_K = 4
D_FF_EXPERT = D_MODEL
SWIGLU_LIMIT = 7.0
SWIGLU_ALPHA = 1.702
MOE_BLOCK = 256
NORM_EPS = 1e-5
MAX_OFFSET = 4096

kernel_name = "hybrid_mla_conformer_memxattn_moe"


def rmsnorm(x, g):
    xf = x.astype(jnp.float32)
    y = xf * lax.rsqrt(jnp.mean(xf * xf, axis=-1, keepdims=True) + NORM_EPS)
    return (y * g.astype(jnp.float32)).astype(x.dtype)


def layernorm(x, g, b):
    xf = x.astype(jnp.float32)
    mu = jnp.mean(xf, axis=-1, keepdims=True)
    var = jnp.mean(jnp.square(xf - mu), axis=-1, keepdims=True)
    y = (xf - mu) * lax.rsqrt(var + NORM_EPS)
    return (y * g.astype(jnp.float32) + b.astype(jnp.float32)).astype(x.dtype)


def rope_angles(pos):
    inv = ROPE_THETA ** (-jnp.arange(0, MLA_ROPE, 2, dtype=jnp.float32) / MLA_ROPE)
    ang = pos.astype(jnp.float32)[..., None] * inv
    return jnp.cos(ang), jnp.sin(ang)


def apply_rope(x, cos, sin):
    half = x.shape[-1] // 2
    x1 = x[..., :half].astype(jnp.float32)
    x2 = x[..., half:].astype(jnp.float32)
    return jnp.concatenate([x1 * cos - x2 * sin, x1 * sin + x2 * cos], axis=-1).astype(x.dtype)


def mla_attention(c_q, c_kv, k_rope_raw, pos, g_q, w_uq, g_kv, w_ukv):
    B, S, _ = c_q.shape
    q = (rmsnorm(c_q, g_q) @ w_uq).reshape(B, S, MLA_HEADS, MLA_NOPE + MLA_ROPE)
    q_nope, q_rope = q[..., :MLA_NOPE], q[..., MLA_NOPE:]
    kv = (rmsnorm(c_kv, g_kv) @ w_ukv).reshape(B, S, MLA_HEADS, MLA_NOPE + MLA_V)
    k_nope, v = kv[..., :MLA_NOPE], kv[..., MLA_NOPE:]
    cos, sin = rope_angles(pos)
    q_rope = apply_rope(q_rope, cos[:, :, None, :], sin[:, :, None, :])
    k_rope = apply_rope(k_rope_raw, cos, sin)
    scale = (MLA_NOPE + MLA_ROPE) ** -0.5
    chunk_id = jnp.arange(S) // CHUNK
    outs = []
    for blk in range(S // Q_BLOCK):
        q0, q1 = blk * Q_BLOCK, (blk + 1) * Q_BLOCK
        s = (jnp.einsum('bqhd,bkhd->bhqk', q_nope[:, q0:q1], k_nope[:, :q1])
             + jnp.einsum('bqhr,bkr->bhqk', q_rope[:, q0:q1], k_rope[:, :q1]))
        s = s.astype(jnp.float32) * scale
        mask = chunk_id[None, :q1] <= chunk_id[q0:q1, None]
        s = jnp.where(mask[None, None], s, -jnp.inf)
        p = jax.nn.softmax(s, axis=-1).astype(v.dtype)
        outs.append(jnp.einsum('bhqk,bkhd->bqhd', p, v[:, :q1]))
    return jnp.concatenate(outs, axis=1).reshape(B, S, MLA_WIDTH)


def conformer_conv(u, w_dw, b_dw, g_ln, b_ln):
    a, gate = u[..., :CONV_CH], u[..., CONV_CH:]
    z = a * jax.nn.sigmoid(gate)
    z = lax.conv_general_dilated(
        z, w_dw[:, None, :], window_strides=(1,), padding=[(CONV_WIDTH - 1, 0)],
        dimension_numbers=('NWC', 'WIO', 'NWC'), feature_group_count=CONV_CH) + b_dw
    return jax.nn.silu(layernorm(z, g_ln, b_ln))


def memory_cross_attention(h, mem_n, w_xq, w_xkv, w_xo):
    B, S, _ = h.shape
    M = mem_n.shape[1]
    q = (h @ w_xq).reshape(B, S, X_HEADS, X_HEAD_DIM)
    kv = (mem_n @ w_xkv).reshape(B, M, 2, X_HEADS, X_HEAD_DIM)
    k, v = kv[:, :, 0], kv[:, :, 1]
    s = jnp.einsum('bqhd,bmhd->bhqm', q, k).astype(jnp.float32) * (X_HEAD_DIM ** -0.5)
    p = jax.nn.softmax(s, axis=-1).astype(v.dtype)
    o = jnp.einsum('bhqm,bmhd->bqhd', p, v).reshape(B, S, D_MODEL)
    return o @ w_xo


def moe_ffn(h, w_router, b_router, w_up, b_up, w_down, b_down):
    B, S, D = h.shape
    N = B * S
    t = h.reshape(N, D)
    logits = (t @ w_router + b_router).astype(jnp.float32)
    top_val, top_idx = lax.top_k(logits, TOP_K)
    gates = jax.nn.softmax(top_val, axis=-1)
    A = N * TOP_K
    flat_e = top_idx.reshape(A)
    flat_tok = jnp.repeat(jnp.arange(N, dtype=jnp.int32), TOP_K)
    flat_g = gates.reshape(A)
    order = jnp.argsort(flat_e)
    se = flat_e[order]
    counts = jnp.bincount(flat_e, length=N_EXPERTS)
    start = jnp.cumsum(counts) - counts
    padded = (counts + MOE_BLOCK - 1) // MOE_BLOCK * MOE_BLOCK
    pend = jnp.cumsum(padded)
    pstart = pend - padded
    dest = pstart[se] + (jnp.arange(A) - start[se])
    P = A + N_EXPERTS * MOE_BLOCK
    nb = P // MOE_BLOCK
    slot_tok = jnp.full((P,), N, dtype=jnp.int32).at[dest].set(flat_tok[order])
    slot_gate = jnp.zeros((P,), jnp.float32).at[dest].set(flat_g[order])
    blk_e = jnp.minimum(jnp.searchsorted(pend, jnp.arange(nb) * MOE_BLOCK, side='right'),
                        N_EXPERTS - 1)
    t_pad = jnp.concatenate([t, jnp.zeros((1, D), t.dtype)], axis=0)

    def expert_block(args):
        tok, e = args
        xb = t_pad[tok]
        up = xb @ w_up[e] + b_up[e]
        glu, lin = up[:, :D_FF_EXPERT], up[:, D_FF_EXPERT:]
        glu = jnp.minimum(glu, SWIGLU_LIMIT)
        lin = jnp.clip(lin, -SWIGLU_LIMIT, SWIGLU_LIMIT)
        act = glu * jax.nn.sigmoid(SWIGLU_ALPHA * glu) * (lin + 1)
        return act @ w_down[e] + b_down[e]

    y = lax.map(expert_block, (slot_tok.reshape(nb, MOE_BLOCK), blk_e))
    y = y.reshape(P, D) * slot_gate[:, None].astype(y.dtype)
    out = jax.ops.segment_sum(y, slot_tok, num_segments=N + 1)[:N]
    return out.reshape(B, S, D)


def setup_inputs(seed: int = 0) -> dict:
    key = jax.random.key(seed)
    ks = jax.random.split(key, 32)
    f32 = jnp.float32
    L = DEPTH

    def w(k, shape, fan_in):
        return jax.random.normal(k, shape, f32) * (fan_in ** -0.5)

    def gain(k, shape):
        return 1.0 + 0.02 * jax.random.normal(k, shape, f32)

    def bias(k, shape):
        return 0.01 * jax.random.normal(k, shape, f32)

    x = jax.random.normal(ks[0], (BATCH, SEQ, D_MODEL), f32)
    mem = jax.random.normal(ks[1], (BATCH, MEM_LEN, D_MODEL), f32)
    offs = jax.random.randint(ks[2], (BATCH, 1), 0, MAX_OFFSET, dtype=jnp.int32)
    positions = offs + jnp.arange(SEQ, dtype=jnp.int32)[None, :]
    return {
        "x": x,
        "mem": mem,
        "positions": positions,
        "g_mix": gain(ks[3], (L, D_MODEL)),
        "w_in": w(ks[4], (L, D_MODEL, IN_COLS), D_MODEL),
        "g_q": gain(ks[5], (L, Q_LORA)),
        "w_uq": w(ks[6], (L, Q_LORA, MLA_HEADS * (MLA_NOPE + MLA_ROPE)), Q_LORA),
        "g_kv": gain(ks[7], (L, KV_LORA)),
        "w_ukv": w(ks[8], (L, KV_LORA, MLA_HEADS * (MLA_NOPE + MLA_V)), KV_LORA),
        "w_dw": w(ks[9], (L, CONV_WIDTH, CONV_CH), CONV_WIDTH),
        "b_dw": bias(ks[10], (L, CONV_CH)),
        "g_conv_ln": gain(ks[11], (L, CONV_CH)),
        "b_conv_ln": bias(ks[12], (L, CONV_CH)),
        "w_out": w(ks[13], (L, D_MIX, D_MODEL), D_MIX),
        "g_xattn": gain(ks[14], (L, D_MODEL)),
        "g_mem": gain(ks[15], (L, D_MODEL)),
        "w_xq": w(ks[16], (L, D_MODEL, D_MODEL), D_MODEL),
        "w_xkv": w(ks[17], (L, D_MODEL, 2 * D_MODEL), D_MODEL),
        "w_xo": w(ks[18], (L, D_MODEL, D_MODEL), D_MODEL),
        "g_ffn": gain(ks[19], (L, D_MODEL)),
        "w_router": w(ks[20], (L, D_MODEL, N_EXPERTS), D_MODEL),
        "b_router": bias(ks[21], (L, N_EXPERTS)),
        "w_up": w(ks[22], (L, N_EXPERTS, D_MODEL, 2 * D_FF_EXPERT), D_MODEL),
        "b_up": bias(ks[23], (L, N_EXPERTS, 2 * D_FF_EXPERT)),
        "w_down": w(ks[24], (L, N_EXPERTS, D_FF_EXPERT, D_MODEL), D_FF_EXPERT),
        "b_down": bias(ks[25], (L, N_EXPERTS, D_MODEL)),
        "g_final": gain(ks[26], (D_MODEL,)),
    }


def reference(x, mem, positions, g_mix, w_in, g_q, w_uq, g_kv, w_ukv, w_dw, b_dw,
              g_conv_ln, b_conv_ln, w_out, g_xattn, g_mem, w_xq, w_xkv, w_xo,
              g_ffn, w_router, b_router, w_up, b_up, w_down, b_down, g_final):
    o1 = Q_LORA
    o2 = o1 + KV_LORA
    o3 = o2 + MLA_ROPE
    for l in range(DEPTH):
        h = rmsnorm(x, g_mix[l])
        u = h @ w_in[l]
        y_mla = mla_attention(u[..., :o1], u[..., o1:o2], u[..., o2:o3], positions,
                              g_q[l], w_uq[l], g_kv[l], w_ukv[l])
        y_conv = conformer_conv(u[..., o3:], w_dw[l], b_dw[l], g_conv_ln[l], b_conv_ln[l])
        x = x + jnp.concatenate([y_mla, y_conv], axis=-1) @ w_out[l]
        x = x + memory_cross_attention(rmsnorm(x, g_xattn[l]), rmsnorm(mem, g_mem[l]),
                                       w_xq[l], w_xkv[l], w_xo[l])
        x = x + moe_ffn(rmsnorm(x, g_ffn[l]), w_router[l], b_router[l],
                        w_up[l], b_up[l], w_down[l], b_down[l])
    return rmsnorm(x, g_final)
```

```cpp
#include <hip/hip_runtime.h>
#include <stdint.h>
#include <stdio.h>

#define LAS __attribute__((address_space(3)))
typedef unsigned short bf16_t;
typedef short bf16x8 __attribute__((ext_vector_type(8)));
typedef short s16x4 __attribute__((ext_vector_type(4)));
typedef float f32x2 __attribute__((ext_vector_type(2)));
typedef float f32x4 __attribute__((ext_vector_type(4)));
typedef float f32x16 __attribute__((ext_vector_type(16)));
typedef unsigned u32x2 __attribute__((ext_vector_type(2)));
typedef unsigned u32x4 __attribute__((ext_vector_type(4)));

constexpr int BATCH = 16, SEQ = 2048, NTOK = BATCH * SEQ, DM = 1024;
constexpr int INC = 1440, INP = 1536;
constexpr int HEADS = 8, QKD = 96, VD = 64;
constexpr int CCH = 512, CW = 31;
constexpr int MEML = 256, NMEM = BATCH * MEML;
constexpr int XH = 4, XD = 256;
constexpr int NE = 32, TOPK = 4;
constexpr int NSLOT = NTOK * TOPK + NE * 256;
constexpr int NTILE_MAX = NSLOT / 256;
constexpr float EPS = 1e-5f;
constexpr float C2_MLA = 0.14724444602590306f;
constexpr float C2_X = 0.09016844005556021f;
constexpr int RT_TOK = 128, RT_UNITS = NTOK / RT_TOK;

constexpr size_t MiB = 1u << 20;
constexpr size_t WS_CTL = 0;
constexpr size_t WS_RSTD_X = 1 * MiB;
constexpr size_t WS_RSTD_Q = WS_RSTD_X + 128 * 1024;
constexpr size_t WS_RSTD_KV = WS_RSTD_Q + 128 * 1024;
constexpr size_t WS_RSTD_X1 = WS_RSTD_KV + 128 * 1024;
constexpr size_t WS_RSTD_X2 = WS_RSTD_X1 + 128 * 1024;
constexpr size_t WS_RSTD_MEM = WS_RSTD_X2 + 128 * 1024;
constexpr size_t WS_ROPE = 2 * MiB;
constexpr size_t WS_TOPI = 6 * MiB;
constexpr size_t WS_TOPG = WS_TOPI + 512 * 1024;
constexpr size_t WS_INV = WS_TOPG + 512 * 1024;
constexpr size_t WS_SLOT_TOK = WS_INV + 512 * 1024;
constexpr size_t WS_SLOT_GATE = WS_SLOT_TOK + 1 * MiB;
constexpr size_t WS_HIST = WS_SLOT_GATE + 1 * MiB;
constexpr size_t WS_TILE_E = WS_HIST + 64 * 1024;
constexpr size_t WS_WR = 12 * MiB;
constexpr size_t WS_WT_IN = 16 * MiB;
constexpr size_t WS_WT_UQ = 19 * MiB;
constexpr size_t WS_WT_UKV = WS_WT_UQ + 512 * 1024;
constexpr size_t WS_WT_OUT = 20 * MiB;
constexpr size_t WS_WT_XQ = 22 * MiB;
constexpr size_t WS_WT_XKV = 24 * MiB;
constexpr size_t WS_WT_XO = 28 * MiB;
constexpr size_t WS_WT_UP = 32 * MiB;
constexpr size_t WS_WT_DOWN = 160 * MiB;
constexpr size_t WS_X2B = 224 * MiB;
constexpr size_t WS_XB = WS_X2B;
constexpr size_t WS_ACT = 288 * MiB;
constexpr size_t WS_U = 288 * MiB;
constexpr size_t WS_Q = 384 * MiB;
constexpr size_t WS_KB = 432 * MiB;
constexpr size_t WS_VB = 480 * MiB;
constexpr size_t WS_YCAT = 512 * MiB;
constexpr size_t WS_YB = 560 * MiB;
constexpr size_t WS_X1B = 576 * MiB;
constexpr size_t WS_XQ = 640 * MiB;
constexpr size_t WS_P = 704 * MiB;
constexpr size_t WS_OX = 768 * MiB;
constexpr size_t WS_MEMB = 832 * MiB;
constexpr size_t WS_KM = 840 * MiB;
constexpr size_t WS_VMT = 848 * MiB;
constexpr size_t WS_END = 856 * MiB;

struct Params {
    const float* x; const float* mem; const int* pos;
    const float *g_mix, *w_in, *g_q, *w_uq, *g_kv, *w_ukv, *w_dw, *b_dw, *g_cln, *b_cln, *w_out, *g_xattn, *g_mem, *w_xq, *w_xkv, *w_xo, *g_ffn, *w_router, *b_router, *w_up, *b_up, *w_down, *b_down, *g_final;
    float* out; unsigned char* ws;
};

__device__ __forceinline__ float bf2f(bf16_t b) { return __uint_as_float((unsigned)b << 16); }
__device__ __forceinline__ unsigned f2bf(float f) { unsigned u = __float_as_uint(f); return (u + 0x7fffu + ((u >> 16) & 1u)) >> 16; }
__device__ __forceinline__ unsigned pk2(float lo, float hi) { return f2bf(lo) | (f2bf(hi) << 16); }
__device__ __forceinline__ float wave_sum(float v) {
#pragma unroll
    for (int o = 1; o < 64; o <<= 1) v += __shfl_xor(v, o);
    return v;
}
__device__ __forceinline__ int perm32(int rho) { const int n = rho >> 4, i = rho & 15; return 8 * (i >> 2) + 4 * n + (i & 3); }
__device__ __forceinline__ float fast_exp2(float x) { return __builtin_amdgcn_exp2f(x); }
__device__ __forceinline__ float sigmoidf_(float x) { return 1.0f / (1.0f + __expf(-x)); }

template <int MODE>
__device__ __forceinline__ void tr_item(const float* W, int N, int K, const float* g, bf16_t* WT, LAS float* scr, int item, int lane) {
    const int nblk = N / 32, kb = item / nblk, nb = item % nblk, k0 = 64 * kb, n0 = 32 * nb;
#pragma unroll 8
    for (int i = 0; i < 32; ++i) { const int kk = 2 * i + (lane >> 5); const float gv = g ? g[k0 + kk] : 1.0f;
        scr[kk * 33 + (lane & 31)] = W[(size_t)(k0 + kk) * N + n0 + (lane & 31)] * gv; }
    asm volatile("s_waitcnt lgkmcnt(0)" ::: "memory");
    const int c = lane & 7;
#pragma unroll
    for (int j = 0; j < 4; ++j) { const int n = (lane >> 3) + 8 * j; const LAS float* s = scr + (8 * c) * 33 + n;
        u32x4 o; o.x = pk2(s[0 * 33], s[1 * 33]); o.y = pk2(s[2 * 33], s[3 * 33]); o.z = pk2(s[4 * 33], s[5 * 33]); o.w = pk2(s[6 * 33], s[7 * 33]);
        const int nn = n0 + n; const int row = (MODE == 1) ? ((((nn & 1023) >> 7) << 8) + ((nn >> 10) << 7) + (nn & 127)) : nn;
        *(u32x4*)(WT + (size_t)row * K + k0 + 8 * c) = o; }
    asm volatile("s_waitcnt lgkmcnt(0)" ::: "memory");
}
__device__ __forceinline__ void row_bf16_rstd(const float* xrow, bf16_t* orow, float* rstd_out, int lane) {
    f32x4 v[4]; float s = 0.f;
#pragma unroll
    for (int j = 0; j < 4; ++j) { v[j] = ((const f32x4*)xrow)[lane + 64 * j]; s += (v[j].x * v[j].x + v[j].y * v[j].y) + (v[j].z * v[j].z + v[j].w * v[j].w); }
    s = wave_sum(s);
    if (lane == 0) *rstd_out = 1.0f / sqrtf(s * (1.0f / 1024.0f) + EPS);
    if (orow) {
#pragma unroll
        for (int j = 0; j < 4; ++j) { u32x2 w; w.x = pk2(v[j].x, v[j].y); w.y = pk2(v[j].z, v[j].w); ((u32x2*)orow)[lane + 64 * j] = w; }
    }
}
__device__ __forceinline__ void sincos_acc(double a, float& s, float& c) {
    const double TWO_PI = 6.283185307179586476925;
    const double n = rint(a * (1.0 / TWO_PI)); const double r = a - n * TWO_PI;
    const double h = 0.5 * r, h2 = h * h;
    const double sh = h * (1.0 + h2 * (-1.0 / 6.0 + h2 * (1.0 / 120.0 + h2 * (-1.0 / 5040.0 + h2 * (1.0 / 362880.0 + h2 * (-1.0 / 39916800.0 + h2 * (1.0 / 6227020800.0 + h2 * (-1.0 / 1307674368000.0 + h2 * (1.0 / 355687428096000.0)))))))));
    const double ch = 1.0 + h2 * (-0.5 + h2 * (1.0 / 24.0 + h2 * (-1.0 / 720.0 + h2 * (1.0 / 40320.0 + h2 * (-1.0 / 3628800.0 + h2 * (1.0 / 479001600.0 + h2 * (-1.0 / 87178291200.0 + h2 * (1.0 / 20922789888000.0 + h2 * (-1.0 / 6402373705728000.0)))))))));
    s = (float)(2.0 * sh * ch); c = (float)(ch * ch - sh * sh);
}
__device__ __forceinline__ double rope_inv(int i) {
    const double t[16] = {1.0, 0.5623413251903491, 0.31622776601683794, 0.1778279410038923, 0.1, 0.05623413251903491, 0.03162277660168379, 0.01778279410038923,
                          0.01, 0.005623413251903491, 0.0031622776601683794, 0.0017782794100389228, 0.001, 0.0005623413251903491, 0.00031622776601683794, 0.00017782794100389227};
    double r = t[0];
#pragma unroll
    for (int k = 1; k < 16; ++k) r = (i == k) ? t[k] : r;
    return r;
}

__device__ __forceinline__ void prep_stage(const Params& p, LAS unsigned char* lds, int vblk, int nblk) {
    const int tid = threadIdx.x, lane = tid & 63, wid = tid >> 6;
    const int gw = vblk * 8 + wid, ngw = nblk * 8;
    LAS float* scr = (LAS float*)(lds + wid * 8448);
    unsigned char* ws = p.ws;
    constexpr int I_IN = 16 * 45, I_UQ = 4 * 24, I_UKV = 2 * 32, I_SQ = 16 * 32, I_XKV = 16 * 64, I_UP1 = 16 * 64, I_DN1 = 16 * 32;
    constexpr int NITEMS = I_IN + I_UQ + I_UKV + 3 * I_SQ + I_XKV + NE * I_UP1 + NE * I_DN1;
    for (int it = gw; it < NITEMS; it += ngw) {
        int r = it;
        if (r < I_IN) { tr_item<0>(p.w_in, INC, 1024, p.g_mix, (bf16_t*)(ws + WS_WT_IN), scr, r, lane); continue; } r -= I_IN;
        if (r < I_UQ) { tr_item<0>(p.w_uq, 768, 256, p.g_q, (bf16_t*)(ws + WS_WT_UQ), scr, r, lane); continue; } r -= I_UQ;
        if (r < I_UKV) { tr_item<0>(p.w_ukv, 1024, 128, p.g_kv, (bf16_t*)(ws + WS_WT_UKV), scr, r, lane); continue; } r -= I_UKV;
        if (r < I_SQ) { tr_item<0>(p.w_out, 1024, 1024, nullptr, (bf16_t*)(ws + WS_WT_OUT), scr, r, lane); continue; } r -= I_SQ;
        if (r < I_SQ) { tr_item<0>(p.w_xq, 1024, 1024, p.g_xattn, (bf16_t*)(ws + WS_WT_XQ), scr, r, lane); continue; } r -= I_SQ;
        if (r < I_SQ) { tr_item<0>(p.w_xo, 1024, 1024, nullptr, (bf16_t*)(ws + WS_WT_XO), scr, r, lane); continue; } r -= I_SQ;
        if (r < I_XKV) { tr_item<0>(p.w_xkv, 2048, 1024, p.g_mem, (bf16_t*)(ws + WS_WT_XKV), scr, r, lane); continue; } r -= I_XKV;
        if (r < NE * I_UP1) { const int e = r / I_UP1; tr_item<1>(p.w_up + (size_t)e * 1024 * 2048, 2048, 1024, p.g_ffn, (bf16_t*)(ws + WS_WT_UP) + (size_t)e * 2048 * 1024, scr, r % I_UP1, lane); continue; } r -= NE * I_UP1;
        { const int e = r / I_DN1; tr_item<0>(p.w_down + (size_t)e * 1024 * 1024, 1024, 1024, nullptr, (bf16_t*)(ws + WS_WT_DOWN) + (size_t)e * 1024 * 1024, scr, r % I_DN1, lane); }
    }
    for (int m = gw; m < NTOK; m += ngw) row_bf16_rstd(p.x + (size_t)m * 1024, (bf16_t*)(ws + WS_XB) + (size_t)m * 1024, (float*)(ws + WS_RSTD_X) + m, lane);
    for (int m = gw; m < NMEM; m += ngw) row_bf16_rstd(p.mem + (size_t)m * 1024, (bf16_t*)(ws + WS_MEMB) + (size_t)m * 1024, (float*)(ws + WS_RSTD_MEM) + m, lane);
    const int gt = vblk * 512 + tid, ngt = nblk * 512;
    for (int i = gt; i < NTOK * 16; i += ngt) { const int row = i >> 4, f = i & 15; float s, c; sincos_acc((double)p.pos[row] * rope_inv(f), s, c);
        float* rt = (float*)(ws + WS_ROPE) + (size_t)row * 32; rt[f] = c; rt[16 + f] = s; }
    for (int i = gt; i < 1024 * 32; i += ngt) ((float*)(ws + WS_WR))[i] = p.g_ffn[i >> 5] * p.w_router[i];
    for (int i = gt; i < (INP - INC) * 1024 / 8; i += ngt) ((u32x4*)((bf16_t*)(ws + WS_WT_IN) + (size_t)INC * 1024))[i] = (u32x4){0u, 0u, 0u, 0u};
}

struct Unit { int pm, pn, z; };
typedef f32x4 Acc[2][2][4][2];

template <bool PERM, class Prov, class Epi>
__device__ __forceinline__ void gemm_unit_naive(const Prov& P, const Epi& E, const Unit& u, LAS unsigned char* lds) {
    const int tid = threadIdx.x, wid = tid >> 6, lane = tid & 63, wr = wid >> 2, wc = wid & 3, fr = lane & 15, fq = lane >> 4;
    const bf16_t* ap[2][4]; const bf16_t* bp[2][2];
#pragma unroll
    for (int ai = 0; ai < 2; ++ai)
#pragma unroll
        for (int m = 0; m < 4; ++m) ap[ai][m] = P.a_row(u, 128 * ai + 64 * wr + 16 * m + fr) + 8 * fq;
#pragma unroll
    for (int bj = 0; bj < 2; ++bj)
#pragma unroll
        for (int n = 0; n < 2; ++n) { const int rho = 16 * n + fr; bp[bj][n] = P.b_row(u, 128 * bj + 32 * wc + (PERM ? perm32(rho) : rho)) + 8 * fq; }
    Acc acc;
#pragma unroll
    for (int a = 0; a < 2; ++a)
#pragma unroll
        for (int b = 0; b < 2; ++b)
#pragma unroll
            for (int m = 0; m < 4; ++m)
#pragma unroll
                for (int n = 0; n < 2; ++n) acc[a][b][m][n] = (f32x4){0.f, 0.f, 0.f, 0.f};
    const int K = P.K;
#pragma unroll 1
    for (int k0 = 0; k0 < K; k0 += 32) {
        bf16x8 a[2][4], b[2][2];
#pragma unroll
        for (int ai = 0; ai < 2; ++ai)
#pragma unroll
            for (int m = 0; m < 4; ++m) a[ai][m] = *(const bf16x8*)(ap[ai][m] + k0);
#pragma unroll
        for (int bj = 0; bj < 2; ++bj)
#pragma unroll
            for (int n = 0; n < 2; ++n) b[bj][n] = *(const bf16x8*)(bp[bj][n] + k0);
#pragma unroll
        for (int ai = 0; ai < 2; ++ai)
#pragma unroll
            for (int bj = 0; bj < 2; ++bj)
#pragma unroll
                for (int m = 0; m < 4; ++m)
#pragma unroll
                    for (int n = 0; n < 2; ++n) acc[ai][bj][m][n] = __builtin_amdgcn_mfma_f32_16x16x32_bf16(b[bj][n], a[ai][m], acc[ai][bj][m][n], 0, 0, 0);
    }
    E(acc, u, wr, wc, fr, fq, lds);
}

struct ProvPlain { const bf16_t* A; int lda; const bf16_t* Bt; int ldb; int K;
    __device__ __forceinline__ const bf16_t* a_row(const Unit& u, int r) const { return A + (size_t)(u.pm * 256 + r) * lda; }
    __device__ __forceinline__ const bf16_t* b_row(const Unit& u, int r) const { return Bt + (size_t)(u.pn * 256 + r) * ldb; } };
struct ProvXS { const bf16_t* XQ; const bf16_t* KM; int K;
    __device__ __forceinline__ const bf16_t* a_row(const Unit& u, int r) const { return XQ + (size_t)((u.z >> 2) * 2048 + u.pm * 256 + r) * 1024 + (u.z & 3) * 256; }
    __device__ __forceinline__ const bf16_t* b_row(const Unit& u, int r) const { return KM + (size_t)((u.z >> 2) * 256 + r) * 1024 + (u.z & 3) * 256; } };
struct ProvXPV { const bf16_t* Pm; const bf16_t* VMT; int K;
    __device__ __forceinline__ const bf16_t* a_row(const Unit& u, int r) const { return Pm + ((size_t)u.z * 2048 + u.pm * 256 + r) * 256; }
    __device__ __forceinline__ const bf16_t* b_row(const Unit& u, int r) const { return VMT + ((size_t)u.z * 256 + r) * 256; } };
struct ProvUp { const bf16_t* X2B; const int* slot_tok; const int* tile_e; const bf16_t* WT; int K;
    __device__ __forceinline__ const bf16_t* a_row(const Unit& u, int r) const { return X2B + (size_t)slot_tok[u.pm * 256 + r] * 1024; }
    __device__ __forceinline__ const bf16_t* b_row(const Unit& u, int r) const { return WT + ((size_t)tile_e[u.pm] * 2048 + u.pn * 256 + r) * 1024; } };
struct ProvDown { const bf16_t* ACT; const int* tile_e; const bf16_t* WT; int K;
    __device__ __forceinline__ const bf16_t* a_row(const Unit& u, int r) const { return ACT + (size_t)(u.pm * 256 + r) * 1024; }
    __device__ __forceinline__ const bf16_t* b_row(const Unit& u, int r) const { return WT + ((size_t)tile_e[u.pm] * 1024 + u.pn * 256 + r) * 1024; } };

#define EPI_ARGS Acc& acc, const Unit& u, int wr, int wc, int fr, int fq, LAS unsigned char* lds
#define FOR_AI_M _Pragma("unroll") for (int ai = 0; ai < 2; ++ai) _Pragma("unroll") for (int m = 0; m < 4; ++m)
#define FOR_BJ _Pragma("unroll") for (int bj = 0; bj < 2; ++bj)
struct EpiScaleBf16 { bf16_t* O; int ldc; const float* rs; float mul;
    __device__ __forceinline__ void operator()(EPI_ARGS) const {
        FOR_AI_M { const int row = u.pm * 256 + 128 * ai + 64 * wr + 16 * m + fr; const float s = rs[row] * mul; bf16_t* rowp = O + (size_t)row * ldc + u.pn * 256 + 32 * wc + 8 * fq;
            FOR_BJ { const f32x4 v0 = acc[ai][bj][m][0] * s, v1 = acc[ai][bj][m][1] * s; u32x4 w; w.x = pk2(v0[0], v0[1]); w.y = pk2(v0[2], v0[3]); w.z = pk2(v1[0], v1[1]); w.w = pk2(v1[2], v1[3]);
                *(u32x4*)(rowp + 128 * bj) = w; } } } };
struct EpiQ { bf16_t* Q; const float* rs; const float* rope;
    __device__ __forceinline__ void operator()(EPI_ARGS) const {
        FOR_AI_M { const int row = u.pm * 256 + 128 * ai + 64 * wr + 16 * m + fr; const float s = rs[row] * C2_MLA;
            const f32x4 cs = *(const f32x4*)(rope + (size_t)row * 32 + 4 * fq), sn = *(const f32x4*)(rope + (size_t)row * 32 + 16 + 4 * fq);
            FOR_BJ { const int colg = u.pn * 256 + 128 * bj + 32 * wc; f32x4 v0 = acc[ai][bj][m][0] * s, v1 = acc[ai][bj][m][1] * s;
                if (((colg >> 5) % 3) == 2) { const f32x4 r0 = v0 * cs - v1 * sn, r1 = v0 * sn + v1 * cs; v0 = r0; v1 = r1; }
                bf16_t* rowp = Q + (size_t)row * 768 + colg + 4 * fq; u32x2 w0, w1; w0.x = pk2(v0[0], v0[1]); w0.y = pk2(v0[2], v0[3]); w1.x = pk2(v1[0], v1[1]); w1.y = pk2(v1[2], v1[3]);
                *(u32x2*)(rowp) = w0; *(u32x2*)(rowp + 16) = w1; } } } };
struct EpiKV { bf16_t* KB; bf16_t* VB; const float* rs;
    __device__ __forceinline__ void operator()(EPI_ARGS) const {
        FOR_AI_M { const int row = u.pm * 256 + 128 * ai + 64 * wr + 16 * m + fr; const float s = rs[row];
            FOR_BJ { const int h = 2 * u.pn + bj, cl = 32 * wc + 8 * fq; const f32x4 v0 = acc[ai][bj][m][0] * s, v1 = acc[ai][bj][m][1] * s;
                u32x4 w; w.x = pk2(v0[0], v0[1]); w.y = pk2(v0[2], v0[3]); w.z = pk2(v1[0], v1[1]); w.w = pk2(v1[2], v1[3]);
                if (wc < 2) *(u32x4*)(KB + (size_t)row * 768 + h * 96 + cl) = w; else *(u32x4*)(VB + (size_t)row * 512 + h * 64 + cl - 64) = w; } } } };
struct EpiResid { const float* base; float* out; bf16_t* ob;
    __device__ __forceinline__ void operator()(EPI_ARGS) const {
        FOR_AI_M { const int row = u.pm * 256 + 128 * ai + 64 * wr + 16 * m + fr;
            FOR_BJ {
#pragma unroll
                for (int n = 0; n < 2; ++n) { const size_t off = (size_t)row * 1024 + u.pn * 256 + 128 * bj + 32 * wc + 16 * n + 4 * fq;
                    const f32x4 v = *(const f32x4*)(base + off) + acc[ai][bj][m][n]; *(f32x4*)(out + off) = v; u32x2 w; w.x = pk2(v[0], v[1]); w.y = pk2(v[2], v[3]); *(u32x2*)(ob + off) = w; } } } } };
struct EpiKVMem { bf16_t* KM; bf16_t* VMT; const float* rs;
    __device__ __forceinline__ void operator()(EPI_ARGS) const {
        FOR_AI_M { const int row = u.pm * 256 + 128 * ai + 64 * wr + 16 * m + fr; const float s = rs[row];
            FOR_BJ {
#pragma unroll
                for (int n = 0; n < 2; ++n) { const int col = u.pn * 256 + 128 * bj + 32 * wc + 16 * n + 4 * fq; const f32x4 v = acc[ai][bj][m][n] * s;
                    if (u.pn < 4) { u32x2 w; w.x = pk2(v[0], v[1]); w.y = pk2(v[2], v[3]); *(u32x2*)(KM + (size_t)row * 1024 + col) = w; }
                    else { const int c2 = col - 1024, h = c2 >> 8, d = c2 & 255, b = row >> 8, mm = row & 255; bf16_t* dst = VMT + ((size_t)(b * 4 + h) * 256 + d) * 256 + mm;
#pragma unroll
                        for (int j = 0; j < 4; ++j) dst[(size_t)j * 256] = (bf16_t)f2bf(v[j]); } } } } } };
struct EpiSoftmaxP { bf16_t* Pm;
    __device__ __forceinline__ void operator()(EPI_ARGS) const {
        LAS float* red = (LAS float*)lds; float rmax[2][4];
        FOR_AI_M { float mx = -3.0e38f;
            FOR_BJ {
#pragma unroll
                for (int n = 0; n < 2; ++n)
#pragma unroll
                    for (int j = 0; j < 4; ++j) mx = fmaxf(mx, acc[ai][bj][m][n][j]); }
            mx = fmaxf(mx, __shfl_xor(mx, 16)); mx = fmaxf(mx, __shfl_xor(mx, 32));
            if (fq == 0) red[(128 * ai + 64 * wr + 16 * m + fr) * 4 + wc] = mx; }
        __syncthreads();
        FOR_AI_M { const f32x4 t = *(const LAS f32x4*)(red + (128 * ai + 64 * wr + 16 * m + fr) * 4); rmax[ai][m] = fmaxf(fmaxf(t[0], t[1]), fmaxf(t[2], t[3])); }
        __syncthreads();
        FOR_AI_M { float s = 0.f;
            FOR_BJ {
#pragma unroll
                for (int n = 0; n < 2; ++n)
#pragma unroll
                    for (int j = 0; j < 4; ++j) { const float e = fast_exp2(acc[ai][bj][m][n][j] - rmax[ai][m]); acc[ai][bj][m][n][j] = e; s += e; } }
            s += __shfl_xor(s, 16); s += __shfl_xor(s, 32);
            if (fq == 0) red[(128 * ai + 64 * wr + 16 * m + fr) * 4 + wc] = s; }
        __syncthreads();
        FOR_AI_M { const int r = 128 * ai + 64 * wr + 16 * m + fr; const f32x4 t = *(const LAS f32x4*)(red + r * 4); const float inv = 1.0f / ((t[0] + t[1]) + (t[2] + t[3]));
            bf16_t* rowp = Pm + ((size_t)u.z * 2048 + u.pm * 256 + r) * 256 + 32 * wc + 8 * fq;
            FOR_BJ { const f32x4 v0 = acc[ai][bj][m][0] * inv, v1 = acc[ai][bj][m][1] * inv; u32x4 w; w.x = pk2(v0[0], v0[1]); w.y = pk2(v0[2], v0[3]); w.z = pk2(v1[0], v1[1]); w.w = pk2(v1[2], v1[3]);
                *(u32x4*)(rowp + 128 * bj) = w; } }
        __syncthreads();
    } };
struct EpiOX { bf16_t* OX;
    __device__ __forceinline__ void operator()(EPI_ARGS) const {
        FOR_AI_M { const int r = 128 * ai + 64 * wr + 16 * m + fr; bf16_t* rowp = OX + (size_t)((u.z >> 2) * 2048 + u.pm * 256 + r) * 1024 + (u.z & 3) * 256 + 32 * wc + 8 * fq;
            FOR_BJ { const f32x4 v0 = acc[ai][bj][m][0], v1 = acc[ai][bj][m][1]; u32x4 w; w.x = pk2(v0[0], v0[1]); w.y = pk2(v0[2], v0[3]); w.z = pk2(v1[0], v1[1]); w.w = pk2(v1[2], v1[3]);
                *(u32x4*)(rowp + 128 * bj) = w; } } } };
struct EpiSwiglu { bf16_t* ACT; const float* rs; const int* slot_tok; const int* tile_e; const float* b_up;
    __device__ __forceinline__ void operator()(EPI_ARGS) const {
        const int e = tile_e[u.pm]; const int cl = 32 * wc + 8 * fq; const float* bg = b_up + (size_t)e * 2048 + u.pn * 128 + cl; const float* bl = bg + 1024;
        const f32x4 bg0 = *(const f32x4*)bg, bg1 = *(const f32x4*)(bg + 4), bl0 = *(const f32x4*)bl, bl1 = *(const f32x4*)(bl + 4);
        FOR_AI_M { const int slot = u.pm * 256 + 128 * ai + 64 * wr + 16 * m + fr; const float s = rs[slot_tok[slot]];
            float o[8];
#pragma unroll
            for (int n = 0; n < 2; ++n)
#pragma unroll
                for (int j = 0; j < 4; ++j) { float g = acc[ai][0][m][n][j] * s + (n ? bg1[j] : bg0[j]); float l = acc[ai][1][m][n][j] * s + (n ? bl1[j] : bl0[j]);
                    g = fminf(g, 7.0f); l = fminf(fmaxf(l, -7.0f), 7.0f); o[4 * n + j] = g * sigmoidf_(1.702f * g) * (l + 1.0f); }
            u32x4 w; w.x = pk2(o[0], o[1]); w.y = pk2(o[2], o[3]); w.z = pk2(o[4], o[5]); w.w = pk2(o[6], o[7]);
            *(u32x4*)(ACT + (size_t)slot * 1024 + u.pn * 128 + cl) = w; } } };
struct EpiDown { bf16_t* YB; const float* gate; const int* tile_e; const float* b_down;
    __device__ __forceinline__ void operator()(EPI_ARGS) const {
        const int e = tile_e[u.pm]; const int c0 = u.pn * 256 + 32 * wc + 8 * fq; f32x4 bv[2][2];
        FOR_BJ { bv[bj][0] = *(const f32x4*)(b_down + (size_t)e * 1024 + c0 + 128 * bj); bv[bj][1] = *(const f32x4*)(b_down + (size_t)e * 1024 + c0 + 128 * bj + 4); }
        FOR_AI_M { const int slot = u.pm * 256 + 128 * ai + 64 * wr + 16 * m + fr; const float g = gate[slot];
            FOR_BJ { const f32x4 v0 = (acc[ai][bj][m][0] + bv[bj][0]) * g, v1 = (acc[ai][bj][m][1] + bv[bj][1]) * g; u32x4 w; w.x = pk2(v0[0], v0[1]); w.y = pk2(v0[2], v0[3]); w.z = pk2(v1[0], v1[1]); w.w = pk2(v1[2], v1[3]);
                *(u32x4*)(YB + (size_t)slot * 1024 + c0 + 128 * bj) = w; } } } };

__device__ __forceinline__ void rowstats_row(const Params& p, int row, int lane) {
    const bf16_t* ur = (const bf16_t*)(p.ws + WS_U) + (size_t)row * INP;
    const u32x2 a = ((const u32x2*)ur)[lane];
    float sq = 0.f; { const float v0 = __uint_as_float(a.x << 16), v1 = __uint_as_float(a.x & 0xffff0000u), v2 = __uint_as_float(a.y << 16), v3 = __uint_as_float(a.y & 0xffff0000u); sq = (v0 * v0 + v1 * v1) + (v2 * v2 + v3 * v3); }
    const unsigned bb = ((const unsigned*)(ur + 256))[lane];
    float sk = 0.f; { const float v0 = __uint_as_float(bb << 16), v1 = __uint_as_float(bb & 0xffff0000u); sk = v0 * v0 + v1 * v1; }
    sq = wave_sum(sq); sk = wave_sum(sk);
    if (lane == 0) { ((float*)(p.ws + WS_RSTD_Q))[row] = 1.0f / sqrtf(sq * (1.0f / 256.0f) + EPS); ((float*)(p.ws + WS_RSTD_KV))[row] = 1.0f / sqrtf(sk * (1.0f / 128.0f) + EPS); }
    const int i = lane & 15; const float x1 = bf2f(ur[384 + i]), x2 = bf2f(ur[400 + i]);
    const float* rt = (const float*)(p.ws + WS_ROPE) + (size_t)row * 32; const float c = rt[i], s = rt[16 + i];
    const float o = ((lane & 31) < 16) ? (x1 * c - x2 * s) : (x1 * s + x2 * c);
    bf16_t* kb = (bf16_t*)(p.ws + WS_KB) + (size_t)row * 768 + 64 + (lane & 31);
    const bf16_t ob = (bf16_t)f2bf(o);
    const int hb = (lane >> 5) * 4;
#pragma unroll
    for (int h = 0; h < 4; ++h) kb[(hb + h) * 96] = ob;
}

constexpr int VT_LD = 72;
__device__ __forceinline__ void mla_unit(const Params& p, LAS unsigned char* lds, int unit) {
    const int tid = threadIdx.x, lane = tid & 63, wid = tid >> 6, r32 = lane & 31, hi = lane >> 5;
    const int qb = unit & 7, h = (unit >> 3) & 7, b = unit >> 6;
    const bf16_t* Qg = (const bf16_t*)(p.ws + WS_Q); const bf16_t* Kg = (const bf16_t*)(p.ws + WS_KB); const bf16_t* Vg = (const bf16_t*)(p.ws + WS_VB);
    LAS bf16_t* vt = (LAS bf16_t*)lds;
    const size_t rowb = (size_t)b * SEQ;
    const int q0 = qb * 256 + wid * 32;
    bf16x8 qf[6];
#pragma unroll
    for (int s = 0; s < 6; ++s) qf[s] = *(const bf16x8*)(Qg + (rowb + q0 + r32) * 768 + h * 96 + 16 * s + 8 * hi);
    const int nt_blk = 4 * qb + 4, nt_me = 4 * qb + (wid >> 1) + 1;
    float mrun = -1.0e30f, lrun = 0.f; f32x16 o0 = {}, o1 = {};
    for (int t = 0; t < nt_blk; ++t) {
        __syncthreads();
        { const int kv = tid >> 3, dc = tid & 7; const bf16x8 v = *(const bf16x8*)(Vg + (rowb + 64 * t + kv) * 512 + h * 64 + 8 * dc);
#pragma unroll
            for (int e = 0; e < 8; ++e) vt[(8 * dc + e) * VT_LD + kv] = (bf16_t)v[e]; }
        __syncthreads();
        if (t < nt_me) {
            f32x16 sc[2];
#pragma unroll
            for (int kb = 0; kb < 2; ++kb) { f32x16 a = {};
                const bf16_t* kr = Kg + (rowb + 64 * t + 32 * kb + r32) * 768 + h * 96 + 8 * hi;
#pragma unroll
                for (int s = 0; s < 6; ++s) { const bf16x8 kf = *(const bf16x8*)(kr + 16 * s); a = __builtin_amdgcn_mfma_f32_32x32x16_bf16(kf, qf[s], a, 0, 0, 0); }
                sc[kb] = a; }
            float mx = sc[0][0];
#pragma unroll
            for (int r = 0; r < 16; ++r) { mx = fmaxf(mx, sc[0][r]); mx = fmaxf(mx, sc[1][r]); }
            mx = fmaxf(mx, __shfl_xor(mx, 32));
            const float mnew = fmaxf(mrun, mx), alpha = fast_exp2(mrun - mnew); mrun = mnew;
            float ls = 0.f; unsigned pw[2][8];
#pragma unroll
            for (int kb = 0; kb < 2; ++kb)
#pragma unroll
                for (int r = 0; r < 16; r += 2) { const float e0 = fast_exp2(sc[kb][r] - mnew), e1 = fast_exp2(sc[kb][r + 1] - mnew); const unsigned w = pk2(e0, e1); pw[kb][r >> 1] = w;
                    ls += __uint_as_float(w << 16) + __uint_as_float(w & 0xffff0000u); }
            lrun = lrun * alpha + ls;
#pragma unroll
            for (int r = 0; r < 16; ++r) { o0[r] *= alpha; o1[r] *= alpha; }
#pragma unroll
            for (int kb = 0; kb < 2; ++kb)
#pragma unroll
                for (int s2 = 0; s2 < 2; ++s2) {
                    u32x4 pu; pu.x = pw[kb][4 * s2 + 0]; pu.y = pw[kb][4 * s2 + 1]; pu.z = pw[kb][4 * s2 + 2]; pu.w = pw[kb][4 * s2 + 3];
                    const bf16x8 pf = __builtin_bit_cast(bf16x8, pu);
                    const int kv0 = 32 * kb + 16 * s2 + 4 * hi;
#pragma unroll
                    for (int db = 0; db < 2; ++db) { const LAS bf16_t* vr = vt + (32 * db + r32) * VT_LD + kv0;
                        const s16x4 lo = *(const LAS s16x4*)vr, hi4 = *(const LAS s16x4*)(vr + 8);
                        const bf16x8 vf = (bf16x8){lo[0], lo[1], lo[2], lo[3], hi4[0], hi4[1], hi4[2], hi4[3]};
                        if (db == 0) o0 = __builtin_amdgcn_mfma_f32_32x32x16_bf16(vf, pf, o0, 0, 0, 0); else o1 = __builtin_amdgcn_mfma_f32_32x32x16_bf16(vf, pf, o1, 0, 0, 0); } }
        }
    }
    lrun += __shfl_xor(lrun, 32);
    const float inv = 1.0f / lrun;
    bf16_t* yo = (bf16_t*)(p.ws + WS_YCAT) + (rowb + q0 + r32) * 1024 + h * 64;
#pragma unroll
    for (int g = 0; g < 4; ++g) { u32x2 w0, w1; w0.x = pk2(o0[4 * g] * inv, o0[4 * g + 1] * inv); w0.y = pk2(o0[4 * g + 2] * inv, o0[4 * g + 3] * inv);
        w1.x = pk2(o1[4 * g] * inv, o1[4 * g + 1] * inv); w1.y = pk2(o1[4 * g + 2] * inv, o1[4 * g + 3] * inv);
        *(u32x2*)(yo + 8 * g + 4 * hi) = w0; *(u32x2*)(yo + 32 + 8 * g + 4 * hi) = w1; }
}

__device__ __forceinline__ void conv_unit(const Params& p, LAS unsigned char* lds, int unit) {
    const int tid = threadIdx.x, lane = tid & 63, wid = tid >> 6, c = tid;
    const int b = unit >> 6, t0 = (unit & 63) * 32;
    LAS float* cl = (LAS float*)lds;
    const bf16_t* U = (const bf16_t*)(p.ws + WS_U);
    float w[31];
#pragma unroll
    for (int j = 0; j < 31; ++j) w[j] = p.w_dw[j * 512 + c];
    const float bias = p.b_dw[c];
    float z[62];
#pragma unroll
    for (int i = 0; i < 62; ++i) { const int t = t0 - 30 + i;
        if (t >= 0) { const bf16_t* ur = U + ((size_t)b * SEQ + t) * INP; const float a = bf2f(ur[416 + c]), g = bf2f(ur[928 + c]); z[i] = a * sigmoidf_(g); } else z[i] = 0.f; }
#pragma unroll
    for (int o = 0; o < 32; ++o) { float acc = bias;
#pragma unroll
        for (int j = 0; j < 31; ++j) acc += w[j] * z[o + j];
        cl[o * 512 + c] = acc; }
    __syncthreads();
#pragma unroll
    for (int oo = 0; oo < 4; ++oo) { const int o = wid * 4 + oo; const LAS float* r = cl + o * 512 + lane * 8;
        const f32x4 v0 = *(const LAS f32x4*)r, v1 = *(const LAS f32x4*)(r + 4);
        float s = (v0[0] + v0[1]) + (v0[2] + v0[3]) + (v1[0] + v1[1]) + (v1[2] + v1[3]); s = wave_sum(s); const float mu = s * (1.0f / 512.0f);
        const f32x4 d0 = v0 - mu, d1 = v1 - mu; float q = (d0[0] * d0[0] + d0[1] * d0[1]) + (d0[2] * d0[2] + d0[3] * d0[3]) + (d1[0] * d1[0] + d1[1] * d1[1]) + (d1[2] * d1[2] + d1[3] * d1[3]);
        q = wave_sum(q); const float rstd = 1.0f / sqrtf(q * (1.0f / 512.0f) + EPS);
        const f32x4 g0 = *(const f32x4*)(p.g_cln + lane * 8), g1 = *(const f32x4*)(p.g_cln + lane * 8 + 4), b0 = *(const f32x4*)(p.b_cln + lane * 8), b1 = *(const f32x4*)(p.b_cln + lane * 8 + 4);
        float y[8];
#pragma unroll
        for (int j = 0; j < 4; ++j) { const float a0 = d0[j] * rstd * g0[j] + b0[j], a1 = d1[j] * rstd * g1[j] + b1[j]; y[j] = a0 * sigmoidf_(a0); y[4 + j] = a1 * sigmoidf_(a1); }
        u32x4 wv; wv.x = pk2(y[0], y[1]); wv.y = pk2(y[2], y[3]); wv.z = pk2(y[4], y[5]); wv.w = pk2(y[6], y[7]);
        *(u32x4*)((bf16_t*)(p.ws + WS_YCAT) + ((size_t)b * SEQ + t0 + o) * 1024 + 512 + lane * 8) = wv; }
    __syncthreads();
}

__device__ __forceinline__ void router1_unit(const Params& p, LAS unsigned char* lds, int unit) {
    const int tid = threadIdx.x;
    LAS float* lg = (LAS float*)lds;
    LAS int* hist = (LAS int*)(lds + 2048);
    const float* WR = (const float*)(p.ws + WS_WR); const float* rs = (const float*)(p.ws + WS_RSTD_X2);
    if (tid < 32) hist[tid] = 0;
    __syncthreads();
    const int e = tid & 31, tl = tid >> 5;
    for (int it = 0; it < RT_TOK / 16; ++it) {
        const int tok = unit * RT_TOK + it * 16 + tl;
        const float* xr = p.out + (size_t)tok * 1024;
        float a0 = 0.f, a1 = 0.f, a2 = 0.f, a3 = 0.f;
#pragma unroll 4
        for (int k = 0; k < 1024; k += 4) { const f32x4 xv = *(const f32x4*)(xr + k);
            a0 += xv[0] * WR[(k + 0) * 32 + e]; a1 += xv[1] * WR[(k + 1) * 32 + e]; a2 += xv[2] * WR[(k + 2) * 32 + e]; a3 += xv[3] * WR[(k + 3) * 32 + e]; }
        lg[tl * 32 + e] = ((a0 + a1) + (a2 + a3)) * rs[tok] + p.b_router[e];
        __syncthreads();
        if (tid < 16) { const int tk = unit * RT_TOK + it * 16 + tid; unsigned used = 0u; float tv[4]; int ti[4];
#pragma unroll
            for (int k = 0; k < 4; ++k) { float best = -3.0e38f; int bi = 0;
                for (int j = 0; j < 32; ++j) { const float v = lg[tid * 32 + j]; if (!((used >> j) & 1u) && v > best) { best = v; bi = j; } }
                used |= 1u << bi; tv[k] = best; ti[k] = bi; }
            const float e1 = __expf(tv[1] - tv[0]), e2 = __expf(tv[2] - tv[0]), e3 = __expf(tv[3] - tv[0]); const float inv = 1.0f / (1.0f + e1 + e2 + e3);
            int* oi = (int*)(p.ws + WS_TOPI) + (size_t)tk * 4; float* og = (float*)(p.ws + WS_TOPG) + (size_t)tk * 4;
            oi[0] = ti[0]; oi[1] = ti[1]; oi[2] = ti[2]; oi[3] = ti[3]; og[0] = inv; og[1] = e1 * inv; og[2] = e2 * inv; og[3] = e3 * inv;
#pragma unroll
            for (int k = 0; k < 4; ++k) atomicAdd((int*)&hist[ti[k]], 1); }
        __syncthreads();
    }
    if (tid < 32) ((int*)(p.ws + WS_HIST))[unit * 32 + tid] = hist[tid];
}
__device__ __forceinline__ void router2_unit(const Params& p, LAS unsigned char* lds, int unit) {
    const int tid = threadIdx.x;
    LAS int* cnt = (LAS int*)lds;
    LAS int* base = cnt + 32;
    LAS int* pst = cnt + 64;
    LAS int* idx = cnt + 128;
    LAS int* dst = cnt + 128 + 512;
    const int* H = (const int*)(p.ws + WS_HIST);
    if (tid < 32) { int tot = 0, bs = 0; for (int b = 0; b < RT_UNITS; ++b) { const int v = H[b * 32 + tid]; tot += v; bs += (b < unit) ? v : 0; } cnt[tid] = tot; base[tid] = bs; }
    { idx[tid] = ((const int*)(p.ws + WS_TOPI))[(size_t)unit * RT_TOK * 4 + tid]; }
    __syncthreads();
    if (tid == 0) { int s = 0; for (int e = 0; e < 32; ++e) { pst[e] = s; s += (cnt[e] + 255) & ~255; } pst[32] = s; }
    __syncthreads();
    if (tid < 32) { int run = pst[tid] + base[tid]; for (int a = 0; a < 512; ++a) if (idx[a] == tid) { dst[a] = run; ++run; } }
    __syncthreads();
    { const int a = tid, d = dst[a]; const int tok = unit * RT_TOK + (a >> 2);
        ((int*)(p.ws + WS_SLOT_TOK))[d] = tok; ((float*)(p.ws + WS_SLOT_GATE))[d] = ((const float*)(p.ws + WS_TOPG))[(size_t)unit * RT_TOK * 4 + a];
        ((int*)(p.ws + WS_INV))[(size_t)unit * RT_TOK * 4 + a] = d; }
    if (unit < 32) { const int e = unit, s0 = pst[e] + cnt[e], s1 = pst[e + 1];
        for (int s = s0 + tid; s < s1; s += 512) { ((int*)(p.ws + WS_SLOT_TOK))[s] = 0; ((float*)(p.ws + WS_SLOT_GATE))[s] = 0.f; } }
    if (unit == 32) { int* te = (int*)(p.ws + WS_TILE_E); const int nt = pst[32] >> 8;
        for (int t = tid; t < NTILE_MAX; t += 512) { int e = 31; for (int k = 31; k >= 0; --k) if (t * 256 < pst[k + 1]) e = k; te[t] = e; }
        if (tid == 0) te[NTILE_MAX] = nt; }
    __syncthreads();
}

__device__ __forceinline__ void final_row(const Params& p, int tok, int lane) {
    float* xr = p.out + (size_t)tok * 1024; const int* inv = (const int*)(p.ws + WS_INV) + (size_t)tok * 4; const bf16_t* YB = (const bf16_t*)(p.ws + WS_YB);
    f32x4 v[4];
#pragma unroll
    for (int j = 0; j < 4; ++j) v[j] = ((const f32x4*)xr)[lane + 64 * j];
#pragma unroll
    for (int k = 0; k < 4; ++k) { const u32x2* yr = (const u32x2*)(YB + (size_t)inv[k] * 1024);
#pragma unroll
        for (int j = 0; j < 4; ++j) { const u32x2 w = yr[lane + 64 * j]; v[j][0] += __uint_as_float(w.x << 16); v[j][1] += __uint_as_float(w.x & 0xffff0000u); v[j][2] += __uint_as_float(w.y << 16); v[j][3] += __uint_as_float(w.y & 0xffff0000u); } }
    float s = 0.f;
#pragma unroll
    for (int j = 0; j < 4; ++j) s += (v[j][0] * v[j][0] + v[j][1] * v[j][1]) + (v[j][2] * v[j][2] + v[j][3] * v[j][3]);
    s = wave_sum(s); const float rstd = 1.0f / sqrtf(s * (1.0f / 1024.0f) + EPS);
#pragma unroll
    for (int j = 0; j < 4; ++j) { const f32x4 g = ((const f32x4*)p.g_final)[lane + 64 * j]; ((f32x4*)xr)[lane + 64 * j] = v[j] * rstd * g; }
}

constexpr int LDS_BYTES = 69632;
enum Stage { ST_PREP, ST_G_IN, ST_ROWSTATS, ST_G_Q, ST_G_KV, ST_CONV, ST_MLA, ST_G_OUT, ST_NORM1, ST_G_KVMEM, ST_G_XQ, ST_G_XS, ST_G_XPV, ST_G_XO, ST_NORM2, ST_R1, ST_R2, ST_G_UP, ST_G_DOWN, ST_FINAL };

template <int ST>
__global__ void __launch_bounds__(512) stage_kernel(Params p) {
    __shared__ __attribute__((aligned(16))) unsigned char lds_raw[LDS_BYTES];
    LAS unsigned char* lds = (LAS unsigned char*)lds_raw;
    unsigned char* ws = p.ws;
    const int bid = blockIdx.x, nb = gridDim.x, tid = threadIdx.x, lane = tid & 63, gw = bid * 8 + (tid >> 6), ngw = nb * 8;
    if constexpr (ST == ST_PREP) { prep_stage(p, lds, bid, nb); }
    else if constexpr (ST == ST_G_IN) { for (int i = bid; i < 128 * 6; i += nb) { Unit u{i / 6, i % 6, 0};
        ProvPlain P{(const bf16_t*)(ws + WS_XB), 1024, (const bf16_t*)(ws + WS_WT_IN), 1024, 1024}; EpiScaleBf16 E{(bf16_t*)(ws + WS_U), INP, (const float*)(ws + WS_RSTD_X), 1.0f};
        gemm_unit_naive<true>(P, E, u, lds); } }
    else if constexpr (ST == ST_ROWSTATS) { for (int r = gw; r < NTOK; r += ngw) rowstats_row(p, r, lane); }
    else if constexpr (ST == ST_G_Q) { for (int i = bid; i < 128 * 3; i += nb) { Unit u{i / 3, i % 3, 0};
        ProvPlain P{(const bf16_t*)(ws + WS_U), INP, (const bf16_t*)(ws + WS_WT_UQ), 256, 256}; EpiQ E{(bf16_t*)(ws + WS_Q), (const float*)(ws + WS_RSTD_Q), (const float*)(ws + WS_ROPE)};
        gemm_unit_naive<false>(P, E, u, lds); } }
    else if constexpr (ST == ST_G_KV) { for (int i = bid; i < 128 * 4; i += nb) { Unit u{i / 4, i % 4, 0};
        ProvPlain P{(const bf16_t*)(ws + WS_U) + 256, INP, (const bf16_t*)(ws + WS_WT_UKV), 128, 128}; EpiKV E{(bf16_t*)(ws + WS_KB), (bf16_t*)(ws + WS_VB), (const float*)(ws + WS_RSTD_KV)};
        gemm_unit_naive<true>(P, E, u, lds); } }
    else if constexpr (ST == ST_CONV) { for (int i = bid; i < BATCH * 64; i += nb) conv_unit(p, lds, i); }
    else if constexpr (ST == ST_MLA) { for (int i = bid; i < BATCH * HEADS * 8; i += nb) mla_unit(p, lds, i); }
    else if constexpr (ST == ST_G_OUT) { for (int i = bid; i < 128 * 4; i += nb) { Unit u{i / 4, i % 4, 0};
        ProvPlain P{(const bf16_t*)(ws + WS_YCAT), 1024, (const bf16_t*)(ws + WS_WT_OUT), 1024, 1024}; EpiResid E{p.x, p.out, (bf16_t*)(ws + WS_X1B)};
        gemm_unit_naive<false>(P, E, u, lds); } }
    else if constexpr (ST == ST_NORM1) { for (int r = gw; r < NTOK; r += ngw) row_bf16_rstd(p.out + (size_t)r * 1024, nullptr, (float*)(ws + WS_RSTD_X1) + r, lane); }
    else if constexpr (ST == ST_G_KVMEM) { for (int i = bid; i < 16 * 8; i += nb) { Unit u{i / 8, i % 8, 0};
        ProvPlain P{(const bf16_t*)(ws + WS_MEMB), 1024, (const bf16_t*)(ws + WS_WT_XKV), 1024, 1024}; EpiKVMem E{(bf16_t*)(ws + WS_KM), (bf16_t*)(ws + WS_VMT), (const float*)(ws + WS_RSTD_MEM)};
        gemm_unit_naive<false>(P, E, u, lds); } }
    else if constexpr (ST == ST_G_XQ) { for (int i = bid; i < 128 * 4; i += nb) { Unit u{i / 4, i % 4, 0};
        ProvPlain P{(const bf16_t*)(ws + WS_X1B), 1024, (const bf16_t*)(ws + WS_WT_XQ), 1024, 1024}; EpiScaleBf16 E{(bf16_t*)(ws + WS_XQ), 1024, (const float*)(ws + WS_RSTD_X1), C2_X};
        gemm_unit_naive<true>(P, E, u, lds); } }
    else if constexpr (ST == ST_G_XS) { for (int i = bid; i < 64 * 8; i += nb) { Unit u{i & 7, 0, i >> 3};
        ProvXS P{(const bf16_t*)(ws + WS_XQ), (const bf16_t*)(ws + WS_KM), 256}; EpiSoftmaxP E{(bf16_t*)(ws + WS_P)};
        gemm_unit_naive<true>(P, E, u, lds); } }
    else if constexpr (ST == ST_G_XPV) { for (int i = bid; i < 64 * 8; i += nb) { Unit u{i & 7, 0, i >> 3};
        ProvXPV P{(const bf16_t*)(ws + WS_P), (const bf16_t*)(ws + WS_VMT), 256}; EpiOX E{(bf16_t*)(ws + WS_OX)};
        gemm_unit_naive<true>(P, E, u, lds); } }
    else if constexpr (ST == ST_G_XO) { for (int i = bid; i < 128 * 4; i += nb) { Unit u{i / 4, i % 4, 0};
        ProvPlain P{(const bf16_t*)(ws + WS_OX), 1024, (const bf16_t*)(ws + WS_WT_XO), 1024, 1024}; EpiResid E{p.out, p.out, (bf16_t*)(ws + WS_X2B)};
        gemm_unit_naive<false>(P, E, u, lds); } }
    else if constexpr (ST == ST_NORM2) { for (int r = gw; r < NTOK; r += ngw) row_bf16_rstd(p.out + (size_t)r * 1024, nullptr, (float*)(ws + WS_RSTD_X2) + r, lane); }
    else if constexpr (ST == ST_R1) { for (int i = bid; i < RT_UNITS; i += nb) router1_unit(p, lds, i); }
    else if constexpr (ST == ST_R2) { for (int i = bid; i < RT_UNITS; i += nb) router2_unit(p, lds, i); }
    else if constexpr (ST == ST_G_UP) { const int* te = (const int*)(ws + WS_TILE_E); const int nt = te[NTILE_MAX];
        for (int i = bid; i < nt * 8; i += nb) { Unit u{i >> 3, i & 7, 0};
        ProvUp P{(const bf16_t*)(ws + WS_X2B), (const int*)(ws + WS_SLOT_TOK), te, (const bf16_t*)(ws + WS_WT_UP), 1024};
        EpiSwiglu E{(bf16_t*)(ws + WS_ACT), (const float*)(ws + WS_RSTD_X2), (const int*)(ws + WS_SLOT_TOK), te, p.b_up};
        gemm_unit_naive<true>(P, E, u, lds); } }
    else if constexpr (ST == ST_G_DOWN) { const int* te = (const int*)(ws + WS_TILE_E); const int nt = te[NTILE_MAX];
        for (int i = bid; i < nt * 4; i += nb) { Unit u{i >> 2, i & 3, 0};
        ProvDown P{(const bf16_t*)(ws + WS_ACT), te, (const bf16_t*)(ws + WS_WT_DOWN), 1024};
        EpiDown E{(bf16_t*)(ws + WS_YB), (const float*)(ws + WS_SLOT_GATE), te, p.b_down};
        gemm_unit_naive<true>(P, E, u, lds); } }
    else if constexpr (ST == ST_FINAL) { for (int r = gw; r < NTOK; r += ngw) final_row(p, r, lane); }
}

extern "C" void kernel_launch(void* const* d_in, const int* in_sizes, int n_in, void* d_out, int out_size, void* d_ws, size_t ws_size, hipStream_t stream) {
    if (n_in != 27 || ws_size < WS_END) { fprintf(stderr, "kernel_launch: unexpected inputs (n_in %d, ws %zu)\n", n_in, ws_size); return; }
    Params p{};
    p.x = (const float*)d_in[0]; p.mem = (const float*)d_in[1]; p.pos = (const int*)d_in[2];
    p.g_mix = (const float*)d_in[3]; p.w_in = (const float*)d_in[4]; p.g_q = (const float*)d_in[5]; p.w_uq = (const float*)d_in[6]; p.g_kv = (const float*)d_in[7]; p.w_ukv = (const float*)d_in[8];
    p.w_dw = (const float*)d_in[9]; p.b_dw = (const float*)d_in[10]; p.g_cln = (const float*)d_in[11]; p.b_cln = (const float*)d_in[12]; p.w_out = (const float*)d_in[13];
    p.g_xattn = (const float*)d_in[14]; p.g_mem = (const float*)d_in[15]; p.w_xq = (const float*)d_in[16]; p.w_xkv = (const float*)d_in[17]; p.w_xo = (const float*)d_in[18];
    p.g_ffn = (const float*)d_in[19]; p.w_router = (const float*)d_in[20]; p.b_router = (const float*)d_in[21]; p.w_up = (const float*)d_in[22]; p.b_up = (const float*)d_in[23];
    p.w_down = (const float*)d_in[24]; p.b_down = (const float*)d_in[25]; p.g_final = (const float*)d_in[26];
    p.out = (float*)d_out; p.ws = (unsigned char*)d_ws;
#define LAUNCH(ST, G) hipLaunchKernelGGL((stage_kernel<ST>), dim3(G), dim3(512), 0, stream, p)
    LAUNCH(ST_PREP, 1024);
    LAUNCH(ST_G_IN, 768);
    LAUNCH(ST_ROWSTATS, 1024);
    LAUNCH(ST_G_Q, 384);
    LAUNCH(ST_G_KV, 512);
    LAUNCH(ST_CONV, 1024);
    LAUNCH(ST_MLA, 1024);
    LAUNCH(ST_G_OUT, 512);
    LAUNCH(ST_NORM1, 1024);
    LAUNCH(ST_G_KVMEM, 128);
    LAUNCH(ST_G_XQ, 512);
    LAUNCH(ST_G_XS, 512);
    LAUNCH(ST_G_XPV, 512);
    LAUNCH(ST_G_XO, 512);
    LAUNCH(ST_NORM2, 1024);
    LAUNCH(ST_R1, RT_UNITS);
    LAUNCH(ST_R2, RT_UNITS);
    LAUNCH(ST_G_UP, NTILE_MAX * 8);
    LAUNCH(ST_G_DOWN, NTILE_MAX * 4);
    LAUNCH(ST_FINAL, 1024);
}
```

```cpp
#include <hip/hip_runtime.h>
#include <stdint.h>
#include <stdio.h>
#include <hip/hip_cooperative_groups.h>
namespace cg = cooperative_groups;

#define LAS __attribute__((address_space(3)))
typedef unsigned short bf16_t;
typedef short bf16x8 __attribute__((ext_vector_type(8)));
typedef short s16x4 __attribute__((ext_vector_type(4)));
typedef float f32x2 __attribute__((ext_vector_type(2)));
typedef float f32x4 __attribute__((ext_vector_type(4)));
typedef float f32x16 __attribute__((ext_vector_type(16)));
typedef unsigned u32x2 __attribute__((ext_vector_type(2)));
typedef unsigned u32x4 __attribute__((ext_vector_type(4)));

constexpr int BATCH = 16, SEQ = 2048, NTOK = BATCH * SEQ, DM = 1024;
constexpr int INC = 1440, INP = 1536;
constexpr int HEADS = 8, QKD = 96, VD = 64;
constexpr int CCH = 512, CW = 31;
constexpr int MEML = 256, NMEM = BATCH * MEML;
constexpr int XH = 4, XD = 256;
constexpr int NE = 32, TOPK = 4;
constexpr int NSLOT = NTOK * TOPK + NE * 256;
constexpr int NTILE_MAX = NSLOT / 256;
constexpr float EPS = 1e-5f;
constexpr float C2_MLA = 0.14724444602590306f;
constexpr float C2_X = 0.09016844005556021f;
constexpr int RT_TOK = 128, RT_UNITS = NTOK / RT_TOK;

constexpr size_t MiB = 1u << 20;
constexpr size_t WS_CTL = 0;
constexpr size_t WS_RSTD_X = 1 * MiB;
constexpr size_t WS_RSTD_Q = WS_RSTD_X + 128 * 1024;
constexpr size_t WS_RSTD_KV = WS_RSTD_Q + 128 * 1024;
constexpr size_t WS_RSTD_X1 = WS_RSTD_KV + 128 * 1024;
constexpr size_t WS_RSTD_X2 = WS_RSTD_X1 + 128 * 1024;
constexpr size_t WS_RSTD_MEM = WS_RSTD_X2 + 128 * 1024;
constexpr size_t WS_ROPE = 2 * MiB;
constexpr size_t WS_TOPI = 6 * MiB;
constexpr size_t WS_TOPG = WS_TOPI + 512 * 1024;
constexpr size_t WS_INV = WS_TOPG + 512 * 1024;
constexpr size_t WS_SLOT_TOK = WS_INV + 512 * 1024;
constexpr size_t WS_SLOT_GATE = WS_SLOT_TOK + 1 * MiB;
constexpr size_t WS_HIST = WS_SLOT_GATE + 1 * MiB;
constexpr size_t WS_TILE_E = WS_HIST + 64 * 1024;
constexpr size_t WS_SSQ_Q = 10 * MiB;
constexpr size_t WS_SSQ_KV = 10 * MiB + 512 * 1024;
constexpr size_t WS_SSQ_X1 = 11 * MiB;
constexpr size_t WS_SSQ_X2 = 13 * MiB;
constexpr size_t WS_WR = 15 * MiB;
constexpr size_t WS_WT_IN = 16 * MiB;
constexpr size_t WS_WT_UQ = 19 * MiB;
constexpr size_t WS_WT_UKV = WS_WT_UQ + 512 * 1024;
constexpr size_t WS_WT_OUT = 20 * MiB;
constexpr size_t WS_WT_XQ = 22 * MiB;
constexpr size_t WS_WT_XKV = 24 * MiB;
constexpr size_t WS_WT_XO = 28 * MiB;
constexpr size_t WS_WT_UP = 32 * MiB;
constexpr size_t WS_WT_DOWN = 160 * MiB;
constexpr size_t WS_X2B = 224 * MiB;
constexpr size_t WS_XB = WS_X2B;
constexpr size_t WS_ACT = 288 * MiB;
constexpr size_t WS_U = 288 * MiB;
constexpr size_t WS_Q = 384 * MiB;
constexpr size_t WS_KB = 432 * MiB;
constexpr size_t WS_VB = 480 * MiB;
constexpr size_t WS_YCAT = 512 * MiB;
constexpr size_t WS_YB = 560 * MiB;
constexpr size_t WS_X1B = 576 * MiB;
constexpr size_t WS_XQ = 640 * MiB;
constexpr size_t WS_P = 704 * MiB;
constexpr size_t WS_OX = 768 * MiB;
constexpr size_t WS_MEMB = 832 * MiB;
constexpr size_t WS_KM = 840 * MiB;
constexpr size_t WS_VMT = 848 * MiB;
constexpr size_t WS_END = 856 * MiB;

struct Params {
    const float* x; const float* mem; const int* pos;
    const float *g_mix, *w_in, *g_q, *w_uq, *g_kv, *w_ukv, *w_dw, *b_dw, *g_cln, *b_cln, *w_out, *g_xattn, *g_mem, *w_xq, *w_xkv, *w_xo, *g_ffn, *w_router, *b_router, *w_up, *b_up, *w_down, *b_down, *g_final;
    float* out; unsigned char* ws;
};

__device__ __forceinline__ float bf2f(bf16_t b) { return __uint_as_float((unsigned)b << 16); }
__device__ __forceinline__ unsigned f2bf(float f) { unsigned u = __float_as_uint(f); return (u + 0x7fffu + ((u >> 16) & 1u)) >> 16; }
__device__ __forceinline__ unsigned pk2(float lo, float hi) { return f2bf(lo) | (f2bf(hi) << 16); }
__device__ __forceinline__ float wave_sum(float v) {
#pragma unroll
    for (int o = 1; o < 64; o <<= 1) v += __shfl_xor(v, o);
    return v;
}
__device__ __forceinline__ int perm32(int rho) { const int n = rho >> 4, i = rho & 15; return 8 * (i >> 2) + 4 * n + (i & 3); }
__device__ __forceinline__ float fast_exp2(float x) { return __builtin_amdgcn_exp2f(x); }
__device__ __forceinline__ float sigmoidf_(float x) { return 1.0f / (1.0f + __expf(-x)); }

template <int MODE>
__device__ __forceinline__ void tr_item(const float* W, int N, int K, const float* g, bf16_t* WT, LAS float* scr, int item, int lane) {
    const int nblk = N / 32, kb = item / nblk, nb = item % nblk, k0 = 64 * kb, n0 = 32 * nb;
#pragma unroll 8
    for (int i = 0; i < 32; ++i) { const int kk = 2 * i + (lane >> 5); const float gv = g ? g[k0 + kk] : 1.0f;
        scr[kk * 33 + (lane & 31)] = W[(size_t)(k0 + kk) * N + n0 + (lane & 31)] * gv; }
    asm volatile("s_waitcnt lgkmcnt(0)" ::: "memory");
    const int c = lane & 7;
#pragma unroll
    for (int j = 0; j < 4; ++j) { const int n = (lane >> 3) + 8 * j; const LAS float* s = scr + (8 * c) * 33 + n;
        u32x4 o; o.x = pk2(s[0 * 33], s[1 * 33]); o.y = pk2(s[2 * 33], s[3 * 33]); o.z = pk2(s[4 * 33], s[5 * 33]); o.w = pk2(s[6 * 33], s[7 * 33]);
        const int nn = n0 + n; const int row = (MODE == 1) ? ((((nn & 1023) >> 7) << 8) + ((nn >> 10) << 7) + (nn & 127)) : nn;
        *(u32x4*)(WT + (size_t)row * K + k0 + 8 * c) = o; }
    asm volatile("s_waitcnt lgkmcnt(0)" ::: "memory");
}
__device__ __forceinline__ void row_bf16_rstd(const float* xrow, bf16_t* orow, float* rstd_out, int lane) {
    f32x4 v[4]; float s = 0.f;
#pragma unroll
    for (int j = 0; j < 4; ++j) { v[j] = ((const f32x4*)xrow)[lane + 64 * j]; s += (v[j].x * v[j].x + v[j].y * v[j].y) + (v[j].z * v[j].z + v[j].w * v[j].w); }
    s = wave_sum(s);
    if (lane == 0) *rstd_out = 1.0f / sqrtf(s * (1.0f / 1024.0f) + EPS);
    if (orow) {
#pragma unroll
        for (int j = 0; j < 4; ++j) { u32x2 w; w.x = pk2(v[j].x, v[j].y); w.y = pk2(v[j].z, v[j].w); ((u32x2*)orow)[lane + 64 * j] = w; }
    }
}
__device__ __forceinline__ void sincos_acc(double a, float& s, float& c) {
    const double TWO_PI = 6.283185307179586476925;
    const double n = rint(a * (1.0 / TWO_PI)); const double r = a - n * TWO_PI;
    const double h = 0.5 * r, h2 = h * h;
    const double sh = h * (1.0 + h2 * (-1.0 / 6.0 + h2 * (1.0 / 120.0 + h2 * (-1.0 / 5040.0 + h2 * (1.0 / 362880.0 + h2 * (-1.0 / 39916800.0 + h2 * (1.0 / 6227020800.0 + h2 * (-1.0 / 1307674368000.0 + h2 * (1.0 / 355687428096000.0)))))))));
    const double ch = 1.0 + h2 * (-0.5 + h2 * (1.0 / 24.0 + h2 * (-1.0 / 720.0 + h2 * (1.0 / 40320.0 + h2 * (-1.0 / 3628800.0 + h2 * (1.0 / 479001600.0 + h2 * (-1.0 / 87178291200.0 + h2 * (1.0 / 20922789888000.0 + h2 * (-1.0 / 6402373705728000.0)))))))));
    s = (float)(2.0 * sh * ch); c = (float)(ch * ch - sh * sh);
}
__device__ __forceinline__ double rope_inv(int i) {
    const double t[16] = {1.0, 0.5623413251903491, 0.31622776601683794, 0.1778279410038923, 0.1, 0.05623413251903491, 0.03162277660168379, 0.01778279410038923,
                          0.01, 0.005623413251903491, 0.0031622776601683794, 0.0017782794100389228, 0.001, 0.0005623413251903491, 0.00031622776601683794, 0.00017782794100389227};
    double r = t[0];
#pragma unroll
    for (int k = 1; k < 16; ++k) r = (i == k) ? t[k] : r;
    return r;
}

__device__ __forceinline__ void prep_stage(const Params& p, LAS unsigned char* lds, int vblk, int nblk, int tid) {
    const int lane = tid & 63, wid = tid >> 6;
    const int gw = vblk * 8 + wid, ngw = nblk * 8;
    LAS float* scr = (LAS float*)(lds + wid * 8448);
    unsigned char* ws = p.ws;
    constexpr int I_IN = 16 * 45, I_UQ = 4 * 24, I_UKV = 2 * 32, I_SQ = 16 * 32, I_XKV = 16 * 64, I_UP1 = 16 * 64, I_DN1 = 16 * 32;
    constexpr int NITEMS = I_IN + I_UQ + I_UKV + 3 * I_SQ + I_XKV + NE * I_UP1 + NE * I_DN1;
    for (int it = gw; it < NITEMS; it += ngw) {
        int r = it;
        if (r < I_IN) { tr_item<0>(p.w_in, INC, 1024, p.g_mix, (bf16_t*)(ws + WS_WT_IN), scr, r, lane); continue; } r -= I_IN;
        if (r < I_UQ) { tr_item<0>(p.w_uq, 768, 256, p.g_q, (bf16_t*)(ws + WS_WT_UQ), scr, r, lane); continue; } r -= I_UQ;
        if (r < I_UKV) { tr_item<0>(p.w_ukv, 1024, 128, p.g_kv, (bf16_t*)(ws + WS_WT_UKV), scr, r, lane); continue; } r -= I_UKV;
        if (r < I_SQ) { tr_item<0>(p.w_out, 1024, 1024, nullptr, (bf16_t*)(ws + WS_WT_OUT), scr, r, lane); continue; } r -= I_SQ;
        if (r < I_SQ) { tr_item<0>(p.w_xq, 1024, 1024, p.g_xattn, (bf16_t*)(ws + WS_WT_XQ), scr, r, lane); continue; } r -= I_SQ;
        if (r < I_SQ) { tr_item<0>(p.w_xo, 1024, 1024, nullptr, (bf16_t*)(ws + WS_WT_XO), scr, r, lane); continue; } r -= I_SQ;
        if (r < I_XKV) { tr_item<0>(p.w_xkv, 2048, 1024, p.g_mem, (bf16_t*)(ws + WS_WT_XKV), scr, r, lane); continue; } r -= I_XKV;
        if (r < NE * I_UP1) { const int e = r / I_UP1; tr_item<1>(p.w_up + (size_t)e * 1024 * 2048, 2048, 1024, p.g_ffn, (bf16_t*)(ws + WS_WT_UP) + (size_t)e * 2048 * 1024, scr, r % I_UP1, lane); continue; } r -= NE * I_UP1;
        { const int e = r / I_DN1; tr_item<0>(p.w_down + (size_t)e * 1024 * 1024, 1024, 1024, nullptr, (bf16_t*)(ws + WS_WT_DOWN) + (size_t)e * 1024 * 1024, scr, r % I_DN1, lane); }
    }
    for (int m = gw; m < NTOK; m += ngw) row_bf16_rstd(p.x + (size_t)m * 1024, (bf16_t*)(ws + WS_XB) + (size_t)m * 1024, (float*)(ws + WS_RSTD_X) + m, lane);
    for (int m = gw; m < NMEM; m += ngw) row_bf16_rstd(p.mem + (size_t)m * 1024, (bf16_t*)(ws + WS_MEMB) + (size_t)m * 1024, (float*)(ws + WS_RSTD_MEM) + m, lane);
    const int gt = vblk * 512 + tid, ngt = nblk * 512;
    for (int i = gt; i < NTOK * 16; i += ngt) { const int row = i >> 4, f = i & 15; float s, c; sincos_acc((double)p.pos[row] * rope_inv(f), s, c);
        float* rt = (float*)(ws + WS_ROPE) + (size_t)row * 32; rt[f] = c; rt[16 + f] = s; }
    for (int i = gt; i < 1024 * 32; i += ngt) ((float*)(ws + WS_WR))[i] = p.g_ffn[i >> 5] * p.w_router[i];
    for (int i = gt; i < (INP - INC) * 1024 / 8; i += ngt) ((u32x4*)((bf16_t*)(ws + WS_WT_IN) + (size_t)INC * 1024))[i] = (u32x4){0u, 0u, 0u, 0u};
}

struct Unit { int pm, pn, z; };
typedef f32x4 Acc[2][2][4][2];

template <bool PERM, class Prov, class Epi>
__device__ __forceinline__ void gemm_unit_naive(const Prov& P, const Epi& E, const Unit& u, LAS unsigned char* lds, int tid) {
    const int wid = tid >> 6, lane = tid & 63, wr = wid >> 2, wc = wid & 3, fr = lane & 15, fq = lane >> 4;
    const bf16_t* ap[2][4]; const bf16_t* bp[2][2];
#pragma unroll
    for (int ai = 0; ai < 2; ++ai)
#pragma unroll
        for (int m = 0; m < 4; ++m) ap[ai][m] = P.a_row(u, 128 * ai + 64 * wr + 16 * m + fr) + 8 * fq;
#pragma unroll
    for (int bj = 0; bj < 2; ++bj)
#pragma unroll
        for (int n = 0; n < 2; ++n) { const int rho = 16 * n + fr; bp[bj][n] = P.b_row(u, 128 * bj + 32 * wc + (PERM ? perm32(rho) : rho)) + 8 * fq; }
    Acc acc;
#pragma unroll
    for (int a = 0; a < 2; ++a)
#pragma unroll
        for (int b = 0; b < 2; ++b)
#pragma unroll
            for (int m = 0; m < 4; ++m)
#pragma unroll
                for (int n = 0; n < 2; ++n) acc[a][b][m][n] = (f32x4){0.f, 0.f, 0.f, 0.f};
    const int K = P.K;
#pragma unroll 1
    for (int k0 = 0; k0 < K; k0 += 32) {
        bf16x8 a[2][4], b[2][2];
#pragma unroll
        for (int ai = 0; ai < 2; ++ai)
#pragma unroll
            for (int m = 0; m < 4; ++m) a[ai][m] = *(const bf16x8*)(ap[ai][m] + k0);
#pragma unroll
        for (int bj = 0; bj < 2; ++bj)
#pragma unroll
            for (int n = 0; n < 2; ++n) b[bj][n] = *(const bf16x8*)(bp[bj][n] + k0);
#pragma unroll
        for (int ai = 0; ai < 2; ++ai)
#pragma unroll
            for (int bj = 0; bj < 2; ++bj)
#pragma unroll
                for (int m = 0; m < 4; ++m)
#pragma unroll
                    for (int n = 0; n < 2; ++n) acc[ai][bj][m][n] = __builtin_amdgcn_mfma_f32_16x16x32_bf16(b[bj][n], a[ai][m], acc[ai][bj][m][n], 0, 0, 0);
    }
    E(acc, u, wr, wc, fr, fq, lds);
}

struct ProvPlain { const bf16_t* A; int lda; const bf16_t* Bt; int ldb; int K;
    __device__ __forceinline__ const bf16_t* a_row(const Unit& u, int r) const { return A + (size_t)(u.pm * 256 + r) * lda; }
    __device__ __forceinline__ const bf16_t* b_row(const Unit& u, int r) const { return Bt + (size_t)(u.pn * 256 + r) * ldb; } };
struct ProvXS { const bf16_t* XQ; const bf16_t* KM; int K;
    __device__ __forceinline__ const bf16_t* a_row(const Unit& u, int r) const { return XQ + (size_t)((u.z >> 2) * 2048 + u.pm * 256 + r) * 1024 + (u.z & 3) * 256; }
    __device__ __forceinline__ const bf16_t* b_row(const Unit& u, int r) const { return KM + (size_t)((u.z >> 2) * 256 + r) * 1024 + (u.z & 3) * 256; } };
struct ProvXPV { const bf16_t* Pm; const bf16_t* VMT; int K;
    __device__ __forceinline__ const bf16_t* a_row(const Unit& u, int r) const { return Pm + ((size_t)u.z * 2048 + u.pm * 256 + r) * 256; }
    __device__ __forceinline__ const bf16_t* b_row(const Unit& u, int r) const { return VMT + ((size_t)u.z * 256 + r) * 256; } };
struct ProvUp { const bf16_t* X2B; const int* slot_tok; const int* tile_e; const bf16_t* WT; int K;
    __device__ __forceinline__ const bf16_t* a_row(const Unit& u, int r) const { return X2B + (size_t)slot_tok[u.pm * 256 + r] * 1024; }
    __device__ __forceinline__ const bf16_t* b_row(const Unit& u, int r) const { return WT + ((size_t)tile_e[u.pm] * 2048 + u.pn * 256 + r) * 1024; } };
struct ProvDown { const bf16_t* ACT; const int* tile_e; const bf16_t* WT; int K;
    __device__ __forceinline__ const bf16_t* a_row(const Unit& u, int r) const { return ACT + (size_t)(u.pm * 256 + r) * 1024; }
    __device__ __forceinline__ const bf16_t* b_row(const Unit& u, int r) const { return WT + ((size_t)tile_e[u.pm] * 1024 + u.pn * 256 + r) * 1024; } };

#define EPI_ARGS Acc& acc, const Unit& u, int wr, int wc, int fr, int fq, LAS unsigned char* lds
#define FOR_AI_M _Pragma("unroll") for (int ai = 0; ai < 2; ++ai) _Pragma("unroll") for (int m = 0; m < 4; ++m)
#define FOR_BJ _Pragma("unroll") for (int bj = 0; bj < 2; ++bj)
struct EpiIn { bf16_t* O; const float* rs; float* ssq_q; float* ssq_kv; const float* rope; bf16_t* KB;
    __device__ __forceinline__ void operator()(EPI_ARGS) const {
        FOR_AI_M { const int row = u.pm * 256 + 128 * ai + 64 * wr + 16 * m + fr; const float s = rs[row]; bf16_t* rowp = O + (size_t)row * INP + u.pn * 256 + 32 * wc + 8 * fq;
            float q0 = 0.f, q1 = 0.f;
            FOR_BJ { const f32x4 v0 = acc[ai][bj][m][0] * s, v1 = acc[ai][bj][m][1] * s; u32x4 w; w.x = pk2(v0[0], v0[1]); w.y = pk2(v0[2], v0[3]); w.z = pk2(v1[0], v1[1]); w.w = pk2(v1[2], v1[3]);
                *(u32x4*)(rowp + 128 * bj) = w;
                const float qq = (v0[0] * v0[0] + v0[1] * v0[1]) + (v0[2] * v0[2] + v0[3] * v0[3]) + (v1[0] * v1[0] + v1[1] * v1[1]) + (v1[2] * v1[2] + v1[3] * v1[3]);
                if (bj == 0) q0 = qq; else q1 = qq; }
            if (u.pn == 0) { float q = q0 + q1; q += __shfl_xor(q, 16); q += __shfl_xor(q, 32); if (fq == 0) ssq_q[(size_t)row * 4 + wc] = q; }
            if (u.pn == 1) { float q = q0; q += __shfl_xor(q, 16); q += __shfl_xor(q, 32); if (fq == 0) ssq_kv[(size_t)row * 4 + wc] = q;
                if (wc == 0) {
                    const int i0 = 8 * (fq & 1); const f32x4 c0 = *(const f32x4*)(rope + (size_t)row * 32 + i0), c1 = *(const f32x4*)(rope + (size_t)row * 32 + i0 + 4);
                    const f32x4 s0 = *(const f32x4*)(rope + (size_t)row * 32 + 16 + i0), s1 = *(const f32x4*)(rope + (size_t)row * 32 + 16 + i0 + 4);
                    const f32x4 v0 = acc[ai][1][m][0] * s, v1 = acc[ai][1][m][1] * s; f32x4 p0, p1;
#pragma unroll
                    for (int j = 0; j < 4; ++j) { p0[j] = __shfl_xor(v0[j], 32); p1[j] = __shfl_xor(v1[j], 32); }
                    f32x4 o0, o1;
                    if (fq < 2) { o0 = v0 * c0 - p0 * s0; o1 = v1 * c1 - p1 * s1; } else { o0 = p0 * s0 + v0 * c0; o1 = p1 * s1 + v1 * c1; }
                    u32x4 w; w.x = pk2(o0[0], o0[1]); w.y = pk2(o0[2], o0[3]); w.z = pk2(o1[0], o1[1]); w.w = pk2(o1[2], o1[3]);
                    bf16_t* kb = KB + (size_t)row * 768 + 64 + 8 * fq;
#pragma unroll
                    for (int h = 0; h < 8; ++h) *(u32x4*)(kb + h * 96) = w; } } } } };
struct EpiScale16 { bf16_t* O; int ldc; const float* ssq; float mul;
    __device__ __forceinline__ void operator()(EPI_ARGS) const {
        FOR_AI_M { const int row = u.pm * 256 + 128 * ai + 64 * wr + 16 * m + fr; const f32x4* sp = (const f32x4*)(ssq + (size_t)row * 16); const f32x4 t = (sp[0] + sp[1]) + (sp[2] + sp[3]);
            const float s = mul / sqrtf(((t[0] + t[1]) + (t[2] + t[3])) * (1.0f / 1024.0f) + EPS); bf16_t* rowp = O + (size_t)row * ldc + u.pn * 256 + 32 * wc + 8 * fq;
            FOR_BJ { const f32x4 v0 = acc[ai][bj][m][0] * s, v1 = acc[ai][bj][m][1] * s; u32x4 w; w.x = pk2(v0[0], v0[1]); w.y = pk2(v0[2], v0[3]); w.z = pk2(v1[0], v1[1]); w.w = pk2(v1[2], v1[3]);
                *(u32x4*)(rowp + 128 * bj) = w; } } } };
struct EpiQ { bf16_t* Q; const float* ssq; const float* rope;
    __device__ __forceinline__ void operator()(EPI_ARGS) const {
        FOR_AI_M { const int row = u.pm * 256 + 128 * ai + 64 * wr + 16 * m + fr; const f32x4 t = *(const f32x4*)(ssq + (size_t)row * 4); const float s = C2_MLA / sqrtf(((t[0] + t[1]) + (t[2] + t[3])) * (1.0f / 256.0f) + EPS);
            const f32x4 cs = *(const f32x4*)(rope + (size_t)row * 32 + 4 * fq), sn = *(const f32x4*)(rope + (size_t)row * 32 + 16 + 4 * fq);
            FOR_BJ { const int colg = u.pn * 256 + 128 * bj + 32 * wc; f32x4 v0 = acc[ai][bj][m][0] * s, v1 = acc[ai][bj][m][1] * s;
                if (((colg >> 5) % 3) == 2) { const f32x4 r0 = v0 * cs - v1 * sn, r1 = v0 * sn + v1 * cs; v0 = r0; v1 = r1; }
                bf16_t* rowp = Q + (size_t)row * 768 + colg + 4 * fq; u32x2 w0, w1; w0.x = pk2(v0[0], v0[1]); w0.y = pk2(v0[2], v0[3]); w1.x = pk2(v1[0], v1[1]); w1.y = pk2(v1[2], v1[3]);
                *(u32x2*)(rowp) = w0; *(u32x2*)(rowp + 16) = w1; } } } };
struct EpiKV { bf16_t* KB; bf16_t* VB; const float* ssq;
    __device__ __forceinline__ void operator()(EPI_ARGS) const {
        FOR_AI_M { const int row = u.pm * 256 + 128 * ai + 64 * wr + 16 * m + fr; const f32x4 t = *(const f32x4*)(ssq + (size_t)row * 4); const float s = 1.0f / sqrtf(((t[0] + t[1]) + (t[2] + t[3])) * (1.0f / 128.0f) + EPS);
            FOR_BJ { const int h = 2 * u.pn + bj, cl = 32 * wc + 8 * fq; const f32x4 v0 = acc[ai][bj][m][0] * s, v1 = acc[ai][bj][m][1] * s;
                u32x4 w; w.x = pk2(v0[0], v0[1]); w.y = pk2(v0[2], v0[3]); w.z = pk2(v1[0], v1[1]); w.w = pk2(v1[2], v1[3]);
                if (wc < 2) *(u32x4*)(KB + (size_t)row * 768 + h * 96 + cl) = w; else *(u32x4*)(VB + (size_t)row * 512 + h * 64 + cl - 64) = w; } } } };
struct EpiResid { const float* base; float* out; bf16_t* ob; float* ssq;
    __device__ __forceinline__ void operator()(EPI_ARGS) const {
        FOR_AI_M { const int row = u.pm * 256 + 128 * ai + 64 * wr + 16 * m + fr; float q = 0.f;
            FOR_BJ {
#pragma unroll
                for (int n = 0; n < 2; ++n) { const size_t off = (size_t)row * 1024 + u.pn * 256 + 128 * bj + 32 * wc + 16 * n + 4 * fq;
                    const f32x4 v = *(const f32x4*)(base + off) + acc[ai][bj][m][n]; *(f32x4*)(out + off) = v; u32x2 w; w.x = pk2(v[0], v[1]); w.y = pk2(v[2], v[3]); *(u32x2*)(ob + off) = w;
                    q += (v[0] * v[0] + v[1] * v[1]) + (v[2] * v[2] + v[3] * v[3]); } }
            q += __shfl_xor(q, 16); q += __shfl_xor(q, 32); if (fq == 0) ssq[(size_t)row * 16 + u.pn * 4 + wc] = q; } } };
struct EpiKVMem { bf16_t* KM; bf16_t* VMT; const float* rs;
    __device__ __forceinline__ void operator()(EPI_ARGS) const {
        FOR_AI_M { const int row = u.pm * 256 + 128 * ai + 64 * wr + 16 * m + fr; const float s = rs[row];
            FOR_BJ {
#pragma unroll
                for (int n = 0; n < 2; ++n) { const int col = u.pn * 256 + 128 * bj + 32 * wc + 16 * n + 4 * fq; const f32x4 v = acc[ai][bj][m][n] * s;
                    if (u.pn < 4) { u32x2 w; w.x = pk2(v[0], v[1]); w.y = pk2(v[2], v[3]); *(u32x2*)(KM + (size_t)row * 1024 + col) = w; }
                    else { const int c2 = col - 1024, h = c2 >> 8, d = c2 & 255, b = row >> 8, mm = row & 255; bf16_t* dst = VMT + ((size_t)(b * 4 + h) * 256 + d) * 256 + mm;
#pragma unroll
                        for (int j = 0; j < 4; ++j) dst[(size_t)j * 256] = (bf16_t)f2bf(v[j]); } } } } } };
struct EpiSoftmaxP { bf16_t* Pm;
    __device__ __forceinline__ void operator()(EPI_ARGS) const {
        LAS float* red = (LAS float*)lds; float rmax[2][4];
        FOR_AI_M { float mx = -3.0e38f;
            FOR_BJ {
#pragma unroll
                for (int n = 0; n < 2; ++n)
#pragma unroll
                    for (int j = 0; j < 4; ++j) mx = fmaxf(mx, acc[ai][bj][m][n][j]); }
            mx = fmaxf(mx, __shfl_xor(mx, 16)); mx = fmaxf(mx, __shfl_xor(mx, 32));
            if (fq == 0) red[(128 * ai + 64 * wr + 16 * m + fr) * 4 + wc] = mx; }
        __syncthreads();
        FOR_AI_M { const f32x4 t = *(const LAS f32x4*)(red + (128 * ai + 64 * wr + 16 * m + fr) * 4); rmax[ai][m] = fmaxf(fmaxf(t[0], t[1]), fmaxf(t[2], t[3])); }
        __syncthreads();
        FOR_AI_M { float s = 0.f;
            FOR_BJ {
#pragma unroll
                for (int n = 0; n < 2; ++n)
#pragma unroll
                    for (int j = 0; j < 4; ++j) { const float e = fast_exp2(acc[ai][bj][m][n][j] - rmax[ai][m]); acc[ai][bj][m][n][j] = e; s += e; } }
            s += __shfl_xor(s, 16); s += __shfl_xor(s, 32);
            if (fq == 0) red[(128 * ai + 64 * wr + 16 * m + fr) * 4 + wc] = s; }
        __syncthreads();
        FOR_AI_M { const int r = 128 * ai + 64 * wr + 16 * m + fr; const f32x4 t = *(const LAS f32x4*)(red + r * 4); const float inv = 1.0f / ((t[0] + t[1]) + (t[2] + t[3]));
            bf16_t* rowp = Pm + ((size_t)u.z * 2048 + u.pm * 256 + r) * 256 + 32 * wc + 8 * fq;
            FOR_BJ { const f32x4 v0 = acc[ai][bj][m][0] * inv, v1 = acc[ai][bj][m][1] * inv; u32x4 w; w.x = pk2(v0[0], v0[1]); w.y = pk2(v0[2], v0[3]); w.z = pk2(v1[0], v1[1]); w.w = pk2(v1[2], v1[3]);
                *(u32x4*)(rowp + 128 * bj) = w; } }
        __syncthreads();
    } };
struct EpiOX { bf16_t* OX;
    __device__ __forceinline__ void operator()(EPI_ARGS) const {
        FOR_AI_M { const int r = 128 * ai + 64 * wr + 16 * m + fr; bf16_t* rowp = OX + (size_t)((u.z >> 2) * 2048 + u.pm * 256 + r) * 1024 + (u.z & 3) * 256 + 32 * wc + 8 * fq;
            FOR_BJ { const f32x4 v0 = acc[ai][bj][m][0], v1 = acc[ai][bj][m][1]; u32x4 w; w.x = pk2(v0[0], v0[1]); w.y = pk2(v0[2], v0[3]); w.z = pk2(v1[0], v1[1]); w.w = pk2(v1[2], v1[3]);
                *(u32x4*)(rowp + 128 * bj) = w; } } } };
struct EpiSwiglu { bf16_t* ACT; const float* rs; const int* slot_tok; const int* tile_e; const float* b_up;
    __device__ __forceinline__ void operator()(EPI_ARGS) const {
        const int e = tile_e[u.pm]; const int cl = 32 * wc + 8 * fq; const float* bg = b_up + (size_t)e * 2048 + u.pn * 128 + cl; const float* bl = bg + 1024;
        const f32x4 bg0 = *(const f32x4*)bg, bg1 = *(const f32x4*)(bg + 4), bl0 = *(const f32x4*)bl, bl1 = *(const f32x4*)(bl + 4);
        FOR_AI_M { const int slot = u.pm * 256 + 128 * ai + 64 * wr + 16 * m + fr; const float s = rs[slot_tok[slot]];
            float o[8];
#pragma unroll
            for (int n = 0; n < 2; ++n)
#pragma unroll
                for (int j = 0; j < 4; ++j) { float g = acc[ai][0][m][n][j] * s + (n ? bg1[j] : bg0[j]); float l = acc[ai][1][m][n][j] * s + (n ? bl1[j] : bl0[j]);
                    g = fminf(g, 7.0f); l = fminf(fmaxf(l, -7.0f), 7.0f); o[4 * n + j] = g * sigmoidf_(1.702f * g) * (l + 1.0f); }
            u32x4 w; w.x = pk2(o[0], o[1]); w.y = pk2(o[2], o[3]); w.z = pk2(o[4], o[5]); w.w = pk2(o[6], o[7]);
            *(u32x4*)(ACT + (size_t)slot * 1024 + u.pn * 128 + cl) = w; } } };
struct EpiDown { bf16_t* YB; const float* gate; const int* tile_e; const float* b_down;
    __device__ __forceinline__ void operator()(EPI_ARGS) const {
        const int e = tile_e[u.pm]; const int c0 = u.pn * 256 + 32 * wc + 8 * fq; f32x4 bv[2][2];
        FOR_BJ { bv[bj][0] = *(const f32x4*)(b_down + (size_t)e * 1024 + c0 + 128 * bj); bv[bj][1] = *(const f32x4*)(b_down + (size_t)e * 1024 + c0 + 128 * bj + 4); }
        FOR_AI_M { const int slot = u.pm * 256 + 128 * ai + 64 * wr + 16 * m + fr; const float g = gate[slot];
            FOR_BJ { const f32x4 v0 = (acc[ai][bj][m][0] + bv[bj][0]) * g, v1 = (acc[ai][bj][m][1] + bv[bj][1]) * g; u32x4 w; w.x = pk2(v0[0], v0[1]); w.y = pk2(v0[2], v0[3]); w.z = pk2(v1[0], v1[1]); w.w = pk2(v1[2], v1[3]);
                *(u32x4*)(YB + (size_t)slot * 1024 + c0 + 128 * bj) = w; } } } };

constexpr int VT_LD = 72;
__device__ __forceinline__ void mla_unit(const Params& p, LAS unsigned char* lds, int unit, int tid) {
    const int lane = tid & 63, wid = tid >> 6, r32 = lane & 31, hi = lane >> 5;
    const int qb = unit & 7, h = (unit >> 3) & 7, b = unit >> 6;
    const bf16_t* Qg = (const bf16_t*)(p.ws + WS_Q); const bf16_t* Kg = (const bf16_t*)(p.ws + WS_KB); const bf16_t* Vg = (const bf16_t*)(p.ws + WS_VB);
    LAS bf16_t* vt = (LAS bf16_t*)lds;
    const size_t rowb = (size_t)b * SEQ;
    const int q0 = qb * 256 + wid * 32;
    bf16x8 qf[6];
#pragma unroll
    for (int s = 0; s < 6; ++s) qf[s] = *(const bf16x8*)(Qg + (rowb + q0 + r32) * 768 + h * 96 + 16 * s + 8 * hi);
    const int nt_blk = 4 * qb + 4, nt_me = 4 * qb + (wid >> 1) + 1;
    float mrun = -1.0e30f, lrun = 0.f; f32x16 o0 = {}, o1 = {};
    for (int t = 0; t < nt_blk; ++t) {
        __syncthreads();
        { const int kv = tid >> 3, dc = tid & 7; const bf16x8 v = *(const bf16x8*)(Vg + (rowb + 64 * t + kv) * 512 + h * 64 + 8 * dc);
#pragma unroll
            for (int e = 0; e < 8; ++e) vt[(8 * dc + e) * VT_LD + kv] = (bf16_t)v[e]; }
        __syncthreads();
        if (t < nt_me) {
            f32x16 sc[2];
#pragma unroll
            for (int kb = 0; kb < 2; ++kb) { f32x16 a = {};
                const bf16_t* kr = Kg + (rowb + 64 * t + 32 * kb + r32) * 768 + h * 96 + 8 * hi;
#pragma unroll
                for (int s = 0; s < 6; ++s) { const bf16x8 kf = *(const bf16x8*)(kr + 16 * s); a = __builtin_amdgcn_mfma_f32_32x32x16_bf16(kf, qf[s], a, 0, 0, 0); }
                sc[kb] = a; }
            float mx = sc[0][0];
#pragma unroll
            for (int r = 0; r < 16; ++r) { mx = fmaxf(mx, sc[0][r]); mx = fmaxf(mx, sc[1][r]); }
            mx = fmaxf(mx, __shfl_xor(mx, 32));
            const float mnew = fmaxf(mrun, mx), alpha = fast_exp2(mrun - mnew); mrun = mnew;
            float ls = 0.f; unsigned pw[2][8];
#pragma unroll
            for (int kb = 0; kb < 2; ++kb)
#pragma unroll
                for (int r = 0; r < 16; r += 2) { const float e0 = fast_exp2(sc[kb][r] - mnew), e1 = fast_exp2(sc[kb][r + 1] - mnew); const unsigned w = pk2(e0, e1); pw[kb][r >> 1] = w;
                    ls += __uint_as_float(w << 16) + __uint_as_float(w & 0xffff0000u); }
            lrun = lrun * alpha + ls;
#pragma unroll
            for (int r = 0; r < 16; ++r) { o0[r] *= alpha; o1[r] *= alpha; }
#pragma unroll
            for (int kb = 0; kb < 2; ++kb)
#pragma unroll
                for (int s2 = 0; s2 < 2; ++s2) {
                    u32x4 pu; pu.x = pw[kb][4 * s2 + 0]; pu.y = pw[kb][4 * s2 + 1]; pu.z = pw[kb][4 * s2 + 2]; pu.w = pw[kb][4 * s2 + 3];
                    const bf16x8 pf = __builtin_bit_cast(bf16x8, pu);
                    const int kv0 = 32 * kb + 16 * s2 + 4 * hi;
#pragma unroll
                    for (int db = 0; db < 2; ++db) { const LAS bf16_t* vr = vt + (32 * db + r32) * VT_LD + kv0;
                        const s16x4 lo = *(const LAS s16x4*)vr, hi4 = *(const LAS s16x4*)(vr + 8);
                        const bf16x8 vf = (bf16x8){lo[0], lo[1], lo[2], lo[3], hi4[0], hi4[1], hi4[2], hi4[3]};
                        if (db == 0) o0 = __builtin_amdgcn_mfma_f32_32x32x16_bf16(vf, pf, o0, 0, 0, 0); else o1 = __builtin_amdgcn_mfma_f32_32x32x16_bf16(vf, pf, o1, 0, 0, 0); } }
        }
    }
    lrun += __shfl_xor(lrun, 32);
    const float inv = 1.0f / lrun;
    bf16_t* yo = (bf16_t*)(p.ws + WS_YCAT) + (rowb + q0 + r32) * 1024 + h * 64;
#pragma unroll
    for (int g = 0; g < 4; ++g) { u32x2 w0, w1; w0.x = pk2(o0[4 * g] * inv, o0[4 * g + 1] * inv); w0.y = pk2(o0[4 * g + 2] * inv, o0[4 * g + 3] * inv);
        w1.x = pk2(o1[4 * g] * inv, o1[4 * g + 1] * inv); w1.y = pk2(o1[4 * g + 2] * inv, o1[4 * g + 3] * inv);
        *(u32x2*)(yo + 8 * g + 4 * hi) = w0; *(u32x2*)(yo + 32 + 8 * g + 4 * hi) = w1; }
}

__device__ __forceinline__ void conv_unit(const Params& p, LAS unsigned char* lds, int unit, int tid) {
    const int lane = tid & 63, wid = tid >> 6, c = tid;
    const int b = unit >> 6, t0 = (unit & 63) * 32;
    LAS float* cl = (LAS float*)lds;
    LAS float* wl = (LAS float*)(lds + 65536);
    const __amdgpu_buffer_rsrc_t wr_ = __builtin_amdgcn_make_buffer_rsrc((void*)p.w_dw, 0, 31 * 512 * 4, 0x00020000);
#pragma unroll
    for (int j = 0; j < 31; ++j) wl[j * 512 + c] = __uint_as_float(__builtin_amdgcn_raw_buffer_load_b32(wr_, c * 4, j * 2048, 0));
    const __amdgpu_buffer_rsrc_t ur = __builtin_amdgcn_make_buffer_rsrc((void*)(p.ws + WS_U), 0, (int)((size_t)NTOK * INP * 2), 0x00020000);
    const int va = (416 + c) * 2, vg = (928 + c) * 2;
    float z[62];
#pragma unroll
    for (int i = 0; i < 62; ++i) { const int t = t0 - 30 + i;
        if (t >= 0) { const int so = (b * SEQ + t) * (INP * 2);
            const float a = bf2f(__builtin_amdgcn_raw_buffer_load_b16(ur, va, so, 0)), g = bf2f(__builtin_amdgcn_raw_buffer_load_b16(ur, vg, so, 0)); z[i] = a * sigmoidf_(g); } else z[i] = 0.f; }
    float acc[32]; const float bias = p.b_dw[c];
#pragma unroll
    for (int o = 0; o < 32; ++o) acc[o] = bias;
#pragma unroll
    for (int j = 0; j < 31; ++j) { const float wj = wl[j * 512 + c];
#pragma unroll
        for (int o = 0; o < 32; ++o) acc[o] += wj * z[o + j]; }
#pragma unroll
    for (int o = 0; o < 32; ++o) cl[o * 512 + c] = acc[o];
    __syncthreads();
#pragma unroll
    for (int oo = 0; oo < 4; ++oo) { const int o = wid * 4 + oo; const LAS float* r = cl + o * 512 + lane * 8;
        const f32x4 v0 = *(const LAS f32x4*)r, v1 = *(const LAS f32x4*)(r + 4);
        float s = (v0[0] + v0[1]) + (v0[2] + v0[3]) + (v1[0] + v1[1]) + (v1[2] + v1[3]); s = wave_sum(s); const float mu = s * (1.0f / 512.0f);
        const f32x4 d0 = v0 - mu, d1 = v1 - mu; float q = (d0[0] * d0[0] + d0[1] * d0[1]) + (d0[2] * d0[2] + d0[3] * d0[3]) + (d1[0] * d1[0] + d1[1] * d1[1]) + (d1[2] * d1[2] + d1[3] * d1[3]);
        q = wave_sum(q); const float rstd = 1.0f / sqrtf(q * (1.0f / 512.0f) + EPS);
        const f32x4 g0 = *(const f32x4*)(p.g_cln + lane * 8), g1 = *(const f32x4*)(p.g_cln + lane * 8 + 4), b0 = *(const f32x4*)(p.b_cln + lane * 8), b1 = *(const f32x4*)(p.b_cln + lane * 8 + 4);
        float y[8];
#pragma unroll
        for (int j = 0; j < 4; ++j) { const float a0 = d0[j] * rstd * g0[j] + b0[j], a1 = d1[j] * rstd * g1[j] + b1[j]; y[j] = a0 * sigmoidf_(a0); y[4 + j] = a1 * sigmoidf_(a1); }
        u32x4 wv; wv.x = pk2(y[0], y[1]); wv.y = pk2(y[2], y[3]); wv.z = pk2(y[4], y[5]); wv.w = pk2(y[6], y[7]);
        *(u32x4*)((bf16_t*)(p.ws + WS_YCAT) + ((size_t)b * SEQ + t0 + o) * 1024 + 512 + lane * 8) = wv; }
    __syncthreads();
}

__device__ __forceinline__ void router1_unit(const Params& p, LAS unsigned char* lds, int unit, int tid) {
    LAS float* lg = (LAS float*)lds;
    LAS int* hist = (LAS int*)(lds + 2048);
    const float* WR = (const float*)(p.ws + WS_WR); const float* ssq = (const float*)(p.ws + WS_SSQ_X2);
    if (tid < 32) hist[tid] = 0;
    __syncthreads();
    const int e = tid & 31, tl = tid >> 5;
    for (int it = 0; it < RT_TOK / 16; ++it) {
        const int tok = unit * RT_TOK + it * 16 + tl;
        const float* xr = p.out + (size_t)tok * 1024;
        float a0 = 0.f, a1 = 0.f, a2 = 0.f, a3 = 0.f;
#pragma unroll 4
        for (int k = 0; k < 1024; k += 4) { const f32x4 xv = *(const f32x4*)(xr + k);
            a0 += xv[0] * WR[(k + 0) * 32 + e]; a1 += xv[1] * WR[(k + 1) * 32 + e]; a2 += xv[2] * WR[(k + 2) * 32 + e]; a3 += xv[3] * WR[(k + 3) * 32 + e]; }
        const f32x4* sp = (const f32x4*)(ssq + (size_t)tok * 16); const f32x4 tq = (sp[0] + sp[1]) + (sp[2] + sp[3]); const float rstd = 1.0f / sqrtf(((tq[0] + tq[1]) + (tq[2] + tq[3])) * (1.0f / 1024.0f) + EPS);
        if (e == 0) ((float*)(p.ws + WS_RSTD_X2))[tok] = rstd;
        lg[tl * 32 + e] = ((a0 + a1) + (a2 + a3)) * rstd + p.b_router[e];
        __syncthreads();
        if (tid < 16) { const int tk = unit * RT_TOK + it * 16 + tid; unsigned used = 0u; float tv[4]; int ti[4];
#pragma unroll
            for (int k = 0; k < 4; ++k) { float best = -3.0e38f; int bi = 0;
                for (int j = 0; j < 32; ++j) { const float v = lg[tid * 32 + j]; if (!((used >> j) & 1u) && v > best) { best = v; bi = j; } }
                used |= 1u << bi; tv[k] = best; ti[k] = bi; }
            const float e1 = __expf(tv[1] - tv[0]), e2 = __expf(tv[2] - tv[0]), e3 = __expf(tv[3] - tv[0]); const float inv = 1.0f / (1.0f + e1 + e2 + e3);
            int* oi = (int*)(p.ws + WS_TOPI) + (size_t)tk * 4; float* og = (float*)(p.ws + WS_TOPG) + (size_t)tk * 4;
            oi[0] = ti[0]; oi[1] = ti[1]; oi[2] = ti[2]; oi[3] = ti[3]; og[0] = inv; og[1] = e1 * inv; og[2] = e2 * inv; og[3] = e3 * inv;
#pragma unroll
            for (int k = 0; k < 4; ++k) atomicAdd((int*)&hist[ti[k]], 1); }
        __syncthreads();
    }
    if (tid < 32) ((int*)(p.ws + WS_HIST))[unit * 32 + tid] = hist[tid];
}
__device__ __forceinline__ void router2_unit(const Params& p, LAS unsigned char* lds, int unit, int tid) {
    LAS int* cnt = (LAS int*)lds;
    LAS int* base = cnt + 32;
    LAS int* pst = cnt + 64;
    LAS int* idx = cnt + 128;
    LAS int* dst = cnt + 128 + 512;
    const int* H = (const int*)(p.ws + WS_HIST);
    if (tid < 32) { int tot = 0, bs = 0; for (int b = 0; b < RT_UNITS; ++b) { const int v = H[b * 32 + tid]; tot += v; bs += (b < unit) ? v : 0; } cnt[tid] = tot; base[tid] = bs; }
    { idx[tid] = ((const int*)(p.ws + WS_TOPI))[(size_t)unit * RT_TOK * 4 + tid]; }
    __syncthreads();
    if (tid == 0) { int s = 0; for (int e = 0; e < 32; ++e) { pst[e] = s; s += (cnt[e] + 255) & ~255; } pst[32] = s; }
    __syncthreads();
    if (tid < 32) { int run = pst[tid] + base[tid]; for (int a = 0; a < 512; ++a) if (idx[a] == tid) { dst[a] = run; ++run; } }
    __syncthreads();
    { const int a = tid, d = dst[a]; const int tok = unit * RT_TOK + (a >> 2);
        ((int*)(p.ws + WS_SLOT_TOK))[d] = tok; ((float*)(p.ws + WS_SLOT_GATE))[d] = ((const float*)(p.ws + WS_TOPG))[(size_t)unit * RT_TOK * 4 + a];
        ((int*)(p.ws + WS_INV))[(size_t)unit * RT_TOK * 4 + a] = d; }
    if (unit < 32) { const int e = unit, s0 = pst[e] + cnt[e], s1 = pst[e + 1];
        for (int s = s0 + tid; s < s1; s += 512) { ((int*)(p.ws + WS_SLOT_TOK))[s] = 0; ((float*)(p.ws + WS_SLOT_GATE))[s] = 0.f; } }
    if (unit == 32) { int* te = (int*)(p.ws + WS_TILE_E); const int nt = pst[32] >> 8;
        for (int t = tid; t < NTILE_MAX; t += 512) { int e = 31; for (int k = 31; k >= 0; --k) if (t * 256 < pst[k + 1]) e = k; te[t] = e; }
        if (tid == 0) te[NTILE_MAX] = nt; }
    __syncthreads();
}

__device__ __forceinline__ void final_row(const Params& p, int tok, int lane) {
    float* xr = p.out + (size_t)tok * 1024; const int* inv = (const int*)(p.ws + WS_INV) + (size_t)tok * 4; const bf16_t* YB = (const bf16_t*)(p.ws + WS_YB);
    f32x4 v[4];
#pragma unroll
    for (int j = 0; j < 4; ++j) v[j] = ((const f32x4*)xr)[lane + 64 * j];
#pragma unroll
    for (int k = 0; k < 4; ++k) { const u32x2* yr = (const u32x2*)(YB + (size_t)inv[k] * 1024);
#pragma unroll
        for (int j = 0; j < 4; ++j) { const u32x2 w = yr[lane + 64 * j]; v[j][0] += __uint_as_float(w.x << 16); v[j][1] += __uint_as_float(w.x & 0xffff0000u); v[j][2] += __uint_as_float(w.y << 16); v[j][3] += __uint_as_float(w.y & 0xffff0000u); } }
    float s = 0.f;
#pragma unroll
    for (int j = 0; j < 4; ++j) s += (v[j][0] * v[j][0] + v[j][1] * v[j][1]) + (v[j][2] * v[j][2] + v[j][3] * v[j][3]);
    s = wave_sum(s); const float rstd = 1.0f / sqrtf(s * (1.0f / 1024.0f) + EPS);
#pragma unroll
    for (int j = 0; j < 4; ++j) { const f32x4 g = ((const f32x4*)p.g_final)[lane + 64 * j]; ((f32x4*)xr)[lane + 64 * j] = v[j] * rstd * g; }
}

constexpr int LDS_BYTES = 147456;
#define GRID_SYNC() grid.sync()

__device__ __forceinline__ void mla_order(int vb, int r, int& unit) {
    const int bh = vb >> 1, s = vb & 1; const int qb = (r == 0) ? s : (r == 1) ? 7 - s : (r == 2) ? 3 - s : 4 + s; unit = bh * 8 + qb;
}

typedef const __attribute__((address_space(4))) Params* CParams;
#define PHASE_BEGIN() CParams pp_ = (CParams)__builtin_amdgcn_kernarg_segment_ptr(); asm volatile("" : "+s"(pp_)); Params p; { const __attribute__((address_space(4))) unsigned long long* q_ = (const __attribute__((address_space(4))) unsigned long long*)pp_; unsigned long long* d_ = (unsigned long long*)&p; _Pragma("unroll") for (int k_ = 0; k_ < (int)(sizeof(Params) / 8); ++k_) d_[k_] = q_[k_]; } unsigned char* ws = p.ws; int tid = threadIdx.x; asm volatile("" : "+v"(tid)); const int lane = tid & 63; (void)lane; (void)ws;

__global__ void __launch_bounds__(512) mega_kernel(Params p_unused) {
    extern __shared__ __attribute__((aligned(16))) unsigned char lds_raw[];
    cg::grid_group grid = cg::this_grid();
    LAS unsigned char* lds = (LAS unsigned char*)lds_raw;
    const int G = gridDim.x, bx = blockIdx.x;
    const int vb = (G % 8 == 0) ? (bx % 8) * (G / 8) + bx / 8 : bx;

    { PHASE_BEGIN(); prep_stage(p, lds, vb, G, tid); }
    GRID_SYNC();
    { PHASE_BEGIN();
    for (int i = vb; i < 768 + 128; i += G) {
        if (i < 768) { Unit u{i / 6, i % 6, 0};
            ProvPlain P{(const bf16_t*)(ws + WS_XB), 1024, (const bf16_t*)(ws + WS_WT_IN), 1024, 1024};
            EpiIn E{(bf16_t*)(ws + WS_U), (const float*)(ws + WS_RSTD_X), (float*)(ws + WS_SSQ_Q), (float*)(ws + WS_SSQ_KV), (const float*)(ws + WS_ROPE), (bf16_t*)(ws + WS_KB)};
            gemm_unit_naive<true>(P, E, u, lds, tid); }
        else { const int j = i - 768; Unit u{j / 8, j % 8, 0};
            ProvPlain P{(const bf16_t*)(ws + WS_MEMB), 1024, (const bf16_t*)(ws + WS_WT_XKV), 1024, 1024}; EpiKVMem E{(bf16_t*)(ws + WS_KM), (bf16_t*)(ws + WS_VMT), (const float*)(ws + WS_RSTD_MEM)};
            gemm_unit_naive<false>(P, E, u, lds, tid); } } }
    GRID_SYNC();
    { PHASE_BEGIN();
    for (int i = vb; i < 384 + 512 + 1024; i += G) {
        if (i < 384) { Unit u{i / 3, i % 3, 0};
            ProvPlain P{(const bf16_t*)(ws + WS_U), INP, (const bf16_t*)(ws + WS_WT_UQ), 256, 256}; EpiQ E{(bf16_t*)(ws + WS_Q), (const float*)(ws + WS_SSQ_Q), (const float*)(ws + WS_ROPE)};
            gemm_unit_naive<false>(P, E, u, lds, tid); }
        else if (i < 384 + 512) { const int j = i - 384; Unit u{j / 4, j % 4, 0};
            ProvPlain P{(const bf16_t*)(ws + WS_U) + 256, INP, (const bf16_t*)(ws + WS_WT_UKV), 128, 128}; EpiKV E{(bf16_t*)(ws + WS_KB), (bf16_t*)(ws + WS_VB), (const float*)(ws + WS_SSQ_KV)};
            gemm_unit_naive<true>(P, E, u, lds, tid); }
        else conv_unit(p, lds, i - 896, tid); } }
    GRID_SYNC();
    { PHASE_BEGIN();
    if (G == 256) { for (int r = 0; r < 4; ++r) { int unit; mla_order(vb, r, unit); mla_unit(p, lds, unit, tid); } }
    else { for (int i = vb; i < 1024; i += G) mla_unit(p, lds, i, tid); } }
    GRID_SYNC();
    { PHASE_BEGIN();
    for (int i = vb; i < 512; i += G) { Unit u{i / 4, i % 4, 0};
        ProvPlain P{(const bf16_t*)(ws + WS_YCAT), 1024, (const bf16_t*)(ws + WS_WT_OUT), 1024, 1024}; EpiResid E{p.x, p.out, (bf16_t*)(ws + WS_X1B), (float*)(ws + WS_SSQ_X1)};
        gemm_unit_naive<false>(P, E, u, lds, tid); }
    }
    GRID_SYNC();
    { PHASE_BEGIN();
    for (int i = vb; i < 512; i += G) { Unit u{i / 4, i % 4, 0};
        ProvPlain P{(const bf16_t*)(ws + WS_X1B), 1024, (const bf16_t*)(ws + WS_WT_XQ), 1024, 1024}; EpiScale16 E{(bf16_t*)(ws + WS_XQ), 1024, (const float*)(ws + WS_SSQ_X1), C2_X};
        gemm_unit_naive<true>(P, E, u, lds, tid); }
    }
    GRID_SYNC();
    { PHASE_BEGIN();
    for (int i = vb; i < 512; i += G) { Unit u{i & 7, 0, i >> 3};
        ProvXS P{(const bf16_t*)(ws + WS_XQ), (const bf16_t*)(ws + WS_KM), 256}; EpiSoftmaxP E{(bf16_t*)(ws + WS_P)};
        gemm_unit_naive<true>(P, E, u, lds, tid); }
    }
    GRID_SYNC();
    { PHASE_BEGIN();
    for (int i = vb; i < 512; i += G) { Unit u{i & 7, 0, i >> 3};
        ProvXPV P{(const bf16_t*)(ws + WS_P), (const bf16_t*)(ws + WS_VMT), 256}; EpiOX E{(bf16_t*)(ws + WS_OX)};
        gemm_unit_naive<true>(P, E, u, lds, tid); }
    }
    GRID_SYNC();
    { PHASE_BEGIN();
    for (int i = vb; i < 512; i += G) { Unit u{i / 4, i % 4, 0};
        ProvPlain P{(const bf16_t*)(ws + WS_OX), 1024, (const bf16_t*)(ws + WS_WT_XO), 1024, 1024}; EpiResid E{p.out, p.out, (bf16_t*)(ws + WS_X2B), (float*)(ws + WS_SSQ_X2)};
        gemm_unit_naive<false>(P, E, u, lds, tid); }
    }
    GRID_SYNC();
    { PHASE_BEGIN(); for (int i = vb; i < RT_UNITS; i += G) router1_unit(p, lds, i, tid); }
    GRID_SYNC();
    { PHASE_BEGIN(); for (int i = vb; i < RT_UNITS; i += G) router2_unit(p, lds, i, tid); }
    GRID_SYNC();
    { PHASE_BEGIN(); const int* te = (const int*)(ws + WS_TILE_E); const int nt = te[NTILE_MAX];
      for (int i = vb; i < nt * 8; i += G) { Unit u{i >> 3, i & 7, 0};
        ProvUp P{(const bf16_t*)(ws + WS_X2B), (const int*)(ws + WS_SLOT_TOK), te, (const bf16_t*)(ws + WS_WT_UP), 1024};
        EpiSwiglu E{(bf16_t*)(ws + WS_ACT), (const float*)(ws + WS_RSTD_X2), (const int*)(ws + WS_SLOT_TOK), te, p.b_up};
        gemm_unit_naive<true>(P, E, u, lds, tid); } }
    GRID_SYNC();
    { PHASE_BEGIN(); const int* te = (const int*)(ws + WS_TILE_E); const int nt = te[NTILE_MAX];
      for (int i = vb; i < nt * 4; i += G) { Unit u{i >> 2, i & 3, 0};
        ProvDown P{(const bf16_t*)(ws + WS_ACT), te, (const bf16_t*)(ws + WS_WT_DOWN), 1024};
        EpiDown E{(bf16_t*)(ws + WS_YB), (const float*)(ws + WS_SLOT_GATE), te, p.b_down};
        gemm_unit_naive<true>(P, E, u, lds, tid); } }
    GRID_SYNC();
    { PHASE_BEGIN(); const int gw = vb * 8 + (tid >> 6), ngw = G * 8; for (int r = gw; r < NTOK; r += ngw) final_row(p, r, lane); }
}

extern "C" void kernel_launch(void* const* d_in, const int* in_sizes, int n_in, void* d_out, int out_size, void* d_ws, size_t ws_size, hipStream_t stream) {
    static int grid = 0;
    if (grid == 0) {
        if (n_in != 27 || ws_size < WS_END) { fprintf(stderr, "kernel_launch: unexpected inputs (n_in %d, ws %zu)\n", n_in, ws_size); grid = -1; return; }
        int dev = 0, cus = 0, per_cu = 0;
        (void)hipGetDevice(&dev); (void)hipDeviceGetAttribute(&cus, hipDeviceAttributeMultiprocessorCount, dev);
        (void)hipFuncSetAttribute((const void*)mega_kernel, hipFuncAttributeMaxDynamicSharedMemorySize, LDS_BYTES);
        (void)hipOccupancyMaxActiveBlocksPerMultiprocessor(&per_cu, (const void*)mega_kernel, 512, LDS_BYTES);
        if (per_cu < 1) { fprintf(stderr, "kernel_launch: occupancy query says %d blocks per CU\n", per_cu); per_cu = 1; }
        if (per_cu > 1) per_cu = 1;
        grid = cus * per_cu;
        (void)hipGetLastError();
    }
    if (grid < 0) return;
    Params p{};
    p.x = (const float*)d_in[0]; p.mem = (const float*)d_in[1]; p.pos = (const int*)d_in[2];
    p.g_mix = (const float*)d_in[3]; p.w_in = (const float*)d_in[4]; p.g_q = (const float*)d_in[5]; p.w_uq = (const float*)d_in[6]; p.g_kv = (const float*)d_in[7]; p.w_ukv = (const float*)d_in[8];
    p.w_dw = (const float*)d_in[9]; p.b_dw = (const float*)d_in[10]; p.g_cln = (const float*)d_in[11]; p.b_cln = (const float*)d_in[12]; p.w_out = (const float*)d_in[13];
    p.g_xattn = (const float*)d_in[14]; p.g_mem = (const float*)d_in[15]; p.w_xq = (const float*)d_in[16]; p.w_xkv = (const float*)d_in[17]; p.w_xo = (const float*)d_in[18];
    p.g_ffn = (const float*)d_in[19]; p.w_router = (const float*)d_in[20]; p.b_router = (const float*)d_in[21]; p.w_up = (const float*)d_in[22]; p.b_up = (const float*)d_in[23];
    p.w_down = (const float*)d_in[24]; p.b_down = (const float*)d_in[25]; p.g_final = (const float*)d_in[26];
    p.out = (float*)d_out; p.ws = (unsigned char*)d_ws;
    void* args[] = {&p};
    hipError_t e = hipLaunchCooperativeKernel((const void*)mega_kernel, dim3(grid), dim3(512), args, LDS_BYTES, stream);
    if (e != hipSuccess) fprintf(stderr, "cooperative launch failed: %s (grid %d)\n", hipGetErrorString(e), grid);
}
```

```cpp
#include <hip/hip_runtime.h>
#include <stdint.h>
#include <stdio.h>
#include <hip/hip_cooperative_groups.h>
namespace cg = cooperative_groups;

#define LAS __attribute__((address_space(3)))
typedef unsigned short bf16_t;
typedef short bf16x8 __attribute__((ext_vector_type(8)));
typedef short s16x4 __attribute__((ext_vector_type(4)));
typedef float f32x2 __attribute__((ext_vector_type(2)));
typedef float f32x4 __attribute__((ext_vector_type(4)));
typedef float f32x16 __attribute__((ext_vector_type(16)));
typedef unsigned u32x2 __attribute__((ext_vector_type(2)));
typedef unsigned u32x4 __attribute__((ext_vector_type(4)));

constexpr int BATCH = 16, SEQ = 2048, NTOK = BATCH * SEQ, DM = 1024;
constexpr int INC = 1440, INP = 1536;
constexpr int HEADS = 8, QKD = 96, VD = 64;
constexpr int CCH = 512, CW = 31;
constexpr int MEML = 256, NMEM = BATCH * MEML;
constexpr int XH = 4, XD = 256;
constexpr int NE = 32, TOPK = 4;
constexpr int NSLOT = NTOK * TOPK + NE * 256;
constexpr int NTILE_MAX = NSLOT / 256;
constexpr float EPS = 1e-5f;
constexpr float C2_MLA = 0.14724444602590306f;
constexpr float C2_X = 0.09016844005556021f;
constexpr int RT_TOK = 128, RT_UNITS = NTOK / RT_TOK;

constexpr size_t MiB = 1u << 20;
constexpr size_t WS_CTL = 0;
constexpr size_t WS_RSTD_X = 1 * MiB;
constexpr size_t WS_RSTD_Q = WS_RSTD_X + 128 * 1024;
constexpr size_t WS_RSTD_KV = WS_RSTD_Q + 128 * 1024;
constexpr size_t WS_RSTD_X1 = WS_RSTD_KV + 128 * 1024;
constexpr size_t WS_RSTD_X2 = WS_RSTD_X1 + 128 * 1024;
constexpr size_t WS_RSTD_MEM = WS_RSTD_X2 + 128 * 1024;
constexpr size_t WS_ROPE = 2 * MiB;
constexpr size_t WS_TOPI = 6 * MiB;
constexpr size_t WS_TOPG = WS_TOPI + 512 * 1024;
constexpr size_t WS_INV = WS_TOPG + 512 * 1024;
constexpr size_t WS_SLOT_TOK = WS_INV + 512 * 1024;
constexpr size_t WS_SLOT_GATE = WS_SLOT_TOK + 1 * MiB;
constexpr size_t WS_SLOT_RS = 15 * MiB + 256 * 1024;
constexpr size_t WS_HIST = WS_SLOT_GATE + 1 * MiB;
constexpr size_t WS_TILE_E = WS_HIST + 64 * 1024;
constexpr size_t WS_SSQ_Q = 10 * MiB;
constexpr size_t WS_SSQ_KV = 10 * MiB + 512 * 1024;
constexpr size_t WS_SSQ_X1 = 11 * MiB;
constexpr size_t WS_SSQ_X2 = 13 * MiB;
constexpr size_t WS_WR = 15 * MiB;
constexpr size_t WS_WT_IN = 16 * MiB;
constexpr size_t WS_WT_UQ = 19 * MiB;
constexpr size_t WS_WT_UKV = WS_WT_UQ + 512 * 1024;
constexpr size_t WS_WT_OUT = 20 * MiB;
constexpr size_t WS_WT_XQ = 22 * MiB;
constexpr size_t WS_WT_XKV = 24 * MiB;
constexpr size_t WS_WT_XO = 28 * MiB;
constexpr size_t WS_WT_UP = 32 * MiB;
constexpr size_t WS_WT_DOWN = 160 * MiB;
constexpr size_t WS_X2B = 224 * MiB;
constexpr size_t WS_XB = WS_X2B;
constexpr size_t WS_ACT = 288 * MiB;
constexpr size_t WS_U = 288 * MiB;
constexpr size_t WS_Q = 384 * MiB;
constexpr size_t WS_KB = 432 * MiB;
constexpr size_t WS_VB = 480 * MiB;
constexpr size_t WS_YCAT = 512 * MiB;
constexpr size_t WS_YB = 560 * MiB;
constexpr size_t WS_XG = WS_YB;
constexpr size_t WS_X1B = 576 * MiB;
constexpr size_t WS_XQ = 640 * MiB;
constexpr size_t WS_P = 704 * MiB;
constexpr size_t WS_OX = 768 * MiB;
constexpr size_t WS_MEMB = 832 * MiB;
constexpr size_t WS_KM = 840 * MiB;
constexpr size_t WS_VMT = 848 * MiB;
constexpr size_t WS_END = 856 * MiB;

struct Params {
    const float* x; const float* mem; const int* pos;
    const float *g_mix, *w_in, *g_q, *w_uq, *g_kv, *w_ukv, *w_dw, *b_dw, *g_cln, *b_cln, *w_out, *g_xattn, *g_mem, *w_xq, *w_xkv, *w_xo, *g_ffn, *w_router, *b_router, *w_up, *b_up, *w_down, *b_down, *g_final;
    float* out; unsigned char* ws;
};

__device__ __forceinline__ float bf2f(bf16_t b) { return __uint_as_float((unsigned)b << 16); }
__device__ __forceinline__ unsigned f2bf(float f) { unsigned u = __float_as_uint(f); return (u + 0x7fffu + ((u >> 16) & 1u)) >> 16; }
__device__ __forceinline__ unsigned pk2(float lo, float hi) { return f2bf(lo) | (f2bf(hi) << 16); }
__device__ __forceinline__ float wave_sum(float v) {
#pragma unroll
    for (int o = 1; o < 64; o <<= 1) v += __shfl_xor(v, o);
    return v;
}
__device__ __forceinline__ int perm32(int rho) { const int n = rho >> 4, i = rho & 15; return 8 * (i >> 2) + 4 * n + (i & 3); }
__device__ __forceinline__ float fast_exp2(float x) { return __builtin_amdgcn_exp2f(x); }
__device__ __forceinline__ float sigmoidf_(float x) { return 1.0f / (1.0f + __expf(-x)); }

template <int MODE>
__device__ __forceinline__ void tr_item(const float* W, int N, int K, const float* g, bf16_t* WT, LAS float* scr, int item, int lane) {
    const int nblk = N / 32, kb = item / nblk, nb = item % nblk, k0 = 64 * kb, n0 = 32 * nb;
#pragma unroll 8
    for (int i = 0; i < 32; ++i) { const int kk = 2 * i + (lane >> 5); const float gv = g ? g[k0 + kk] : 1.0f;
        scr[kk * 33 + (lane & 31)] = W[(size_t)(k0 + kk) * N + n0 + (lane & 31)] * gv; }
    asm volatile("s_waitcnt lgkmcnt(0)" ::: "memory");
    const int c = lane & 7;
#pragma unroll
    for (int j = 0; j < 4; ++j) { const int n = (lane >> 3) + 8 * j; const LAS float* s = scr + (8 * c) * 33 + n;
        u32x4 o; o.x = pk2(s[0 * 33], s[1 * 33]); o.y = pk2(s[2 * 33], s[3 * 33]); o.z = pk2(s[4 * 33], s[5 * 33]); o.w = pk2(s[6 * 33], s[7 * 33]);
        const int nn = n0 + n; const int row = (MODE == 1) ? ((((nn & 1023) >> 7) << 8) + ((nn >> 10) << 7) + (nn & 127)) : nn;
        *(u32x4*)(WT + (size_t)row * K + k0 + 8 * c) = o; }
    asm volatile("s_waitcnt lgkmcnt(0)" ::: "memory");
}
__device__ __forceinline__ void row_bf16_rstd(const float* xrow, bf16_t* orow, float* rstd_out, int lane) {
    f32x4 v[4]; float s = 0.f;
#pragma unroll
    for (int j = 0; j < 4; ++j) { v[j] = ((const f32x4*)xrow)[lane + 64 * j]; s += (v[j].x * v[j].x + v[j].y * v[j].y) + (v[j].z * v[j].z + v[j].w * v[j].w); }
    s = wave_sum(s);
    if (lane == 0) *rstd_out = 1.0f / sqrtf(s * (1.0f / 1024.0f) + EPS);
    if (orow) {
#pragma unroll
        for (int j = 0; j < 4; ++j) { u32x2 w; w.x = pk2(v[j].x, v[j].y); w.y = pk2(v[j].z, v[j].w); ((u32x2*)orow)[lane + 64 * j] = w; }
    }
}
__device__ __forceinline__ void sincos_acc(double a, float& s, float& c) {
    const double TWO_PI = 6.283185307179586476925;
    const double n = rint(a * (1.0 / TWO_PI)); const double r = a - n * TWO_PI;
    const double h = 0.5 * r, h2 = h * h;
    const double sh = h * (1.0 + h2 * (-1.0 / 6.0 + h2 * (1.0 / 120.0 + h2 * (-1.0 / 5040.0 + h2 * (1.0 / 362880.0 + h2 * (-1.0 / 39916800.0 + h2 * (1.0 / 6227020800.0 + h2 * (-1.0 / 1307674368000.0 + h2 * (1.0 / 355687428096000.0)))))))));
    const double ch = 1.0 + h2 * (-0.5 + h2 * (1.0 / 24.0 + h2 * (-1.0 / 720.0 + h2 * (1.0 / 40320.0 + h2 * (-1.0 / 3628800.0 + h2 * (1.0 / 479001600.0 + h2 * (-1.0 / 87178291200.0 + h2 * (1.0 / 20922789888000.0 + h2 * (-1.0 / 6402373705728000.0)))))))));
    s = (float)(2.0 * sh * ch); c = (float)(ch * ch - sh * sh);
}
__device__ __forceinline__ double rope_inv(int i) {
    const double t[16] = {1.0, 0.5623413251903491, 0.31622776601683794, 0.1778279410038923, 0.1, 0.05623413251903491, 0.03162277660168379, 0.01778279410038923,
                          0.01, 0.005623413251903491, 0.0031622776601683794, 0.0017782794100389228, 0.001, 0.0005623413251903491, 0.00031622776601683794, 0.00017782794100389227};
    double r = t[0];
#pragma unroll
    for (int k = 1; k < 16; ++k) r = (i == k) ? t[k] : r;
    return r;
}

__device__ __forceinline__ void prep_stage(const Params& p, LAS unsigned char* lds, int vblk, int nblk, int tid) {
    const int lane = tid & 63, wid = tid >> 6;
    const int gw = vblk * 8 + wid, ngw = nblk * 8;
    LAS float* scr = (LAS float*)(lds + wid * 8448);
    unsigned char* ws = p.ws;
    constexpr int I_IN = 16 * 45, I_UQ = 4 * 24, I_UKV = 2 * 32, I_SQ = 16 * 32, I_XKV = 16 * 64, I_UP1 = 16 * 64, I_DN1 = 16 * 32;
    constexpr int NITEMS = I_IN + I_UQ + I_UKV + 3 * I_SQ + I_XKV + NE * I_UP1 + NE * I_DN1;
    for (int it = gw; it < NITEMS; it += ngw) {
        int r = it;
        if (r < I_IN) { tr_item<0>(p.w_in, INC, 1024, p.g_mix, (bf16_t*)(ws + WS_WT_IN), scr, r, lane); continue; } r -= I_IN;
        if (r < I_UQ) { tr_item<0>(p.w_uq, 768, 256, p.g_q, (bf16_t*)(ws + WS_WT_UQ), scr, r, lane); continue; } r -= I_UQ;
        if (r < I_UKV) { tr_item<0>(p.w_ukv, 1024, 128, p.g_kv, (bf16_t*)(ws + WS_WT_UKV), scr, r, lane); continue; } r -= I_UKV;
        if (r < I_SQ) { tr_item<0>(p.w_out, 1024, 1024, nullptr, (bf16_t*)(ws + WS_WT_OUT), scr, r, lane); continue; } r -= I_SQ;
        if (r < I_SQ) { tr_item<0>(p.w_xq, 1024, 1024, p.g_xattn, (bf16_t*)(ws + WS_WT_XQ), scr, r, lane); continue; } r -= I_SQ;
        if (r < I_SQ) { tr_item<0>(p.w_xo, 1024, 1024, nullptr, (bf16_t*)(ws + WS_WT_XO), scr, r, lane); continue; } r -= I_SQ;
        if (r < I_XKV) { tr_item<0>(p.w_xkv, 2048, 1024, p.g_mem, (bf16_t*)(ws + WS_WT_XKV), scr, r, lane); continue; } r -= I_XKV;
        if (r < NE * I_UP1) { const int e = r / I_UP1; tr_item<1>(p.w_up + (size_t)e * 1024 * 2048, 2048, 1024, p.g_ffn, (bf16_t*)(ws + WS_WT_UP) + (size_t)e * 2048 * 1024, scr, r % I_UP1, lane); continue; } r -= NE * I_UP1;
        { const int e = r / I_DN1; tr_item<0>(p.w_down + (size_t)e * 1024 * 1024, 1024, 1024, nullptr, (bf16_t*)(ws + WS_WT_DOWN) + (size_t)e * 1024 * 1024, scr, r % I_DN1, lane); }
    }
    for (int m = gw; m < NTOK; m += ngw) row_bf16_rstd(p.x + (size_t)m * 1024, (bf16_t*)(ws + WS_XB) + (size_t)m * 1024, (float*)(ws + WS_RSTD_X) + m, lane);
    for (int m = gw; m < NMEM; m += ngw) row_bf16_rstd(p.mem + (size_t)m * 1024, (bf16_t*)(ws + WS_MEMB) + (size_t)m * 1024, (float*)(ws + WS_RSTD_MEM) + m, lane);
    const int gt = vblk * 512 + tid, ngt = nblk * 512;
    for (int i = gt; i < NTOK * 16; i += ngt) { const int row = i >> 4, f = i & 15; float s, c; sincos_acc((double)p.pos[row] * rope_inv(f), s, c);
        float* rt = (float*)(ws + WS_ROPE) + (size_t)row * 32; rt[f] = c; rt[16 + f] = s; }
    for (int i = gt; i < 1024 * 32; i += ngt) ((float*)(ws + WS_WR))[i] = p.g_ffn[i >> 5] * p.w_router[i];
    for (int i = gt; i < (INP - INC) * 1024 / 8; i += ngt) ((u32x4*)((bf16_t*)(ws + WS_WT_IN) + (size_t)INC * 1024))[i] = (u32x4){0u, 0u, 0u, 0u};
}

struct Unit { int pm, pn, z; };
typedef f32x4 Acc[2][2][4][2];

template <bool PERM, class Prov, class Epi>
__device__ __forceinline__ void gemm_unit_naive(const Prov& P, const Epi& E, const Unit& u, LAS unsigned char* lds, int tid) {
    const int wid = tid >> 6, lane = tid & 63, wr = wid >> 2, wc = wid & 3, fr = lane & 15, fq = lane >> 4;
    const bf16_t* ap[2][4]; const bf16_t* bp[2][2];
#pragma unroll
    for (int ai = 0; ai < 2; ++ai)
#pragma unroll
        for (int m = 0; m < 4; ++m) ap[ai][m] = P.a_row(u, 128 * ai + 64 * wr + 16 * m + fr) + 8 * fq;
#pragma unroll
    for (int bj = 0; bj < 2; ++bj)
#pragma unroll
        for (int n = 0; n < 2; ++n) { const int rho = 16 * n + fr; bp[bj][n] = P.b_row(u, 128 * bj + 32 * wc + (PERM ? perm32(rho) : rho)) + 8 * fq; }
    Acc acc;
#pragma unroll
    for (int a = 0; a < 2; ++a)
#pragma unroll
        for (int b = 0; b < 2; ++b)
#pragma unroll
            for (int m = 0; m < 4; ++m)
#pragma unroll
                for (int n = 0; n < 2; ++n) acc[a][b][m][n] = (f32x4){0.f, 0.f, 0.f, 0.f};
    const int K = P.K;
#pragma unroll 1
    for (int k0 = 0; k0 < K; k0 += 32) {
        bf16x8 a[2][4], b[2][2];
#pragma unroll
        for (int ai = 0; ai < 2; ++ai)
#pragma unroll
            for (int m = 0; m < 4; ++m) a[ai][m] = *(const bf16x8*)(ap[ai][m] + k0);
#pragma unroll
        for (int bj = 0; bj < 2; ++bj)
#pragma unroll
            for (int n = 0; n < 2; ++n) b[bj][n] = *(const bf16x8*)(bp[bj][n] + k0);
#pragma unroll
        for (int ai = 0; ai < 2; ++ai)
#pragma unroll
            for (int bj = 0; bj < 2; ++bj)
#pragma unroll
                for (int m = 0; m < 4; ++m)
#pragma unroll
                    for (int n = 0; n < 2; ++n) acc[ai][bj][m][n] = __builtin_amdgcn_mfma_f32_16x16x32_bf16(b[bj][n], a[ai][m], acc[ai][bj][m][n], 0, 0, 0);
    }
    E(acc, u, wr, wc, fr, fq, lds);
}

struct ProvPlain { const bf16_t* A; int lda; const bf16_t* Bt; int ldb; int K;
    __device__ __forceinline__ const bf16_t* a_row(const Unit& u, int r) const { return A + (size_t)(u.pm * 256 + r) * lda; }
    __device__ __forceinline__ const bf16_t* b_row(const Unit& u, int r) const { return Bt + (size_t)(u.pn * 256 + r) * ldb; } };
struct ProvXS { const bf16_t* XQ; const bf16_t* KM; int K;
    __device__ __forceinline__ const bf16_t* a_row(const Unit& u, int r) const { return XQ + (size_t)((u.z >> 2) * 2048 + u.pm * 256 + r) * 1024 + (u.z & 3) * 256; }
    __device__ __forceinline__ const bf16_t* b_row(const Unit& u, int r) const { return KM + (size_t)((u.z >> 2) * 256 + r) * 1024 + (u.z & 3) * 256; } };
struct ProvXPV { const bf16_t* Pm; const bf16_t* VMT; int K;
    __device__ __forceinline__ const bf16_t* a_row(const Unit& u, int r) const { return Pm + ((size_t)u.z * 2048 + u.pm * 256 + r) * 256; }
    __device__ __forceinline__ const bf16_t* b_row(const Unit& u, int r) const { return VMT + ((size_t)u.z * 256 + r) * 256; } };
struct ProvUp { const bf16_t* X2B; const int* slot_tok; const int* tile_e; const bf16_t* WT; int K;
    __device__ __forceinline__ const bf16_t* a_row(const Unit& u, int r) const { return X2B + (size_t)slot_tok[u.pm * 256 + r] * 1024; }
    __device__ __forceinline__ const bf16_t* b_row(const Unit& u, int r) const { return WT + ((size_t)tile_e[u.pm] * 2048 + u.pn * 256 + r) * 1024; } };
struct ProvDown { const bf16_t* ACT; const int* tile_e; const bf16_t* WT; int K;
    __device__ __forceinline__ const bf16_t* a_row(const Unit& u, int r) const { return ACT + (size_t)(u.pm * 256 + r) * 1024; }
    __device__ __forceinline__ const bf16_t* b_row(const Unit& u, int r) const { return WT + ((size_t)tile_e[u.pm] * 1024 + u.pn * 256 + r) * 1024; } };

#define EPI_BAR() do { asm volatile("s_waitcnt lgkmcnt(0)" ::: "memory"); __builtin_amdgcn_s_barrier(); asm volatile("" ::: "memory"); } while (0)
#define EPI_ARGS Acc& acc, const Unit& u, int wr, int wc, int fr, int fq, LAS unsigned char* lds
#define FOR_AI_M _Pragma("unroll") for (int ai = 0; ai < 2; ++ai) _Pragma("unroll") for (int m = 0; m < 4; ++m)
#define FOR_BJ _Pragma("unroll") for (int bj = 0; bj < 2; ++bj)
struct EpiIn { bf16_t* O; const float* rs; float* ssq_q; float* ssq_kv; const float* rope; bf16_t* KB;
    __device__ __forceinline__ void operator()(EPI_ARGS) const {
        FOR_AI_M { const int row = u.pm * 256 + 128 * ai + 64 * wr + 16 * m + fr; const float s = rs[row]; bf16_t* rowp = O + (size_t)row * INP + u.pn * 256 + 32 * wc + 8 * fq;
            float q0 = 0.f, q1 = 0.f;
            FOR_BJ { const f32x4 v0 = acc[ai][bj][m][0] * s, v1 = acc[ai][bj][m][1] * s; u32x4 w; w.x = pk2(v0[0], v0[1]); w.y = pk2(v0[2], v0[3]); w.z = pk2(v1[0], v1[1]); w.w = pk2(v1[2], v1[3]);
                *(u32x4*)(rowp + 128 * bj) = w;
                const float qq = (v0[0] * v0[0] + v0[1] * v0[1]) + (v0[2] * v0[2] + v0[3] * v0[3]) + (v1[0] * v1[0] + v1[1] * v1[1]) + (v1[2] * v1[2] + v1[3] * v1[3]);
                if (bj == 0) q0 = qq; else q1 = qq; }
            if (u.pn == 0) { float q = q0 + q1; q += __shfl_xor(q, 16); q += __shfl_xor(q, 32); if (fq == 0) ssq_q[(size_t)row * 4 + wc] = q; }
            if (u.pn == 1) { float q = q0; q += __shfl_xor(q, 16); q += __shfl_xor(q, 32); if (fq == 0) ssq_kv[(size_t)row * 4 + wc] = q;
                if (wc == 0) {
                    const int i0 = 8 * (fq & 1); const f32x4 c0 = *(const f32x4*)(rope + (size_t)row * 32 + i0), c1 = *(const f32x4*)(rope + (size_t)row * 32 + i0 + 4);
                    const f32x4 s0 = *(const f32x4*)(rope + (size_t)row * 32 + 16 + i0), s1 = *(const f32x4*)(rope + (size_t)row * 32 + 16 + i0 + 4);
                    const f32x4 v0 = acc[ai][1][m][0] * s, v1 = acc[ai][1][m][1] * s; f32x4 p0, p1;
#pragma unroll
                    for (int j = 0; j < 4; ++j) { p0[j] = __shfl_xor(v0[j], 32); p1[j] = __shfl_xor(v1[j], 32); }
                    f32x4 o0, o1;
                    if (fq < 2) { o0 = v0 * c0 - p0 * s0; o1 = v1 * c1 - p1 * s1; } else { o0 = p0 * s0 + v0 * c0; o1 = p1 * s1 + v1 * c1; }
                    u32x4 w; w.x = pk2(o0[0], o0[1]); w.y = pk2(o0[2], o0[3]); w.z = pk2(o1[0], o1[1]); w.w = pk2(o1[2], o1[3]);
                    bf16_t* kb = KB + (size_t)row * 768 + 64 + 8 * fq;
#pragma unroll
                    for (int h = 0; h < 8; ++h) *(u32x4*)(kb + h * 96) = w; } } } } };
struct EpiScale16 { bf16_t* O; int ldc; const float* ssq; float mul;
    __device__ __forceinline__ void operator()(EPI_ARGS) const {
        FOR_AI_M { const int row = u.pm * 256 + 128 * ai + 64 * wr + 16 * m + fr; const f32x4* sp = (const f32x4*)(ssq + (size_t)row * 16); const f32x4 t = (sp[0] + sp[1]) + (sp[2] + sp[3]);
            const float s = mul / sqrtf(((t[0] + t[1]) + (t[2] + t[3])) * (1.0f / 1024.0f) + EPS); bf16_t* rowp = O + (size_t)row * ldc + u.pn * 256 + 32 * wc + 8 * fq;
            FOR_BJ { const f32x4 v0 = acc[ai][bj][m][0] * s, v1 = acc[ai][bj][m][1] * s; u32x4 w; w.x = pk2(v0[0], v0[1]); w.y = pk2(v0[2], v0[3]); w.z = pk2(v1[0], v1[1]); w.w = pk2(v1[2], v1[3]);
                *(u32x4*)(rowp + 128 * bj) = w; } } } };
struct EpiQ { bf16_t* Q; const float* ssq; const float* rope;
    __device__ __forceinline__ void operator()(EPI_ARGS) const {
        FOR_AI_M { const int row = u.pm * 256 + 128 * ai + 64 * wr + 16 * m + fr; const f32x4 t = *(const f32x4*)(ssq + (size_t)row * 4); const float s = C2_MLA / sqrtf(((t[0] + t[1]) + (t[2] + t[3])) * (1.0f / 256.0f) + EPS);
            const f32x4 cs = *(const f32x4*)(rope + (size_t)row * 32 + 4 * fq), sn = *(const f32x4*)(rope + (size_t)row * 32 + 16 + 4 * fq);
            FOR_BJ { const int colg = u.pn * 256 + 128 * bj + 32 * wc; f32x4 v0 = acc[ai][bj][m][0] * s, v1 = acc[ai][bj][m][1] * s;
                if (((colg >> 5) % 3) == 2) { const f32x4 r0 = v0 * cs - v1 * sn, r1 = v0 * sn + v1 * cs; v0 = r0; v1 = r1; }
                bf16_t* rowp = Q + (size_t)row * 768 + colg + 4 * fq; u32x2 w0, w1; w0.x = pk2(v0[0], v0[1]); w0.y = pk2(v0[2], v0[3]); w1.x = pk2(v1[0], v1[1]); w1.y = pk2(v1[2], v1[3]);
                *(u32x2*)(rowp) = w0; *(u32x2*)(rowp + 16) = w1; } } } };
struct EpiKV { bf16_t* KB; bf16_t* VB; const float* ssq;
    __device__ __forceinline__ void operator()(EPI_ARGS) const {
        FOR_AI_M { const int row = u.pm * 256 + 128 * ai + 64 * wr + 16 * m + fr; const f32x4 t = *(const f32x4*)(ssq + (size_t)row * 4); const float s = 1.0f / sqrtf(((t[0] + t[1]) + (t[2] + t[3])) * (1.0f / 128.0f) + EPS);
            FOR_BJ { const int h = 2 * u.pn + bj, cl = 32 * wc + 8 * fq; const f32x4 v0 = acc[ai][bj][m][0] * s, v1 = acc[ai][bj][m][1] * s;
                u32x4 w; w.x = pk2(v0[0], v0[1]); w.y = pk2(v0[2], v0[3]); w.z = pk2(v1[0], v1[1]); w.w = pk2(v1[2], v1[3]);
                if (wc < 2) *(u32x4*)(KB + (size_t)row * 768 + h * 96 + cl) = w; else *(u32x4*)(VB + (size_t)row * 512 + h * 64 + cl - 64) = w; } } } };
struct EpiResid { const float* base; float* out; bf16_t* ob; float* ssq;
    __device__ __forceinline__ void operator()(EPI_ARGS) const {
        FOR_AI_M { const int row = u.pm * 256 + 128 * ai + 64 * wr + 16 * m + fr; float q = 0.f;
            FOR_BJ {
#pragma unroll
                for (int n = 0; n < 2; ++n) { const size_t off = (size_t)row * 1024 + u.pn * 256 + 128 * bj + 32 * wc + 16 * n + 4 * fq;
                    const f32x4 v = *(const f32x4*)(base + off) + acc[ai][bj][m][n]; *(f32x4*)(out + off) = v; u32x2 w; w.x = pk2(v[0], v[1]); w.y = pk2(v[2], v[3]); *(u32x2*)(ob + off) = w;
                    q += (v[0] * v[0] + v[1] * v[1]) + (v[2] * v[2] + v[3] * v[3]); } }
            q += __shfl_xor(q, 16); q += __shfl_xor(q, 32); if (fq == 0) ssq[(size_t)row * 16 + u.pn * 4 + wc] = q; } } };
struct EpiKVMem { bf16_t* KM; bf16_t* VMT; const float* rs;
    __device__ __forceinline__ void operator()(EPI_ARGS) const {
        FOR_AI_M { const int row = u.pm * 256 + 128 * ai + 64 * wr + 16 * m + fr; const float s = rs[row];
            FOR_BJ {
#pragma unroll
                for (int n = 0; n < 2; ++n) { const int col = u.pn * 256 + 128 * bj + 32 * wc + 16 * n + 4 * fq; const f32x4 v = acc[ai][bj][m][n] * s;
                    if (u.pn < 4) { u32x2 w; w.x = pk2(v[0], v[1]); w.y = pk2(v[2], v[3]); *(u32x2*)(KM + (size_t)row * 1024 + col) = w; }
                    else { const int c2 = col - 1024, h = c2 >> 8, d = c2 & 255, b = row >> 8, mm = row & 255; bf16_t* dst = VMT + ((size_t)(b * 4 + h) * 256 + d) * 256 + mm;
#pragma unroll
                        for (int j = 0; j < 4; ++j) dst[(size_t)j * 256] = (bf16_t)f2bf(v[j]); } } } } } };
struct EpiSoftmaxP { bf16_t* Pm;
    __device__ __forceinline__ void operator()(EPI_ARGS) const {
        LAS float* red = (LAS float*)lds; float rmax[2][4];
        FOR_AI_M { float mx = -3.0e38f;
            FOR_BJ {
#pragma unroll
                for (int n = 0; n < 2; ++n)
#pragma unroll
                    for (int j = 0; j < 4; ++j) mx = fmaxf(mx, acc[ai][bj][m][n][j]); }
            mx = fmaxf(mx, __shfl_xor(mx, 16)); mx = fmaxf(mx, __shfl_xor(mx, 32));
            if (fq == 0) red[(128 * ai + 64 * wr + 16 * m + fr) * 4 + wc] = mx; }
        EPI_BAR();
        FOR_AI_M { const f32x4 t = *(const LAS f32x4*)(red + (128 * ai + 64 * wr + 16 * m + fr) * 4); rmax[ai][m] = fmaxf(fmaxf(t[0], t[1]), fmaxf(t[2], t[3])); }
        EPI_BAR();
        FOR_AI_M { float s = 0.f;
            FOR_BJ {
#pragma unroll
                for (int n = 0; n < 2; ++n)
#pragma unroll
                    for (int j = 0; j < 4; ++j) { const float e = fast_exp2(acc[ai][bj][m][n][j] - rmax[ai][m]); acc[ai][bj][m][n][j] = e; s += e; } }
            s += __shfl_xor(s, 16); s += __shfl_xor(s, 32);
            if (fq == 0) red[(128 * ai + 64 * wr + 16 * m + fr) * 4 + wc] = s; }
        EPI_BAR();
        FOR_AI_M { const int r = 128 * ai + 64 * wr + 16 * m + fr; const f32x4 t = *(const LAS f32x4*)(red + r * 4); const float inv = 1.0f / ((t[0] + t[1]) + (t[2] + t[3]));
            bf16_t* rowp = Pm + ((size_t)u.z * 2048 + u.pm * 256 + r) * 256 + 32 * wc + 8 * fq;
            FOR_BJ { const f32x4 v0 = acc[ai][bj][m][0] * inv, v1 = acc[ai][bj][m][1] * inv; u32x4 w; w.x = pk2(v0[0], v0[1]); w.y = pk2(v0[2], v0[3]); w.z = pk2(v1[0], v1[1]); w.w = pk2(v1[2], v1[3]);
                *(u32x4*)(rowp + 128 * bj) = w; } }
        EPI_BAR();
    } };
struct EpiOX { bf16_t* OX;
    __device__ __forceinline__ void operator()(EPI_ARGS) const {
        FOR_AI_M { const int r = 128 * ai + 64 * wr + 16 * m + fr; bf16_t* rowp = OX + (size_t)((u.z >> 2) * 2048 + u.pm * 256 + r) * 1024 + (u.z & 3) * 256 + 32 * wc + 8 * fq;
            FOR_BJ { const f32x4 v0 = acc[ai][bj][m][0], v1 = acc[ai][bj][m][1]; u32x4 w; w.x = pk2(v0[0], v0[1]); w.y = pk2(v0[2], v0[3]); w.z = pk2(v1[0], v1[1]); w.w = pk2(v1[2], v1[3]);
                *(u32x4*)(rowp + 128 * bj) = w; } } } };
struct EpiSwiglu { bf16_t* ACT; const float* slot_rs; const int* tile_e; const float* b_up;
    __device__ __forceinline__ void operator()(EPI_ARGS) const {
        const int e = tile_e[u.pm]; const int cl = 32 * wc + 8 * fq; const float* bg = b_up + (size_t)e * 2048 + u.pn * 128 + cl; const float* bl = bg + 1024;
        const f32x4 bg0 = *(const f32x4*)bg, bg1 = *(const f32x4*)(bg + 4), bl0 = *(const f32x4*)bl, bl1 = *(const f32x4*)(bl + 4);
        FOR_AI_M { const int slot = u.pm * 256 + 128 * ai + 64 * wr + 16 * m + fr; const float s = slot_rs[slot];
            float o[8];
#pragma unroll
            for (int n = 0; n < 2; ++n)
#pragma unroll
                for (int j = 0; j < 4; ++j) { float g = acc[ai][0][m][n][j] * s + (n ? bg1[j] : bg0[j]); float l = acc[ai][1][m][n][j] * s + (n ? bl1[j] : bl0[j]);
                    g = fminf(g, 7.0f); l = fminf(fmaxf(l, -7.0f), 7.0f); o[4 * n + j] = g * sigmoidf_(1.702f * g) * (l + 1.0f); }
            u32x4 w; w.x = pk2(o[0], o[1]); w.y = pk2(o[2], o[3]); w.z = pk2(o[4], o[5]); w.w = pk2(o[6], o[7]);
            *(u32x4*)(ACT + (size_t)slot * 1024 + u.pn * 128 + cl) = w; } } };
struct EpiDown { bf16_t* YB; const float* gate; const int* tile_e; const float* b_down;
    __device__ __forceinline__ void operator()(EPI_ARGS) const {
        const int e = tile_e[u.pm]; const int c0 = u.pn * 256 + 32 * wc + 8 * fq; f32x4 bv[2][2];
        FOR_BJ { bv[bj][0] = *(const f32x4*)(b_down + (size_t)e * 1024 + c0 + 128 * bj); bv[bj][1] = *(const f32x4*)(b_down + (size_t)e * 1024 + c0 + 128 * bj + 4); }
        FOR_AI_M { const int slot = u.pm * 256 + 128 * ai + 64 * wr + 16 * m + fr; const float g = gate[slot];
            FOR_BJ { const f32x4 v0 = (acc[ai][bj][m][0] + bv[bj][0]) * g, v1 = (acc[ai][bj][m][1] + bv[bj][1]) * g; u32x4 w; w.x = pk2(v0[0], v0[1]); w.y = pk2(v0[2], v0[3]); w.z = pk2(v1[0], v1[1]); w.w = pk2(v1[2], v1[3]);
                *(u32x4*)(YB + (size_t)slot * 1024 + c0 + 128 * bj) = w; } } } };


namespace pg8 {
constexpr int BK = 64, HALF = 128, HTB = HALF * BK * 2, STAGE_BYTES = 8 * HTB;
__device__ __forceinline__ int lds_byte(int r, int c) { const int st = (r >> 4) * 2 + (c >> 5), rr = r & 15, cc = c & 31, ob = rr * 64 + cc * 2; return st * 1024 + (ob ^ (((ob >> 9) & 1) << 5)); }
__device__ __forceinline__ void stage_rc(int b, int& R, int& C) { const int st = b / 1024, sb = b % 1024, swz = sb ^ (((sb >> 9) & 1) << 5); R = (st >> 1) * 16 + swz / 64; C = (st & 1) * 32 + (swz % 64) / 2; }

template <bool PERM, class Prov, class Sched, class Epi>
__device__ __forceinline__ void gemm_phase(LAS unsigned char* lds, LAS unsigned char* lds_epi, const Prov& P, const Sched& S, const Epi& E, int tid) {
    const int wid = __builtin_amdgcn_readfirstlane(tid >> 6), lane = tid & 63, wr = wid >> 2, wc = wid & 3, fr = lane & 15, fq = lane >> 4;
    const int K = P.K, nt = K / BK;
    unsigned voffA[2], voffB[2];
#pragma unroll
    for (int i = 0; i < 2; ++i) { int R, C; stage_rc(tid * 16 + i * 8192, R, C); const int Rb = PERM ? ((R & ~31) + perm32(R & 31)) : R;
        voffA[i] = (unsigned)(R * P.lda + C) * 2u; voffB[i] = (unsigned)(Rb * P.ldb + C) * 2u; }
    const size_t kstep = (size_t)(BK * 2);
    const size_t hstepA = (size_t)HALF * P.lda * 2, hstepB = (size_t)HALF * P.ldb * 2;
    const unsigned ldsw = (unsigned)wid * 1024u;
    const int aoff = lds_byte(wr * 64 + fr, fq * 8), boff = lds_byte(wc * 32 + fr, fq * 8);
#define PG8_SA(b, h) (((b) * 2 + (h)) * HTB)
#define PG8_SB(b, h) ((4 + (b) * 2 + (h)) * HTB)
#define PG8_STAGE(bufoff, gbase, voff) do { _Pragma("unroll") for (int _i = 0; _i < 2; ++_i) \
        __builtin_amdgcn_global_load_lds((const unsigned*)((const char*)(gbase) + (voff)[_i]), (LAS unsigned*)(lds + (bufoff) + ldsw + _i * 8192), 16, 0, 0); } while (0)
#define PG8_LDA(dst, b, h) do { _Pragma("unroll") for (int m = 0; m < 4; ++m) _Pragma("unroll") for (int k = 0; k < 2; ++k) dst[m][k] = *(const LAS bf16x8*)(lds + PG8_SA(b, h) + aoff + m * 2048 + k * 1024); } while (0)
#define PG8_LDB(dst, b, h) do { _Pragma("unroll") for (int n = 0; n < 2; ++n) _Pragma("unroll") for (int k = 0; k < 2; ++k) dst[n][k] = *(const LAS bf16x8*)(lds + PG8_SB(b, h) + boff + n * 2048 + k * 1024); } while (0)
#define PG8_MMA(ai, bj, At, Bt) do { __builtin_amdgcn_s_setprio(1); _Pragma("unroll") for (int m = 0; m < 4; ++m) _Pragma("unroll") for (int n = 0; n < 2; ++n) _Pragma("unroll") for (int k = 0; k < 2; ++k) \
        acc[ai][bj][m][n] = __builtin_amdgcn_mfma_f32_16x16x32_bf16(Bt[n][k], At[m][k], acc[ai][bj][m][n], 0, 0, 0); __builtin_amdgcn_s_setprio(0); } while (0)
#define PG8_WAIT_V(n) asm volatile("s_waitcnt vmcnt(" #n ")" ::: "memory")
#define PG8_WAIT_L(n) asm volatile("s_waitcnt lgkmcnt(" #n ")" ::: "memory")
#define PG8_BAR __builtin_amdgcn_s_barrier()
#define PG8_SCHED __builtin_amdgcn_sched_barrier(0)
    Unit cur, nxt; int ui = 0;
    if (!S.next(0, cur)) return;
    Acc acc;
#pragma unroll
    for (int a = 0; a < 2; ++a)
#pragma unroll
        for (int b = 0; b < 2; ++b)
#pragma unroll
            for (int m = 0; m < 4; ++m)
#pragma unroll
                for (int n = 0; n < 2; ++n) acc[a][b][m][n] = (f32x4){0.f, 0.f, 0.f, 0.f};
    bf16x8 At[4][2], B0[2][2], B1[2][2];
    const char* cA = (const char*)P.a_base(cur); const char* cB = (const char*)P.b_base(cur);
    PG8_STAGE(PG8_SB(0, 0), cB, voffB); PG8_STAGE(PG8_SB(0, 1), cB + hstepB, voffB); PG8_STAGE(PG8_SA(0, 0), cA, voffA); PG8_STAGE(PG8_SA(0, 1), cA + hstepA, voffA);
    if (wr == 1) PG8_BAR;
    PG8_WAIT_V(2); PG8_BAR;
    PG8_STAGE(PG8_SB(1, 0), cB + kstep, voffB); PG8_STAGE(PG8_SA(1, 0), cA + kstep, voffA); PG8_STAGE(PG8_SB(1, 1), cB + hstepB + kstep, voffB);
    PG8_WAIT_V(6); PG8_BAR;
    for (;;) {
        const bool has_next = S.next(ui + 1, nxt);
        const char* nA = has_next ? (const char*)P.a_base(nxt) : cA; const char* nB = has_next ? (const char*)P.b_base(nxt) : cB;
        for (int t = 0; t < nt; t += 2) {
            const bool last = (t == nt - 2);
            const char* a1 = cA + (size_t)(t + 1) * kstep;
            const char* a2 = last ? nA : cA + (size_t)(t + 2) * kstep; const char* b2 = last ? nB : cB + (size_t)(t + 2) * kstep;
            const char* a3 = a2 + kstep; const char* b3 = b2 + kstep;
            PG8_LDB(B0, 0, 0); PG8_LDB(B1, 0, 1); PG8_SCHED; PG8_LDA(At, 0, 0); PG8_STAGE(PG8_SA(1, 1), a1 + hstepA, voffA);
            PG8_WAIT_V(8); PG8_WAIT_L(0); PG8_BAR; PG8_MMA(0, 0, At, B0); PG8_MMA(0, 1, At, B1); PG8_BAR; PG8_SCHED;
            PG8_LDA(At, 0, 1); PG8_STAGE(PG8_SB(0, 0), b2, voffB); PG8_STAGE(PG8_SB(0, 1), b2 + hstepB, voffB); PG8_STAGE(PG8_SA(0, 0), a2, voffA);
            PG8_WAIT_V(8); PG8_WAIT_L(0); PG8_BAR; PG8_MMA(1, 0, At, B0); PG8_MMA(1, 1, At, B1); PG8_BAR; PG8_SCHED;
            PG8_LDB(B0, 1, 0); PG8_LDB(B1, 1, 1); PG8_SCHED; PG8_LDA(At, 1, 0); PG8_STAGE(PG8_SA(0, 1), a2 + hstepA, voffA);
            PG8_WAIT_V(8); PG8_WAIT_L(0); PG8_BAR; PG8_MMA(0, 0, At, B0); PG8_MMA(0, 1, At, B1); PG8_BAR; PG8_SCHED;
            PG8_LDA(At, 1, 1); PG8_STAGE(PG8_SB(1, 0), b3, voffB); PG8_STAGE(PG8_SB(1, 1), b3 + hstepB, voffB); PG8_STAGE(PG8_SA(1, 0), a3, voffA);
            PG8_WAIT_V(8); PG8_WAIT_L(0); PG8_BAR; PG8_MMA(1, 0, At, B0); PG8_MMA(1, 1, At, B1); PG8_BAR; PG8_SCHED;
        }
        if (wr == 0) PG8_BAR;
        E(acc, cur, wr, wc, fr, fq, lds_epi);
        if (!has_next) break;
#pragma unroll
        for (int a = 0; a < 2; ++a)
#pragma unroll
            for (int b = 0; b < 2; ++b)
#pragma unroll
                for (int m = 0; m < 4; ++m)
#pragma unroll
                    for (int n = 0; n < 2; ++n) acc[a][b][m][n] = (f32x4){0.f, 0.f, 0.f, 0.f};
        cur = nxt; cA = nA; cB = nB; ++ui;
        if (wr == 1) PG8_BAR;
    }
    PG8_WAIT_V(0);
    PG8_BAR;
#undef PG8_SA
#undef PG8_SB
#undef PG8_STAGE
#undef PG8_LDA
#undef PG8_LDB
#undef PG8_MMA
#undef PG8_WAIT_V
#undef PG8_WAIT_L
#undef PG8_BAR
#undef PG8_SCHED
}
struct Order { int nM, nN, nwg, G, c;
    __device__ __forceinline__ void init(int nM_, int nN_, int G_, int c_) { nM = nM_; nN = nN_; nwg = nM * nN; G = G_; c = c_; }
    __device__ __forceinline__ bool next(int i, int& pm, int& pn) const {
        const long L = (long)i * G + c; if (L >= nwg) return false;
        int wgid = (int)L; { const int q = nwg / 8, r = nwg % 8, xcd = wgid % 8, off = wgid / 8; wgid = (xcd < r ? xcd * (q + 1) : r * (q + 1) + (xcd - r) * q) + off; }
        const int nig = 8 * nN, gid = wgid / nig, fm = gid * 8, gsz = (nM - fm) < 8 ? (nM - fm) : 8;
        pm = fm + ((wgid % nig) % gsz); pn = (wgid % nig) / gsz; return true; } };
struct SchedPlain { Order o; __device__ __forceinline__ bool next(int i, Unit& u) const { u.z = 0; return o.next(i, u.pm, u.pn); } };
struct SchedBatch8 { Order o; __device__ __forceinline__ bool next(int i, Unit& u) const { int pm, pn; if (!o.next(i, pm, pn)) return false; u.z = pm >> 3; u.pm = pm & 7; u.pn = 0; return true; } };
}

struct PvPlain { const bf16_t* A; const bf16_t* Bt; int lda, ldb, K;
    __device__ __forceinline__ const bf16_t* a_base(const Unit& u) const { return A + (size_t)u.pm * 256 * lda; }
    __device__ __forceinline__ const bf16_t* b_base(const Unit& u) const { return Bt + (size_t)u.pn * 256 * ldb; } };
struct PvXS { const bf16_t* XQ; const bf16_t* KM; int lda, ldb, K;
    __device__ __forceinline__ const bf16_t* a_base(const Unit& u) const { return XQ + (size_t)((u.z >> 2) * 2048 + u.pm * 256) * 1024 + (u.z & 3) * 256; }
    __device__ __forceinline__ const bf16_t* b_base(const Unit& u) const { return KM + (size_t)((u.z >> 2) * 256) * 1024 + (u.z & 3) * 256; } };
struct PvXPV { const bf16_t* Pm; const bf16_t* VMT; int lda, ldb, K;
    __device__ __forceinline__ const bf16_t* a_base(const Unit& u) const { return Pm + ((size_t)u.z * 2048 + u.pm * 256) * 256; }
    __device__ __forceinline__ const bf16_t* b_base(const Unit& u) const { return VMT + (size_t)u.z * 65536; } };
struct PvExp { const bf16_t* A; const bf16_t* WT; const int* tile_e; int lda, ldb, K, nrow;
    __device__ __forceinline__ const bf16_t* a_base(const Unit& u) const { return A + (size_t)u.pm * 256 * 1024; }
    __device__ __forceinline__ const bf16_t* b_base(const Unit& u) const { return WT + ((size_t)tile_e[u.pm] * nrow + u.pn * 256) * 1024; } };

constexpr int VT_LD = 72;
__device__ __forceinline__ void mla_unit(const Params& p, LAS unsigned char* lds, int unit, int tid) {
    const int lane = tid & 63, wid = tid >> 6, r32 = lane & 31, hi = lane >> 5;
    const int qb = unit & 7, h = (unit >> 3) & 7, b = unit >> 6;
    const bf16_t* Qg = (const bf16_t*)(p.ws + WS_Q); const bf16_t* Kg = (const bf16_t*)(p.ws + WS_KB); const bf16_t* Vg = (const bf16_t*)(p.ws + WS_VB);
    LAS bf16_t* vt = (LAS bf16_t*)lds;
    const size_t rowb = (size_t)b * SEQ;
    const int q0 = qb * 256 + wid * 32;
    bf16x8 qf[6];
#pragma unroll
    for (int s = 0; s < 6; ++s) qf[s] = *(const bf16x8*)(Qg + (rowb + q0 + r32) * 768 + h * 96 + 16 * s + 8 * hi);
    const int nt_blk = 4 * qb + 4, nt_me = 4 * qb + (wid >> 1) + 1;
    float mrun = -1.0e30f, lrun = 0.f; f32x16 o0 = {}, o1 = {};
    for (int t = 0; t < nt_blk; ++t) {
        __syncthreads();
        { const int kv = tid >> 3, dc = tid & 7; const bf16x8 v = *(const bf16x8*)(Vg + (rowb + 64 * t + kv) * 512 + h * 64 + 8 * dc);
#pragma unroll
            for (int e = 0; e < 8; ++e) vt[(8 * dc + e) * VT_LD + kv] = (bf16_t)v[e]; }
        __syncthreads();
        if (t < nt_me) {
            f32x16 sc[2];
#pragma unroll
            for (int kb = 0; kb < 2; ++kb) { f32x16 a = {};
                const bf16_t* kr = Kg + (rowb + 64 * t + 32 * kb + r32) * 768 + h * 96 + 8 * hi;
#pragma unroll
                for (int s = 0; s < 6; ++s) { const bf16x8 kf = *(const bf16x8*)(kr + 16 * s); a = __builtin_amdgcn_mfma_f32_32x32x16_bf16(kf, qf[s], a, 0, 0, 0); }
                sc[kb] = a; }
            float mx = sc[0][0];
#pragma unroll
            for (int r = 0; r < 16; ++r) { mx = fmaxf(mx, sc[0][r]); mx = fmaxf(mx, sc[1][r]); }
            mx = fmaxf(mx, __shfl_xor(mx, 32));
            const float mnew = fmaxf(mrun, mx), alpha = fast_exp2(mrun - mnew); mrun = mnew;
            float ls = 0.f; unsigned pw[2][8];
#pragma unroll
            for (int kb = 0; kb < 2; ++kb)
#pragma unroll
                for (int r = 0; r < 16; r += 2) { const float e0 = fast_exp2(sc[kb][r] - mnew), e1 = fast_exp2(sc[kb][r + 1] - mnew); const unsigned w = pk2(e0, e1); pw[kb][r >> 1] = w;
                    ls += __uint_as_float(w << 16) + __uint_as_float(w & 0xffff0000u); }
            lrun = lrun * alpha + ls;
#pragma unroll
            for (int r = 0; r < 16; ++r) { o0[r] *= alpha; o1[r] *= alpha; }
#pragma unroll
            for (int kb = 0; kb < 2; ++kb)
#pragma unroll
                for (int s2 = 0; s2 < 2; ++s2) {
                    u32x4 pu; pu.x = pw[kb][4 * s2 + 0]; pu.y = pw[kb][4 * s2 + 1]; pu.z = pw[kb][4 * s2 + 2]; pu.w = pw[kb][4 * s2 + 3];
                    const bf16x8 pf = __builtin_bit_cast(bf16x8, pu);
                    const int kv0 = 32 * kb + 16 * s2 + 4 * hi;
#pragma unroll
                    for (int db = 0; db < 2; ++db) { const LAS bf16_t* vr = vt + (32 * db + r32) * VT_LD + kv0;
                        const s16x4 lo = *(const LAS s16x4*)vr, hi4 = *(const LAS s16x4*)(vr + 8);
                        const bf16x8 vf = (bf16x8){lo[0], lo[1], lo[2], lo[3], hi4[0], hi4[1], hi4[2], hi4[3]};
                        if (db == 0) o0 = __builtin_amdgcn_mfma_f32_32x32x16_bf16(vf, pf, o0, 0, 0, 0); else o1 = __builtin_amdgcn_mfma_f32_32x32x16_bf16(vf, pf, o1, 0, 0, 0); } }
        }
    }
    lrun += __shfl_xor(lrun, 32);
    const float inv = 1.0f / lrun;
    bf16_t* yo = (bf16_t*)(p.ws + WS_YCAT) + (rowb + q0 + r32) * 1024 + h * 64;
#pragma unroll
    for (int g = 0; g < 4; ++g) { u32x2 w0, w1; w0.x = pk2(o0[4 * g] * inv, o0[4 * g + 1] * inv); w0.y = pk2(o0[4 * g + 2] * inv, o0[4 * g + 3] * inv);
        w1.x = pk2(o1[4 * g] * inv, o1[4 * g + 1] * inv); w1.y = pk2(o1[4 * g + 2] * inv, o1[4 * g + 3] * inv);
        *(u32x2*)(yo + 8 * g + 4 * hi) = w0; *(u32x2*)(yo + 32 + 8 * g + 4 * hi) = w1; }
}

__device__ __forceinline__ void conv_unit(const Params& p, LAS unsigned char* lds, int unit, int tid) {
    const int lane = tid & 63, wid = tid >> 6, c = tid;
    const int b = unit >> 6, t0 = (unit & 63) * 32;
    LAS float* cl = (LAS float*)lds;
    LAS float* wl = (LAS float*)(lds + 65536);
    const __amdgpu_buffer_rsrc_t wr_ = __builtin_amdgcn_make_buffer_rsrc((void*)p.w_dw, 0, 31 * 512 * 4, 0x00020000);
#pragma unroll
    for (int j = 0; j < 31; ++j) wl[j * 512 + c] = __uint_as_float(__builtin_amdgcn_raw_buffer_load_b32(wr_, c * 4, j * 2048, 0));
    const __amdgpu_buffer_rsrc_t ur = __builtin_amdgcn_make_buffer_rsrc((void*)(p.ws + WS_U), 0, (int)((size_t)NTOK * INP * 2), 0x00020000);
    const int va = (416 + c) * 2, vg = (928 + c) * 2;
    float z[62];
#pragma unroll
    for (int i = 0; i < 62; ++i) { const int t = t0 - 30 + i;
        if (t >= 0) { const int so = (b * SEQ + t) * (INP * 2);
            const float a = bf2f(__builtin_amdgcn_raw_buffer_load_b16(ur, va, so, 0)), g = bf2f(__builtin_amdgcn_raw_buffer_load_b16(ur, vg, so, 0)); z[i] = a * sigmoidf_(g); } else z[i] = 0.f; }
    float acc[32]; const float bias = p.b_dw[c];
#pragma unroll
    for (int o = 0; o < 32; ++o) acc[o] = bias;
#pragma unroll
    for (int j = 0; j < 31; ++j) { const float wj = wl[j * 512 + c];
#pragma unroll
        for (int o = 0; o < 32; ++o) acc[o] += wj * z[o + j]; }
#pragma unroll
    for (int o = 0; o < 32; ++o) cl[o * 512 + c] = acc[o];
    __syncthreads();
#pragma unroll
    for (int oo = 0; oo < 4; ++oo) { const int o = wid * 4 + oo; const LAS float* r = cl + o * 512 + lane * 8;
        const f32x4 v0 = *(const LAS f32x4*)r, v1 = *(const LAS f32x4*)(r + 4);
        float s = (v0[0] + v0[1]) + (v0[2] + v0[3]) + (v1[0] + v1[1]) + (v1[2] + v1[3]); s = wave_sum(s); const float mu = s * (1.0f / 512.0f);
        const f32x4 d0 = v0 - mu, d1 = v1 - mu; float q = (d0[0] * d0[0] + d0[1] * d0[1]) + (d0[2] * d0[2] + d0[3] * d0[3]) + (d1[0] * d1[0] + d1[1] * d1[1]) + (d1[2] * d1[2] + d1[3] * d1[3]);
        q = wave_sum(q); const float rstd = 1.0f / sqrtf(q * (1.0f / 512.0f) + EPS);
        const f32x4 g0 = *(const f32x4*)(p.g_cln + lane * 8), g1 = *(const f32x4*)(p.g_cln + lane * 8 + 4), b0 = *(const f32x4*)(p.b_cln + lane * 8), b1 = *(const f32x4*)(p.b_cln + lane * 8 + 4);
        float y[8];
#pragma unroll
        for (int j = 0; j < 4; ++j) { const float a0 = d0[j] * rstd * g0[j] + b0[j], a1 = d1[j] * rstd * g1[j] + b1[j]; y[j] = a0 * sigmoidf_(a0); y[4 + j] = a1 * sigmoidf_(a1); }
        u32x4 wv; wv.x = pk2(y[0], y[1]); wv.y = pk2(y[2], y[3]); wv.z = pk2(y[4], y[5]); wv.w = pk2(y[6], y[7]);
        *(u32x4*)((bf16_t*)(p.ws + WS_YCAT) + ((size_t)b * SEQ + t0 + o) * 1024 + 512 + lane * 8) = wv; }
    __syncthreads();
}

__device__ __forceinline__ void router1_unit(const Params& p, LAS unsigned char* lds, int unit, int tid) {
    LAS float* lg = (LAS float*)lds;
    LAS int* hist = (LAS int*)(lds + 2048);
    const float* WR = (const float*)(p.ws + WS_WR); const float* ssq = (const float*)(p.ws + WS_SSQ_X2);
    if (tid < 32) hist[tid] = 0;
    __syncthreads();
    const int e = tid & 31, tl = tid >> 5;
    for (int it = 0; it < RT_TOK / 16; ++it) {
        const int tok = unit * RT_TOK + it * 16 + tl;
        const float* xr = p.out + (size_t)tok * 1024;
        float a0 = 0.f, a1 = 0.f, a2 = 0.f, a3 = 0.f;
#pragma unroll 4
        for (int k = 0; k < 1024; k += 4) { const f32x4 xv = *(const f32x4*)(xr + k);
            a0 += xv[0] * WR[(k + 0) * 32 + e]; a1 += xv[1] * WR[(k + 1) * 32 + e]; a2 += xv[2] * WR[(k + 2) * 32 + e]; a3 += xv[3] * WR[(k + 3) * 32 + e]; }
        const f32x4* sp = (const f32x4*)(ssq + (size_t)tok * 16); const f32x4 tq = (sp[0] + sp[1]) + (sp[2] + sp[3]); const float rstd = 1.0f / sqrtf(((tq[0] + tq[1]) + (tq[2] + tq[3])) * (1.0f / 1024.0f) + EPS);
        if (e == 0) ((float*)(p.ws + WS_RSTD_X2))[tok] = rstd;
        lg[tl * 32 + e] = ((a0 + a1) + (a2 + a3)) * rstd + p.b_router[e];
        __syncthreads();
        if (tid < 16) { const int tk = unit * RT_TOK + it * 16 + tid; unsigned used = 0u; float tv[4]; int ti[4];
#pragma unroll
            for (int k = 0; k < 4; ++k) { float best = -3.0e38f; int bi = 0;
                for (int j = 0; j < 32; ++j) { const float v = lg[tid * 32 + j]; if (!((used >> j) & 1u) && v > best) { best = v; bi = j; } }
                used |= 1u << bi; tv[k] = best; ti[k] = bi; }
            const float e1 = __expf(tv[1] - tv[0]), e2 = __expf(tv[2] - tv[0]), e3 = __expf(tv[3] - tv[0]); const float inv = 1.0f / (1.0f + e1 + e2 + e3);
            int* oi = (int*)(p.ws + WS_TOPI) + (size_t)tk * 4; float* og = (float*)(p.ws + WS_TOPG) + (size_t)tk * 4;
            oi[0] = ti[0]; oi[1] = ti[1]; oi[2] = ti[2]; oi[3] = ti[3]; og[0] = inv; og[1] = e1 * inv; og[2] = e2 * inv; og[3] = e3 * inv;
#pragma unroll
            for (int k = 0; k < 4; ++k) atomicAdd((int*)&hist[ti[k]], 1); }
        __syncthreads();
    }
    if (tid < 32) ((int*)(p.ws + WS_HIST))[unit * 32 + tid] = hist[tid];
}
__device__ __forceinline__ void router2_unit(const Params& p, LAS unsigned char* lds, int unit, int tid) {
    LAS int* cnt = (LAS int*)lds;
    LAS int* base = cnt + 32;
    LAS int* pst = cnt + 64;
    LAS int* idx = cnt + 128;
    LAS int* dst = cnt + 128 + 512;
    const int* H = (const int*)(p.ws + WS_HIST);
    if (tid < 32) { int tot = 0, bs = 0; for (int b = 0; b < RT_UNITS; ++b) { const int v = H[b * 32 + tid]; tot += v; bs += (b < unit) ? v : 0; } cnt[tid] = tot; base[tid] = bs; }
    { idx[tid] = ((const int*)(p.ws + WS_TOPI))[(size_t)unit * RT_TOK * 4 + tid]; }
    __syncthreads();
    if (tid == 0) { int s = 0; for (int e = 0; e < 32; ++e) { pst[e] = s; s += (cnt[e] + 255) & ~255; } pst[32] = s; }
    __syncthreads();
    if (tid < 32) { int run = pst[tid] + base[tid]; for (int a = 0; a < 512; ++a) if (idx[a] == tid) { dst[a] = run; ++run; } }
    __syncthreads();
    { const int a = tid, d = dst[a]; const int tok = unit * RT_TOK + (a >> 2);
        ((int*)(p.ws + WS_SLOT_TOK))[d] = tok; ((float*)(p.ws + WS_SLOT_GATE))[d] = ((const float*)(p.ws + WS_TOPG))[(size_t)unit * RT_TOK * 4 + a];
        ((int*)(p.ws + WS_INV))[(size_t)unit * RT_TOK * 4 + a] = d; ((float*)(p.ws + WS_SLOT_RS))[d] = ((const float*)(p.ws + WS_RSTD_X2))[tok]; }
    { const int wid = tid >> 6, lane = tid & 63;
      for (int a = wid; a < 512; a += 8) { const int d = dst[a]; const int tok = unit * RT_TOK + (a >> 2);
        const u32x4* src = (const u32x4*)((const bf16_t*)(p.ws + WS_X2B) + (size_t)tok * 1024); u32x4* dp = (u32x4*)((bf16_t*)(p.ws + WS_XG) + (size_t)d * 1024);
        const u32x4 v0 = src[lane], v1 = src[lane + 64]; dp[lane] = v0; dp[lane + 64] = v1; } }
    if (unit < 32) { const int e = unit, s0 = pst[e] + cnt[e], s1 = pst[e + 1];
        for (int s = s0 + tid; s < s1; s += 512) { ((int*)(p.ws + WS_SLOT_TOK))[s] = 0; ((float*)(p.ws + WS_SLOT_GATE))[s] = 0.f; ((float*)(p.ws + WS_SLOT_RS))[s] = 0.f; } }
    if (unit == 32) { int* te = (int*)(p.ws + WS_TILE_E); const int nt = pst[32] >> 8;
        for (int t = tid; t < NTILE_MAX; t += 512) { int e = 31; for (int k = 31; k >= 0; --k) if (t * 256 < pst[k + 1]) e = k; te[t] = e; }
        if (tid == 0) te[NTILE_MAX] = nt; }
    __syncthreads();
}

__device__ __forceinline__ void final_row(const Params& p, int tok, int lane) {
    float* xr = p.out + (size_t)tok * 1024; const int* inv = (const int*)(p.ws + WS_INV) + (size_t)tok * 4; const bf16_t* YB = (const bf16_t*)(p.ws + WS_YB);
    f32x4 v[4];
#pragma unroll
    for (int j = 0; j < 4; ++j) v[j] = ((const f32x4*)xr)[lane + 64 * j];
#pragma unroll
    for (int k = 0; k < 4; ++k) { const u32x2* yr = (const u32x2*)(YB + (size_t)inv[k] * 1024);
#pragma unroll
        for (int j = 0; j < 4; ++j) { const u32x2 w = yr[lane + 64 * j]; v[j][0] += __uint_as_float(w.x << 16); v[j][1] += __uint_as_float(w.x & 0xffff0000u); v[j][2] += __uint_as_float(w.y << 16); v[j][3] += __uint_as_float(w.y & 0xffff0000u); } }
    float s = 0.f;
#pragma unroll
    for (int j = 0; j < 4; ++j) s += (v[j][0] * v[j][0] + v[j][1] * v[j][1]) + (v[j][2] * v[j][2] + v[j][3] * v[j][3]);
    s = wave_sum(s); const float rstd = 1.0f / sqrtf(s * (1.0f / 1024.0f) + EPS);
#pragma unroll
    for (int j = 0; j < 4; ++j) { const f32x4 g = ((const f32x4*)p.g_final)[lane + 64 * j]; ((f32x4*)xr)[lane + 64 * j] = v[j] * rstd * g; }
}


#define XB_TMO      128
#define XB_XCNT(j)  (256  + 64 * (j))
#define XB_XSUB(j)  (1280 + 64 * (j))
#define XB_XGEN(j)  (2304 + 64 * (j))
#define XB_TOP      3328
#define XB_TOPGEN   3392
#define XCD_BAR_WORDS 3456
#define XB_SPIN_CAP (1u << 18)
__device__ __forceinline__ unsigned xb_ld(unsigned* p)              { return __hip_atomic_load(p, __ATOMIC_RELAXED, __HIP_MEMORY_SCOPE_AGENT); }
__device__ __forceinline__ unsigned xb_add(unsigned* p, unsigned v) { return __hip_atomic_fetch_add(p, v, __ATOMIC_RELAXED, __HIP_MEMORY_SCOPE_AGENT); }
__device__ __forceinline__ unsigned xb_xcc_id() { return (unsigned)__builtin_amdgcn_s_getreg((3 << 11) | 20) & 0xFu; }
#define XB_SPIN(cond, bar) do { unsigned _sp = 0; while (cond) { __builtin_amdgcn_s_sleep(1); \
    if ((++_sp & 255u) == 0u) { if (xb_ld(&(bar)[XB_TMO])) break; if (_sp > XB_SPIN_CAP) { atomicAdd(&(bar)[XB_TMO], 1u); break; } } } } while (0)
struct XcdBarrier { unsigned* bar; unsigned x; volatile LAS unsigned* st; };
__device__ __forceinline__ XcdBarrier xcd_barrier_post(unsigned* bar, volatile LAS unsigned* st) {
    XcdBarrier b; b.bar = bar; b.x = xb_xcc_id(); b.st = st;
    if (threadIdx.x == 0) (void)xb_add(&bar[XB_XCNT(b.x)], 1u);
    return b;
}
__device__ __forceinline__ void xcd_barrier_complete(unsigned* bar, unsigned x, unsigned& nloc, unsigned& nx) {
    const unsigned G = gridDim.x * gridDim.y * gridDim.z;
    unsigned sum, cnt, mine, sp = 0u;
    for (;;) {
        sum = 0u; cnt = 0u; mine = 0u;
#pragma unroll
        for (unsigned j = 0; j < 16; ++j) { const unsigned c = xb_ld(&bar[XB_XCNT(j)]); sum += c; cnt += (c > 0u) ? 1u : 0u; mine = (j == x) ? c : mine; }
        if (sum == G) break;
        __builtin_amdgcn_s_sleep(1);
        if ((++sp & 255u) == 0u) { if (xb_ld(&bar[XB_TMO])) break; if (sp > XB_SPIN_CAP) { atomicAdd(&bar[XB_TMO], 1u); break; } }
    }
    nloc = mine > 0u ? mine : 1u; nx = cnt > 0u ? cnt : 1u;
}
__device__ __forceinline__ void xcd_barrier(const XcdBarrier& b) {
    asm volatile("s_waitcnt vmcnt(0)" ::: "memory");
    __syncthreads();
    if (threadIdx.x == 0) {
        unsigned* bar = b.bar;
        __builtin_amdgcn_s_waitcnt(0);
        unsigned nloc = b.st[0], nx = b.st[1];
        if (nloc == 0u) { xcd_barrier_complete(bar, b.x, nloc, nx); b.st[0] = nloc; b.st[1] = nx; }
        const unsigned old = xb_add(&bar[XB_XSUB(b.x)], 1u);
        const unsigned gen = old / nloc;
        if (old + 1u == (gen + 1u) * nloc) {
            __builtin_amdgcn_fence(__ATOMIC_RELEASE, "agent");
            asm volatile("s_waitcnt vmcnt(0)" ::: "memory");
            const unsigned og = xb_add(&bar[XB_TOP], 1u);
            const unsigned tg = og / nx;
            if (og + 1u == (tg + 1u) * nx) xb_add(&bar[XB_TOPGEN], 1u);
            else XB_SPIN(xb_ld(&bar[XB_TOPGEN]) == tg, bar);
            __builtin_amdgcn_fence(__ATOMIC_ACQUIRE, "agent");
            xb_add(&bar[XB_XGEN(b.x)], 1u);
            asm volatile("s_waitcnt vmcnt(0)" ::: "memory");
        } else {
            XB_SPIN(xb_ld(&bar[XB_XGEN(b.x)]) == gen, bar);
            __builtin_amdgcn_fence(__ATOMIC_ACQUIRE, "agent");
            asm volatile("s_waitcnt vmcnt(0)" ::: "memory");
        }
    }
    __syncthreads();
}

constexpr int EPI_LDS = 131072;
constexpr int LDS_BYTES = 147456;
#ifndef USE_CG_SYNC
#define USE_CG_SYNC 0
#endif
#if USE_CG_SYNC
#define GRID_SYNC() grid.sync()
#else
#define GRID_SYNC() xcd_barrier(xbar)
#endif
constexpr int XB_LDS = 147328;

__device__ __forceinline__ void mla_order(int vb, int r, int& unit) {
    const int bh = vb >> 1, s = vb & 1; const int qb = (r == 0) ? s : (r == 1) ? 7 - s : (r == 2) ? 3 - s : 4 + s; unit = bh * 8 + qb;
}

typedef const __attribute__((address_space(4))) Params* CParams;
#define PHASE_BEGIN() CParams pp_ = (CParams)__builtin_amdgcn_kernarg_segment_ptr(); asm volatile("" : "+s"(pp_)); Params p; { const __attribute__((address_space(4))) unsigned long long* q_ = (const __attribute__((address_space(4))) unsigned long long*)pp_; unsigned long long* d_ = (unsigned long long*)&p; _Pragma("unroll") for (int k_ = 0; k_ < (int)(sizeof(Params) / 8); ++k_) d_[k_] = q_[k_]; } unsigned char* ws = p.ws; int tid = threadIdx.x; asm volatile("" : "+v"(tid)); const int lane = tid & 63; (void)lane; (void)ws;

__global__ void __launch_bounds__(512) mega_kernel(Params p_unused) {
    extern __shared__ __attribute__((aligned(16))) unsigned char lds_raw[];
#if USE_CG_SYNC
    cg::grid_group grid = cg::this_grid();
#endif
    LAS unsigned char* lds = (LAS unsigned char*)lds_raw;
    if (threadIdx.x < 2) ((volatile LAS unsigned*)(lds + XB_LDS))[threadIdx.x] = 0u;
    __syncthreads();
    const XcdBarrier xbar = xcd_barrier_post((unsigned*)(((CParams)__builtin_amdgcn_kernarg_segment_ptr())->ws + WS_CTL), (volatile LAS unsigned*)(lds + XB_LDS)); (void)xbar;
    const int G = gridDim.x, bx = blockIdx.x;
    const int vb = (G % 8 == 0) ? (bx % 8) * (G / 8) + bx / 8 : bx;

    { PHASE_BEGIN(); prep_stage(p, lds, vb, G, tid); }
    GRID_SYNC();
    { PHASE_BEGIN();
      { PvPlain P{(const bf16_t*)(ws + WS_XB), (const bf16_t*)(ws + WS_WT_IN), 1024, 1024, 1024}; pg8::SchedPlain S; S.o.init(128, 6, G, bx);
        EpiIn E{(bf16_t*)(ws + WS_U), (const float*)(ws + WS_RSTD_X), (float*)(ws + WS_SSQ_Q), (float*)(ws + WS_SSQ_KV), (const float*)(ws + WS_ROPE), (bf16_t*)(ws + WS_KB)};
        pg8::gemm_phase<true>(lds, lds + EPI_LDS, P, S, E, tid); }
      { PvPlain P{(const bf16_t*)(ws + WS_MEMB), (const bf16_t*)(ws + WS_WT_XKV), 1024, 1024, 1024}; pg8::SchedPlain S; S.o.init(16, 8, G, (bx + 128) % G);
        EpiKVMem E{(bf16_t*)(ws + WS_KM), (bf16_t*)(ws + WS_VMT), (const float*)(ws + WS_RSTD_MEM)};
        pg8::gemm_phase<false>(lds, lds + EPI_LDS, P, S, E, tid); } }
    GRID_SYNC();
    { PHASE_BEGIN();
      { PvPlain P{(const bf16_t*)(ws + WS_U), (const bf16_t*)(ws + WS_WT_UQ), INP, 256, 256}; pg8::SchedPlain S; S.o.init(128, 3, G, bx);
        EpiQ E{(bf16_t*)(ws + WS_Q), (const float*)(ws + WS_SSQ_Q), (const float*)(ws + WS_ROPE)};
        pg8::gemm_phase<false>(lds, lds + EPI_LDS, P, S, E, tid); }
      { PvPlain P{(const bf16_t*)(ws + WS_U) + 256, (const bf16_t*)(ws + WS_WT_UKV), INP, 128, 128}; pg8::SchedPlain S; S.o.init(128, 4, G, (bx + 128) % G);
        EpiKV E{(bf16_t*)(ws + WS_KB), (bf16_t*)(ws + WS_VB), (const float*)(ws + WS_SSQ_KV)};
        pg8::gemm_phase<true>(lds, lds + EPI_LDS, P, S, E, tid); }
      { int tid2 = threadIdx.x; asm volatile("" : "+v"(tid2)); for (int i = vb; i < 1024; i += G) conv_unit(p, lds, i, tid2); } }
    GRID_SYNC();
    { PHASE_BEGIN();
    if (G == 256) { for (int r = 0; r < 4; ++r) { int unit; mla_order(vb, r, unit); mla_unit(p, lds, unit, tid); } }
    else { for (int i = vb; i < 1024; i += G) mla_unit(p, lds, i, tid); } }
    GRID_SYNC();
    { PHASE_BEGIN();
      PvPlain P{(const bf16_t*)(ws + WS_YCAT), (const bf16_t*)(ws + WS_WT_OUT), 1024, 1024, 1024}; pg8::SchedPlain S; S.o.init(128, 4, G, bx);
      EpiResid E{p.x, p.out, (bf16_t*)(ws + WS_X1B), (float*)(ws + WS_SSQ_X1)};
      pg8::gemm_phase<false>(lds, lds + EPI_LDS, P, S, E, tid); }
    GRID_SYNC();
    { PHASE_BEGIN();
      PvPlain P{(const bf16_t*)(ws + WS_X1B), (const bf16_t*)(ws + WS_WT_XQ), 1024, 1024, 1024}; pg8::SchedPlain S; S.o.init(128, 4, G, bx);
      EpiScale16 E{(bf16_t*)(ws + WS_XQ), 1024, (const float*)(ws + WS_SSQ_X1), C2_X};
      pg8::gemm_phase<true>(lds, lds + EPI_LDS, P, S, E, tid); }
    GRID_SYNC();
    { PHASE_BEGIN();
      PvXS P{(const bf16_t*)(ws + WS_XQ), (const bf16_t*)(ws + WS_KM), 1024, 1024, 256}; pg8::SchedBatch8 S; S.o.init(512, 1, G, bx);
      EpiSoftmaxP E{(bf16_t*)(ws + WS_P)};
      pg8::gemm_phase<true>(lds, lds + EPI_LDS, P, S, E, tid); }
    GRID_SYNC();
    { PHASE_BEGIN();
      PvXPV P{(const bf16_t*)(ws + WS_P), (const bf16_t*)(ws + WS_VMT), 256, 256, 256}; pg8::SchedBatch8 S; S.o.init(512, 1, G, bx);
      EpiOX E{(bf16_t*)(ws + WS_OX)};
      pg8::gemm_phase<true>(lds, lds + EPI_LDS, P, S, E, tid); }
    GRID_SYNC();
    { PHASE_BEGIN();
      PvPlain P{(const bf16_t*)(ws + WS_OX), (const bf16_t*)(ws + WS_WT_XO), 1024, 1024, 1024}; pg8::SchedPlain S; S.o.init(128, 4, G, bx);
      EpiResid E{p.out, p.out, (bf16_t*)(ws + WS_X2B), (float*)(ws + WS_SSQ_X2)};
      pg8::gemm_phase<false>(lds, lds + EPI_LDS, P, S, E, tid); }
    GRID_SYNC();
    { PHASE_BEGIN(); for (int i = vb; i < RT_UNITS; i += G) router1_unit(p, lds, i, tid); }
    GRID_SYNC();
    { PHASE_BEGIN(); for (int i = vb; i < RT_UNITS; i += G) router2_unit(p, lds, i, tid); }
    GRID_SYNC();
    { PHASE_BEGIN(); const int* te = (const int*)(ws + WS_TILE_E); const int nt = te[NTILE_MAX];
      PvExp P{(const bf16_t*)(ws + WS_XG), (const bf16_t*)(ws + WS_WT_UP), te, 1024, 1024, 1024, 2048}; pg8::SchedPlain S; S.o.init(nt, 8, G, bx);
      EpiSwiglu E{(bf16_t*)(ws + WS_ACT), (const float*)(ws + WS_SLOT_RS), te, p.b_up};
      pg8::gemm_phase<true>(lds, lds + EPI_LDS, P, S, E, tid); }
    GRID_SYNC();
    { PHASE_BEGIN(); const int* te = (const int*)(ws + WS_TILE_E); const int nt = te[NTILE_MAX];
      PvExp P{(const bf16_t*)(ws + WS_ACT), (const bf16_t*)(ws + WS_WT_DOWN), te, 1024, 1024, 1024, 1024}; pg8::SchedPlain S; S.o.init(nt, 4, G, bx);
      EpiDown E{(bf16_t*)(ws + WS_YB), (const float*)(ws + WS_SLOT_GATE), te, p.b_down};
      pg8::gemm_phase<true>(lds, lds + EPI_LDS, P, S, E, tid); }
    GRID_SYNC();
    { PHASE_BEGIN(); const int gw = vb * 8 + (tid >> 6), ngw = G * 8; for (int r = gw; r < NTOK; r += ngw) final_row(p, r, lane); }
}

extern "C" void kernel_launch(void* const* d_in, const int* in_sizes, int n_in, void* d_out, int out_size, void* d_ws, size_t ws_size, hipStream_t stream) {
    static int grid = 0;
    if (grid == 0) {
        if (n_in != 27 || ws_size < WS_END) { fprintf(stderr, "kernel_launch: unexpected inputs (n_in %d, ws %zu)\n", n_in, ws_size); grid = -1; return; }
        int dev = 0, cus = 0, per_cu = 0;
        (void)hipGetDevice(&dev); (void)hipDeviceGetAttribute(&cus, hipDeviceAttributeMultiprocessorCount, dev);
        (void)hipFuncSetAttribute((const void*)mega_kernel, hipFuncAttributeMaxDynamicSharedMemorySize, LDS_BYTES);
        (void)hipOccupancyMaxActiveBlocksPerMultiprocessor(&per_cu, (const void*)mega_kernel, 512, LDS_BYTES);
        if (per_cu < 1) { fprintf(stderr, "kernel_launch: occupancy query says %d blocks per CU\n", per_cu); per_cu = 1; }
        if (per_cu > 1) per_cu = 1;
        grid = cus * per_cu;
        (void)hipGetLastError();
    }
    if (grid < 0) return;
    (void)hipMemsetAsync((char*)d_ws + WS_CTL, 0, XCD_BAR_WORDS * 4, stream);
    Params p{};
    p.x = (const float*)d_in[0]; p.mem = (const float*)d_in[1]; p.pos = (const int*)d_in[2];
    p.g_mix = (const float*)d_in[3]; p.w_in = (const float*)d_in[4]; p.g_q = (const float*)d_in[5]; p.w_uq = (const float*)d_in[6]; p.g_kv = (const float*)d_in[7]; p.w_ukv = (const float*)d_in[8];
    p.w_dw = (const float*)d_in[9]; p.b_dw = (const float*)d_in[10]; p.g_cln = (const float*)d_in[11]; p.b_cln = (const float*)d_in[12]; p.w_out = (const float*)d_in[13];
    p.g_xattn = (const float*)d_in[14]; p.g_mem = (const float*)d_in[15]; p.w_xq = (const float*)d_in[16]; p.w_xkv = (const float*)d_in[17]; p.w_xo = (const float*)d_in[18];
    p.g_ffn = (const float*)d_in[19]; p.w_router = (const float*)d_in[20]; p.b_router = (const float*)d_in[21]; p.w_up = (const float*)d_in[22]; p.b_up = (const float*)d_in[23];
    p.w_down = (const float*)d_in[24]; p.b_down = (const float*)d_in[25]; p.g_final = (const float*)d_in[26];
    p.out = (float*)d_out; p.ws = (unsigned char*)d_ws;
    void* args[] = {&p};
    hipError_t e = hipLaunchCooperativeKernel((const void*)mega_kernel, dim3(grid), dim3(512), args, LDS_BYTES, stream);
    if (e != hipSuccess) fprintf(stderr, "cooperative launch failed: %s (grid %d)\n", hipGetErrorString(e), grid);
}
```

```cpp
#include <hip/hip_runtime.h>
#include <stdint.h>
#include <stdio.h>
#include <hip/hip_cooperative_groups.h>
namespace cg = cooperative_groups;

#ifndef PROBE_MASK
#define PROBE_MASK 0
#endif
#ifndef PROBE_EPI
#define PROBE_EPI 0
#endif
#define LAS __attribute__((address_space(3)))
typedef unsigned short bf16_t;
typedef short bf16x8 __attribute__((ext_vector_type(8)));
typedef short s16x4 __attribute__((ext_vector_type(4)));
typedef float f32x2 __attribute__((ext_vector_type(2)));
typedef float f32x4 __attribute__((ext_vector_type(4)));
typedef float f32x16 __attribute__((ext_vector_type(16)));
typedef unsigned u32x2 __attribute__((ext_vector_type(2)));
typedef unsigned u32x4 __attribute__((ext_vector_type(4)));

constexpr int BATCH = 16, SEQ = 2048, NTOK = BATCH * SEQ, DM = 1024;
constexpr int INC = 1440, INP = 1536;
constexpr int HEADS = 8, QKD = 96, VD = 64;
constexpr int CCH = 512, CW = 31;
constexpr int MEML = 256, NMEM = BATCH * MEML;
constexpr int XH = 4, XD = 256;
constexpr int NE = 32, TOPK = 4;
constexpr int NSLOT = NTOK * TOPK + NE * 256;
constexpr int NTILE_MAX = NSLOT / 256;
constexpr float EPS = 1e-5f;
constexpr float C2_MLA = 0.14724444602590306f;
constexpr float C2_X = 0.09016844005556021f;
constexpr int RT_TOK = 128, RT_UNITS = NTOK / RT_TOK;

constexpr size_t MiB = 1u << 20;
constexpr size_t WS_CTL = 0;
constexpr size_t WS_RSTD_X = 1 * MiB;
constexpr size_t WS_RSTD_Q = WS_RSTD_X + 128 * 1024;
constexpr size_t WS_RSTD_KV = WS_RSTD_Q + 128 * 1024;
constexpr size_t WS_RSTD_X1 = WS_RSTD_KV + 128 * 1024;
constexpr size_t WS_RSTD_X2 = WS_RSTD_X1 + 128 * 1024;
constexpr size_t WS_RSTD_MEM = WS_RSTD_X2 + 128 * 1024;
constexpr size_t WS_ROPE = 2 * MiB;
constexpr size_t WS_TOPI = 6 * MiB;
constexpr size_t WS_TOPG = WS_TOPI + 512 * 1024;
constexpr size_t WS_INV = WS_TOPG + 512 * 1024;
constexpr size_t WS_SLOT_TOK = WS_INV + 512 * 1024;
constexpr size_t WS_SLOT_GATE = WS_SLOT_TOK + 1 * MiB;
constexpr size_t WS_SLOT_RS = 15 * MiB + 256 * 1024;
constexpr size_t WS_HIST = WS_SLOT_GATE + 1 * MiB;
constexpr size_t WS_TILE_E = WS_HIST + 64 * 1024;
constexpr size_t WS_SSQ_Q = 10 * MiB;
constexpr size_t WS_SSQ_KV = 10 * MiB + 512 * 1024;
constexpr size_t WS_SSQ_X1 = 11 * MiB;
constexpr size_t WS_SSQ_X2 = 13 * MiB;
constexpr size_t WS_WR = 15 * MiB;
constexpr size_t WS_WT_IN = 16 * MiB;
constexpr size_t WS_WT_UQ = 19 * MiB;
constexpr size_t WS_WT_UKV = WS_WT_UQ + 512 * 1024;
constexpr size_t WS_WT_OUT = 20 * MiB;
constexpr size_t WS_WT_XQ = 22 * MiB;
constexpr size_t WS_WT_XKV = 24 * MiB;
constexpr size_t WS_WT_XO = 28 * MiB;
constexpr size_t WS_WT_UP = 32 * MiB;
constexpr size_t WS_WT_DOWN = 160 * MiB;
constexpr size_t WS_X2B = 224 * MiB;
constexpr size_t WS_XB = WS_X2B;
constexpr size_t WS_ACT = 288 * MiB;
constexpr size_t WS_U = 288 * MiB;
constexpr size_t WS_Q = 384 * MiB;
constexpr size_t WS_KB = 432 * MiB;
constexpr size_t WS_VB = 480 * MiB;
constexpr size_t WS_YCAT = 512 * MiB;
constexpr size_t WS_YB = 560 * MiB;
constexpr size_t WS_XG = WS_YB;
constexpr size_t WS_X1B = 576 * MiB;
constexpr size_t WS_XQ = 640 * MiB;
constexpr size_t WS_P = 704 * MiB;
constexpr size_t WS_OX = 768 * MiB;
constexpr size_t WS_MEMB = 832 * MiB;
constexpr size_t WS_KM = 840 * MiB;
constexpr size_t WS_VMT = 848 * MiB;
constexpr size_t WS_END = 856 * MiB;

struct Params {
    const float* x; const float* mem; const int* pos;
    const float *g_mix, *w_in, *g_q, *w_uq, *g_kv, *w_ukv, *w_dw, *b_dw, *g_cln, *b_cln, *w_out, *g_xattn, *g_mem, *w_xq, *w_xkv, *w_xo, *g_ffn, *w_router, *b_router, *w_up, *b_up, *w_down, *b_down, *g_final;
    float* out; unsigned char* ws;
};

__device__ __forceinline__ float bf2f(bf16_t b) { return __uint_as_float((unsigned)b << 16); }
__device__ __forceinline__ unsigned f2bf(float f) { unsigned u = __float_as_uint(f); return (u + 0x7fffu + ((u >> 16) & 1u)) >> 16; }
typedef __bf16 bf16x2_t __attribute__((ext_vector_type(2)));
__device__ __forceinline__ unsigned pk2(float lo, float hi) { const f32x2 v = {lo, hi}; const bf16x2_t b = __builtin_convertvector(v, bf16x2_t); return __builtin_bit_cast(unsigned, b); }
__device__ __forceinline__ float wave_sum(float v) {
#pragma unroll
    for (int o = 1; o < 64; o <<= 1) v += __shfl_xor(v, o);
    return v;
}
__device__ __forceinline__ int perm32(int rho) { const int n = rho >> 4, i = rho & 15; return 8 * (i >> 2) + 4 * n + (i & 3); }
__device__ __forceinline__ float fast_exp2(float x) { return __builtin_amdgcn_exp2f(x); }
__device__ __forceinline__ float sigmoidf_(float x) { return 1.0f / (1.0f + __expf(-x)); }

struct TrDesc { const float* W; const float* g; bf16_t* WT; int N, K, mode, k0, n0; };
__device__ __forceinline__ void tr_load(const TrDesc& d, float (&v)[32], int lane) {
    const float* src = d.W + (size_t)(d.k0 + (lane >> 5)) * d.N + d.n0 + (lane & 31);
#pragma unroll
    for (int i = 0; i < 32; ++i) v[i] = src[(size_t)(2 * i) * d.N];
}
__device__ __forceinline__ void tr_store(const TrDesc& d, const float (&v)[32], LAS float* scr, int lane) {
#pragma unroll
    for (int i = 0; i < 32; ++i) scr[(2 * i + (lane >> 5)) * 33 + (lane & 31)] = v[i];
    asm volatile("s_waitcnt lgkmcnt(0)" ::: "memory");
    const int c = lane & 7;
    f32x4 g0 = {1.f, 1.f, 1.f, 1.f}, g1 = {1.f, 1.f, 1.f, 1.f};
    if (d.g) { g0 = *(const f32x4*)(d.g + d.k0 + 8 * c); g1 = *(const f32x4*)(d.g + d.k0 + 8 * c + 4); }
#pragma unroll
    for (int j = 0; j < 4; ++j) { const int n = (lane >> 3) + 8 * j; const LAS float* sp = scr + (8 * c) * 33 + n;
        u32x4 o; o.x = pk2(sp[0 * 33] * g0[0], sp[1 * 33] * g0[1]); o.y = pk2(sp[2 * 33] * g0[2], sp[3 * 33] * g0[3]); o.z = pk2(sp[4 * 33] * g1[0], sp[5 * 33] * g1[1]); o.w = pk2(sp[6 * 33] * g1[2], sp[7 * 33] * g1[3]);
        const int nn = d.n0 + n; const int row = (d.mode == 1) ? ((((nn & 1023) >> 7) << 8) + ((nn >> 10) << 7) + (nn & 127)) : nn;
        *(u32x4*)(d.WT + (size_t)row * d.K + d.k0 + 8 * c) = o; }
    asm volatile("s_waitcnt lgkmcnt(0)" ::: "memory");
}
__device__ __forceinline__ void row_bf16_rstd(const float* xrow, bf16_t* orow, float* rstd_out, int lane) {
    f32x4 v[4]; float s = 0.f;
#pragma unroll
    for (int j = 0; j < 4; ++j) { v[j] = ((const f32x4*)xrow)[lane + 64 * j]; s += (v[j].x * v[j].x + v[j].y * v[j].y) + (v[j].z * v[j].z + v[j].w * v[j].w); }
    s = wave_sum(s);
    if (lane == 0) *rstd_out = 1.0f / sqrtf(s * (1.0f / 1024.0f) + EPS);
    if (orow) {
#pragma unroll
        for (int j = 0; j < 4; ++j) { u32x2 w; w.x = pk2(v[j].x, v[j].y); w.y = pk2(v[j].z, v[j].w); ((u32x2*)orow)[lane + 64 * j] = w; }
    }
}
__device__ __forceinline__ void sincos_acc(double a, float& s, float& c) {
    const double TWO_PI = 6.283185307179586476925;
    const double n = rint(a * (1.0 / TWO_PI)); const double r = a - n * TWO_PI;
    const double h = 0.5 * r, h2 = h * h;
    const double sh = h * (1.0 + h2 * (-1.0 / 6.0 + h2 * (1.0 / 120.0 + h2 * (-1.0 / 5040.0 + h2 * (1.0 / 362880.0 + h2 * (-1.0 / 39916800.0 + h2 * (1.0 / 6227020800.0 + h2 * (-1.0 / 1307674368000.0 + h2 * (1.0 / 355687428096000.0)))))))));
    const double ch = 1.0 + h2 * (-0.5 + h2 * (1.0 / 24.0 + h2 * (-1.0 / 720.0 + h2 * (1.0 / 40320.0 + h2 * (-1.0 / 3628800.0 + h2 * (1.0 / 479001600.0 + h2 * (-1.0 / 87178291200.0 + h2 * (1.0 / 20922789888000.0 + h2 * (-1.0 / 6402373705728000.0)))))))));
    s = (float)(2.0 * sh * ch); c = (float)(ch * ch - sh * sh);
}
__device__ __forceinline__ double rope_inv(int i) {
    const double t[16] = {1.0, 0.5623413251903491, 0.31622776601683794, 0.1778279410038923, 0.1, 0.05623413251903491, 0.03162277660168379, 0.01778279410038923,
                          0.01, 0.005623413251903491, 0.0031622776601683794, 0.0017782794100389228, 0.001, 0.0005623413251903491, 0.00031622776601683794, 0.00017782794100389227};
    double r = t[0];
#pragma unroll
    for (int k = 1; k < 16; ++k) r = (i == k) ? t[k] : r;
    return r;
}

__device__ __forceinline__ void prep_stage(const Params& p, LAS unsigned char* lds, int vblk, int nblk, int tid) {
    const int lane = tid & 63, wid = tid >> 6;
    const int gw = vblk * 8 + wid, ngw = nblk * 8;
    LAS float* scr = (LAS float*)(lds + wid * 8448);
    unsigned char* ws = p.ws;
    constexpr int I_IN = 16 * 45, I_UQ = 4 * 24, I_UKV = 2 * 32, I_SQ = 16 * 32, I_XKV = 16 * 64, I_UP1 = 16 * 64, I_DN1 = 16 * 32;
    constexpr int NITEMS = I_IN + I_UQ + I_UKV + 3 * I_SQ + I_XKV + NE * I_UP1 + NE * I_DN1;
    auto get_desc = [&](int it) -> TrDesc {
        TrDesc d; int r = it; int item;
        if (r < I_IN) { d.W = p.w_in; d.N = INC; d.K = 1024; d.g = p.g_mix; d.WT = (bf16_t*)(ws + WS_WT_IN); d.mode = 0; item = r; }
        else if ((r -= I_IN) < I_UQ) { d.W = p.w_uq; d.N = 768; d.K = 256; d.g = p.g_q; d.WT = (bf16_t*)(ws + WS_WT_UQ); d.mode = 0; item = r; }
        else if ((r -= I_UQ) < I_UKV) { d.W = p.w_ukv; d.N = 1024; d.K = 128; d.g = p.g_kv; d.WT = (bf16_t*)(ws + WS_WT_UKV); d.mode = 0; item = r; }
        else if ((r -= I_UKV) < I_SQ) { d.W = p.w_out; d.N = 1024; d.K = 1024; d.g = nullptr; d.WT = (bf16_t*)(ws + WS_WT_OUT); d.mode = 0; item = r; }
        else if ((r -= I_SQ) < I_SQ) { d.W = p.w_xq; d.N = 1024; d.K = 1024; d.g = p.g_xattn; d.WT = (bf16_t*)(ws + WS_WT_XQ); d.mode = 0; item = r; }
        else if ((r -= I_SQ) < I_SQ) { d.W = p.w_xo; d.N = 1024; d.K = 1024; d.g = nullptr; d.WT = (bf16_t*)(ws + WS_WT_XO); d.mode = 0; item = r; }
        else if ((r -= I_SQ) < I_XKV) { d.W = p.w_xkv; d.N = 2048; d.K = 1024; d.g = p.g_mem; d.WT = (bf16_t*)(ws + WS_WT_XKV); d.mode = 0; item = r; }
        else if ((r -= I_XKV) < NE * I_UP1) { const int e = r / I_UP1; d.W = p.w_up + (size_t)e * 1024 * 2048; d.N = 2048; d.K = 1024; d.g = p.g_ffn; d.WT = (bf16_t*)(ws + WS_WT_UP) + (size_t)e * 2048 * 1024; d.mode = 1; item = r % I_UP1; }
        else { r -= NE * I_UP1; const int e = r / I_DN1; d.W = p.w_down + (size_t)e * 1024 * 1024; d.N = 1024; d.K = 1024; d.g = nullptr; d.WT = (bf16_t*)(ws + WS_WT_DOWN) + (size_t)e * 1024 * 1024; d.mode = 0; item = r % I_DN1; }
        const int nblk = d.N / 32; d.k0 = 64 * (item / nblk); d.n0 = 32 * (item % nblk); return d; };
    if (gw < NITEMS) {
        TrDesc dc = get_desc(gw); float vc[32]; tr_load(dc, vc, lane);
        for (int it = gw; it < NITEMS; it += ngw) {
            const int nx = it + ngw; TrDesc dn = dc; float vn[32];
            if (nx < NITEMS) { dn = get_desc(nx); tr_load(dn, vn, lane); }
            tr_store(dc, vc, scr, lane);
            if (nx < NITEMS) { dc = dn;
#pragma unroll
                for (int i = 0; i < 32; ++i) vc[i] = vn[i]; }
        }
    }
    for (int m = gw; m < NTOK; m += ngw) row_bf16_rstd(p.x + (size_t)m * 1024, (bf16_t*)(ws + WS_XB) + (size_t)m * 1024, (float*)(ws + WS_RSTD_X) + m, lane);
    for (int m = gw; m < NMEM; m += ngw) row_bf16_rstd(p.mem + (size_t)m * 1024, (bf16_t*)(ws + WS_MEMB) + (size_t)m * 1024, (float*)(ws + WS_RSTD_MEM) + m, lane);
    const int gt = vblk * 512 + tid, ngt = nblk * 512;
    for (int i = gt; i < NTOK * 16; i += ngt) { const int row = i >> 4, f = i & 15; float s, c; sincos_acc((double)p.pos[row] * rope_inv(f), s, c);
        float* rt = (float*)(ws + WS_ROPE) + (size_t)row * 32; rt[f] = c; rt[16 + f] = s; }
    for (int i = gt; i < 1024 * 32; i += ngt) { const int k = i >> 5, e = i & 31; const float v = p.g_ffn[k] * p.w_router[i]; const unsigned hb = f2bf(v); const float lo = v - __uint_as_float(hb << 16);
        ((bf16_t*)(ws + WS_WR))[e * 1024 + k] = (bf16_t)hb; ((bf16_t*)(ws + WS_WR))[32768 + e * 1024 + k] = (bf16_t)f2bf(lo); }
    for (int i = gt; i < (INP - INC) * 1024 / 8; i += ngt) ((u32x4*)((bf16_t*)(ws + WS_WT_IN) + (size_t)INC * 1024))[i] = (u32x4){0u, 0u, 0u, 0u};
}

struct Unit { int pm, pn, z; };
typedef f32x4 Acc[2][2][4][2];

template <bool PERM, class Prov, class Epi>
__device__ __forceinline__ void gemm_unit_naive(const Prov& P, const Epi& E, const Unit& u, LAS unsigned char* lds, int tid) {
    const int wid = tid >> 6, lane = tid & 63, wr = wid >> 2, wc = wid & 3, fr = lane & 15, fq = lane >> 4;
    const bf16_t* ap[2][4]; const bf16_t* bp[2][2];
#pragma unroll
    for (int ai = 0; ai < 2; ++ai)
#pragma unroll
        for (int m = 0; m < 4; ++m) ap[ai][m] = P.a_row(u, 128 * ai + 64 * wr + 16 * m + fr) + 8 * fq;
#pragma unroll
    for (int bj = 0; bj < 2; ++bj)
#pragma unroll
        for (int n = 0; n < 2; ++n) { const int rho = 16 * n + fr; bp[bj][n] = P.b_row(u, 128 * bj + 32 * wc + (PERM ? perm32(rho) : rho)) + 8 * fq; }
    Acc acc;
#pragma unroll
    for (int a = 0; a < 2; ++a)
#pragma unroll
        for (int b = 0; b < 2; ++b)
#pragma unroll
            for (int m = 0; m < 4; ++m)
#pragma unroll
                for (int n = 0; n < 2; ++n) acc[a][b][m][n] = (f32x4){0.f, 0.f, 0.f, 0.f};
    const int K = P.K;
#pragma unroll 1
    for (int k0 = 0; k0 < K; k0 += 32) {
        bf16x8 a[2][4], b[2][2];
#pragma unroll
        for (int ai = 0; ai < 2; ++ai)
#pragma unroll
            for (int m = 0; m < 4; ++m) a[ai][m] = *(const bf16x8*)(ap[ai][m] + k0);
#pragma unroll
        for (int bj = 0; bj < 2; ++bj)
#pragma unroll
            for (int n = 0; n < 2; ++n) b[bj][n] = *(const bf16x8*)(bp[bj][n] + k0);
#pragma unroll
        for (int ai = 0; ai < 2; ++ai)
#pragma unroll
            for (int bj = 0; bj < 2; ++bj)
#pragma unroll
                for (int m = 0; m < 4; ++m)
#pragma unroll
                    for (int n = 0; n < 2; ++n) acc[ai][bj][m][n] = __builtin_amdgcn_mfma_f32_16x16x32_bf16(b[bj][n], a[ai][m], acc[ai][bj][m][n], 0, 0, 0);
    }
    E(acc, u, wr, wc, fr, fq, lds);
}

struct ProvPlain { const bf16_t* A; int lda; const bf16_t* Bt; int ldb; int K;
    __device__ __forceinline__ const bf16_t* a_row(const Unit& u, int r) const { return A + (size_t)(u.pm * 256 + r) * lda; }
    __device__ __forceinline__ const bf16_t* b_row(const Unit& u, int r) const { return Bt + (size_t)(u.pn * 256 + r) * ldb; } };
struct ProvXS { const bf16_t* XQ; const bf16_t* KM; int K;
    __device__ __forceinline__ const bf16_t* a_row(const Unit& u, int r) const { return XQ + (size_t)((u.z >> 2) * 2048 + u.pm * 256 + r) * 1024 + (u.z & 3) * 256; }
    __device__ __forceinline__ const bf16_t* b_row(const Unit& u, int r) const { return KM + (size_t)((u.z >> 2) * 256 + r) * 1024 + (u.z & 3) * 256; } };
struct ProvXPV { const bf16_t* Pm; const bf16_t* VMT; int K;
    __device__ __forceinline__ const bf16_t* a_row(const Unit& u, int r) const { return Pm + ((size_t)u.z * 2048 + u.pm * 256 + r) * 256; }
    __device__ __forceinline__ const bf16_t* b_row(const Unit& u, int r) const { return VMT + ((size_t)u.z * 256 + r) * 256; } };
struct ProvUp { const bf16_t* X2B; const int* slot_tok; const int* tile_e; const bf16_t* WT; int K;
    __device__ __forceinline__ const bf16_t* a_row(const Unit& u, int r) const { return X2B + (size_t)slot_tok[u.pm * 256 + r] * 1024; }
    __device__ __forceinline__ const bf16_t* b_row(const Unit& u, int r) const { return WT + ((size_t)tile_e[u.pm] * 2048 + u.pn * 256 + r) * 1024; } };
struct ProvDown { const bf16_t* ACT; const int* tile_e; const bf16_t* WT; int K;
    __device__ __forceinline__ const bf16_t* a_row(const Unit& u, int r) const { return ACT + (size_t)(u.pm * 256 + r) * 1024; }
    __device__ __forceinline__ const bf16_t* b_row(const Unit& u, int r) const { return WT + ((size_t)tile_e[u.pm] * 1024 + u.pn * 256 + r) * 1024; } };

#define EPI_BAR() do { asm volatile("s_waitcnt lgkmcnt(0)" ::: "memory"); __builtin_amdgcn_s_barrier(); asm volatile("" ::: "memory"); } while (0)
#define EPI_ARGS Acc& acc, const Unit& u, int wr, int wc, int fr, int fq, LAS unsigned char* lds
#define FOR_AI_M _Pragma("unroll") for (int ai = 0; ai < 2; ++ai) _Pragma("unroll") for (int m = 0; m < 4; ++m)
#define FOR_BJ _Pragma("unroll") for (int bj = 0; bj < 2; ++bj)
struct EpiIn { bf16_t* O; const float* rs; float* ssq_q; float* ssq_kv; const float* rope; bf16_t* KB;
    __device__ __forceinline__ void operator()(EPI_ARGS) const {
        FOR_AI_M { const int row = u.pm * 256 + 128 * ai + 64 * wr + 16 * m + fr; const float s = rs[row]; bf16_t* rowp = O + (size_t)row * INP + u.pn * 256 + 32 * wc + 8 * fq;
            float q0 = 0.f, q1 = 0.f;
            FOR_BJ { const f32x4 v0 = acc[ai][bj][m][0] * s, v1 = acc[ai][bj][m][1] * s; u32x4 w; w.x = pk2(v0[0], v0[1]); w.y = pk2(v0[2], v0[3]); w.z = pk2(v1[0], v1[1]); w.w = pk2(v1[2], v1[3]);
                *(u32x4*)(rowp + 128 * bj) = w;
                const float qq = (v0[0] * v0[0] + v0[1] * v0[1]) + (v0[2] * v0[2] + v0[3] * v0[3]) + (v1[0] * v1[0] + v1[1] * v1[1]) + (v1[2] * v1[2] + v1[3] * v1[3]);
                if (bj == 0) q0 = qq; else q1 = qq; }
            if (u.pn == 0) { float q = q0 + q1; q += __shfl_xor(q, 16); q += __shfl_xor(q, 32); if (fq == 0) ssq_q[(size_t)row * 4 + wc] = q; }
            if (u.pn == 1) { float q = q0; q += __shfl_xor(q, 16); q += __shfl_xor(q, 32); if (fq == 0) ssq_kv[(size_t)row * 4 + wc] = q;
                if (wc == 0) {
                    const int i0 = 8 * (fq & 1); const f32x4 c0 = *(const f32x4*)(rope + (size_t)row * 32 + i0), c1 = *(const f32x4*)(rope + (size_t)row * 32 + i0 + 4);
                    const f32x4 s0 = *(const f32x4*)(rope + (size_t)row * 32 + 16 + i0), s1 = *(const f32x4*)(rope + (size_t)row * 32 + 16 + i0 + 4);
                    const f32x4 v0 = acc[ai][1][m][0] * s, v1 = acc[ai][1][m][1] * s; f32x4 p0, p1;
#pragma unroll
                    for (int j = 0; j < 4; ++j) { p0[j] = __shfl_xor(v0[j], 32); p1[j] = __shfl_xor(v1[j], 32); }
                    f32x4 o0, o1;
                    if (fq < 2) { o0 = v0 * c0 - p0 * s0; o1 = v1 * c1 - p1 * s1; } else { o0 = p0 * s0 + v0 * c0; o1 = p1 * s1 + v1 * c1; }
                    u32x4 w; w.x = pk2(o0[0], o0[1]); w.y = pk2(o0[2], o0[3]); w.z = pk2(o1[0], o1[1]); w.w = pk2(o1[2], o1[3]);
                    bf16_t* kb = KB + (size_t)row * 768 + 64 + 8 * fq;
#pragma unroll
                    for (int h = 0; h < 8; ++h) *(u32x4*)(kb + h * 96) = w; } } } } };
struct EpiScale16 { bf16_t* O; int ldc; const float* ssq; float mul;
    __device__ __forceinline__ void operator()(EPI_ARGS) const {
        FOR_AI_M { const int row = u.pm * 256 + 128 * ai + 64 * wr + 16 * m + fr; const f32x4* sp = (const f32x4*)(ssq + (size_t)row * 16); const f32x4 t = (sp[0] + sp[1]) + (sp[2] + sp[3]);
            const float s = mul / sqrtf(((t[0] + t[1]) + (t[2] + t[3])) * (1.0f / 1024.0f) + EPS); bf16_t* rowp = O + (size_t)row * ldc + u.pn * 256 + 32 * wc + 8 * fq;
            FOR_BJ { const f32x4 v0 = acc[ai][bj][m][0] * s, v1 = acc[ai][bj][m][1] * s; u32x4 w; w.x = pk2(v0[0], v0[1]); w.y = pk2(v0[2], v0[3]); w.z = pk2(v1[0], v1[1]); w.w = pk2(v1[2], v1[3]);
                *(u32x4*)(rowp + 128 * bj) = w; } } } };
struct EpiQ { bf16_t* Q; const float* ssq; const float* rope;
    __device__ __forceinline__ void operator()(EPI_ARGS) const {
        FOR_AI_M { const int row = u.pm * 256 + 128 * ai + 64 * wr + 16 * m + fr; const f32x4 t = *(const f32x4*)(ssq + (size_t)row * 4); const float s = C2_MLA / sqrtf(((t[0] + t[1]) + (t[2] + t[3])) * (1.0f / 256.0f) + EPS);
            const f32x4 cs = *(const f32x4*)(rope + (size_t)row * 32 + 4 * fq), sn = *(const f32x4*)(rope + (size_t)row * 32 + 16 + 4 * fq);
            FOR_BJ { const int colg = u.pn * 256 + 128 * bj + 32 * wc; f32x4 v0 = acc[ai][bj][m][0] * s, v1 = acc[ai][bj][m][1] * s;
                if (((colg >> 5) % 3) == 2) { const f32x4 r0 = v0 * cs - v1 * sn, r1 = v0 * sn + v1 * cs; v0 = r0; v1 = r1; }
                bf16_t* rowp = Q + (size_t)row * 768 + colg + 4 * fq; u32x2 w0, w1; w0.x = pk2(v0[0], v0[1]); w0.y = pk2(v0[2], v0[3]); w1.x = pk2(v1[0], v1[1]); w1.y = pk2(v1[2], v1[3]);
                *(u32x2*)(rowp) = w0; *(u32x2*)(rowp + 16) = w1; } } } };
struct EpiKV { bf16_t* KB; bf16_t* VB; const float* ssq;
    __device__ __forceinline__ void operator()(EPI_ARGS) const {
        FOR_AI_M { const int row = u.pm * 256 + 128 * ai + 64 * wr + 16 * m + fr; const f32x4 t = *(const f32x4*)(ssq + (size_t)row * 4); const float s = 1.0f / sqrtf(((t[0] + t[1]) + (t[2] + t[3])) * (1.0f / 128.0f) + EPS);
            FOR_BJ { const int h = 2 * u.pn + bj, cl = 32 * wc + 8 * fq; const f32x4 v0 = acc[ai][bj][m][0] * s, v1 = acc[ai][bj][m][1] * s;
                u32x4 w; w.x = pk2(v0[0], v0[1]); w.y = pk2(v0[2], v0[3]); w.z = pk2(v1[0], v1[1]); w.w = pk2(v1[2], v1[3]);
                if (wc < 2) *(u32x4*)(KB + (size_t)row * 768 + h * 96 + cl) = w; else *(u32x4*)(VB + (size_t)row * 512 + h * 64 + cl - 64) = w; } } } };
struct EpiResid { const float* base; float* out; bf16_t* ob; float* ssq;
    __device__ __forceinline__ void operator()(EPI_ARGS) const {
        FOR_AI_M { const int row = u.pm * 256 + 128 * ai + 64 * wr + 16 * m + fr; float q = 0.f;
            FOR_BJ {
#pragma unroll
                for (int n = 0; n < 2; ++n) { const size_t off = (size_t)row * 1024 + u.pn * 256 + 128 * bj + 32 * wc + 16 * n + 4 * fq;
                    const f32x4 v = *(const f32x4*)(base + off) + acc[ai][bj][m][n]; *(f32x4*)(out + off) = v; u32x2 w; w.x = pk2(v[0], v[1]); w.y = pk2(v[2], v[3]); *(u32x2*)(ob + off) = w;
                    q += (v[0] * v[0] + v[1] * v[1]) + (v[2] * v[2] + v[3] * v[3]); } }
            if (ssq) { q += __shfl_xor(q, 16); q += __shfl_xor(q, 32); if (fq == 0) ssq[(size_t)row * 16 + u.pn * 4 + wc] = q; } } } };
struct EpiKVMem { bf16_t* KM; bf16_t* VMT; const float* rs;
    __device__ __forceinline__ void operator()(EPI_ARGS) const {
        FOR_AI_M { const int row = u.pm * 256 + 128 * ai + 64 * wr + 16 * m + fr; const float s = rs[row];
            FOR_BJ {
#pragma unroll
                for (int n = 0; n < 2; ++n) { const int col = u.pn * 256 + 128 * bj + 32 * wc + 16 * n + 4 * fq; const f32x4 v = acc[ai][bj][m][n] * s;
                    if (u.pn < 4) { u32x2 w; w.x = pk2(v[0], v[1]); w.y = pk2(v[2], v[3]); *(u32x2*)(KM + (size_t)row * 1024 + col) = w; }
                    else { const int c2 = col - 1024, h = c2 >> 8, d = c2 & 255, b = row >> 8, mm = row & 255; bf16_t* dst = VMT + ((size_t)(b * 4 + h) * 256 + d) * 256 + mm;
#pragma unroll
                        for (int j = 0; j < 4; ++j) dst[(size_t)j * 256] = (bf16_t)f2bf(v[j]); } } } } } };
struct EpiSoftmaxP { bf16_t* Pm;
    __device__ __forceinline__ void operator()(EPI_ARGS) const {
        LAS float* red = (LAS float*)lds; float rmax[2][4];
        FOR_AI_M { float mx = -3.0e38f;
            FOR_BJ {
#pragma unroll
                for (int n = 0; n < 2; ++n)
#pragma unroll
                    for (int j = 0; j < 4; ++j) mx = fmaxf(mx, acc[ai][bj][m][n][j]); }
            mx = fmaxf(mx, __shfl_xor(mx, 16)); mx = fmaxf(mx, __shfl_xor(mx, 32));
            if (fq == 0) red[(128 * ai + 64 * wr + 16 * m + fr) * 4 + wc] = mx; }
        EPI_BAR();
        FOR_AI_M { const f32x4 t = *(const LAS f32x4*)(red + (128 * ai + 64 * wr + 16 * m + fr) * 4); rmax[ai][m] = fmaxf(fmaxf(t[0], t[1]), fmaxf(t[2], t[3])); }
        EPI_BAR();
        FOR_AI_M { float s = 0.f;
            FOR_BJ {
#pragma unroll
                for (int n = 0; n < 2; ++n)
#pragma unroll
                    for (int j = 0; j < 4; ++j) { const float e = fast_exp2(acc[ai][bj][m][n][j] - rmax[ai][m]); acc[ai][bj][m][n][j] = e; s += e; } }
            s += __shfl_xor(s, 16); s += __shfl_xor(s, 32);
            if (fq == 0) red[(128 * ai + 64 * wr + 16 * m + fr) * 4 + wc] = s; }
        EPI_BAR();
        FOR_AI_M { const int r = 128 * ai + 64 * wr + 16 * m + fr; const f32x4 t = *(const LAS f32x4*)(red + r * 4); const float inv = 1.0f / ((t[0] + t[1]) + (t[2] + t[3]));
            bf16_t* rowp = Pm + ((size_t)u.z * 2048 + u.pm * 256 + r) * 256 + 32 * wc + 8 * fq;
            FOR_BJ { const f32x4 v0 = acc[ai][bj][m][0] * inv, v1 = acc[ai][bj][m][1] * inv; u32x4 w; w.x = pk2(v0[0], v0[1]); w.y = pk2(v0[2], v0[3]); w.z = pk2(v1[0], v1[1]); w.w = pk2(v1[2], v1[3]);
                *(u32x4*)(rowp + 128 * bj) = w; } }
        EPI_BAR();
    } };
struct EpiOX { bf16_t* OX;
    __device__ __forceinline__ void operator()(EPI_ARGS) const {
        FOR_AI_M { const int r = 128 * ai + 64 * wr + 16 * m + fr; bf16_t* rowp = OX + (size_t)((u.z >> 2) * 2048 + u.pm * 256 + r) * 1024 + (u.z & 3) * 256 + 32 * wc + 8 * fq;
            FOR_BJ { const f32x4 v0 = acc[ai][bj][m][0], v1 = acc[ai][bj][m][1]; u32x4 w; w.x = pk2(v0[0], v0[1]); w.y = pk2(v0[2], v0[3]); w.z = pk2(v1[0], v1[1]); w.w = pk2(v1[2], v1[3]);
                *(u32x4*)(rowp + 128 * bj) = w; } } } };
struct EpiSwiglu { bf16_t* ACT; const float* slot_rs; const int* tile_e; const float* b_up;
    __device__ __forceinline__ void operator()(EPI_ARGS) const {
        const int e = tile_e[u.pm]; const int cl = 32 * wc + 8 * fq; const float* bg = b_up + (size_t)e * 2048 + u.pn * 128 + cl; const float* bl = bg + 1024;
        f32x4 bgv[2], blv[2]; bgv[0] = *(const f32x4*)bg; bgv[1] = *(const f32x4*)(bg + 4); blv[0] = *(const f32x4*)bl; blv[1] = *(const f32x4*)(bl + 4);
        FOR_AI_M { const int slot = u.pm * 256 + 128 * ai + 64 * wr + 16 * m + fr; const float s = slot_rs[slot];
            f32x4 o[2];
#pragma unroll
            for (int n = 0; n < 2; ++n) { f32x4 g = acc[ai][0][m][n] * s + bgv[n], l = acc[ai][1][m][n] * s + blv[n];
                g = __builtin_elementwise_min(g, (f32x4){7.f, 7.f, 7.f, 7.f}); l = __builtin_elementwise_min(__builtin_elementwise_max(l, (f32x4){-7.f, -7.f, -7.f, -7.f}), (f32x4){7.f, 7.f, 7.f, 7.f}) + 1.0f;
                const f32x4 t = g * (-1.702f * 1.4426950408889634f); f32x4 ex;
#pragma unroll
                for (int j = 0; j < 4; ++j) ex[j] = __builtin_amdgcn_exp2f(t[j]);
                ex = ex + 1.0f; f32x4 rc;
#pragma unroll
                for (int j = 0; j < 4; ++j) rc[j] = __builtin_amdgcn_rcpf(ex[j]);
                o[n] = (g * rc) * l; }
            u32x4 w; w.x = pk2(o[0][0], o[0][1]); w.y = pk2(o[0][2], o[0][3]); w.z = pk2(o[1][0], o[1][1]); w.w = pk2(o[1][2], o[1][3]);
            *(u32x4*)(ACT + (size_t)slot * 1024 + u.pn * 128 + cl) = w; } } };
struct EpiDown { bf16_t* YB; const float* gate; const int* tile_e; const float* b_down;
    __device__ __forceinline__ void operator()(EPI_ARGS) const {
        const int e = tile_e[u.pm]; const int c0 = u.pn * 256 + 32 * wc + 8 * fq; f32x4 bv[2][2];
        FOR_BJ { bv[bj][0] = *(const f32x4*)(b_down + (size_t)e * 1024 + c0 + 128 * bj); bv[bj][1] = *(const f32x4*)(b_down + (size_t)e * 1024 + c0 + 128 * bj + 4); }
        FOR_AI_M { const int slot = u.pm * 256 + 128 * ai + 64 * wr + 16 * m + fr; const float g = gate[slot];
            FOR_BJ { const f32x4 v0 = (acc[ai][bj][m][0] + bv[bj][0]) * g, v1 = (acc[ai][bj][m][1] + bv[bj][1]) * g; u32x4 w; w.x = pk2(v0[0], v0[1]); w.y = pk2(v0[2], v0[3]); w.z = pk2(v1[0], v1[1]); w.w = pk2(v1[2], v1[3]);
                *(u32x4*)(YB + (size_t)slot * 1024 + c0 + 128 * bj) = w; } } } };


namespace pg8 {
constexpr int BK = 64, HALF = 128, HTB = HALF * BK * 2, STAGE_BYTES = 8 * HTB;
__device__ __forceinline__ int lds_byte(int r, int c) { const int st = (r >> 4) * 2 + (c >> 5), rr = r & 15, cc = c & 31, ob = rr * 64 + cc * 2; return st * 1024 + (ob ^ (((ob >> 9) & 1) << 5)); }
__device__ __forceinline__ void stage_rc(int b, int& R, int& C) { const int st = b / 1024, sb = b % 1024, swz = sb ^ (((sb >> 9) & 1) << 5); R = (st >> 1) * 16 + swz / 64; C = (st & 1) * 32 + (swz % 64) / 2; }

template <bool PERM, bool GATHER, class Prov, class Sched, class Epi>
__device__ __forceinline__ void gemm_phase(LAS unsigned char* lds, LAS unsigned char* lds_epi, const Prov& P, const Sched& S, const Epi& E, int tid, unsigned long long* tepi = nullptr) {
    const int wid = __builtin_amdgcn_readfirstlane(tid >> 6), lane = tid & 63, wr = wid >> 2, wc = wid & 3, fr = lane & 15, fq = lane >> 4;
    const int K = P.K, nt = K / BK;
    unsigned voffA[2], voffB[2], voffG[2][2]; int Rg[2]; unsigned Cg[2];
#pragma unroll
    for (int i = 0; i < 2; ++i) { int R, C; stage_rc(tid * 16 + i * 8192, R, C); const int Rb = PERM ? ((R & ~31) + perm32(R & 31)) : R;
        voffA[i] = (unsigned)(R * P.lda + C) * 2u; voffB[i] = (unsigned)(Rb * P.ldb + C) * 2u; Rg[i] = R; Cg[i] = (unsigned)C * 2u; }
    LAS int* rtab = (LAS int*)(lds_epi + 8192);
    const size_t kstep = (size_t)(BK * 2);
    const size_t hstepA = GATHER ? 0 : (size_t)HALF * P.lda * 2, hstepB = (size_t)HALF * P.ldb * 2;
    const unsigned ldsw = (unsigned)wid * 1024u;
    const int aoff = lds_byte(wr * 64 + fr, fq * 8), boff = lds_byte(wc * 32 + fr, fq * 8);
#define PG8_SA(b, h) (((b) * 2 + (h)) * HTB)
#define PG8_SB(b, h) ((4 + (b) * 2 + (h)) * HTB)
#define PG8_STAGE(bufoff, gbase, voff) do { _Pragma("unroll") for (int _i = 0; _i < 2; ++_i) \
        __builtin_amdgcn_global_load_lds((const unsigned*)((const char*)(gbase) + (voff)[_i]), (LAS unsigned*)(lds + (bufoff) + ldsw + _i * 8192), 16, 0, 0); } while (0)
#define PG8_STAGE_A(bufoff, gbase, h) do { if constexpr (GATHER) { PG8_STAGE(bufoff, gbase, voffG[h]); } else { PG8_STAGE(bufoff, (gbase) + (h) * hstepA, voffA); } } while (0)
#define PG8_LDA(dst, b, h) do { _Pragma("unroll") for (int m = 0; m < 4; ++m) _Pragma("unroll") for (int k = 0; k < 2; ++k) dst[m][k] = *(const LAS bf16x8*)(lds + PG8_SA(b, h) + aoff + m * 2048 + k * 1024); } while (0)
#define PG8_LDB(dst, b, h) do { _Pragma("unroll") for (int n = 0; n < 2; ++n) _Pragma("unroll") for (int k = 0; k < 2; ++k) dst[n][k] = *(const LAS bf16x8*)(lds + PG8_SB(b, h) + boff + n * 2048 + k * 1024); } while (0)
#define PG8_MMA(ai, bj, At, Bt) do { __builtin_amdgcn_s_setprio(1); _Pragma("unroll") for (int m = 0; m < 4; ++m) _Pragma("unroll") for (int n = 0; n < 2; ++n) _Pragma("unroll") for (int k = 0; k < 2; ++k) \
        acc[ai][bj][m][n] = __builtin_amdgcn_mfma_f32_16x16x32_bf16(Bt[n][k], At[m][k], acc[ai][bj][m][n], 0, 0, 0); __builtin_amdgcn_s_setprio(0); } while (0)
#define PG8_WAIT_V(n) asm volatile("s_waitcnt vmcnt(" #n ")" ::: "memory")
#define PG8_WAIT_L(n) asm volatile("s_waitcnt lgkmcnt(" #n ")" ::: "memory")
#define PG8_BAR __builtin_amdgcn_s_barrier()
#define PG8_SCHED __builtin_amdgcn_sched_barrier(0)
    Unit cur, nxt; int ui = 0;
    if (!S.next(0, cur)) return;
    Acc acc;
#pragma unroll
    for (int a = 0; a < 2; ++a)
#pragma unroll
        for (int b = 0; b < 2; ++b)
#pragma unroll
            for (int m = 0; m < 4; ++m)
#pragma unroll
                for (int n = 0; n < 2; ++n) acc[a][b][m][n] = (f32x4){0.f, 0.f, 0.f, 0.f};
    bf16x8 At[4][2], B0[2][2], B1[2][2];
    const char* cA = (const char*)P.a_base(cur); const char* cB = (const char*)P.b_base(cur);
    if constexpr (GATHER) {
#pragma unroll
        for (int h = 0; h < 2; ++h)
#pragma unroll
            for (int i = 0; i < 2; ++i) voffG[h][i] = (unsigned)P.row_tok(cur, h * HALF + Rg[i]) * (unsigned)(P.lda * 2) + Cg[i];
    }
    PG8_STAGE(PG8_SB(0, 0), cB, voffB); PG8_STAGE(PG8_SB(0, 1), cB + hstepB, voffB); PG8_STAGE_A(PG8_SA(0, 0), cA, 0); PG8_STAGE_A(PG8_SA(0, 1), cA, 1);
    if (wr == 1) PG8_BAR;
    PG8_WAIT_V(2); PG8_BAR;
    PG8_STAGE(PG8_SB(1, 0), cB + kstep, voffB); PG8_STAGE_A(PG8_SA(1, 0), cA + kstep, 0); PG8_STAGE(PG8_SB(1, 1), cB + hstepB + kstep, voffB);
    PG8_WAIT_V(6); PG8_BAR;
    for (;;) {
        const bool has_next = S.next(ui + 1, nxt);
        const char* nA = has_next ? (const char*)P.a_base(nxt) : cA; const char* nB = has_next ? (const char*)P.b_base(nxt) : cB;
        if constexpr (GATHER) { if (has_next && wr == 0) rtab[tid] = P.row_tok(nxt, tid); }
        for (int t = 0; t < nt; t += 2) {
            const bool last = (t == nt - 2);
            const char* a1 = cA + (size_t)(t + 1) * kstep;
            const char* a2 = last ? nA : cA + (size_t)(t + 2) * kstep; const char* b2 = last ? nB : cB + (size_t)(t + 2) * kstep;
            const char* a3 = a2 + kstep; const char* b3 = b2 + kstep;
            PG8_LDB(B0, 0, 0); PG8_LDB(B1, 0, 1); PG8_SCHED; PG8_LDA(At, 0, 0); PG8_STAGE_A(PG8_SA(1, 1), a1, 1);
            if constexpr (GATHER) { if (last && has_next) {
#pragma unroll
                for (int h = 0; h < 2; ++h)
#pragma unroll
                    for (int i = 0; i < 2; ++i) voffG[h][i] = (unsigned)rtab[h * HALF + Rg[i]] * (unsigned)(P.lda * 2) + Cg[i]; } }
            PG8_WAIT_V(8); PG8_WAIT_L(0); PG8_BAR; PG8_MMA(0, 0, At, B0); PG8_MMA(0, 1, At, B1); PG8_BAR; PG8_SCHED;
            PG8_LDA(At, 0, 1); PG8_STAGE(PG8_SB(0, 0), b2, voffB); PG8_STAGE(PG8_SB(0, 1), b2 + hstepB, voffB); PG8_STAGE_A(PG8_SA(0, 0), a2, 0);
            PG8_WAIT_V(8); PG8_WAIT_L(0); PG8_BAR; PG8_MMA(1, 0, At, B0); PG8_MMA(1, 1, At, B1); PG8_BAR; PG8_SCHED;
            PG8_LDB(B0, 1, 0); PG8_LDB(B1, 1, 1); PG8_SCHED; PG8_LDA(At, 1, 0); PG8_STAGE_A(PG8_SA(0, 1), a2, 1);
            PG8_WAIT_V(8); PG8_WAIT_L(0); PG8_BAR; PG8_MMA(0, 0, At, B0); PG8_MMA(0, 1, At, B1); PG8_BAR; PG8_SCHED;
            PG8_LDA(At, 1, 1); PG8_STAGE(PG8_SB(1, 0), b3, voffB); PG8_STAGE(PG8_SB(1, 1), b3 + hstepB, voffB); PG8_STAGE_A(PG8_SA(1, 0), a3, 0);
            PG8_WAIT_V(8); PG8_WAIT_L(0); PG8_BAR; PG8_MMA(1, 0, At, B0); PG8_MMA(1, 1, At, B1); PG8_BAR; PG8_SCHED;
        }
#if PROBE_EPI
        const unsigned long long te0_ = __builtin_amdgcn_s_memrealtime();
#endif
        if (wr == 0) PG8_BAR;
        E(acc, cur, wr, wc, fr, fq, lds_epi);
#if PROBE_EPI
        if (tepi) { asm volatile("s_waitcnt vmcnt(8)" ::: "memory"); *tepi += __builtin_amdgcn_s_memrealtime() - te0_; }
#endif
        if (!has_next) break;
#pragma unroll
        for (int a = 0; a < 2; ++a)
#pragma unroll
            for (int b = 0; b < 2; ++b)
#pragma unroll
                for (int m = 0; m < 4; ++m)
#pragma unroll
                    for (int n = 0; n < 2; ++n) acc[a][b][m][n] = (f32x4){0.f, 0.f, 0.f, 0.f};
        cur = nxt; cA = nA; cB = nB; ++ui;
        if (wr == 1) PG8_BAR;
    }
    PG8_WAIT_V(0);
    PG8_BAR;
#undef PG8_SA
#undef PG8_SB
#undef PG8_STAGE
#undef PG8_STAGE_A
#undef PG8_LDA
#undef PG8_LDB
#undef PG8_MMA
#undef PG8_WAIT_V
#undef PG8_WAIT_L
#undef PG8_BAR
#undef PG8_SCHED
}
struct Order { int nM, nN, nwg, G, c;
    __device__ __forceinline__ void init(int nM_, int nN_, int G_, int c_) { nM = nM_; nN = nN_; nwg = nM * nN; G = G_; c = c_; }
    __device__ __forceinline__ bool next(int i, int& pm, int& pn) const {
        const long L = (long)i * G + c; if (L >= nwg) return false;
        int wgid = (int)L; { const int q = nwg / 8, r = nwg % 8, xcd = wgid % 8, off = wgid / 8; wgid = (xcd < r ? xcd * (q + 1) : r * (q + 1) + (xcd - r) * q) + off; }
        const int nig = 8 * nN, gid = wgid / nig, fm = gid * 8, gsz = (nM - fm) < 8 ? (nM - fm) : 8;
        pm = fm + ((wgid % nig) % gsz); pn = (wgid % nig) / gsz; return true; } };
struct SchedPlain { Order o; __device__ __forceinline__ bool next(int i, Unit& u) const { u.z = 0; return o.next(i, u.pm, u.pn); } };
struct SchedBatch8 { Order o; __device__ __forceinline__ bool next(int i, Unit& u) const { int pm, pn; if (!o.next(i, pm, pn)) return false; u.z = pm >> 3; u.pm = pm & 7; u.pn = 0; return true; } };
}

struct PvUpG { const bf16_t* X; const bf16_t* WT; const int* tile_e; const int* slot_tok; int lda, ldb, K;
    __device__ __forceinline__ const bf16_t* a_base(const Unit&) const { return X; }
    __device__ __forceinline__ const bf16_t* b_base(const Unit& u) const { return WT + ((size_t)tile_e[u.pm] * 2048 + u.pn * 256) * 1024; }
    __device__ __forceinline__ int row_tok(const Unit& u, int r) const { return slot_tok[u.pm * 256 + r]; } };
struct PvPlain { const bf16_t* A; const bf16_t* Bt; int lda, ldb, K;
    __device__ __forceinline__ const bf16_t* a_base(const Unit& u) const { return A + (size_t)u.pm * 256 * lda; }
    __device__ __forceinline__ const bf16_t* b_base(const Unit& u) const { return Bt + (size_t)u.pn * 256 * ldb; } };
struct PvXS { const bf16_t* XQ; const bf16_t* KM; int lda, ldb, K;
    __device__ __forceinline__ const bf16_t* a_base(const Unit& u) const { return XQ + (size_t)((u.z >> 2) * 2048 + u.pm * 256) * 1024 + (u.z & 3) * 256; }
    __device__ __forceinline__ const bf16_t* b_base(const Unit& u) const { return KM + (size_t)((u.z >> 2) * 256) * 1024 + (u.z & 3) * 256; } };
struct PvXPV { const bf16_t* Pm; const bf16_t* VMT; int lda, ldb, K;
    __device__ __forceinline__ const bf16_t* a_base(const Unit& u) const { return Pm + ((size_t)u.z * 2048 + u.pm * 256) * 256; }
    __device__ __forceinline__ const bf16_t* b_base(const Unit& u) const { return VMT + (size_t)u.z * 65536; } };
struct PvExp { const bf16_t* A; const bf16_t* WT; const int* tile_e; int lda, ldb, K, nrow;
    __device__ __forceinline__ const bf16_t* a_base(const Unit& u) const { return A + (size_t)u.pm * 256 * 1024; }
    __device__ __forceinline__ const bf16_t* b_base(const Unit& u) const { return WT + ((size_t)tile_e[u.pm] * nrow + u.pn * 256) * 1024; } };

constexpr int MLA_KBUF = 12288, MLA_VBUF = 8192, MLA_V0 = 2 * MLA_KBUF;
typedef short v4i16_t __attribute__((ext_vector_type(4)));
__device__ __forceinline__ s16x4 lds_tr16(const LAS unsigned char* p) { return __builtin_bit_cast(s16x4, __builtin_amdgcn_ds_read_tr16_b64_v4i16((LAS v4i16_t*)p)); }
__device__ __forceinline__ void mla_unit(const Params& p, LAS unsigned char* lds, int unit, int tid) {
    const int lane = tid & 63, wid = __builtin_amdgcn_readfirstlane(tid >> 6), r32 = lane & 31, hi = lane >> 5;
    const int qb = unit & 7, h = (unit >> 3) & 7, b = unit >> 6;
    const bf16_t* Qg = (const bf16_t*)(p.ws + WS_Q); const bf16_t* Kg = (const bf16_t*)(p.ws + WS_KB); const bf16_t* Vg = (const bf16_t*)(p.ws + WS_VB);
    const size_t rowb = (size_t)b * SEQ;
    const int q0 = qb * 256 + wid * 32;
    const int k0r = tid / 12, k0c = tid % 12, k1r = (512 + tid) / 12, k1c = (512 + tid) % 12; const bool has_k1 = tid < 256;
    const bf16_t* ksrc0 = Kg + (rowb + k0r) * 768 + h * 96 + k0c * 8; const bf16_t* ksrc1 = Kg + (rowb + k1r) * 768 + h * 96 + k1c * 8;
    const bf16_t* vsrc = Vg + (rowb + (tid >> 3)) * 512 + h * 64 + (tid & 7) * 8;
    const int kdst0 = k0c * 1024 + k0r * 16, kdst1 = k1c * 1024 + k1r * 16, vdst = MLA_V0 + ((tid & 7) >> 2) * 4096 + (tid >> 3) * 64 + (tid & 3) * 16;
    const int kfo = hi * 1024 + r32 * 16;
    const int vfo = MLA_V0 + ((lane >> 4) & 1) * 32 + (lane & 3) * 8 + (4 * hi + ((lane & 15) >> 2)) * 64;
    bf16x8 qf[6];
#pragma unroll
    for (int s = 0; s < 6; ++s) qf[s] = *(const bf16x8*)(Qg + (rowb + q0 + r32) * 768 + h * 96 + 16 * s + 8 * hi);
    const int nt_blk = 4 * qb + 4, nt_me = 4 * qb + (wid >> 1) + 1;
    u32x4 sk0, sk1 = {0u, 0u, 0u, 0u}, sv;
    sk0 = *(const u32x4*)ksrc0; if (has_k1) sk1 = *(const u32x4*)ksrc1; sv = *(const u32x4*)vsrc;
    *(LAS u32x4*)(lds + kdst0) = sk0; if (has_k1) *(LAS u32x4*)(lds + kdst1) = sk1; *(LAS u32x4*)(lds + vdst) = sv;
    __syncthreads();
    float mrun = -1.0e30f, lrun = 0.f; f32x16 o0 = {}, o1 = {};
    for (int t = 0; t < nt_blk; ++t) {
        const bool pre = (t + 1 < nt_blk);
        if (pre) { const size_t go = (size_t)(t + 1) * 64; sk0 = *(const u32x4*)(ksrc0 + go * 768); if (has_k1) sk1 = *(const u32x4*)(ksrc1 + go * 768); sv = *(const u32x4*)(vsrc + go * 512); }
        if (t < nt_me) {
            const LAS unsigned char* kb_ = lds + (t & 1) * MLA_KBUF + kfo; const LAS unsigned char* vb_ = lds + (t & 1) * MLA_VBUF + vfo;
            f32x16 sc[2];
#pragma unroll
            for (int kb = 0; kb < 2; ++kb) { f32x16 a = {};
#pragma unroll
                for (int s = 0; s < 6; ++s) { const bf16x8 kf = *(const LAS bf16x8*)(kb_ + s * 2048 + kb * 512); a = __builtin_amdgcn_mfma_f32_32x32x16_bf16(kf, qf[s], a, 0, 0, 0); }
                sc[kb] = a; }
            float mx = sc[0][0];
#pragma unroll
            for (int r = 0; r < 16; ++r) { mx = fmaxf(mx, sc[0][r]); mx = fmaxf(mx, sc[1][r]); }
            mx = fmaxf(mx, __shfl_xor(mx, 32));
            const float mnew = fmaxf(mrun, mx), alpha = fast_exp2(mrun - mnew); mrun = mnew;
            float ls = 0.f; unsigned pw[2][8];
#pragma unroll
            for (int kb = 0; kb < 2; ++kb)
#pragma unroll
                for (int r = 0; r < 16; r += 2) { const float e0 = fast_exp2(sc[kb][r] - mnew), e1 = fast_exp2(sc[kb][r + 1] - mnew); const unsigned w = pk2(e0, e1); pw[kb][r >> 1] = w;
                    ls += __uint_as_float(w << 16) + __uint_as_float(w & 0xffff0000u); }
            lrun = lrun * alpha + ls;
#pragma unroll
            for (int r = 0; r < 16; ++r) { o0[r] *= alpha; o1[r] *= alpha; }
#pragma unroll
            for (int kb = 0; kb < 2; ++kb)
#pragma unroll
                for (int s2 = 0; s2 < 2; ++s2) {
                    const bf16x8 pf = __builtin_bit_cast(bf16x8, (u32x4){pw[kb][4 * s2 + 0], pw[kb][4 * s2 + 1], pw[kb][4 * s2 + 2], pw[kb][4 * s2 + 3]});
#pragma unroll
                    for (int db = 0; db < 2; ++db) { const LAS unsigned char* vr = vb_ + db * 4096 + kb * 2048 + s2 * 1024;
                        const s16x4 lo = lds_tr16(vr), hi4 = lds_tr16(vr + 512);
                        const bf16x8 vf = (bf16x8){lo[0], lo[1], lo[2], lo[3], hi4[0], hi4[1], hi4[2], hi4[3]};
                        if (db == 0) o0 = __builtin_amdgcn_mfma_f32_32x32x16_bf16(vf, pf, o0, 0, 0, 0); else o1 = __builtin_amdgcn_mfma_f32_32x32x16_bf16(vf, pf, o1, 0, 0, 0); } }
        }
        if (pre) { LAS unsigned char* nb = lds + ((t + 1) & 1) * MLA_KBUF; *(LAS u32x4*)(nb + kdst0) = sk0; if (has_k1) *(LAS u32x4*)(nb + kdst1) = sk1;
            *(LAS u32x4*)(lds + ((t + 1) & 1) * MLA_VBUF + vdst) = sv; }
        __syncthreads();
    }
    lrun += __shfl_xor(lrun, 32);
    const float inv = 1.0f / lrun;
    bf16_t* yo = (bf16_t*)(p.ws + WS_YCAT) + (rowb + q0 + r32) * 1024 + h * 64;
#pragma unroll
    for (int g = 0; g < 4; ++g) { u32x2 w0, w1; w0.x = pk2(o0[4 * g] * inv, o0[4 * g + 1] * inv); w0.y = pk2(o0[4 * g + 2] * inv, o0[4 * g + 3] * inv);
        w1.x = pk2(o1[4 * g] * inv, o1[4 * g + 1] * inv); w1.y = pk2(o1[4 * g + 2] * inv, o1[4 * g + 3] * inv);
        *(u32x2*)(yo + 8 * g + 4 * hi) = w0; *(u32x2*)(yo + 32 + 8 * g + 4 * hi) = w1; }
}

__device__ __forceinline__ void conv_unit(const Params& p, LAS unsigned char* lds, int unit, int tid) {
    const int lane = tid & 63, wid = tid >> 6, c = tid;
    const int b = unit >> 6, t0 = (unit & 63) * 32;
    LAS float* cl = (LAS float*)lds;
    LAS float* wl = (LAS float*)(lds + 65536);
    const __amdgpu_buffer_rsrc_t wr_ = __builtin_amdgcn_make_buffer_rsrc((void*)p.w_dw, 0, 31 * 512 * 4, 0x00020000);
#pragma unroll
    for (int j = 0; j < 31; ++j) wl[j * 512 + c] = __uint_as_float(__builtin_amdgcn_raw_buffer_load_b32(wr_, c * 4, j * 2048, 0));
    const __amdgpu_buffer_rsrc_t ur = __builtin_amdgcn_make_buffer_rsrc((void*)(p.ws + WS_U), 0, (int)((size_t)NTOK * INP * 2), 0x00020000);
    const int va = (416 + c) * 2, vg = (928 + c) * 2;
    float z[62];
#pragma unroll
    for (int i = 0; i < 62; ++i) { const int t = t0 - 30 + i;
        if (t >= 0) { const int so = (b * SEQ + t) * (INP * 2);
            const float a = bf2f(__builtin_amdgcn_raw_buffer_load_b16(ur, va, so, 0)), g = bf2f(__builtin_amdgcn_raw_buffer_load_b16(ur, vg, so, 0)); z[i] = a * sigmoidf_(g); } else z[i] = 0.f; }
    float acc[32]; const float bias = p.b_dw[c];
#pragma unroll
    for (int o = 0; o < 32; ++o) acc[o] = bias;
#pragma unroll
    for (int j = 0; j < 31; ++j) { const float wj = wl[j * 512 + c];
#pragma unroll
        for (int o = 0; o < 32; ++o) acc[o] += wj * z[o + j]; }
#pragma unroll
    for (int o = 0; o < 32; ++o) cl[o * 512 + c] = acc[o];
    __syncthreads();
#pragma unroll
    for (int oo = 0; oo < 4; ++oo) { const int o = wid * 4 + oo; const LAS float* r = cl + o * 512 + lane * 8;
        const f32x4 v0 = *(const LAS f32x4*)r, v1 = *(const LAS f32x4*)(r + 4);
        float s = (v0[0] + v0[1]) + (v0[2] + v0[3]) + (v1[0] + v1[1]) + (v1[2] + v1[3]); s = wave_sum(s); const float mu = s * (1.0f / 512.0f);
        const f32x4 d0 = v0 - mu, d1 = v1 - mu; float q = (d0[0] * d0[0] + d0[1] * d0[1]) + (d0[2] * d0[2] + d0[3] * d0[3]) + (d1[0] * d1[0] + d1[1] * d1[1]) + (d1[2] * d1[2] + d1[3] * d1[3]);
        q = wave_sum(q); const float rstd = 1.0f / sqrtf(q * (1.0f / 512.0f) + EPS);
        const f32x4 g0 = *(const f32x4*)(p.g_cln + lane * 8), g1 = *(const f32x4*)(p.g_cln + lane * 8 + 4), b0 = *(const f32x4*)(p.b_cln + lane * 8), b1 = *(const f32x4*)(p.b_cln + lane * 8 + 4);
        float y[8];
#pragma unroll
        for (int j = 0; j < 4; ++j) { const float a0 = d0[j] * rstd * g0[j] + b0[j], a1 = d1[j] * rstd * g1[j] + b1[j]; y[j] = a0 * sigmoidf_(a0); y[4 + j] = a1 * sigmoidf_(a1); }
        u32x4 wv; wv.x = pk2(y[0], y[1]); wv.y = pk2(y[2], y[3]); wv.z = pk2(y[4], y[5]); wv.w = pk2(y[6], y[7]);
        *(u32x4*)((bf16_t*)(p.ws + WS_YCAT) + ((size_t)b * SEQ + t0 + o) * 1024 + 512 + lane * 8) = wv; }
    __syncthreads();
}

__device__ __forceinline__ void router1_unit(const Params& p, LAS unsigned char* lds, int unit, int tid) {
    const int lane = tid & 63, wid = tid >> 6, r = lane & 15, q = lane >> 4;
    LAS float* lg = (LAS float*)lds + wid * 512;
    LAS int* hist = (LAS int*)(lds + 16384);
    const bf16_t* WH = (const bf16_t*)(p.ws + WS_WR); const bf16_t* WL = WH + 32768;
    if (tid < 32) hist[tid] = 0;
    __syncthreads();
    const int tok0 = unit * RT_TOK + wid * 16;
    const float* xr = p.out + (size_t)(tok0 + r) * 1024 + 8 * q;
    f32x4 acc0 = {0.f, 0.f, 0.f, 0.f}, acc1 = {0.f, 0.f, 0.f, 0.f}; float ssq = 0.f;
#pragma unroll 4
    for (int ks = 0; ks < 32; ++ks) {
        const f32x4 x0 = *(const f32x4*)(xr + 32 * ks), x1 = *(const f32x4*)(xr + 32 * ks + 4);
        ssq += (x0[0] * x0[0] + x0[1] * x0[1]) + (x0[2] * x0[2] + x0[3] * x0[3]) + (x1[0] * x1[0] + x1[1] * x1[1]) + (x1[2] * x1[2] + x1[3] * x1[3]);
        unsigned h[4], l[4];
#pragma unroll
        for (int j = 0; j < 2; ++j) { const float a = x0[2 * j], b = x0[2 * j + 1]; const unsigned ha = f2bf(a), hb = f2bf(b); h[j] = ha | (hb << 16); l[j] = pk2(a - __uint_as_float(ha << 16), b - __uint_as_float(hb << 16)); }
#pragma unroll
        for (int j = 0; j < 2; ++j) { const float a = x1[2 * j], b = x1[2 * j + 1]; const unsigned ha = f2bf(a), hb = f2bf(b); h[2 + j] = ha | (hb << 16); l[2 + j] = pk2(a - __uint_as_float(ha << 16), b - __uint_as_float(hb << 16)); }
        const bf16x8 ah = __builtin_bit_cast(bf16x8, (u32x4){h[0], h[1], h[2], h[3]}), al = __builtin_bit_cast(bf16x8, (u32x4){l[0], l[1], l[2], l[3]});
        const bf16x8 bh0 = *(const bf16x8*)(WH + (size_t)r * 1024 + 32 * ks + 8 * q), bh1 = *(const bf16x8*)(WH + (size_t)(16 + r) * 1024 + 32 * ks + 8 * q);
        const bf16x8 bl0 = *(const bf16x8*)(WL + (size_t)r * 1024 + 32 * ks + 8 * q), bl1 = *(const bf16x8*)(WL + (size_t)(16 + r) * 1024 + 32 * ks + 8 * q);
        acc0 = __builtin_amdgcn_mfma_f32_16x16x32_bf16(ah, bh0, acc0, 0, 0, 0); acc1 = __builtin_amdgcn_mfma_f32_16x16x32_bf16(ah, bh1, acc1, 0, 0, 0);
        acc0 = __builtin_amdgcn_mfma_f32_16x16x32_bf16(al, bh0, acc0, 0, 0, 0); acc1 = __builtin_amdgcn_mfma_f32_16x16x32_bf16(al, bh1, acc1, 0, 0, 0);
        acc0 = __builtin_amdgcn_mfma_f32_16x16x32_bf16(ah, bl0, acc0, 0, 0, 0); acc1 = __builtin_amdgcn_mfma_f32_16x16x32_bf16(ah, bl1, acc1, 0, 0, 0);
    }
    ssq += __shfl_xor(ssq, 16); ssq += __shfl_xor(ssq, 32);
    const float rstd_r = 1.0f / sqrtf(ssq * (1.0f / 1024.0f) + EPS);
    if (lane < 16) ((float*)(p.ws + WS_RSTD_X2))[tok0 + lane] = rstd_r;
    const float be0 = p.b_router[r], be1 = p.b_router[16 + r];
#pragma unroll
    for (int j = 0; j < 4; ++j) { const float rs = __shfl(rstd_r, 4 * q + j); lg[(4 * q + j) * 32 + r] = acc0[j] * rs + be0; lg[(4 * q + j) * 32 + 16 + r] = acc1[j] * rs + be1; }
    asm volatile("s_waitcnt lgkmcnt(0)" ::: "memory");
    if (lane < 16) { const int tk = tok0 + lane; unsigned used = 0u; float tv[4]; int ti[4];
#pragma unroll
        for (int k = 0; k < 4; ++k) { float best = -3.0e38f; int bi = 0;
            for (int j = 0; j < 32; ++j) { const float v = lg[lane * 32 + j]; if (!((used >> j) & 1u) && v > best) { best = v; bi = j; } }
            used |= 1u << bi; tv[k] = best; ti[k] = bi; }
        const float e1 = __expf(tv[1] - tv[0]), e2 = __expf(tv[2] - tv[0]), e3 = __expf(tv[3] - tv[0]); const float inv = 1.0f / (1.0f + e1 + e2 + e3);
        int* oi = (int*)(p.ws + WS_TOPI) + (size_t)tk * 4; float* og = (float*)(p.ws + WS_TOPG) + (size_t)tk * 4;
        oi[0] = ti[0]; oi[1] = ti[1]; oi[2] = ti[2]; oi[3] = ti[3]; og[0] = inv; og[1] = e1 * inv; og[2] = e2 * inv; og[3] = e3 * inv;
#pragma unroll
        for (int k = 0; k < 4; ++k) atomicAdd((int*)&hist[ti[k]], 1); }
    __syncthreads();
    if (tid < 32) ((int*)(p.ws + WS_HIST))[unit * 32 + tid] = hist[tid];
    __syncthreads();
}
__device__ __forceinline__ void router2_unit(const Params& p, LAS unsigned char* lds, int unit, int tid) {
    LAS int* cnt = (LAS int*)lds;
    LAS int* base = cnt + 32;
    LAS int* pst = cnt + 64;
    LAS int* idx = cnt + 128;
    LAS int* dst = cnt + 128 + 512;
    const int* H = (const int*)(p.ws + WS_HIST);
    if (tid < 32) { int tot = 0, bs = 0; for (int b = 0; b < RT_UNITS; ++b) { const int v = H[b * 32 + tid]; tot += v; bs += (b < unit) ? v : 0; } cnt[tid] = tot; base[tid] = bs; }
    { idx[tid] = ((const int*)(p.ws + WS_TOPI))[(size_t)unit * RT_TOK * 4 + tid]; }
    __syncthreads();
    if (tid == 0) { int s = 0; for (int e = 0; e < 32; ++e) { pst[e] = s; s += (cnt[e] + 255) & ~255; } pst[32] = s; }
    __syncthreads();
    if (tid < 32) { int run = pst[tid] + base[tid]; for (int a = 0; a < 512; ++a) if (idx[a] == tid) { dst[a] = run; ++run; } }
    __syncthreads();
    { const int a = tid, d = dst[a]; const int tok = unit * RT_TOK + (a >> 2);
        ((int*)(p.ws + WS_SLOT_TOK))[d] = tok; ((float*)(p.ws + WS_SLOT_GATE))[d] = ((const float*)(p.ws + WS_TOPG))[(size_t)unit * RT_TOK * 4 + a];
        ((int*)(p.ws + WS_INV))[(size_t)unit * RT_TOK * 4 + a] = d; ((float*)(p.ws + WS_SLOT_RS))[d] = ((const float*)(p.ws + WS_RSTD_X2))[tok]; }
    if (unit < 32) { const int e = unit, s0 = pst[e] + cnt[e], s1 = pst[e + 1];
        for (int s = s0 + tid; s < s1; s += 512) { ((int*)(p.ws + WS_SLOT_TOK))[s] = 0; ((float*)(p.ws + WS_SLOT_GATE))[s] = 0.f; ((float*)(p.ws + WS_SLOT_RS))[s] = 0.f; } }
    if (unit == 32) { int* te = (int*)(p.ws + WS_TILE_E); const int nt = pst[32] >> 8;
        for (int t = tid; t < NTILE_MAX; t += 512) { int e = 31; for (int k = 31; k >= 0; --k) if (t * 256 < pst[k + 1]) e = k; te[t] = e; }
        if (tid == 0) te[NTILE_MAX] = nt; }
    __syncthreads();
}

__device__ __forceinline__ void final_row(const Params& p, int tok, int lane) {
    float* xr = p.out + (size_t)tok * 1024; const int* inv = (const int*)(p.ws + WS_INV) + (size_t)tok * 4; const bf16_t* YB = (const bf16_t*)(p.ws + WS_YB);
    f32x4 v[4];
#pragma unroll
    for (int j = 0; j < 4; ++j) v[j] = ((const f32x4*)xr)[lane + 64 * j];
#pragma unroll
    for (int k = 0; k < 4; ++k) { const u32x2* yr = (const u32x2*)(YB + (size_t)inv[k] * 1024);
#pragma unroll
        for (int j = 0; j < 4; ++j) { const u32x2 w = yr[lane + 64 * j]; v[j][0] += __uint_as_float(w.x << 16); v[j][1] += __uint_as_float(w.x & 0xffff0000u); v[j][2] += __uint_as_float(w.y << 16); v[j][3] += __uint_as_float(w.y & 0xffff0000u); } }
    float s = 0.f;
#pragma unroll
    for (int j = 0; j < 4; ++j) s += (v[j][0] * v[j][0] + v[j][1] * v[j][1]) + (v[j][2] * v[j][2] + v[j][3] * v[j][3]);
    s = wave_sum(s); const float rstd = 1.0f / sqrtf(s * (1.0f / 1024.0f) + EPS);
#pragma unroll
    for (int j = 0; j < 4; ++j) { const f32x4 g = ((const f32x4*)p.g_final)[lane + 64 * j]; ((f32x4*)xr)[lane + 64 * j] = v[j] * rstd * g; }
}


#define XB_TMO      128
#define XB_XCNT(j)  (256  + 64 * (j))
#define XB_XSUB(j)  (1280 + 64 * (j))
#define XB_XGEN(j)  (2304 + 64 * (j))
#define XB_TOP      3328
#define XB_TOPGEN   3392
#define XCD_BAR_WORDS 3456
#define XB_SPIN_CAP (1u << 18)
__device__ __forceinline__ unsigned xb_ld(unsigned* p)              { return __hip_atomic_load(p, __ATOMIC_RELAXED, __HIP_MEMORY_SCOPE_AGENT); }
__device__ __forceinline__ unsigned xb_add(unsigned* p, unsigned v) { return __hip_atomic_fetch_add(p, v, __ATOMIC_RELAXED, __HIP_MEMORY_SCOPE_AGENT); }
__device__ __forceinline__ unsigned xb_xcc_id() { return (unsigned)__builtin_amdgcn_s_getreg((3 << 11) | 20) & 0xFu; }
#define XB_SPIN(cond, bar) do { unsigned _sp = 0; while (cond) { __builtin_amdgcn_s_sleep(1); \
    if ((++_sp & 255u) == 0u) { if (xb_ld(&(bar)[XB_TMO])) break; if (_sp > XB_SPIN_CAP) { atomicAdd(&(bar)[XB_TMO], 1u); break; } } } } while (0)
struct XcdBarrier { unsigned* bar; unsigned x; volatile LAS unsigned* st; };
__device__ __forceinline__ XcdBarrier xcd_barrier_post(unsigned* bar, volatile LAS unsigned* st) {
    XcdBarrier b; b.bar = bar; b.x = xb_xcc_id(); b.st = st;
    if (threadIdx.x == 0) (void)xb_add(&bar[XB_XCNT(b.x)], 1u);
    return b;
}
__device__ __forceinline__ void xcd_barrier_complete(unsigned* bar, unsigned x, unsigned& nloc, unsigned& nx) {
    const unsigned G = gridDim.x * gridDim.y * gridDim.z;
    unsigned sum, cnt, mine, sp = 0u;
    for (;;) {
        sum = 0u; cnt = 0u; mine = 0u;
#pragma unroll
        for (unsigned j = 0; j < 16; ++j) { const unsigned c = xb_ld(&bar[XB_XCNT(j)]); sum += c; cnt += (c > 0u) ? 1u : 0u; mine = (j == x) ? c : mine; }
        if (sum == G) break;
        __builtin_amdgcn_s_sleep(1);
        if ((++sp & 255u) == 0u) { if (xb_ld(&bar[XB_TMO])) break; if (sp > XB_SPIN_CAP) { atomicAdd(&bar[XB_TMO], 1u); break; } }
    }
    nloc = mine > 0u ? mine : 1u; nx = cnt > 0u ? cnt : 1u;
}
__device__ __forceinline__ void xcd_barrier(const XcdBarrier& b) {
    asm volatile("s_waitcnt vmcnt(0)" ::: "memory");
    __syncthreads();
    if (threadIdx.x == 0) {
        unsigned* bar = b.bar;
        __builtin_amdgcn_s_waitcnt(0);
        unsigned nloc = b.st[0], nx = b.st[1];
        if (nloc == 0u) { xcd_barrier_complete(bar, b.x, nloc, nx); b.st[0] = nloc; b.st[1] = nx; }
        const unsigned old = xb_add(&bar[XB_XSUB(b.x)], 1u);
        const unsigned gen = old / nloc;
        if (old + 1u == (gen + 1u) * nloc) {
            __builtin_amdgcn_fence(__ATOMIC_RELEASE, "agent");
            asm volatile("s_waitcnt vmcnt(0)" ::: "memory");
            const unsigned og = xb_add(&bar[XB_TOP], 1u);
            const unsigned tg = og / nx;
            if (og + 1u == (tg + 1u) * nx) xb_add(&bar[XB_TOPGEN], 1u);
            else XB_SPIN(xb_ld(&bar[XB_TOPGEN]) == tg, bar);
            __builtin_amdgcn_fence(__ATOMIC_ACQUIRE, "agent");
            xb_add(&bar[XB_XGEN(b.x)], 1u);
            asm volatile("s_waitcnt vmcnt(0)" ::: "memory");
        } else {
            XB_SPIN(xb_ld(&bar[XB_XGEN(b.x)]) == gen, bar);
            __builtin_amdgcn_fence(__ATOMIC_ACQUIRE, "agent");
            asm volatile("s_waitcnt vmcnt(0)" ::: "memory");
        }
    }
    __syncthreads();
}

constexpr int EPI_LDS = 131072;
constexpr int LDS_BYTES = 147456;

#ifndef USE_CG_SYNC
#define USE_CG_SYNC 0
#endif
#if USE_CG_SYNC
#define GRID_SYNC_() grid.sync()
#else
#define GRID_SYNC_() xcd_barrier(xbar)
#endif
#if PROBE_MASK || PROBE_EPI
#define GRID_SYNC() do { GRID_SYNC_(); const unsigned long long tn_ = __builtin_amdgcn_s_memrealtime(); if ((PROBE_MASK >> ph_) & 1) tacc_ += tn_ - tprev_; tprev_ = tn_; ++ph_; } while (0)
#else
#define GRID_SYNC() GRID_SYNC_()
#endif
constexpr int XB_LDS = 147328;

__device__ __forceinline__ void mla_order(int vb, int r, int& unit) {
    const int bh = vb >> 1, s = vb & 1; const int qb = (r == 0) ? s : (r == 1) ? 7 - s : (r == 2) ? 3 - s : 4 + s; unit = bh * 8 + qb;
}

typedef const __attribute__((address_space(4))) Params* CParams;
#define PHASE_BEGIN() CParams pp_ = (CParams)__builtin_amdgcn_kernarg_segment_ptr(); asm volatile("" : "+s"(pp_)); Params p; { const __attribute__((address_space(4))) unsigned long long* q_ = (const __attribute__((address_space(4))) unsigned long long*)pp_; unsigned long long* d_ = (unsigned long long*)&p; _Pragma("unroll") for (int k_ = 0; k_ < (int)(sizeof(Params) / 8); ++k_) d_[k_] = q_[k_]; } unsigned char* ws = p.ws; int tid = threadIdx.x; asm volatile("" : "+v"(tid)); const int lane = tid & 63; (void)lane; (void)ws;

__global__ void __launch_bounds__(512) mega_kernel(Params p_unused) {
    extern __shared__ __attribute__((aligned(16))) unsigned char lds_raw[];
#if USE_CG_SYNC
    cg::grid_group grid = cg::this_grid();
#endif
    LAS unsigned char* lds = (LAS unsigned char*)lds_raw;
    if (threadIdx.x < 2) ((volatile LAS unsigned*)(lds + XB_LDS))[threadIdx.x] = 0u;
    __syncthreads();
    const XcdBarrier xbar = xcd_barrier_post((unsigned*)(((CParams)__builtin_amdgcn_kernarg_segment_ptr())->ws + WS_CTL), (volatile LAS unsigned*)(lds + XB_LDS)); (void)xbar;
    const int G = gridDim.x, bx = blockIdx.x;
    const int vb = (G % 8 == 0) ? (bx % 8) * (G / 8) + bx / 8 : bx;

#if PROBE_MASK || PROBE_EPI
    unsigned long long tprev_ = __builtin_amdgcn_s_memrealtime(), tacc_ = 0; int ph_ = 0;
#endif
    { PHASE_BEGIN(); prep_stage(p, lds, vb, G, tid); }
    GRID_SYNC();
    { PHASE_BEGIN();
      { PvPlain P{(const bf16_t*)(ws + WS_XB), (const bf16_t*)(ws + WS_WT_IN), 1024, 1024, 1024}; pg8::SchedPlain S; S.o.init(128, 6, G, bx);
        EpiIn E{(bf16_t*)(ws + WS_U), (const float*)(ws + WS_RSTD_X), (float*)(ws + WS_SSQ_Q), (float*)(ws + WS_SSQ_KV), (const float*)(ws + WS_ROPE), (bf16_t*)(ws + WS_KB)};
        pg8::gemm_phase<true, false>(lds, lds + EPI_LDS, P, S, E, tid); }
      { PvPlain P{(const bf16_t*)(ws + WS_MEMB), (const bf16_t*)(ws + WS_WT_XKV), 1024, 1024, 1024}; pg8::SchedPlain S; S.o.init(16, 8, G, (bx + 128) % G);
        EpiKVMem E{(bf16_t*)(ws + WS_KM), (bf16_t*)(ws + WS_VMT), (const float*)(ws + WS_RSTD_MEM)};
        pg8::gemm_phase<false, false>(lds, lds + EPI_LDS, P, S, E, tid); } }
    GRID_SYNC();
    { PHASE_BEGIN();
      { PvPlain P{(const bf16_t*)(ws + WS_U), (const bf16_t*)(ws + WS_WT_UQ), INP, 256, 256}; pg8::SchedPlain S; S.o.init(128, 3, G, bx);
        EpiQ E{(bf16_t*)(ws + WS_Q), (const float*)(ws + WS_SSQ_Q), (const float*)(ws + WS_ROPE)};
        pg8::gemm_phase<false, false>(lds, lds + EPI_LDS, P, S, E, tid); }
      { PvPlain P{(const bf16_t*)(ws + WS_U) + 256, (const bf16_t*)(ws + WS_WT_UKV), INP, 128, 128}; pg8::SchedPlain S; S.o.init(128, 4, G, (bx + 128) % G);
        EpiKV E{(bf16_t*)(ws + WS_KB), (bf16_t*)(ws + WS_VB), (const float*)(ws + WS_SSQ_KV)};
        pg8::gemm_phase<true, false>(lds, lds + EPI_LDS, P, S, E, tid); }
      { int tid2 = threadIdx.x; asm volatile("" : "+v"(tid2)); for (int i = vb; i < 1024; i += G) conv_unit(p, lds, i, tid2); } }
    GRID_SYNC();
    { PHASE_BEGIN();
    if (G == 256) { for (int r = 0; r < 4; ++r) { int unit; mla_order(vb, r, unit); mla_unit(p, lds, unit, tid); } }
    else { for (int i = vb; i < 1024; i += G) mla_unit(p, lds, i, tid); } }
    GRID_SYNC();
    { PHASE_BEGIN();
      PvPlain P{(const bf16_t*)(ws + WS_YCAT), (const bf16_t*)(ws + WS_WT_OUT), 1024, 1024, 1024}; pg8::SchedPlain S; S.o.init(128, 4, G, bx);
      EpiResid E{p.x, p.out, (bf16_t*)(ws + WS_X1B), (float*)(ws + WS_SSQ_X1)};
      pg8::gemm_phase<false, false>(lds, lds + EPI_LDS, P, S, E, tid); }
    GRID_SYNC();
    { PHASE_BEGIN();
      PvPlain P{(const bf16_t*)(ws + WS_X1B), (const bf16_t*)(ws + WS_WT_XQ), 1024, 1024, 1024}; pg8::SchedPlain S; S.o.init(128, 4, G, bx);
      EpiScale16 E{(bf16_t*)(ws + WS_XQ), 1024, (const float*)(ws + WS_SSQ_X1), C2_X};
      pg8::gemm_phase<true, false>(lds, lds + EPI_LDS, P, S, E, tid); }
    GRID_SYNC();
    { PHASE_BEGIN();
      PvXS P{(const bf16_t*)(ws + WS_XQ), (const bf16_t*)(ws + WS_KM), 1024, 1024, 256}; pg8::SchedBatch8 S; S.o.init(512, 1, G, bx);
      EpiSoftmaxP E{(bf16_t*)(ws + WS_P)};
      pg8::gemm_phase<true, false>(lds, lds + EPI_LDS, P, S, E, tid); }
    GRID_SYNC();
    { PHASE_BEGIN();
      PvXPV P{(const bf16_t*)(ws + WS_P), (const bf16_t*)(ws + WS_VMT), 256, 256, 256}; pg8::SchedBatch8 S; S.o.init(512, 1, G, bx);
      EpiOX E{(bf16_t*)(ws + WS_OX)};
      pg8::gemm_phase<true, false>(lds, lds + EPI_LDS, P, S, E, tid); }
    GRID_SYNC();
    { PHASE_BEGIN();
      PvPlain P{(const bf16_t*)(ws + WS_OX), (const bf16_t*)(ws + WS_WT_XO), 1024, 1024, 1024}; pg8::SchedPlain S; S.o.init(128, 4, G, bx);
      EpiResid E{p.out, p.out, (bf16_t*)(ws + WS_X2B), nullptr};
      pg8::gemm_phase<false, false>(lds, lds + EPI_LDS, P, S, E, tid); }
    GRID_SYNC();
    { PHASE_BEGIN(); for (int i = vb; i < RT_UNITS; i += G) router1_unit(p, lds, i, tid); }
    GRID_SYNC();
    { PHASE_BEGIN(); for (int i = vb; i < RT_UNITS; i += G) router2_unit(p, lds, i, tid); }
    GRID_SYNC();
    { PHASE_BEGIN(); const int* te = (const int*)(ws + WS_TILE_E); const int nt = te[NTILE_MAX];
      PvUpG P{(const bf16_t*)(ws + WS_X2B), (const bf16_t*)(ws + WS_WT_UP), te, (const int*)(ws + WS_SLOT_TOK), 1024, 1024, 1024}; pg8::SchedPlain S; S.o.init(nt, 8, G, bx);
      EpiSwiglu E{(bf16_t*)(ws + WS_ACT), (const float*)(ws + WS_SLOT_RS), te, p.b_up};
#if PROBE_EPI
      pg8::gemm_phase<true, true>(lds, lds + EPI_LDS, P, S, E, tid, &tacc_);
#else
      pg8::gemm_phase<true, true>(lds, lds + EPI_LDS, P, S, E, tid);
#endif
    }
    GRID_SYNC();
    { PHASE_BEGIN(); const int* te = (const int*)(ws + WS_TILE_E); const int nt = te[NTILE_MAX];
      PvExp P{(const bf16_t*)(ws + WS_ACT), (const bf16_t*)(ws + WS_WT_DOWN), te, 1024, 1024, 1024, 1024}; pg8::SchedPlain S; S.o.init(nt, 4, G, bx);
      EpiDown E{(bf16_t*)(ws + WS_YB), (const float*)(ws + WS_SLOT_GATE), te, p.b_down};
      pg8::gemm_phase<true, false>(lds, lds + EPI_LDS, P, S, E, tid); }
    GRID_SYNC();
    { PHASE_BEGIN(); const int gw = vb * 8 + (tid >> 6), ngw = G * 8; for (int r = gw; r < NTOK; r += ngw) final_row(p, r, lane); }
#if PROBE_MASK || PROBE_EPI
    { const unsigned long long tn_ = __builtin_amdgcn_s_memrealtime(); if ((PROBE_MASK >> ph_) & 1) tacc_ += tn_ - tprev_;
      const unsigned long long t0_ = __builtin_amdgcn_s_memrealtime(); while (__builtin_amdgcn_s_memrealtime() - t0_ < 4ull * tacc_) __builtin_amdgcn_s_sleep(8); }
#endif
}

extern "C" void kernel_launch(void* const* d_in, const int* in_sizes, int n_in, void* d_out, int out_size, void* d_ws, size_t ws_size, hipStream_t stream) {
    static int grid = 0;
    if (grid == 0) {
        if (n_in != 27 || ws_size < WS_END) { fprintf(stderr, "kernel_launch: unexpected inputs (n_in %d, ws %zu)\n", n_in, ws_size); grid = -1; return; }
        int dev = 0, cus = 0, per_cu = 0;
        (void)hipGetDevice(&dev); (void)hipDeviceGetAttribute(&cus, hipDeviceAttributeMultiprocessorCount, dev);
        (void)hipFuncSetAttribute((const void*)mega_kernel, hipFuncAttributeMaxDynamicSharedMemorySize, LDS_BYTES);
        (void)hipOccupancyMaxActiveBlocksPerMultiprocessor(&per_cu, (const void*)mega_kernel, 512, LDS_BYTES);
        if (per_cu < 1) { fprintf(stderr, "kernel_launch: occupancy query says %d blocks per CU\n", per_cu); per_cu = 1; }
        if (per_cu > 1) per_cu = 1;
        grid = cus * per_cu;
        (void)hipGetLastError();
    }
    if (grid < 0) return;
    (void)hipMemsetAsync((char*)d_ws + WS_CTL, 0, XCD_BAR_WORDS * 4, stream);
    Params p{};
    p.x = (const float*)d_in[0]; p.mem = (const float*)d_in[1]; p.pos = (const int*)d_in[2];
    p.g_mix = (const float*)d_in[3]; p.w_in = (const float*)d_in[4]; p.g_q = (const float*)d_in[5]; p.w_uq = (const float*)d_in[6]; p.g_kv = (const float*)d_in[7]; p.w_ukv = (const float*)d_in[8];
    p.w_dw = (const float*)d_in[9]; p.b_dw = (const float*)d_in[10]; p.g_cln = (const float*)d_in[11]; p.b_cln = (const float*)d_in[12]; p.w_out = (const float*)d_in[13];
    p.g_xattn = (const float*)d_in[14]; p.g_mem = (const float*)d_in[15]; p.w_xq = (const float*)d_in[16]; p.w_xkv = (const float*)d_in[17]; p.w_xo = (const float*)d_in[18];
    p.g_ffn = (const float*)d_in[19]; p.w_router = (const float*)d_in[20]; p.b_router = (const float*)d_in[21]; p.w_up = (const float*)d_in[22]; p.b_up = (const float*)d_in[23];
    p.w_down = (const float*)d_in[24]; p.b_down = (const float*)d_in[25]; p.g_final = (const float*)d_in[26];
    p.out = (float*)d_out; p.ws = (unsigned char*)d_ws;
    void* args[] = {&p};
    hipError_t e = hipLaunchCooperativeKernel((const void*)mega_kernel, dim3(grid), dim3(512), args, LDS_BYTES, stream);
    if (e != hipSuccess) fprintf(stderr, "cooperative launch failed: %s (grid %d)\n", hipGetErrorString(e), grid);
}
```

```cpp
#include <hip/hip_runtime.h>
#include <stdint.h>
#include <stdio.h>
#include <hip/hip_cooperative_groups.h>
namespace cg = cooperative_groups;

#ifndef PROBE_MASK
#define PROBE_MASK 0
#endif
#ifndef PROBE_EPI
#define PROBE_EPI 0
#endif
#ifndef PROBE_XA
#define PROBE_XA 0
#endif
#define LAS __attribute__((address_space(3)))
typedef unsigned short bf16_t;
typedef short bf16x8 __attribute__((ext_vector_type(8)));
typedef short s16x4 __attribute__((ext_vector_type(4)));
typedef float f32x2 __attribute__((ext_vector_type(2)));
typedef float f32x4 __attribute__((ext_vector_type(4)));
typedef float f32x16 __attribute__((ext_vector_type(16)));
typedef unsigned u32x2 __attribute__((ext_vector_type(2)));
typedef unsigned u32x4 __attribute__((ext_vector_type(4)));

constexpr int BATCH = 16, SEQ = 2048, NTOK = BATCH * SEQ, DM = 1024;
constexpr int INC = 1440, INP = 1536, ULD = 512;
constexpr int HEADS = 8, QKD = 96, VD = 64;
constexpr int CCH = 512, CW = 31;
constexpr int MEML = 256, NMEM = BATCH * MEML;
constexpr int XH = 4, XD = 256;
constexpr int NE = 32, TOPK = 4;
constexpr int NSLOT = NTOK * TOPK + NE * 256;
constexpr int NTILE_MAX = NSLOT / 256;
constexpr float EPS = 1e-5f;
constexpr float C2_MLA = 0.14724444602590306f;
constexpr float C2_X = 0.09016844005556021f;
constexpr int RT_TOK = 128, RT_UNITS = NTOK / RT_TOK;

constexpr size_t MiB = 1u << 20;
constexpr size_t WS_CTL = 0;
constexpr size_t WS_RSTD_X = 1 * MiB;
constexpr size_t WS_RSTD_Q = WS_RSTD_X + 128 * 1024;
constexpr size_t WS_RSTD_KV = WS_RSTD_Q + 128 * 1024;
constexpr size_t WS_RSTD_X1 = WS_RSTD_KV + 128 * 1024;
constexpr size_t WS_RSTD_X2 = WS_RSTD_X1 + 128 * 1024;
constexpr size_t WS_RSTD_MEM = WS_RSTD_X2 + 128 * 1024;
constexpr size_t WS_ROPE = 2 * MiB;
constexpr size_t WS_TOPI = 6 * MiB;
constexpr size_t WS_TOPG = WS_TOPI + 512 * 1024;
constexpr size_t WS_INV = WS_TOPG + 512 * 1024;
constexpr size_t WS_SLOT_TOK = WS_INV + 512 * 1024;
constexpr size_t WS_SLOT_GATE = WS_SLOT_TOK + 1 * MiB;
constexpr size_t WS_SLOT_RS = 15 * MiB + 256 * 1024;
constexpr size_t WS_HIST = WS_SLOT_GATE + 1 * MiB;
constexpr size_t WS_TILE_E = WS_HIST + 64 * 1024;
constexpr size_t WS_SSQ_Q = 10 * MiB;
constexpr size_t WS_SSQ_KV = 10 * MiB + 512 * 1024;
constexpr size_t WS_SSQ_X1 = 11 * MiB;
constexpr size_t WS_SSQ_X2 = 13 * MiB;
constexpr size_t WS_WR = 15 * MiB;
constexpr size_t WS_WT_IN = 16 * MiB;
constexpr size_t WS_WT_UQ = 19 * MiB;
constexpr size_t WS_WT_UKV = WS_WT_UQ + 512 * 1024;
constexpr size_t WS_WT_OUT = 20 * MiB;
constexpr size_t WS_WT_XQ = 22 * MiB;
constexpr size_t WS_WT_XKV = 24 * MiB;
constexpr size_t WS_WT_XO = 28 * MiB;
constexpr size_t WS_WT_UP = 32 * MiB;
constexpr size_t WS_WT_DOWN = 160 * MiB;
constexpr size_t WS_X2B = 224 * MiB;
constexpr size_t WS_XB = WS_X2B;
constexpr size_t WS_ACT = 288 * MiB;
constexpr size_t WS_U = 288 * MiB;
constexpr size_t WS_Z = 320 * MiB;
constexpr size_t WS_Q = 384 * MiB;
constexpr size_t WS_KB = 432 * MiB;
constexpr size_t WS_VB = 480 * MiB;
constexpr size_t WS_YCAT = 512 * MiB;
constexpr size_t WS_YB = 560 * MiB;
constexpr size_t WS_XG = WS_YB;
constexpr size_t WS_X1B = 576 * MiB;
constexpr size_t WS_XQ = 640 * MiB;
constexpr size_t WS_P = 704 * MiB;
constexpr size_t WS_OX = 768 * MiB;
constexpr size_t WS_MEMB = 832 * MiB;
constexpr size_t WS_KM = 840 * MiB;
constexpr size_t WS_VMT = 848 * MiB;
constexpr size_t WS_END = 856 * MiB;

struct Params {
    const float* x; const float* mem; const int* pos;
    const float *g_mix, *w_in, *g_q, *w_uq, *g_kv, *w_ukv, *w_dw, *b_dw, *g_cln, *b_cln, *w_out, *g_xattn, *g_mem, *w_xq, *w_xkv, *w_xo, *g_ffn, *w_router, *b_router, *w_up, *b_up, *w_down, *b_down, *g_final;
    float* out; unsigned char* ws;
};

__device__ __forceinline__ float bf2f(bf16_t b) { return __uint_as_float((unsigned)b << 16); }
__device__ __forceinline__ unsigned f2bf(float f) { unsigned u = __float_as_uint(f); return (u + 0x7fffu + ((u >> 16) & 1u)) >> 16; }
typedef __bf16 bf16x2_t __attribute__((ext_vector_type(2)));
__device__ __forceinline__ unsigned pk2(float lo, float hi) { const f32x2 v = {lo, hi}; const bf16x2_t b = __builtin_convertvector(v, bf16x2_t); return __builtin_bit_cast(unsigned, b); }
__device__ __forceinline__ float wave_sum(float v) {
#pragma unroll
    for (int o = 1; o < 64; o <<= 1) v += __shfl_xor(v, o);
    return v;
}
__device__ __forceinline__ int perm32(int rho) { const int n = rho >> 4, i = rho & 15; return 8 * (i >> 2) + 4 * n + (i & 3); }
__device__ __forceinline__ float fast_exp2(float x) { return __builtin_amdgcn_exp2f(x); }
__device__ __forceinline__ float sigmoidf_(float x) { return 1.0f / (1.0f + __expf(-x)); }

struct TrDesc { const float* W; const float* g; bf16_t* WT; int N, K, mode, k0, n0; };
__device__ __forceinline__ void tr_load(const TrDesc& d, float (&v)[32], int lane) {
    const float* src = d.W + (size_t)(d.k0 + (lane >> 5)) * d.N + d.n0 + (lane & 31);
#pragma unroll
    for (int i = 0; i < 32; ++i) v[i] = src[(size_t)(2 * i) * d.N];
}
__device__ __forceinline__ void tr_store(const TrDesc& d, const float (&v)[32], LAS float* scr, int lane) {
#pragma unroll
    for (int i = 0; i < 32; ++i) scr[(2 * i + (lane >> 5)) * 33 + (lane & 31)] = v[i];
    asm volatile("s_waitcnt lgkmcnt(0)" ::: "memory");
    const int c = lane & 7;
    f32x4 g0 = {1.f, 1.f, 1.f, 1.f}, g1 = {1.f, 1.f, 1.f, 1.f};
    if (d.g) { g0 = *(const f32x4*)(d.g + d.k0 + 8 * c); g1 = *(const f32x4*)(d.g + d.k0 + 8 * c + 4); }
#pragma unroll
    for (int j = 0; j < 4; ++j) { const int n = (lane >> 3) + 8 * j; const LAS float* sp = scr + (8 * c) * 33 + n;
        u32x4 o; o.x = pk2(sp[0 * 33] * g0[0], sp[1 * 33] * g0[1]); o.y = pk2(sp[2 * 33] * g0[2], sp[3 * 33] * g0[3]); o.z = pk2(sp[4 * 33] * g1[0], sp[5 * 33] * g1[1]); o.w = pk2(sp[6 * 33] * g1[2], sp[7 * 33] * g1[3]);
        const int nn = d.n0 + n; int row = nn; if (d.mode == 1) row = (((nn & 1023) >> 7) << 8) + ((nn >> 10) << 7) + (nn & 127);
        if (d.mode == 2 && nn >= 416) { const int c = (nn - 416) & 511, isg = (nn - 416) >> 9; row = 512 + ((c >> 7) << 8) + (isg << 7) + (c & 127); }
        *(u32x4*)(d.WT + (size_t)row * d.K + d.k0 + 8 * c) = o; }
    asm volatile("s_waitcnt lgkmcnt(0)" ::: "memory");
}
__device__ __forceinline__ void row_bf16_rstd(const float* xrow, bf16_t* orow, float* rstd_out, int lane) {
    f32x4 v[4]; float s = 0.f;
#pragma unroll
    for (int j = 0; j < 4; ++j) { v[j] = ((const f32x4*)xrow)[lane + 64 * j]; s += (v[j].x * v[j].x + v[j].y * v[j].y) + (v[j].z * v[j].z + v[j].w * v[j].w); }
    s = wave_sum(s);
    if (lane == 0) *rstd_out = 1.0f / sqrtf(s * (1.0f / 1024.0f) + EPS);
    if (orow) {
#pragma unroll
        for (int j = 0; j < 4; ++j) { u32x2 w; w.x = pk2(v[j].x, v[j].y); w.y = pk2(v[j].z, v[j].w); ((u32x2*)orow)[lane + 64 * j] = w; }
    }
}
__device__ __forceinline__ void sincos_acc(double a, float& s, float& c) {
    const double TWO_PI = 6.283185307179586476925;
    const double n = rint(a * (1.0 / TWO_PI)); const double r = a - n * TWO_PI;
    const double h = 0.5 * r, h2 = h * h;
    const double sh = h * (1.0 + h2 * (-1.0 / 6.0 + h2 * (1.0 / 120.0 + h2 * (-1.0 / 5040.0 + h2 * (1.0 / 362880.0 + h2 * (-1.0 / 39916800.0 + h2 * (1.0 / 6227020800.0 + h2 * (-1.0 / 1307674368000.0 + h2 * (1.0 / 355687428096000.0)))))))));
    const double ch = 1.0 + h2 * (-0.5 + h2 * (1.0 / 24.0 + h2 * (-1.0 / 720.0 + h2 * (1.0 / 40320.0 + h2 * (-1.0 / 3628800.0 + h2 * (1.0 / 479001600.0 + h2 * (-1.0 / 87178291200.0 + h2 * (1.0 / 20922789888000.0 + h2 * (-1.0 / 6402373705728000.0)))))))));
    s = (float)(2.0 * sh * ch); c = (float)(ch * ch - sh * sh);
}
__device__ __forceinline__ double rope_inv(int i) {
    const double t[16] = {1.0, 0.5623413251903491, 0.31622776601683794, 0.1778279410038923, 0.1, 0.05623413251903491, 0.03162277660168379, 0.01778279410038923,
                          0.01, 0.005623413251903491, 0.0031622776601683794, 0.0017782794100389228, 0.001, 0.0005623413251903491, 0.00031622776601683794, 0.00017782794100389227};
    double r = t[0];
#pragma unroll
    for (int k = 1; k < 16; ++k) r = (i == k) ? t[k] : r;
    return r;
}

__device__ __forceinline__ void prep_stage(const Params& p, LAS unsigned char* lds, int vblk, int nblk, int tid) {
    const int lane = tid & 63, wid = tid >> 6;
    const int gw = vblk * 8 + wid, ngw = nblk * 8;
    LAS float* scr = (LAS float*)(lds + wid * 8448);
    unsigned char* ws = p.ws;
    constexpr int I_IN = 16 * 45, I_UQ = 4 * 24, I_UKV = 2 * 32, I_SQ = 16 * 32, I_XKV = 16 * 64, I_UP1 = 16 * 64, I_DN1 = 16 * 32;
    constexpr int NITEMS = I_IN + I_UQ + I_UKV + 3 * I_SQ + I_XKV + NE * I_UP1 + NE * I_DN1;
    auto get_desc = [&](int it) -> TrDesc {
        TrDesc d; int r = it; int item;
        if (r < I_IN) { d.W = p.w_in; d.N = INC; d.K = 1024; d.g = p.g_mix; d.WT = (bf16_t*)(ws + WS_WT_IN); d.mode = 2; item = r; }
        else if ((r -= I_IN) < I_UQ) { d.W = p.w_uq; d.N = 768; d.K = 256; d.g = p.g_q; d.WT = (bf16_t*)(ws + WS_WT_UQ); d.mode = 0; item = r; }
        else if ((r -= I_UQ) < I_UKV) { d.W = p.w_ukv; d.N = 1024; d.K = 128; d.g = p.g_kv; d.WT = (bf16_t*)(ws + WS_WT_UKV); d.mode = 0; item = r; }
        else if ((r -= I_UKV) < I_SQ) { d.W = p.w_out; d.N = 1024; d.K = 1024; d.g = nullptr; d.WT = (bf16_t*)(ws + WS_WT_OUT); d.mode = 0; item = r; }
        else if ((r -= I_SQ) < I_SQ) { d.W = p.w_xq; d.N = 1024; d.K = 1024; d.g = p.g_xattn; d.WT = (bf16_t*)(ws + WS_WT_XQ); d.mode = 0; item = r; }
        else if ((r -= I_SQ) < I_SQ) { d.W = p.w_xo; d.N = 1024; d.K = 1024; d.g = nullptr; d.WT = (bf16_t*)(ws + WS_WT_XO); d.mode = 0; item = r; }
        else if ((r -= I_SQ) < I_XKV) { d.W = p.w_xkv; d.N = 2048; d.K = 1024; d.g = p.g_mem; d.WT = (bf16_t*)(ws + WS_WT_XKV); d.mode = 0; item = r; }
        else if ((r -= I_XKV) < NE * I_UP1) { const int e = r / I_UP1; d.W = p.w_up + (size_t)e * 1024 * 2048; d.N = 2048; d.K = 1024; d.g = p.g_ffn; d.WT = (bf16_t*)(ws + WS_WT_UP) + (size_t)e * 2048 * 1024; d.mode = 1; item = r % I_UP1; }
        else { r -= NE * I_UP1; const int e = r / I_DN1; d.W = p.w_down + (size_t)e * 1024 * 1024; d.N = 1024; d.K = 1024; d.g = nullptr; d.WT = (bf16_t*)(ws + WS_WT_DOWN) + (size_t)e * 1024 * 1024; d.mode = 0; item = r % I_DN1; }
        const int nblk = d.N / 32; d.k0 = 64 * (item / nblk); d.n0 = 32 * (item % nblk); return d; };
    if (gw < NITEMS) {
        TrDesc dc = get_desc(gw); float vc[32]; tr_load(dc, vc, lane);
        for (int it = gw; it < NITEMS; it += ngw) {
            const int nx = it + ngw; TrDesc dn = dc; float vn[32];
            if (nx < NITEMS) { dn = get_desc(nx); tr_load(dn, vn, lane); }
            tr_store(dc, vc, scr, lane);
            if (nx < NITEMS) { dc = dn;
#pragma unroll
                for (int i = 0; i < 32; ++i) vc[i] = vn[i]; }
        }
    }
    for (int m = gw; m < NTOK; m += ngw) row_bf16_rstd(p.x + (size_t)m * 1024, (bf16_t*)(ws + WS_XB) + (size_t)m * 1024, (float*)(ws + WS_RSTD_X) + m, lane);
    for (int m = gw; m < NMEM; m += ngw) row_bf16_rstd(p.mem + (size_t)m * 1024, (bf16_t*)(ws + WS_MEMB) + (size_t)m * 1024, (float*)(ws + WS_RSTD_MEM) + m, lane);
    const int gt = vblk * 512 + tid, ngt = nblk * 512;
    for (int i = gt; i < NTOK * 16; i += ngt) { const int row = i >> 4, f = i & 15; float s, c; sincos_acc((double)p.pos[row] * rope_inv(f), s, c);
        float* rt = (float*)(ws + WS_ROPE) + (size_t)row * 32; rt[f] = c; rt[16 + f] = s; }
    for (int i = gt; i < 1024 * 32; i += ngt) { const int k = i >> 5, e = i & 31; const float v = p.g_ffn[k] * p.w_router[i]; const unsigned hb = f2bf(v); const float lo = v - __uint_as_float(hb << 16);
        ((bf16_t*)(ws + WS_WR))[e * 1024 + k] = (bf16_t)hb; ((bf16_t*)(ws + WS_WR))[32768 + e * 1024 + k] = (bf16_t)f2bf(lo); }
    for (int i = gt; i < 96 * 1024 / 8; i += ngt) ((u32x4*)((bf16_t*)(ws + WS_WT_IN) + (size_t)416 * 1024))[i] = (u32x4){0u, 0u, 0u, 0u};
}

struct Unit { int pm, pn, z; };
typedef f32x4 Acc[2][2][4][2];

template <bool PERM, class Prov, class Epi>
__device__ __forceinline__ void gemm_unit_naive(const Prov& P, const Epi& E, const Unit& u, LAS unsigned char* lds, int tid) {
    const int wid = tid >> 6, lane = tid & 63, wr = wid >> 2, wc = wid & 3, fr = lane & 15, fq = lane >> 4;
    const bf16_t* ap[2][4]; const bf16_t* bp[2][2];
#pragma unroll
    for (int ai = 0; ai < 2; ++ai)
#pragma unroll
        for (int m = 0; m < 4; ++m) ap[ai][m] = P.a_row(u, 128 * ai + 64 * wr + 16 * m + fr) + 8 * fq;
#pragma unroll
    for (int bj = 0; bj < 2; ++bj)
#pragma unroll
        for (int n = 0; n < 2; ++n) { const int rho = 16 * n + fr; bp[bj][n] = P.b_row(u, 128 * bj + 32 * wc + (PERM ? perm32(rho) : rho)) + 8 * fq; }
    Acc acc;
#pragma unroll
    for (int a = 0; a < 2; ++a)
#pragma unroll
        for (int b = 0; b < 2; ++b)
#pragma unroll
            for (int m = 0; m < 4; ++m)
#pragma unroll
                for (int n = 0; n < 2; ++n) acc[a][b][m][n] = (f32x4){0.f, 0.f, 0.f, 0.f};
    const int K = P.K;
#pragma unroll 1
    for (int k0 = 0; k0 < K; k0 += 32) {
        bf16x8 a[2][4], b[2][2];
#pragma unroll
        for (int ai = 0; ai < 2; ++ai)
#pragma unroll
            for (int m = 0; m < 4; ++m) a[ai][m] = *(const bf16x8*)(ap[ai][m] + k0);
#pragma unroll
        for (int bj = 0; bj < 2; ++bj)
#pragma unroll
            for (int n = 0; n < 2; ++n) b[bj][n] = *(const bf16x8*)(bp[bj][n] + k0);
#pragma unroll
        for (int ai = 0; ai < 2; ++ai)
#pragma unroll
            for (int bj = 0; bj < 2; ++bj)
#pragma unroll
                for (int m = 0; m < 4; ++m)
#pragma unroll
                    for (int n = 0; n < 2; ++n) acc[ai][bj][m][n] = __builtin_amdgcn_mfma_f32_16x16x32_bf16(b[bj][n], a[ai][m], acc[ai][bj][m][n], 0, 0, 0);
    }
    E(acc, u, wr, wc, fr, fq, lds, (const LAS float*)lds);
}

struct ProvPlain { const bf16_t* A; int lda; const bf16_t* Bt; int ldb; int K;
    __device__ __forceinline__ const bf16_t* a_row(const Unit& u, int r) const { return A + (size_t)(u.pm * 256 + r) * lda; }
    __device__ __forceinline__ const bf16_t* b_row(const Unit& u, int r) const { return Bt + (size_t)(u.pn * 256 + r) * ldb; } };
struct ProvXS { const bf16_t* XQ; const bf16_t* KM; int K;
    __device__ __forceinline__ const bf16_t* a_row(const Unit& u, int r) const { return XQ + (size_t)((u.z >> 2) * 2048 + u.pm * 256 + r) * 1024 + (u.z & 3) * 256; }
    __device__ __forceinline__ const bf16_t* b_row(const Unit& u, int r) const { return KM + (size_t)((u.z >> 2) * 256 + r) * 1024 + (u.z & 3) * 256; } };
struct ProvXPV { const bf16_t* Pm; const bf16_t* VMT; int K;
    __device__ __forceinline__ const bf16_t* a_row(const Unit& u, int r) const { return Pm + ((size_t)u.z * 2048 + u.pm * 256 + r) * 256; }
    __device__ __forceinline__ const bf16_t* b_row(const Unit& u, int r) const { return VMT + ((size_t)u.z * 256 + r) * 256; } };
struct ProvUp { const bf16_t* X2B; const int* slot_tok; const int* tile_e; const bf16_t* WT; int K;
    __device__ __forceinline__ const bf16_t* a_row(const Unit& u, int r) const { return X2B + (size_t)slot_tok[u.pm * 256 + r] * 1024; }
    __device__ __forceinline__ const bf16_t* b_row(const Unit& u, int r) const { return WT + ((size_t)tile_e[u.pm] * 2048 + u.pn * 256 + r) * 1024; } };
struct ProvDown { const bf16_t* ACT; const int* tile_e; const bf16_t* WT; int K;
    __device__ __forceinline__ const bf16_t* a_row(const Unit& u, int r) const { return ACT + (size_t)(u.pm * 256 + r) * 1024; }
    __device__ __forceinline__ const bf16_t* b_row(const Unit& u, int r) const { return WT + ((size_t)tile_e[u.pm] * 1024 + u.pn * 256 + r) * 1024; } };

#define EPI_BAR() do { asm volatile("s_waitcnt lgkmcnt(0)" ::: "memory"); __builtin_amdgcn_s_barrier(); asm volatile("" ::: "memory"); } while (0)
#define EPI_ARGS Acc& acc, const Unit& u, int wr, int wc, int fr, int fq, LAS unsigned char* lds, const LAS float* tab
#define EPI_NOPF __device__ __forceinline__ void prefetch(const Unit&, LAS float*, int) const {}
#define FOR_AI_M _Pragma("unroll") for (int ai = 0; ai < 2; ++ai) _Pragma("unroll") for (int m = 0; m < 4; ++m)
#define FOR_BJ _Pragma("unroll") for (int bj = 0; bj < 2; ++bj)
struct EpiIn { bf16_t* U; bf16_t* Z; const float* rs; float* ssq_q; float* ssq_kv; const float* rope; bf16_t* KB;
    EPI_NOPF
    __device__ __forceinline__ void operator()(EPI_ARGS) const {
        if (u.pn >= 2) {
            FOR_AI_M { const int row = u.pm * 256 + 128 * ai + 64 * wr + 16 * m + fr; const float s = rs[row]; f32x4 o[2];
#pragma unroll
                for (int n = 0; n < 2; ++n) { const f32x4 av = acc[ai][0][m][n] * s, gv = acc[ai][1][m][n] * s; const f32x4 t = gv * (-1.4426950408889634f); f32x4 ex;
#pragma unroll
                    for (int j = 0; j < 4; ++j) ex[j] = __builtin_amdgcn_exp2f(t[j]);
                    ex = ex + 1.0f; f32x4 rc;
#pragma unroll
                    for (int j = 0; j < 4; ++j) rc[j] = __builtin_amdgcn_rcpf(ex[j]);
                    o[n] = av * rc; }
                u32x4 w; w.x = pk2(o[0][0], o[0][1]); w.y = pk2(o[0][2], o[0][3]); w.z = pk2(o[1][0], o[1][1]); w.w = pk2(o[1][2], o[1][3]);
                *(u32x4*)(Z + (size_t)row * 512 + (u.pn - 2) * 128 + 32 * wc + 8 * fq) = w; }
            return; }
        FOR_AI_M { const int row = u.pm * 256 + 128 * ai + 64 * wr + 16 * m + fr; const float s = rs[row]; bf16_t* rowp = U + (size_t)row * ULD + u.pn * 256 + 32 * wc + 8 * fq;
            float q0 = 0.f, q1 = 0.f;
            FOR_BJ { const f32x4 v0 = acc[ai][bj][m][0] * s, v1 = acc[ai][bj][m][1] * s; u32x4 w; w.x = pk2(v0[0], v0[1]); w.y = pk2(v0[2], v0[3]); w.z = pk2(v1[0], v1[1]); w.w = pk2(v1[2], v1[3]);
                *(u32x4*)(rowp + 128 * bj) = w;
                const float qq = (v0[0] * v0[0] + v0[1] * v0[1]) + (v0[2] * v0[2] + v0[3] * v0[3]) + (v1[0] * v1[0] + v1[1] * v1[1]) + (v1[2] * v1[2] + v1[3] * v1[3]);
                if (bj == 0) q0 = qq; else q1 = qq; }
            if (u.pn == 0) { float q = q0 + q1; q += __shfl_xor(q, 16); q += __shfl_xor(q, 32); if (fq == 0) ssq_q[(size_t)row * 4 + wc] = q; }
            if (u.pn == 1) { float q = q0; q += __shfl_xor(q, 16); q += __shfl_xor(q, 32); if (fq == 0) ssq_kv[(size_t)row * 4 + wc] = q;
                if (wc == 0) {
                    const int i0 = 8 * (fq & 1); const f32x4 c0 = *(const f32x4*)(rope + (size_t)row * 32 + i0), c1 = *(const f32x4*)(rope + (size_t)row * 32 + i0 + 4);
                    const f32x4 s0 = *(const f32x4*)(rope + (size_t)row * 32 + 16 + i0), s1 = *(const f32x4*)(rope + (size_t)row * 32 + 16 + i0 + 4);
                    const f32x4 v0 = acc[ai][1][m][0] * s, v1 = acc[ai][1][m][1] * s; f32x4 p0, p1;
#pragma unroll
                    for (int j = 0; j < 4; ++j) { p0[j] = __shfl_xor(v0[j], 32); p1[j] = __shfl_xor(v1[j], 32); }
                    f32x4 o0, o1;
                    if (fq < 2) { o0 = v0 * c0 - p0 * s0; o1 = v1 * c1 - p1 * s1; } else { o0 = p0 * s0 + v0 * c0; o1 = p1 * s1 + v1 * c1; }
                    u32x4 w; w.x = pk2(o0[0], o0[1]); w.y = pk2(o0[2], o0[3]); w.z = pk2(o1[0], o1[1]); w.w = pk2(o1[2], o1[3]);
                    bf16_t* kb = KB + (size_t)row * 768 + 64 + 8 * fq;
#pragma unroll
                    for (int h = 0; h < 8; ++h) *(u32x4*)(kb + h * 96) = w; } } } } };
struct EpiScale16 { bf16_t* O; int ldc; const float* ssq; float mul;
    EPI_NOPF
    __device__ __forceinline__ void operator()(EPI_ARGS) const {
        FOR_AI_M { const int row = u.pm * 256 + 128 * ai + 64 * wr + 16 * m + fr; const f32x4* sp = (const f32x4*)(ssq + (size_t)row * 16); const f32x4 t = (sp[0] + sp[1]) + (sp[2] + sp[3]);
            const float s = mul / sqrtf(((t[0] + t[1]) + (t[2] + t[3])) * (1.0f / 1024.0f) + EPS); bf16_t* rowp = O + (size_t)row * ldc + u.pn * 256 + 32 * wc + 8 * fq;
            FOR_BJ { const f32x4 v0 = acc[ai][bj][m][0] * s, v1 = acc[ai][bj][m][1] * s; u32x4 w; w.x = pk2(v0[0], v0[1]); w.y = pk2(v0[2], v0[3]); w.z = pk2(v1[0], v1[1]); w.w = pk2(v1[2], v1[3]);
                *(u32x4*)(rowp + 128 * bj) = w; } } } };
struct EpiQ { bf16_t* Q; const float* ssq; const float* rope;
    EPI_NOPF
    __device__ __forceinline__ void operator()(EPI_ARGS) const {
        FOR_AI_M { const int row = u.pm * 256 + 128 * ai + 64 * wr + 16 * m + fr; const f32x4 t = *(const f32x4*)(ssq + (size_t)row * 4); const float s = C2_MLA / sqrtf(((t[0] + t[1]) + (t[2] + t[3])) * (1.0f / 256.0f) + EPS);
            const f32x4 cs = *(const f32x4*)(rope + (size_t)row * 32 + 4 * fq), sn = *(const f32x4*)(rope + (size_t)row * 32 + 16 + 4 * fq);
            FOR_BJ { const int colg = u.pn * 256 + 128 * bj + 32 * wc; f32x4 v0 = acc[ai][bj][m][0] * s, v1 = acc[ai][bj][m][1] * s;
                if (((colg >> 5) % 3) == 2) { const f32x4 r0 = v0 * cs - v1 * sn, r1 = v0 * sn + v1 * cs; v0 = r0; v1 = r1; }
                bf16_t* rowp = Q + (size_t)row * 768 + colg + 4 * fq; u32x2 w0, w1; w0.x = pk2(v0[0], v0[1]); w0.y = pk2(v0[2], v0[3]); w1.x = pk2(v1[0], v1[1]); w1.y = pk2(v1[2], v1[3]);
                *(u32x2*)(rowp) = w0; *(u32x2*)(rowp + 16) = w1; } } } };
struct EpiKV { bf16_t* KB; bf16_t* VB; const float* ssq;
    EPI_NOPF
    __device__ __forceinline__ void operator()(EPI_ARGS) const {
        FOR_AI_M { const int row = u.pm * 256 + 128 * ai + 64 * wr + 16 * m + fr; const f32x4 t = *(const f32x4*)(ssq + (size_t)row * 4); const float s = 1.0f / sqrtf(((t[0] + t[1]) + (t[2] + t[3])) * (1.0f / 128.0f) + EPS);
            FOR_BJ { const int h = 2 * u.pn + bj, cl = 32 * wc + 8 * fq; const f32x4 v0 = acc[ai][bj][m][0] * s, v1 = acc[ai][bj][m][1] * s;
                u32x4 w; w.x = pk2(v0[0], v0[1]); w.y = pk2(v0[2], v0[3]); w.z = pk2(v1[0], v1[1]); w.w = pk2(v1[2], v1[3]);
                if (wc < 2) *(u32x4*)(KB + (size_t)row * 768 + h * 96 + cl) = w; else *(u32x4*)(VB + (size_t)row * 512 + h * 64 + cl - 64) = w; } } } };
struct EpiResid { const bf16_t* base; bf16_t* ob; float* ssq;
    EPI_NOPF
    __device__ __forceinline__ void operator()(EPI_ARGS) const {
        FOR_AI_M { const int row = u.pm * 256 + 128 * ai + 64 * wr + 16 * m + fr; float q = 0.f;
            FOR_BJ { const size_t off = (size_t)row * 1024 + u.pn * 256 + 128 * bj + 32 * wc + 8 * fq;
                const u32x4 bw = *(const u32x4*)(base + off);
                f32x4 v0, v1; v0[0] = __uint_as_float(bw.x << 16); v0[1] = __uint_as_float(bw.x & 0xffff0000u); v0[2] = __uint_as_float(bw.y << 16); v0[3] = __uint_as_float(bw.y & 0xffff0000u);
                v1[0] = __uint_as_float(bw.z << 16); v1[1] = __uint_as_float(bw.z & 0xffff0000u); v1[2] = __uint_as_float(bw.w << 16); v1[3] = __uint_as_float(bw.w & 0xffff0000u);
                v0 = v0 + acc[ai][bj][m][0]; v1 = v1 + acc[ai][bj][m][1];
                u32x4 w; w.x = pk2(v0[0], v0[1]); w.y = pk2(v0[2], v0[3]); w.z = pk2(v1[0], v1[1]); w.w = pk2(v1[2], v1[3]); *(u32x4*)(ob + off) = w;
                q += (v0[0] * v0[0] + v0[1] * v0[1]) + (v0[2] * v0[2] + v0[3] * v0[3]) + (v1[0] * v1[0] + v1[1] * v1[1]) + (v1[2] * v1[2] + v1[3] * v1[3]); }
            if (ssq) { q += __shfl_xor(q, 16); q += __shfl_xor(q, 32); if (fq == 0) ssq[(size_t)row * 16 + u.pn * 4 + wc] = q; } } } };
struct EpiKVMem { bf16_t* KM; bf16_t* VMT; const float* rs;
    EPI_NOPF
    __device__ __forceinline__ void operator()(EPI_ARGS) const {
        FOR_AI_M { const int row = u.pm * 256 + 128 * ai + 64 * wr + 16 * m + fr; const float s = rs[row];
            FOR_BJ {
#pragma unroll
                for (int n = 0; n < 2; ++n) { const int col = u.pn * 256 + 128 * bj + 32 * wc + 16 * n + 4 * fq; const f32x4 v = acc[ai][bj][m][n] * s;
                    if (u.pn < 4) { u32x2 w; w.x = pk2(v[0], v[1]); w.y = pk2(v[2], v[3]); *(u32x2*)(KM + (size_t)row * 1024 + col) = w; }
                    else { const int c2 = col - 1024, h = c2 >> 8, d = c2 & 255, b = row >> 8, mm = row & 255; bf16_t* dst = VMT + ((size_t)(b * 4 + h) * 256 + d) * 256 + mm;
#pragma unroll
                        for (int j = 0; j < 4; ++j) dst[(size_t)j * 256] = (bf16_t)f2bf(v[j]); } } } } } };
struct EpiSoftmaxP { bf16_t* Pm;
    EPI_NOPF
    __device__ __forceinline__ void operator()(EPI_ARGS) const {
        LAS float* red = (LAS float*)lds; float rmax[2][4];
        FOR_AI_M { float mx = -3.0e38f;
            FOR_BJ {
#pragma unroll
                for (int n = 0; n < 2; ++n)
#pragma unroll
                    for (int j = 0; j < 4; ++j) mx = fmaxf(mx, acc[ai][bj][m][n][j]); }
            mx = fmaxf(mx, __shfl_xor(mx, 16)); mx = fmaxf(mx, __shfl_xor(mx, 32));
            if (fq == 0) red[(128 * ai + 64 * wr + 16 * m + fr) * 4 + wc] = mx; }
        EPI_BAR();
        FOR_AI_M { const f32x4 t = *(const LAS f32x4*)(red + (128 * ai + 64 * wr + 16 * m + fr) * 4); rmax[ai][m] = fmaxf(fmaxf(t[0], t[1]), fmaxf(t[2], t[3])); }
        EPI_BAR();
        FOR_AI_M { float s = 0.f;
            FOR_BJ {
#pragma unroll
                for (int n = 0; n < 2; ++n)
#pragma unroll
                    for (int j = 0; j < 4; ++j) { const float e = fast_exp2(acc[ai][bj][m][n][j] - rmax[ai][m]); acc[ai][bj][m][n][j] = e; s += e; } }
            s += __shfl_xor(s, 16); s += __shfl_xor(s, 32);
            if (fq == 0) red[(128 * ai + 64 * wr + 16 * m + fr) * 4 + wc] = s; }
        EPI_BAR();
        FOR_AI_M { const int r = 128 * ai + 64 * wr + 16 * m + fr; const f32x4 t = *(const LAS f32x4*)(red + r * 4); const float inv = 1.0f / ((t[0] + t[1]) + (t[2] + t[3]));
            bf16_t* rowp = Pm + ((size_t)u.z * 2048 + u.pm * 256 + r) * 256 + 32 * wc + 8 * fq;
            FOR_BJ { const f32x4 v0 = acc[ai][bj][m][0] * inv, v1 = acc[ai][bj][m][1] * inv; u32x4 w; w.x = pk2(v0[0], v0[1]); w.y = pk2(v0[2], v0[3]); w.z = pk2(v1[0], v1[1]); w.w = pk2(v1[2], v1[3]);
                *(u32x4*)(rowp + 128 * bj) = w; } }
        EPI_BAR();
    } };
struct EpiOX { bf16_t* OX;
    EPI_NOPF
    __device__ __forceinline__ void operator()(EPI_ARGS) const {
        FOR_AI_M { const int r = 128 * ai + 64 * wr + 16 * m + fr; bf16_t* rowp = OX + (size_t)((u.z >> 2) * 2048 + u.pm * 256 + r) * 1024 + (u.z & 3) * 256 + 32 * wc + 8 * fq;
            FOR_BJ { const f32x4 v0 = acc[ai][bj][m][0], v1 = acc[ai][bj][m][1]; u32x4 w; w.x = pk2(v0[0], v0[1]); w.y = pk2(v0[2], v0[3]); w.z = pk2(v1[0], v1[1]); w.w = pk2(v1[2], v1[3]);
                *(u32x4*)(rowp + 128 * bj) = w; } } } };
struct EpiSwiglu { bf16_t* ACT; const float* slot_rs; const int* tile_e; const float* b_up;
    __device__ __forceinline__ void prefetch(const Unit& u, LAS float* t, int tid) const { const int e = tile_e[u.pm];
        t[tid] = slot_rs[u.pm * 256 + tid]; t[256 + tid] = b_up[(size_t)e * 2048 + ((tid >> 7) << 10) + u.pn * 128 + (tid & 127)]; }
    __device__ __forceinline__ void operator()(EPI_ARGS) const {
        const int cl = 32 * wc + 8 * fq;
        f32x4 bgv[2], blv[2]; bgv[0] = *(const LAS f32x4*)(tab + 256 + cl); bgv[1] = *(const LAS f32x4*)(tab + 256 + cl + 4); blv[0] = *(const LAS f32x4*)(tab + 384 + cl); blv[1] = *(const LAS f32x4*)(tab + 384 + cl + 4);
        FOR_AI_M { const int rl = 128 * ai + 64 * wr + 16 * m + fr; const int slot = u.pm * 256 + rl; const float s = tab[rl];
            f32x4 o[2];
#pragma unroll
            for (int n = 0; n < 2; ++n) { f32x4 g = acc[ai][0][m][n] * s + bgv[n], l = acc[ai][1][m][n] * s + blv[n];
                g = __builtin_elementwise_min(g, (f32x4){7.f, 7.f, 7.f, 7.f}); l = __builtin_elementwise_min(__builtin_elementwise_max(l, (f32x4){-7.f, -7.f, -7.f, -7.f}), (f32x4){7.f, 7.f, 7.f, 7.f}) + 1.0f;
                const f32x4 t = g * (-1.702f * 1.4426950408889634f); f32x4 ex;
#pragma unroll
                for (int j = 0; j < 4; ++j) ex[j] = __builtin_amdgcn_exp2f(t[j]);
                ex = ex + 1.0f; f32x4 rc;
#pragma unroll
                for (int j = 0; j < 4; ++j) rc[j] = __builtin_amdgcn_rcpf(ex[j]);
                o[n] = (g * rc) * l; }
            u32x4 w; w.x = pk2(o[0][0], o[0][1]); w.y = pk2(o[0][2], o[0][3]); w.z = pk2(o[1][0], o[1][1]); w.w = pk2(o[1][2], o[1][3]);
            *(u32x4*)(ACT + (size_t)slot * 1024 + u.pn * 128 + cl) = w; } } };
struct EpiDown { bf16_t* YB; const float* gate; const int* tile_e; const float* b_down;
    __device__ __forceinline__ void prefetch(const Unit& u, LAS float* t, int tid) const { const int e = tile_e[u.pm];
        t[tid] = gate[u.pm * 256 + tid]; t[256 + tid] = b_down[(size_t)e * 1024 + u.pn * 256 + tid]; }
    __device__ __forceinline__ void operator()(EPI_ARGS) const {
        const int cl = 32 * wc + 8 * fq; f32x4 bv[2][2];
        FOR_BJ { bv[bj][0] = *(const LAS f32x4*)(tab + 256 + cl + 128 * bj); bv[bj][1] = *(const LAS f32x4*)(tab + 256 + cl + 128 * bj + 4); }
        FOR_AI_M { const int rl = 128 * ai + 64 * wr + 16 * m + fr; const int slot = u.pm * 256 + rl; const float g = tab[rl];
            FOR_BJ { const f32x4 v0 = (acc[ai][bj][m][0] + bv[bj][0]) * g, v1 = (acc[ai][bj][m][1] + bv[bj][1]) * g; u32x4 w; w.x = pk2(v0[0], v0[1]); w.y = pk2(v0[2], v0[3]); w.z = pk2(v1[0], v1[1]); w.w = pk2(v1[2], v1[3]);
                *(u32x4*)(YB + (size_t)slot * 1024 + u.pn * 256 + cl + 128 * bj) = w; } } } };


namespace pg8 {
constexpr int BK = 64, HALF = 128, HTB = HALF * BK * 2, STAGE_BYTES = 8 * HTB;
__device__ __forceinline__ int lds_byte(int r, int c) { const int st = (r >> 4) * 2 + (c >> 5), rr = r & 15, cc = c & 31, ob = rr * 64 + cc * 2; return st * 1024 + (ob ^ (((ob >> 9) & 1) << 5)); }
__device__ __forceinline__ void stage_rc(int b, int& R, int& C) { const int st = b / 1024, sb = b % 1024, swz = sb ^ (((sb >> 9) & 1) << 5); R = (st >> 1) * 16 + swz / 64; C = (st & 1) * 32 + (swz % 64) / 2; }

template <bool PERM, bool GATHER, class Prov, class Sched, class Epi>
__device__ __forceinline__ void gemm_phase(LAS unsigned char* lds, LAS unsigned char* lds_epi, const Prov& P, const Sched& S, const Epi& E, int tid, unsigned long long* tepi = nullptr) {
    const int wid = __builtin_amdgcn_readfirstlane(tid >> 6), lane = tid & 63, wr = wid >> 2, wc = wid & 3, fr = lane & 15, fq = lane >> 4;
    const int K = P.K, nt = K / BK;
    unsigned voffA[2], voffB[2], voffG[2][2]; int Rg[2]; unsigned Cg[2];
#pragma unroll
    for (int i = 0; i < 2; ++i) { int R, C; stage_rc(tid * 16 + i * 8192, R, C); const int Rb = PERM ? ((R & ~31) + perm32(R & 31)) : R;
        voffA[i] = (unsigned)(R * P.lda + C) * 2u; voffB[i] = (unsigned)(Rb * P.ldb + C) * 2u; Rg[i] = R; Cg[i] = (unsigned)C * 2u; }
    LAS int* rtab = (LAS int*)(lds_epi + 8192);
    const size_t kstep = (size_t)(BK * 2);
    const size_t hstepA = GATHER ? 0 : (size_t)HALF * P.lda * 2, hstepB = (size_t)HALF * P.ldb * 2;
    const unsigned ldsw = (unsigned)wid * 1024u;
    const int aoff = lds_byte(wr * 64 + fr, fq * 8), boff = lds_byte(wc * 32 + fr, fq * 8);
#define PG8_SA(b, h) (((b) * 2 + (h)) * HTB)
#define PG8_SB(b, h) ((4 + (b) * 2 + (h)) * HTB)
#define PG8_STAGE(bufoff, gbase, voff) do { _Pragma("unroll") for (int _i = 0; _i < 2; ++_i) \
        __builtin_amdgcn_global_load_lds((const unsigned*)((const char*)(gbase) + (voff)[_i]), (LAS unsigned*)(lds + (bufoff) + ldsw + _i * 8192), 16, 0, 0); } while (0)
#define PG8_STAGE_A(bufoff, gbase, h) do { if constexpr (GATHER) { PG8_STAGE(bufoff, gbase, voffG[h]); } else { PG8_STAGE(bufoff, (gbase) + (h) * hstepA, voffA); } } while (0)
#define PG8_LDA(dst, b, h) do { _Pragma("unroll") for (int m = 0; m < 4; ++m) _Pragma("unroll") for (int k = 0; k < 2; ++k) dst[m][k] = *(const LAS bf16x8*)(lds + PG8_SA(b, h) + aoff + m * 2048 + k * 1024); } while (0)
#define PG8_LDB(dst, b, h) do { _Pragma("unroll") for (int n = 0; n < 2; ++n) _Pragma("unroll") for (int k = 0; k < 2; ++k) dst[n][k] = *(const LAS bf16x8*)(lds + PG8_SB(b, h) + boff + n * 2048 + k * 1024); } while (0)
#define PG8_MMA(ai, bj, At, Bt) do { __builtin_amdgcn_s_setprio(1); _Pragma("unroll") for (int m = 0; m < 4; ++m) _Pragma("unroll") for (int n = 0; n < 2; ++n) _Pragma("unroll") for (int k = 0; k < 2; ++k) \
        acc[ai][bj][m][n] = __builtin_amdgcn_mfma_f32_16x16x32_bf16(Bt[n][k], At[m][k], acc[ai][bj][m][n], 0, 0, 0); __builtin_amdgcn_s_setprio(0); } while (0)
#define PG8_WAIT_V(n) asm volatile("s_waitcnt vmcnt(" #n ")" ::: "memory")
#define PG8_WAIT_L(n) asm volatile("s_waitcnt lgkmcnt(" #n ")" ::: "memory")
#define PG8_BAR __builtin_amdgcn_s_barrier()
#define PG8_SCHED __builtin_amdgcn_sched_barrier(0)
    Unit cur, nxt; int ui = 0;
    if (!S.next(0, cur)) return;
    Acc acc;
#pragma unroll
    for (int a = 0; a < 2; ++a)
#pragma unroll
        for (int b = 0; b < 2; ++b)
#pragma unroll
            for (int m = 0; m < 4; ++m)
#pragma unroll
                for (int n = 0; n < 2; ++n) acc[a][b][m][n] = (f32x4){0.f, 0.f, 0.f, 0.f};
    bf16x8 At[4][2], B0[2][2], B1[2][2];
    const char* cA = (const char*)P.a_base(cur); const char* cB = (const char*)P.b_base(cur);
    if constexpr (GATHER) {
#pragma unroll
        for (int h = 0; h < 2; ++h)
#pragma unroll
            for (int i = 0; i < 2; ++i) voffG[h][i] = (unsigned)P.row_tok(cur, h * HALF + Rg[i]) * (unsigned)(P.lda * 2) + Cg[i];
    }
    PG8_STAGE(PG8_SB(0, 0), cB, voffB); PG8_STAGE(PG8_SB(0, 1), cB + hstepB, voffB); PG8_STAGE_A(PG8_SA(0, 0), cA, 0); PG8_STAGE_A(PG8_SA(0, 1), cA, 1);
    if (wr == 1) PG8_BAR;
    PG8_WAIT_V(2); PG8_BAR;
    PG8_STAGE(PG8_SB(1, 0), cB + kstep, voffB); PG8_STAGE_A(PG8_SA(1, 0), cA + kstep, 0); PG8_STAGE(PG8_SB(1, 1), cB + hstepB + kstep, voffB);
    PG8_WAIT_V(6); PG8_BAR;
    for (;;) {
        const bool has_next = S.next(ui + 1, nxt);
        const char* nA = has_next ? (const char*)P.a_base(nxt) : cA; const char* nB = has_next ? (const char*)P.b_base(nxt) : cB;
        if constexpr (GATHER) { if (has_next && wr == 0) rtab[tid] = P.row_tok(nxt, tid); }
        if (wr == 0) E.prefetch(cur, (LAS float*)(lds_epi + 4096) + (ui & 1) * 512, tid);
        for (int t = 0; t < nt; t += 2) {
            const bool last = (t == nt - 2);
            const char* a1 = cA + (size_t)(t + 1) * kstep;
            const char* a2 = last ? nA : cA + (size_t)(t + 2) * kstep; const char* b2 = last ? nB : cB + (size_t)(t + 2) * kstep;
            const char* a3 = a2 + kstep; const char* b3 = b2 + kstep;
            PG8_LDB(B0, 0, 0); PG8_LDB(B1, 0, 1); PG8_SCHED; PG8_LDA(At, 0, 0); PG8_STAGE_A(PG8_SA(1, 1), a1, 1);
            if constexpr (GATHER) { if (last && has_next) {
#pragma unroll
                for (int h = 0; h < 2; ++h)
#pragma unroll
                    for (int i = 0; i < 2; ++i) voffG[h][i] = (unsigned)rtab[h * HALF + Rg[i]] * (unsigned)(P.lda * 2) + Cg[i]; } }
            PG8_WAIT_V(8); PG8_WAIT_L(0); PG8_BAR; PG8_MMA(0, 0, At, B0); PG8_MMA(0, 1, At, B1); PG8_BAR; PG8_SCHED;
            PG8_LDA(At, 0, 1); PG8_STAGE(PG8_SB(0, 0), b2, voffB); PG8_STAGE(PG8_SB(0, 1), b2 + hstepB, voffB); PG8_STAGE_A(PG8_SA(0, 0), a2, 0);
            PG8_WAIT_V(8); PG8_WAIT_L(0); PG8_BAR; PG8_MMA(1, 0, At, B0); PG8_MMA(1, 1, At, B1); PG8_BAR; PG8_SCHED;
            PG8_LDB(B0, 1, 0); PG8_LDB(B1, 1, 1); PG8_SCHED; PG8_LDA(At, 1, 0); PG8_STAGE_A(PG8_SA(0, 1), a2, 1);
            PG8_WAIT_V(8); PG8_WAIT_L(0); PG8_BAR; PG8_MMA(0, 0, At, B0); PG8_MMA(0, 1, At, B1); PG8_BAR; PG8_SCHED;
            PG8_LDA(At, 1, 1); PG8_STAGE(PG8_SB(1, 0), b3, voffB); PG8_STAGE(PG8_SB(1, 1), b3 + hstepB, voffB); PG8_STAGE_A(PG8_SA(1, 0), a3, 0);
            PG8_WAIT_V(8); PG8_WAIT_L(0); PG8_BAR; PG8_MMA(1, 0, At, B0); PG8_MMA(1, 1, At, B1); PG8_BAR; PG8_SCHED;
        }
#if PROBE_EPI
        const unsigned long long te0_ = __builtin_amdgcn_s_memrealtime();
#endif
        if (wr == 0) PG8_BAR;
        E(acc, cur, wr, wc, fr, fq, lds_epi, (const LAS float*)(lds_epi + 4096) + (ui & 1) * 512);
#if PROBE_EPI
        if (tepi) { asm volatile("s_waitcnt vmcnt(8)" ::: "memory"); *tepi += __builtin_amdgcn_s_memrealtime() - te0_; }
#endif
        if (!has_next) break;
#pragma unroll
        for (int a = 0; a < 2; ++a)
#pragma unroll
            for (int b = 0; b < 2; ++b)
#pragma unroll
                for (int m = 0; m < 4; ++m)
#pragma unroll
                    for (int n = 0; n < 2; ++n) acc[a][b][m][n] = (f32x4){0.f, 0.f, 0.f, 0.f};
        cur = nxt; cA = nA; cB = nB; ++ui;
        if (wr == 1) PG8_BAR;
    }
    PG8_WAIT_V(0);
    PG8_BAR;
#undef PG8_SA
#undef PG8_SB
#undef PG8_STAGE
#undef PG8_STAGE_A
#undef PG8_LDA
#undef PG8_LDB
#undef PG8_MMA
#undef PG8_WAIT_V
#undef PG8_WAIT_L
#undef PG8_BAR
#undef PG8_SCHED
}
struct Order { int nM, nN, nwg, G, c;
    __device__ __forceinline__ void init(int nM_, int nN_, int G_, int c_) { nM = nM_; nN = nN_; nwg = nM * nN; G = G_; c = c_; }
    __device__ __forceinline__ bool next(int i, int& pm, int& pn) const {
        const long L = (long)i * G + c; if (L >= nwg) return false;
        int wgid = (int)L; { const int q = nwg / 8, r = nwg % 8, xcd = wgid % 8, off = wgid / 8; wgid = (xcd < r ? xcd * (q + 1) : r * (q + 1) + (xcd - r) * q) + off; }
        const int nig = 8 * nN, gid = wgid / nig, fm = gid * 8, gsz = (nM - fm) < 8 ? (nM - fm) : 8;
        pm = fm + ((wgid % nig) % gsz); pn = (wgid % nig) / gsz; return true; } };
struct SchedPlain { Order o; __device__ __forceinline__ bool next(int i, Unit& u) const { u.z = 0; return o.next(i, u.pm, u.pn); } };
struct SchedBatch8 { Order o; __device__ __forceinline__ bool next(int i, Unit& u) const { int pm, pn; if (!o.next(i, pm, pn)) return false; u.z = pm >> 3; u.pm = pm & 7; u.pn = 0; return true; } };
}

struct PvUpG { const bf16_t* X; const bf16_t* WT; const int* tile_e; const int* slot_tok; int lda, ldb, K;
    __device__ __forceinline__ const bf16_t* a_base(const Unit&) const { return X; }
    __device__ __forceinline__ const bf16_t* b_base(const Unit& u) const { return WT + ((size_t)tile_e[u.pm] * 2048 + u.pn * 256) * 1024; }
    __device__ __forceinline__ int row_tok(const Unit& u, int r) const { return slot_tok[u.pm * 256 + r]; } };
struct PvPlain { const bf16_t* A; const bf16_t* Bt; int lda, ldb, K;
    __device__ __forceinline__ const bf16_t* a_base(const Unit& u) const { return A + (size_t)u.pm * 256 * lda; }
    __device__ __forceinline__ const bf16_t* b_base(const Unit& u) const { return Bt + (size_t)u.pn * 256 * ldb; } };
struct PvXS { const bf16_t* XQ; const bf16_t* KM; int lda, ldb, K;
    __device__ __forceinline__ const bf16_t* a_base(const Unit& u) const { return XQ + (size_t)((u.z >> 2) * 2048 + u.pm * 256) * 1024 + (u.z & 3) * 256; }
    __device__ __forceinline__ const bf16_t* b_base(const Unit& u) const { return KM + (size_t)((u.z >> 2) * 256) * 1024 + (u.z & 3) * 256; } };
struct PvXPV { const bf16_t* Pm; const bf16_t* VMT; int lda, ldb, K;
    __device__ __forceinline__ const bf16_t* a_base(const Unit& u) const { return Pm + ((size_t)u.z * 2048 + u.pm * 256) * 256; }
    __device__ __forceinline__ const bf16_t* b_base(const Unit& u) const { return VMT + (size_t)u.z * 65536; } };
struct PvExp { const bf16_t* A; const bf16_t* WT; const int* tile_e; int lda, ldb, K, nrow;
    __device__ __forceinline__ const bf16_t* a_base(const Unit& u) const { return A + (size_t)u.pm * 256 * 1024; }
    __device__ __forceinline__ const bf16_t* b_base(const Unit& u) const { return WT + ((size_t)tile_e[u.pm] * nrow + u.pn * 256) * 1024; } };

constexpr int MLA_KT = 12288, MLA_VT = 8192, MLA_KBUF = 2 * MLA_KT, MLA_VBUF = 2 * MLA_VT, MLA_V0 = 2 * MLA_KBUF;
typedef short v4i16_t __attribute__((ext_vector_type(4)));
__device__ __forceinline__ s16x4 lds_tr16(const LAS unsigned char* p) { return __builtin_bit_cast(s16x4, __builtin_amdgcn_ds_read_tr16_b64_v4i16((LAS v4i16_t*)p)); }
__device__ __forceinline__ void mla_unit(const Params& p, LAS unsigned char* lds, int unit, int tid) {
    const int lane = tid & 63, wid = __builtin_amdgcn_readfirstlane(tid >> 6), r32 = lane & 31, hi = lane >> 5;
    const int qb = unit & 7, h = (unit >> 3) & 7, b = unit >> 6;
    const bf16_t* Qg = (const bf16_t*)(p.ws + WS_Q); const bf16_t* Kg = (const bf16_t*)(p.ws + WS_KB); const bf16_t* Vg = (const bf16_t*)(p.ws + WS_VB);
    const size_t rowb = (size_t)b * SEQ;
    const int q0 = qb * 256 + wid * 32;
    int ksrc[3], kdst[3], vsrc[2], vdst[2];
    const bf16_t* Kbh = Kg + rowb * 768 + h * 96; const bf16_t* Vbh = Vg + rowb * 512 + h * 64;
#pragma unroll
    for (int i = 0; i < 3; ++i) { const int pk = tid + 512 * i, r = pk / 12, c = pk % 12; ksrc[i] = r * 768 + c * 8; kdst[i] = (r >> 6) * MLA_KT + c * 1024 + (r & 63) * 16; }
#pragma unroll
    for (int i = 0; i < 2; ++i) { const int pk = tid + 512 * i, r = pk >> 3, c = pk & 7; vsrc[i] = r * 512 + c * 8; vdst[i] = MLA_V0 + (r >> 6) * MLA_VT + (c >> 2) * 4096 + (r & 63) * 64 + (c & 3) * 16; }
    const int kfo = hi * 1024 + r32 * 16;
    const int vfo = MLA_V0 + ((lane >> 4) & 1) * 32 + (lane & 3) * 8 + (4 * hi + ((lane & 15) >> 2)) * 64;
    bf16x8 qf[6];
#pragma unroll
    for (int s = 0; s < 6; ++s) qf[s] = *(const bf16x8*)(Qg + (rowb + q0 + r32) * 768 + h * 96 + 16 * s + 8 * hi);
    const int ns_blk = 2 * qb + 2, nt_me = 4 * qb + (wid >> 1) + 1;
    u32x4 sk[3], sv[2];
#pragma unroll
    for (int i = 0; i < 3; ++i) sk[i] = *(const u32x4*)(Kbh + ksrc[i]);
#pragma unroll
    for (int i = 0; i < 2; ++i) sv[i] = *(const u32x4*)(Vbh + vsrc[i]);
#pragma unroll
    for (int i = 0; i < 3; ++i) *(LAS u32x4*)(lds + kdst[i]) = sk[i];
#pragma unroll
    for (int i = 0; i < 2; ++i) *(LAS u32x4*)(lds + vdst[i]) = sv[i];
    __syncthreads();
    float mrun = -1.0e30f, lrun = 0.f; f32x16 o0 = {}, o1 = {};
    for (int st = 0; st < ns_blk; ++st) {
        const bool pre = (st + 1 < ns_blk);
        if (pre) { const bf16_t* kn = Kbh + (size_t)(st + 1) * 128 * 768; const bf16_t* vn = Vbh + (size_t)(st + 1) * 128 * 512;
#pragma unroll
            for (int i = 0; i < 3; ++i) sk[i] = *(const u32x4*)(kn + ksrc[i]);
#pragma unroll
            for (int i = 0; i < 2; ++i) sv[i] = *(const u32x4*)(vn + vsrc[i]); }
#pragma unroll
        for (int tt = 0; tt < 2; ++tt) {
          const int t = 2 * st + tt;
          if (t < nt_me) {
            const LAS unsigned char* kb_ = lds + (st & 1) * MLA_KBUF + tt * MLA_KT + kfo; const LAS unsigned char* vb_ = lds + (st & 1) * MLA_VBUF + tt * MLA_VT + vfo;
            f32x16 sc[2]; bf16x8 kf[2][6]; s16x4 vlo[8], vhi[8];
#pragma unroll
            for (int kb = 0; kb < 2; ++kb)
#pragma unroll
                for (int s = 0; s < 6; ++s) kf[kb][s] = *(const LAS bf16x8*)(kb_ + s * 2048 + kb * 512);
            __builtin_amdgcn_sched_barrier(0);
#pragma unroll
            for (int kb = 0; kb < 2; ++kb) { f32x16 a = {};
#pragma unroll
                for (int s = 0; s < 6; ++s) a = __builtin_amdgcn_mfma_f32_32x32x16_bf16(kf[kb][s], qf[s], a, 0, 0, 0);
                sc[kb] = a; }
            __builtin_amdgcn_sched_barrier(0);
#pragma unroll
            for (int i = 0; i < 8; ++i) { const LAS unsigned char* vr = vb_ + (i & 1) * 4096 + (i >> 2) * 2048 + ((i >> 1) & 1) * 1024; vlo[i] = lds_tr16(vr); vhi[i] = lds_tr16(vr + 512); }
            __builtin_amdgcn_sched_barrier(0);
            float mx = sc[0][0];
#pragma unroll
            for (int r = 0; r < 16; ++r) { mx = fmaxf(mx, sc[0][r]); mx = fmaxf(mx, sc[1][r]); }
            mx = fmaxf(mx, __shfl_xor(mx, 32));
            const float mnew = fmaxf(mrun, mx), alpha = fast_exp2(mrun - mnew); mrun = mnew;
            float ls = 0.f; unsigned pw[2][8];
#pragma unroll
            for (int kb = 0; kb < 2; ++kb)
#pragma unroll
                for (int r = 0; r < 16; r += 2) { const float e0 = fast_exp2(sc[kb][r] - mnew), e1 = fast_exp2(sc[kb][r + 1] - mnew); const unsigned w = pk2(e0, e1); pw[kb][r >> 1] = w;
                    ls += __uint_as_float(w << 16) + __uint_as_float(w & 0xffff0000u); }
            lrun = lrun * alpha + ls;
#pragma unroll
            for (int r = 0; r < 16; ++r) { o0[r] *= alpha; o1[r] *= alpha; }
#pragma unroll
            for (int kb = 0; kb < 2; ++kb)
#pragma unroll
                for (int s2 = 0; s2 < 2; ++s2) {
                    const bf16x8 pf = __builtin_bit_cast(bf16x8, (u32x4){pw[kb][4 * s2 + 0], pw[kb][4 * s2 + 1], pw[kb][4 * s2 + 2], pw[kb][4 * s2 + 3]});
#pragma unroll
                    for (int db = 0; db < 2; ++db) { const int i = 4 * kb + 2 * s2 + db;
                        const bf16x8 vf = (bf16x8){vlo[i][0], vlo[i][1], vlo[i][2], vlo[i][3], vhi[i][0], vhi[i][1], vhi[i][2], vhi[i][3]};
                        if (db == 0) o0 = __builtin_amdgcn_mfma_f32_32x32x16_bf16(vf, pf, o0, 0, 0, 0); else o1 = __builtin_amdgcn_mfma_f32_32x32x16_bf16(vf, pf, o1, 0, 0, 0); } }
          }
        }
        if (pre) { LAS unsigned char* nk = lds + ((st + 1) & 1) * MLA_KBUF; LAS unsigned char* nv = lds + ((st + 1) & 1) * MLA_VBUF;
#pragma unroll
            for (int i = 0; i < 3; ++i) *(LAS u32x4*)(nk + kdst[i]) = sk[i];
#pragma unroll
            for (int i = 0; i < 2; ++i) *(LAS u32x4*)(nv + vdst[i]) = sv[i]; }
        __syncthreads();
    }
    lrun += __shfl_xor(lrun, 32);
    const float inv = 1.0f / lrun;
    bf16_t* yo = (bf16_t*)(p.ws + WS_YCAT) + (rowb + q0 + r32) * 1024 + h * 64;
#pragma unroll
    for (int g = 0; g < 4; ++g) { u32x2 w0, w1; w0.x = pk2(o0[4 * g] * inv, o0[4 * g + 1] * inv); w0.y = pk2(o0[4 * g + 2] * inv, o0[4 * g + 3] * inv);
        w1.x = pk2(o1[4 * g] * inv, o1[4 * g + 1] * inv); w1.y = pk2(o1[4 * g + 2] * inv, o1[4 * g + 3] * inv);
        *(u32x2*)(yo + 8 * g + 4 * hi) = w0; *(u32x2*)(yo + 32 + 8 * g + 4 * hi) = w1; }
}

constexpr int XA_KB = 32768, XA_BUF = 65536;
__device__ __forceinline__ void xattn_range(const Params& p, LAS unsigned char* lds, int u0, int nu, int tid, unsigned long long* tacc = nullptr) {
    const int lane = tid & 63, wid = __builtin_amdgcn_readfirstlane(tid >> 6), fr = lane & 15, fq = lane >> 4;
    const bf16_t* XQ = (const bf16_t*)(p.ws + WS_XQ); const bf16_t* KM = (const bf16_t*)(p.ws + WS_KM); const bf16_t* VMT = (const bf16_t*)(p.ws + WS_VMT); bf16_t* OX = (bf16_t*)(p.ws + WS_OX);
    const int kpos0 = 8 * wid + (lane >> 5);
    const int vrow = 32 * wid + (lane >> 3), vslot = (lane & 7) ^ (vrow & 7);
    const int vsrc = vrow * 256 + vslot * 8;
    const int nstep = nu * 4;
#define XA_DMA(step) do { const int un_ = u0 + ((step) >> 2), t_ = (step) & 3, z_ = un_ >> 4; \
        const bf16_t* kp_ = KM + ((size_t)((z_ >> 2) * 256 + 64 * t_)) * 1024 + (z_ & 3) * 256; const bf16_t* vp_ = VMT + (size_t)z_ * 65536 + 64 * t_ + vsrc; \
        LAS unsigned char* nb_ = lds + ((step) & 1) * XA_BUF + wid * 4096; \
        _Pragma("unroll") for (int i_ = 0; i_ < 4; ++i_) { const int pos_ = kpos0 + 2 * i_; const int key_ = (pos_ & 32) + 8 * ((pos_ >> 2) & 3) + 4 * ((pos_ >> 4) & 1) + (pos_ & 3); \
            __builtin_amdgcn_global_load_lds((const unsigned*)(kp_ + key_ * 1024 + (((lane & 31) ^ (pos_ & 15)) << 3)), (LAS unsigned*)(nb_ + i_ * 1024), 16, 0, 0); \
            __builtin_amdgcn_global_load_lds((const unsigned*)(vp_ + i_ * 8 * 256), (LAS unsigned*)(nb_ + XA_KB + i_ * 1024), 16, 0, 0); } } while (0)
    XA_DMA(0);
    bf16x8 qf[8]; f32x4 oacc[16]; float mrun = -1.0e30f, lrun = 0.f;
    { const int z = u0 >> 4; const size_t qrow = (size_t)(z >> 2) * 2048 + (u0 & 15) * 128 + wid * 16 + fr;
#pragma unroll
      for (int ks = 0; ks < 8; ++ks) qf[ks] = *(const bf16x8*)(XQ + qrow * 1024 + (z & 3) * 256 + 32 * ks + 8 * fq); }
    __syncthreads();
    for (int step = 0; step < nstep; ++step) {
        const int t = step & 3, un = u0 + (step >> 2), z = un >> 4, b = z >> 2, h = z & 3;
        const size_t qrow = (size_t)b * 2048 + (un & 15) * 128 + wid * 16 + fr;
        if (t == 0) {
#pragma unroll
            for (int db = 0; db < 16; ++db) oacc[db] = (f32x4){0.f, 0.f, 0.f, 0.f};
            mrun = -1.0e30f; lrun = 0.f; }
        if (step + 1 < nstep) XA_DMA(step + 1);
        { const LAS unsigned char* kb = lds + (step & 1) * XA_BUF; const LAS unsigned char* vb = kb + XA_KB;
          f32x4 sacc[4]; bf16x8 kfa[8], kfb[8];
#define XA_LDK(dst, kvb) do { _Pragma("unroll") for (int ks = 0; ks < 8; ++ks) dst[ks] = *(const LAS bf16x8*)(kb + (16 * (kvb) + fr) * 512 + (((4 * ks + fq) ^ fr) << 4)); } while (0)
#define XA_QK(src, kvb) do { f32x4 a_ = {0.f, 0.f, 0.f, 0.f}; _Pragma("unroll") for (int ks = 0; ks < 8; ++ks) a_ = __builtin_amdgcn_mfma_f32_16x16x32_bf16(src[ks], qf[ks], a_, 0, 0, 0); sacc[kvb] = a_; } while (0)
          XA_LDK(kfa, 0); XA_LDK(kfb, 1); __builtin_amdgcn_sched_barrier(0);
          XA_QK(kfa, 0); XA_LDK(kfa, 2); __builtin_amdgcn_sched_barrier(0);
          XA_QK(kfb, 1); XA_LDK(kfb, 3); __builtin_amdgcn_sched_barrier(0);
          XA_QK(kfa, 2); __builtin_amdgcn_sched_barrier(0);
          XA_QK(kfb, 3);
#undef XA_LDK
#undef XA_QK
          float mx = sacc[0][0];
#pragma unroll
          for (int kvb = 0; kvb < 4; ++kvb)
#pragma unroll
              for (int j = 0; j < 4; ++j) mx = fmaxf(mx, sacc[kvb][j]);
          mx = fmaxf(mx, __shfl_xor(mx, 16)); mx = fmaxf(mx, __shfl_xor(mx, 32));
          const float mnew = fmaxf(mrun, mx), alpha = fast_exp2(mrun - mnew); mrun = mnew;
          float ls = 0.f; u32x4 pw[2];
#pragma unroll
          for (int s2 = 0; s2 < 2; ++s2) { unsigned w[4];
#pragma unroll
              for (int hh = 0; hh < 2; ++hh)
#pragma unroll
                  for (int jj = 0; jj < 2; ++jj) { const float e0 = fast_exp2(sacc[2 * s2 + hh][2 * jj] - mnew), e1 = fast_exp2(sacc[2 * s2 + hh][2 * jj + 1] - mnew); const unsigned ww = pk2(e0, e1); w[2 * hh + jj] = ww;
                      ls += __uint_as_float(ww << 16) + __uint_as_float(ww & 0xffff0000u); }
              pw[s2] = (u32x4){w[0], w[1], w[2], w[3]}; }
          lrun = lrun * alpha + ls;
#pragma unroll
          for (int db = 0; db < 16; ++db) oacc[db] = oacc[db] * alpha;
          { bf16x8 vfa[8], vfb[8];
#define XA_LDV(dst, s2, d0) do { _Pragma("unroll") for (int i = 0; i < 8; ++i) dst[i] = *(const LAS bf16x8*)(vb + (16 * ((d0) + i) + fr) * 128 + (((4 * (s2) + fq) ^ (fr & 7)) << 4)); } while (0)
#define XA_PV(src, s2, d0) do { const bf16x8 pf_ = __builtin_bit_cast(bf16x8, pw[s2]); _Pragma("unroll") for (int i = 0; i < 8; ++i) oacc[(d0) + i] = __builtin_amdgcn_mfma_f32_16x16x32_bf16(src[i], pf_, oacc[(d0) + i], 0, 0, 0); } while (0)
            XA_LDV(vfa, 0, 0); XA_LDV(vfb, 0, 8); __builtin_amdgcn_sched_barrier(0);
            XA_PV(vfa, 0, 0); XA_LDV(vfa, 1, 0); __builtin_amdgcn_sched_barrier(0);
            XA_PV(vfb, 0, 8); XA_LDV(vfb, 1, 8); __builtin_amdgcn_sched_barrier(0);
            XA_PV(vfa, 1, 0); __builtin_amdgcn_sched_barrier(0);
            XA_PV(vfb, 1, 8);
#undef XA_LDV
#undef XA_PV
          } }
        if (t == 3) { float lt = lrun; lt += __shfl_xor(lt, 16); lt += __shfl_xor(lt, 32); const float inv = 1.0f / lt;
            int t3 = threadIdx.x; asm volatile("" : "+v"(t3));
            const size_t qrow3 = (size_t)b * 2048 + (un & 15) * 128 + (t3 >> 6) * 16 + (t3 & 15);
            bf16_t* orow = OX + qrow3 * 1024 + h * 256 + 4 * ((t3 >> 4) & 3);
#pragma unroll
            for (int db = 0; db < 16; ++db) { const f32x4 v = oacc[db] * inv; u32x2 w; w.x = pk2(v[0], v[1]); w.y = pk2(v[2], v[3]); *(u32x2*)(orow + 16 * db) = w; }
            if (step + 1 < nstep) { const int un2 = un + 1, z2 = un2 >> 4; const size_t qr2 = (size_t)(z2 >> 2) * 2048 + (un2 & 15) * 128 + wid * 16 + fr;
#pragma unroll
                for (int ks = 0; ks < 8; ++ks) qf[ks] = *(const bf16x8*)(XQ + qr2 * 1024 + (z2 & 3) * 256 + 32 * ks + 8 * fq); } }
#if PROBE_XA
        const unsigned long long tb0_ = __builtin_amdgcn_s_memrealtime();
#endif
        __syncthreads();
#if PROBE_XA
        if (tacc) *tacc += __builtin_amdgcn_s_memrealtime() - tb0_;
#endif
    }
#undef XA_DMA
}

__device__ __forceinline__ void conv_unit(const Params& p, LAS unsigned char* lds, int unit, int tid) {
    const int lane = tid & 63, wid = tid >> 6, c = tid;
    const int b = unit >> 5, t0 = (unit & 31) * 64;
    LAS float* cl = (LAS float*)lds;
    LAS float* wl = (LAS float*)(lds + 65536);
    const __amdgpu_buffer_rsrc_t wr_ = __builtin_amdgcn_make_buffer_rsrc((void*)p.w_dw, 0, 31 * 512 * 4, 0x00020000);
#pragma unroll
    for (int j = 0; j < 31; ++j) wl[j * 512 + c] = __uint_as_float(__builtin_amdgcn_raw_buffer_load_b32(wr_, c * 4, j * 2048, 0));
    const __amdgpu_buffer_rsrc_t zr = __builtin_amdgcn_make_buffer_rsrc((void*)(p.ws + WS_Z), 0, (int)((size_t)NTOK * 512 * 2), 0x00020000);
    float z[94];
#pragma unroll
    for (int i = 0; i < 94; ++i) { const int t = t0 - 30 + i;
        if (t >= 0) z[i] = bf2f(__builtin_amdgcn_raw_buffer_load_b16(zr, c * 2, (b * SEQ + t) * 1024, 0)); else z[i] = 0.f; }
    const float bias = p.b_dw[c];
    const f32x4 g0 = *(const f32x4*)(p.g_cln + lane * 8), g1 = *(const f32x4*)(p.g_cln + lane * 8 + 4), b0 = *(const f32x4*)(p.b_cln + lane * 8), b1 = *(const f32x4*)(p.b_cln + lane * 8 + 4);
#pragma unroll
    for (int ps = 0; ps < 2; ++ps) {
        float acc[32];
#pragma unroll
        for (int o = 0; o < 32; ++o) acc[o] = bias;
#pragma unroll
        for (int j = 0; j < 31; ++j) { const float wj = wl[j * 512 + c];
#pragma unroll
            for (int o = 0; o < 32; ++o) acc[o] += wj * z[32 * ps + o + j]; }
#pragma unroll
        for (int o = 0; o < 32; ++o) cl[o * 512 + c] = acc[o];
        __syncthreads();
#pragma unroll
        for (int oo = 0; oo < 4; ++oo) { const int o = wid * 4 + oo; const LAS float* r = cl + o * 512 + lane * 8;
            const f32x4 v0 = *(const LAS f32x4*)r, v1 = *(const LAS f32x4*)(r + 4);
            float s = (v0[0] + v0[1]) + (v0[2] + v0[3]) + (v1[0] + v1[1]) + (v1[2] + v1[3]); s = wave_sum(s); const float mu = s * (1.0f / 512.0f);
            const f32x4 d0 = v0 - mu, d1 = v1 - mu; float q = (d0[0] * d0[0] + d0[1] * d0[1]) + (d0[2] * d0[2] + d0[3] * d0[3]) + (d1[0] * d1[0] + d1[1] * d1[1]) + (d1[2] * d1[2] + d1[3] * d1[3]);
            q = wave_sum(q); const float rstd = 1.0f / sqrtf(q * (1.0f / 512.0f) + EPS);
            float y[8];
#pragma unroll
            for (int j = 0; j < 4; ++j) { const float a0 = d0[j] * rstd * g0[j] + b0[j], a1 = d1[j] * rstd * g1[j] + b1[j]; y[j] = a0 * sigmoidf_(a0); y[4 + j] = a1 * sigmoidf_(a1); }
            u32x4 wv; wv.x = pk2(y[0], y[1]); wv.y = pk2(y[2], y[3]); wv.z = pk2(y[4], y[5]); wv.w = pk2(y[6], y[7]);
            *(u32x4*)((bf16_t*)(p.ws + WS_YCAT) + ((size_t)b * SEQ + t0 + 32 * ps + o) * 1024 + 512 + lane * 8) = wv; }
        __syncthreads();
    }
}

__device__ __forceinline__ void router1_unit(const Params& p, LAS unsigned char* lds, int unit, int tid) {
    const int lane = tid & 63, wid = tid >> 6, r = lane & 15, q = lane >> 4;
    LAS float* lg = (LAS float*)lds + wid * 512;
    LAS int* hist = (LAS int*)(lds + 16384);
    const bf16_t* WH = (const bf16_t*)(p.ws + WS_WR); const bf16_t* WL = WH + 32768;
    if (tid < 32) hist[tid] = 0;
    __syncthreads();
    const int tok0 = unit * RT_TOK + wid * 16;
    const bf16_t* xr = (const bf16_t*)(p.ws + WS_X2B) + (size_t)(tok0 + r) * 1024 + 8 * q;
    f32x4 acc0 = {0.f, 0.f, 0.f, 0.f}, acc1 = {0.f, 0.f, 0.f, 0.f}; float ssq = 0.f;
#pragma unroll 8
    for (int ks = 0; ks < 32; ++ks) {
        const u32x4 xw = *(const u32x4*)(xr + 32 * ks);
        { const float a0 = __uint_as_float(xw.x << 16), a1 = __uint_as_float(xw.x & 0xffff0000u), a2 = __uint_as_float(xw.y << 16), a3 = __uint_as_float(xw.y & 0xffff0000u);
          const float a4 = __uint_as_float(xw.z << 16), a5 = __uint_as_float(xw.z & 0xffff0000u), a6 = __uint_as_float(xw.w << 16), a7 = __uint_as_float(xw.w & 0xffff0000u);
          ssq += (a0 * a0 + a1 * a1) + (a2 * a2 + a3 * a3) + (a4 * a4 + a5 * a5) + (a6 * a6 + a7 * a7); }
        const bf16x8 ah = __builtin_bit_cast(bf16x8, xw);
        const bf16x8 bh0 = *(const bf16x8*)(WH + (size_t)r * 1024 + 32 * ks + 8 * q), bh1 = *(const bf16x8*)(WH + (size_t)(16 + r) * 1024 + 32 * ks + 8 * q);
        const bf16x8 bl0 = *(const bf16x8*)(WL + (size_t)r * 1024 + 32 * ks + 8 * q), bl1 = *(const bf16x8*)(WL + (size_t)(16 + r) * 1024 + 32 * ks + 8 * q);
        acc0 = __builtin_amdgcn_mfma_f32_16x16x32_bf16(ah, bh0, acc0, 0, 0, 0); acc1 = __builtin_amdgcn_mfma_f32_16x16x32_bf16(ah, bh1, acc1, 0, 0, 0);
        acc0 = __builtin_amdgcn_mfma_f32_16x16x32_bf16(ah, bl0, acc0, 0, 0, 0); acc1 = __builtin_amdgcn_mfma_f32_16x16x32_bf16(ah, bl1, acc1, 0, 0, 0);
    }
    ssq += __shfl_xor(ssq, 16); ssq += __shfl_xor(ssq, 32);
    const float rstd_r = 1.0f / sqrtf(ssq * (1.0f / 1024.0f) + EPS);
    if (lane < 16) ((float*)(p.ws + WS_RSTD_X2))[tok0 + lane] = rstd_r;
    const float be0 = p.b_router[r], be1 = p.b_router[16 + r];
#pragma unroll
    for (int j = 0; j < 4; ++j) { const float rs = __shfl(rstd_r, 4 * q + j); lg[(4 * q + j) * 32 + r] = acc0[j] * rs + be0; lg[(4 * q + j) * 32 + 16 + r] = acc1[j] * rs + be1; }
    asm volatile("s_waitcnt lgkmcnt(0)" ::: "memory");
    if (lane < 16) { const int tk = tok0 + lane; unsigned used = 0u; float tv[4]; int ti[4];
#pragma unroll
        for (int k = 0; k < 4; ++k) { float best = -3.0e38f; int bi = 0;
            for (int j = 0; j < 32; ++j) { const float v = lg[lane * 32 + j]; if (!((used >> j) & 1u) && v > best) { best = v; bi = j; } }
            used |= 1u << bi; tv[k] = best; ti[k] = bi; }
        const float e1 = __expf(tv[1] - tv[0]), e2 = __expf(tv[2] - tv[0]), e3 = __expf(tv[3] - tv[0]); const float inv = 1.0f / (1.0f + e1 + e2 + e3);
        int* oi = (int*)(p.ws + WS_TOPI) + (size_t)tk * 4; float* og = (float*)(p.ws + WS_TOPG) + (size_t)tk * 4;
        oi[0] = ti[0]; oi[1] = ti[1]; oi[2] = ti[2]; oi[3] = ti[3]; og[0] = inv; og[1] = e1 * inv; og[2] = e2 * inv; og[3] = e3 * inv;
#pragma unroll
        for (int k = 0; k < 4; ++k) atomicAdd((int*)&hist[ti[k]], 1); }
    __syncthreads();
    if (tid < 32) ((int*)(p.ws + WS_HIST))[unit * 32 + tid] = hist[tid];
    __syncthreads();
}
__device__ __forceinline__ void router2_unit(const Params& p, LAS unsigned char* lds, int unit, int tid) {
    const int lane = tid & 63, wid = tid >> 6;
    LAS int* cnt = (LAS int*)lds;
    LAS int* base = cnt + 32;
    LAS int* pst = cnt + 64;
    LAS int* part = cnt + 128;
    LAS int* wcnt = cnt + 128 + 1024;
    const int* H = (const int*)(p.ws + WS_HIST);
    { const int e = tid & 31, pt = tid >> 5; int tot = 0, bs = 0;
#pragma unroll 4
      for (int j = 0; j < 16; ++j) { const int bq = pt * 16 + j; const int v = H[bq * 32 + e]; tot += v; bs += (bq < unit) ? v : 0; }
      part[pt * 64 + e] = tot; part[pt * 64 + 32 + e] = bs; }
    const int my_e = ((const int*)(p.ws + WS_TOPI))[(size_t)unit * RT_TOK * 4 + tid];
    int my_rank = 0;
#pragma unroll 4
    for (int e = 0; e < 32; ++e) { const unsigned long long m = __ballot(my_e == e); if (my_e == e) my_rank = __popcll(m & ((1ull << lane) - 1ull)); if (lane == 0) wcnt[wid * 32 + e] = __popcll(m); }
    __syncthreads();
    if (tid < 32) { int tot = 0, bs = 0;
#pragma unroll
        for (int pt = 0; pt < 16; ++pt) { tot += part[pt * 64 + tid]; bs += part[pt * 64 + 32 + tid]; }
        cnt[tid] = tot; base[tid] = bs; }
    __syncthreads();
    if (tid == 0) { int sacc = 0; for (int e = 0; e < 32; ++e) { pst[e] = sacc; sacc += (cnt[e] + 255) & ~255; } pst[32] = sacc; }
    __syncthreads();
    { int woff = 0;
#pragma unroll
      for (int w = 0; w < 8; ++w) woff += (w < wid) ? wcnt[w * 32 + my_e] : 0;
      const int d = pst[my_e] + base[my_e] + woff + my_rank; const int tok = unit * RT_TOK + (tid >> 2);
      ((int*)(p.ws + WS_SLOT_TOK))[d] = tok; ((float*)(p.ws + WS_SLOT_GATE))[d] = ((const float*)(p.ws + WS_TOPG))[(size_t)unit * RT_TOK * 4 + tid];
      ((int*)(p.ws + WS_INV))[(size_t)unit * RT_TOK * 4 + tid] = d; ((float*)(p.ws + WS_SLOT_RS))[d] = ((const float*)(p.ws + WS_RSTD_X2))[tok]; }
    if (unit < 32) { const int e = unit, s0 = pst[e] + cnt[e], s1 = pst[e + 1];
        for (int s = s0 + tid; s < s1; s += 512) { ((int*)(p.ws + WS_SLOT_TOK))[s] = 0; ((float*)(p.ws + WS_SLOT_GATE))[s] = 0.f; ((float*)(p.ws + WS_SLOT_RS))[s] = 0.f; } }
    if (unit == 32) { int* te = (int*)(p.ws + WS_TILE_E); const int nt = pst[32] >> 8;
        for (int t = tid; t < NTILE_MAX; t += 512) { int e = 31; for (int k = 31; k >= 0; --k) if (t * 256 < pst[k + 1]) e = k; te[t] = e; }
        if (tid == 0) te[NTILE_MAX] = nt; }
    __syncthreads();
}

__device__ __forceinline__ void final_row(const Params& p, int tok, int lane) {
    float* xr = p.out + (size_t)tok * 1024; const int* inv = (const int*)(p.ws + WS_INV) + (size_t)tok * 4; const bf16_t* YB = (const bf16_t*)(p.ws + WS_YB);
    f32x4 v[4];
    { const u32x2* x2 = (const u32x2*)((const bf16_t*)(p.ws + WS_X2B) + (size_t)tok * 1024);
#pragma unroll
      for (int j = 0; j < 4; ++j) { const u32x2 w = x2[lane + 64 * j]; v[j][0] = __uint_as_float(w.x << 16); v[j][1] = __uint_as_float(w.x & 0xffff0000u); v[j][2] = __uint_as_float(w.y << 16); v[j][3] = __uint_as_float(w.y & 0xffff0000u); } }
#pragma unroll
    for (int k = 0; k < 4; ++k) { const u32x2* yr = (const u32x2*)(YB + (size_t)inv[k] * 1024);
#pragma unroll
        for (int j = 0; j < 4; ++j) { const u32x2 w = yr[lane + 64 * j]; v[j][0] += __uint_as_float(w.x << 16); v[j][1] += __uint_as_float(w.x & 0xffff0000u); v[j][2] += __uint_as_float(w.y << 16); v[j][3] += __uint_as_float(w.y & 0xffff0000u); } }
    float s = 0.f;
#pragma unroll
    for (int j = 0; j < 4; ++j) s += (v[j][0] * v[j][0] + v[j][1] * v[j][1]) + (v[j][2] * v[j][2] + v[j][3] * v[j][3]);
    s = wave_sum(s); const float rstd = 1.0f / sqrtf(s * (1.0f / 1024.0f) + EPS);
#pragma unroll
    for (int j = 0; j < 4; ++j) { const f32x4 g = ((const f32x4*)p.g_final)[lane + 64 * j]; ((f32x4*)xr)[lane + 64 * j] = v[j] * rstd * g; }
}


#define XB_TMO      128
#define XB_XCNT(j)  (256  + 64 * (j))
#define XB_XSUB(j)  (1280 + 64 * (j))
#define XB_XGEN(j)  (2304 + 64 * (j))
#define XB_TOP      3328
#define XB_TOPGEN   3392
#define XCD_BAR_WORDS 3456
#define XB_SPIN_CAP (1u << 18)
__device__ __forceinline__ unsigned xb_ld(unsigned* p)              { return __hip_atomic_load(p, __ATOMIC_RELAXED, __HIP_MEMORY_SCOPE_AGENT); }
__device__ __forceinline__ unsigned xb_add(unsigned* p, unsigned v) { return __hip_atomic_fetch_add(p, v, __ATOMIC_RELAXED, __HIP_MEMORY_SCOPE_AGENT); }
__device__ __forceinline__ unsigned xb_xcc_id() { return (unsigned)__builtin_amdgcn_s_getreg((3 << 11) | 20) & 0xFu; }
#define XB_SPIN(cond, bar) do { unsigned _sp = 0; while (cond) { __builtin_amdgcn_s_sleep(1); \
    if ((++_sp & 255u) == 0u) { if (xb_ld(&(bar)[XB_TMO])) break; if (_sp > XB_SPIN_CAP) { atomicAdd(&(bar)[XB_TMO], 1u); break; } } } } while (0)
struct XcdBarrier { unsigned* bar; unsigned x; volatile LAS unsigned* st; };
__device__ __forceinline__ XcdBarrier xcd_barrier_post(unsigned* bar, volatile LAS unsigned* st) {
    XcdBarrier b; b.bar = bar; b.x = xb_xcc_id(); b.st = st;
    if (threadIdx.x == 0) (void)xb_add(&bar[XB_XCNT(b.x)], 1u);
    return b;
}
__device__ __forceinline__ void xcd_barrier_complete(unsigned* bar, unsigned x, unsigned& nloc, unsigned& nx) {
    const unsigned G = gridDim.x * gridDim.y * gridDim.z;
    unsigned sum, cnt, mine, sp = 0u;
    for (;;) {
        sum = 0u; cnt = 0u; mine = 0u;
#pragma unroll
        for (unsigned j = 0; j < 16; ++j) { const unsigned c = xb_ld(&bar[XB_XCNT(j)]); sum += c; cnt += (c > 0u) ? 1u : 0u; mine = (j == x) ? c : mine; }
        if (sum == G) break;
        __builtin_amdgcn_s_sleep(1);
        if ((++sp & 255u) == 0u) { if (xb_ld(&bar[XB_TMO])) break; if (sp > XB_SPIN_CAP) { atomicAdd(&bar[XB_TMO], 1u); break; } }
    }
    nloc = mine > 0u ? mine : 1u; nx = cnt > 0u ? cnt : 1u;
}
__device__ __forceinline__ void xcd_barrier(const XcdBarrier& b) {
    asm volatile("s_waitcnt vmcnt(0)" ::: "memory");
    __syncthreads();
    if (threadIdx.x == 0) {
        unsigned* bar = b.bar;
        __builtin_amdgcn_s_waitcnt(0);
        unsigned nloc = b.st[0], nx = b.st[1];
        if (nloc == 0u) { xcd_barrier_complete(bar, b.x, nloc, nx); b.st[0] = nloc; b.st[1] = nx; }
        const unsigned old = xb_add(&bar[XB_XSUB(b.x)], 1u);
        const unsigned gen = old / nloc;
        if (old + 1u == (gen + 1u) * nloc) {
            __builtin_amdgcn_fence(__ATOMIC_RELEASE, "agent");
            asm volatile("s_waitcnt vmcnt(0)" ::: "memory");
            const unsigned og = xb_add(&bar[XB_TOP], 1u);
            const unsigned tg = og / nx;
            if (og + 1u == (tg + 1u) * nx) xb_add(&bar[XB_TOPGEN], 1u);
            else XB_SPIN(xb_ld(&bar[XB_TOPGEN]) == tg, bar);
            __builtin_amdgcn_fence(__ATOMIC_ACQUIRE, "agent");
            xb_add(&bar[XB_XGEN(b.x)], 1u);
            asm volatile("s_waitcnt vmcnt(0)" ::: "memory");
        } else {
            XB_SPIN(xb_ld(&bar[XB_XGEN(b.x)]) == gen, bar);
            __builtin_amdgcn_fence(__ATOMIC_ACQUIRE, "agent");
            asm volatile("s_waitcnt vmcnt(0)" ::: "memory");
        }
    }
    __syncthreads();
}

constexpr int EPI_LDS = 131072;
constexpr int LDS_BYTES = 155648;

#ifndef USE_CG_SYNC
#define USE_CG_SYNC 0
#endif
#if USE_CG_SYNC
#define GRID_SYNC_() grid.sync()
#else
#define GRID_SYNC_() xcd_barrier(xbar)
#endif
#if PROBE_MASK || PROBE_EPI || PROBE_XA
#define GRID_SYNC() do { GRID_SYNC_(); const unsigned long long tn_ = __builtin_amdgcn_s_memrealtime(); if ((PROBE_MASK >> ph_) & 1) tacc_ += tn_ - tprev_; tprev_ = tn_; ++ph_; } while (0)
#else
#define GRID_SYNC() GRID_SYNC_()
#endif
constexpr int XB_LDS = 155520;

__device__ __forceinline__ void mla_order(int vb, int r, int& unit) {
    const int bh = vb >> 1, s = vb & 1; const int qb = (r == 0) ? s : (r == 1) ? 7 - s : (r == 2) ? 3 - s : 4 + s; unit = bh * 8 + qb;
}

#define GAS __attribute__((address_space(1)))
#define FROM_W(f, T, k) p_.f = (T*)(GAS T*)(w_[k])
__device__ __forceinline__ void params_from_words(Params& p_, const unsigned long long (&w_)[29]) {
    FROM_W(x, const float, 0); FROM_W(mem, const float, 1); FROM_W(pos, const int, 2);
    FROM_W(g_mix, const float, 3); FROM_W(w_in, const float, 4); FROM_W(g_q, const float, 5); FROM_W(w_uq, const float, 6); FROM_W(g_kv, const float, 7); FROM_W(w_ukv, const float, 8); FROM_W(w_dw, const float, 9); FROM_W(b_dw, const float, 10);
    FROM_W(g_cln, const float, 11); FROM_W(b_cln, const float, 12); FROM_W(w_out, const float, 13); FROM_W(g_xattn, const float, 14); FROM_W(g_mem, const float, 15); FROM_W(w_xq, const float, 16); FROM_W(w_xkv, const float, 17); FROM_W(w_xo, const float, 18);
    FROM_W(g_ffn, const float, 19); FROM_W(w_router, const float, 20); FROM_W(b_router, const float, 21); FROM_W(w_up, const float, 22); FROM_W(b_up, const float, 23); FROM_W(w_down, const float, 24); FROM_W(b_down, const float, 25); FROM_W(g_final, const float, 26);
    FROM_W(out, float, 27); FROM_W(ws, unsigned char, 28);
}
static_assert(sizeof(Params) == 29 * 8, "Params = 29 pointers");
typedef const __attribute__((address_space(4))) Params* CParams;
#define PHASE_BEGIN() CParams pp_ = (CParams)__builtin_amdgcn_kernarg_segment_ptr(); asm volatile("" : "+s"(pp_)); Params p; { const __attribute__((address_space(4))) unsigned long long* q_ = (const __attribute__((address_space(4))) unsigned long long*)pp_; unsigned long long w_[29]; _Pragma("unroll") for (int k_ = 0; k_ < 29; ++k_) w_[k_] = q_[k_]; params_from_words(p, w_); } unsigned char* ws = p.ws; int tid = threadIdx.x; asm volatile("" : "+v"(tid)); const int lane = tid & 63; (void)lane; (void)ws;

__global__ void __launch_bounds__(512) mega_kernel(Params p_unused) {
    extern __shared__ __attribute__((aligned(16))) unsigned char lds_raw[];
#if USE_CG_SYNC
    cg::grid_group grid = cg::this_grid();
#endif
    LAS unsigned char* lds = (LAS unsigned char*)lds_raw;
    if (threadIdx.x < 2) ((volatile LAS unsigned*)(lds + XB_LDS))[threadIdx.x] = 0u;
    __syncthreads();
    const XcdBarrier xbar = xcd_barrier_post((unsigned*)(((CParams)__builtin_amdgcn_kernarg_segment_ptr())->ws + WS_CTL), (volatile LAS unsigned*)(lds + XB_LDS)); (void)xbar;
    const int G = gridDim.x, bx = blockIdx.x;
    const int vb = (G % 8 == 0) ? (bx % 8) * (G / 8) + bx / 8 : bx;

#if PROBE_MASK || PROBE_EPI || PROBE_XA
    unsigned long long tprev_ = __builtin_amdgcn_s_memrealtime(), tacc_ = 0; int ph_ = 0;
#endif
    { PHASE_BEGIN(); prep_stage(p, lds, vb, G, tid); }
    GRID_SYNC();
    { PHASE_BEGIN();
      { PvPlain P{(const bf16_t*)(ws + WS_XB), (const bf16_t*)(ws + WS_WT_IN), 1024, 1024, 1024}; pg8::SchedPlain S; S.o.init(128, 6, G, bx);
        EpiIn E{(bf16_t*)(ws + WS_U), (bf16_t*)(ws + WS_Z), (const float*)(ws + WS_RSTD_X), (float*)(ws + WS_SSQ_Q), (float*)(ws + WS_SSQ_KV), (const float*)(ws + WS_ROPE), (bf16_t*)(ws + WS_KB)};
        pg8::gemm_phase<true, false>(lds, lds + EPI_LDS, P, S, E, tid); }
      { PvPlain P{(const bf16_t*)(ws + WS_MEMB), (const bf16_t*)(ws + WS_WT_XKV), 1024, 1024, 1024}; pg8::SchedPlain S; S.o.init(16, 8, G, (bx + 128) % G);
        EpiKVMem E{(bf16_t*)(ws + WS_KM), (bf16_t*)(ws + WS_VMT), (const float*)(ws + WS_RSTD_MEM)};
        pg8::gemm_phase<false, false>(lds, lds + EPI_LDS, P, S, E, tid); } }
    GRID_SYNC();
    { PHASE_BEGIN();
      { PvPlain P{(const bf16_t*)(ws + WS_U), (const bf16_t*)(ws + WS_WT_UQ), ULD, 256, 256}; pg8::SchedPlain S; S.o.init(128, 3, G, bx);
        EpiQ E{(bf16_t*)(ws + WS_Q), (const float*)(ws + WS_SSQ_Q), (const float*)(ws + WS_ROPE)};
        pg8::gemm_phase<false, false>(lds, lds + EPI_LDS, P, S, E, tid); }
      { PvPlain P{(const bf16_t*)(ws + WS_U) + 256, (const bf16_t*)(ws + WS_WT_UKV), ULD, 128, 128}; pg8::SchedPlain S; S.o.init(128, 4, G, (bx + 128) % G);
        EpiKV E{(bf16_t*)(ws + WS_KB), (bf16_t*)(ws + WS_VB), (const float*)(ws + WS_SSQ_KV)};
        pg8::gemm_phase<true, false>(lds, lds + EPI_LDS, P, S, E, tid); }
      { int tid2 = threadIdx.x; asm volatile("" : "+v"(tid2)); for (int i = vb; i < 512; i += G) conv_unit(p, lds, i, tid2); } }
    GRID_SYNC();
    { PHASE_BEGIN();
    if (G == 256) { for (int r = 0; r < 4; ++r) { int unit; mla_order(vb, r, unit); mla_unit(p, lds, unit, tid); } }
    else { for (int i = vb; i < 1024; i += G) mla_unit(p, lds, i, tid); } }
    GRID_SYNC();
    { PHASE_BEGIN();
      PvPlain P{(const bf16_t*)(ws + WS_YCAT), (const bf16_t*)(ws + WS_WT_OUT), 1024, 1024, 1024}; pg8::SchedPlain S; S.o.init(128, 4, G, bx);
      EpiResid E{(const bf16_t*)(ws + WS_XB), (bf16_t*)(ws + WS_X1B), (float*)(ws + WS_SSQ_X1)};
      pg8::gemm_phase<true, false>(lds, lds + EPI_LDS, P, S, E, tid); }
    GRID_SYNC();
    { PHASE_BEGIN();
      PvPlain P{(const bf16_t*)(ws + WS_X1B), (const bf16_t*)(ws + WS_WT_XQ), 1024, 1024, 1024}; pg8::SchedPlain S; S.o.init(128, 4, G, bx);
      EpiScale16 E{(bf16_t*)(ws + WS_XQ), 1024, (const float*)(ws + WS_SSQ_X1), C2_X};
      pg8::gemm_phase<true, false>(lds, lds + EPI_LDS, P, S, E, tid); }
    GRID_SYNC();
    { PHASE_BEGIN();
#if PROBE_XA
      if (G == 256) xattn_range(p, lds, vb * 4, 4, tid, &tacc_);
#else
      if (G == 256) xattn_range(p, lds, vb * 4, 4, tid);
#endif
      else { for (int i = vb; i < 1024; i += G) xattn_range(p, lds, i, 1, tid); } }
    GRID_SYNC();
    { PHASE_BEGIN();
      PvPlain P{(const bf16_t*)(ws + WS_OX), (const bf16_t*)(ws + WS_WT_XO), 1024, 1024, 1024}; pg8::SchedPlain S; S.o.init(128, 4, G, bx);
      EpiResid E{(const bf16_t*)(ws + WS_X1B), (bf16_t*)(ws + WS_X2B), nullptr};
      pg8::gemm_phase<true, false>(lds, lds + EPI_LDS, P, S, E, tid); }
    GRID_SYNC();
    { PHASE_BEGIN(); for (int i = vb; i < RT_UNITS; i += G) router1_unit(p, lds, i, tid); }
    GRID_SYNC();
    { PHASE_BEGIN(); for (int i = vb; i < RT_UNITS; i += G) router2_unit(p, lds, i, tid); }
    GRID_SYNC();
    { PHASE_BEGIN(); const int* te = (const int*)(ws + WS_TILE_E); const int nt = te[NTILE_MAX];
      PvUpG P{(const bf16_t*)(ws + WS_X2B), (const bf16_t*)(ws + WS_WT_UP), te, (const int*)(ws + WS_SLOT_TOK), 1024, 1024, 1024}; pg8::SchedPlain S; S.o.init(nt, 8, G, bx);
      EpiSwiglu E{(bf16_t*)(ws + WS_ACT), (const float*)(ws + WS_SLOT_RS), te, p.b_up};
#if PROBE_EPI
      pg8::gemm_phase<true, true>(lds, lds + EPI_LDS, P, S, E, tid, &tacc_);
#else
      pg8::gemm_phase<true, true>(lds, lds + EPI_LDS, P, S, E, tid);
#endif
    }
    GRID_SYNC();
    { PHASE_BEGIN(); const int* te = (const int*)(ws + WS_TILE_E); const int nt = te[NTILE_MAX];
      PvExp P{(const bf16_t*)(ws + WS_ACT), (const bf16_t*)(ws + WS_WT_DOWN), te, 1024, 1024, 1024, 1024}; pg8::SchedPlain S; S.o.init(nt, 4, G, bx);
      EpiDown E{(bf16_t*)(ws + WS_YB), (const float*)(ws + WS_SLOT_GATE), te, p.b_down};
      pg8::gemm_phase<true, false>(lds, lds + EPI_LDS, P, S, E, tid); }
    GRID_SYNC();
    { PHASE_BEGIN(); const int gw = vb * 8 + (tid >> 6), ngw = G * 8; for (int r = gw; r < NTOK; r += ngw) final_row(p, r, lane); }
#if PROBE_MASK || PROBE_EPI || PROBE_XA
    { const unsigned long long tn_ = __builtin_amdgcn_s_memrealtime(); if ((PROBE_MASK >> ph_) & 1) tacc_ += tn_ - tprev_;
      const unsigned long long t0_ = __builtin_amdgcn_s_memrealtime(); while (__builtin_amdgcn_s_memrealtime() - t0_ < 4ull * tacc_) __builtin_amdgcn_s_sleep(8); }
#endif
}

extern "C" void kernel_launch(void* const* d_in, const int* in_sizes, int n_in, void* d_out, int out_size, void* d_ws, size_t ws_size, hipStream_t stream) {
    static int grid = 0;
    if (grid == 0) {
        if (n_in != 27 || ws_size < WS_END) { fprintf(stderr, "kernel_launch: unexpected inputs (n_in %d, ws %zu)\n", n_in, ws_size); grid = -1; return; }
        int dev = 0, cus = 0, per_cu = 0;
        (void)hipGetDevice(&dev); (void)hipDeviceGetAttribute(&cus, hipDeviceAttributeMultiprocessorCount, dev);
        (void)hipFuncSetAttribute((const void*)mega_kernel, hipFuncAttributeMaxDynamicSharedMemorySize, LDS_BYTES);
        (void)hipOccupancyMaxActiveBlocksPerMultiprocessor(&per_cu, (const void*)mega_kernel, 512, LDS_BYTES);
        if (per_cu < 1) { fprintf(stderr, "kernel_launch: occupancy query says %d blocks per CU\n", per_cu); per_cu = 1; }
        if (per_cu > 1) per_cu = 1;
        grid = cus * per_cu;
        (void)hipGetLastError();
    }
    if (grid < 0) return;
    (void)hipMemsetAsync((char*)d_ws + WS_CTL, 0, XCD_BAR_WORDS * 4, stream);
    Params p{};
    p.x = (const float*)d_in[0]; p.mem = (const float*)d_in[1]; p.pos = (const int*)d_in[2];
    p.g_mix = (const float*)d_in[3]; p.w_in = (const float*)d_in[4]; p.g_q = (const float*)d_in[5]; p.w_uq = (const float*)d_in[6]; p.g_kv = (const float*)d_in[7]; p.w_ukv = (const float*)d_in[8];
    p.w_dw = (const float*)d_in[9]; p.b_dw = (const float*)d_in[10]; p.g_cln = (const float*)d_in[11]; p.b_cln = (const float*)d_in[12]; p.w_out = (const float*)d_in[13];
    p.g_xattn = (const float*)d_in[14]; p.g_mem = (const float*)d_in[15]; p.w_xq = (const float*)d_in[16]; p.w_xkv = (const float*)d_in[17]; p.w_xo = (const float*)d_in[18];
    p.g_ffn = (const float*)d_in[19]; p.w_router = (const float*)d_in[20]; p.b_router = (const float*)d_in[21]; p.w_up = (const float*)d_in[22]; p.b_up = (const float*)d_in[23];
    p.w_down = (const float*)d_in[24]; p.b_down = (const float*)d_in[25]; p.g_final = (const float*)d_in[26];
    p.out = (float*)d_out; p.ws = (unsigned char*)d_ws;
    void* args[] = {&p};
    hipError_t e = hipLaunchCooperativeKernel((const void*)mega_kernel, dim3(grid), dim3(512), args, LDS_BYTES, stream);
    if (e != hipSuccess) fprintf(stderr, "cooperative launch failed: %s (grid %d)\n", hipGetErrorString(e), grid);
}
```

```cpp
#include <hip/hip_runtime.h>
#include <stdint.h>
#include <stdio.h>
#include <hip/hip_cooperative_groups.h>
namespace cg = cooperative_groups;

#ifndef PROBE_MASK
#define PROBE_MASK 0
#endif
#ifndef PROBE_EPI
#define PROBE_EPI 0
#endif
#ifndef PROBE_XA
#define PROBE_XA 0
#endif
#ifndef PROBE_SUB
#define PROBE_SUB 0
#endif
#if PROBE_SUB
#define SUB_T0(id) unsigned long long ts_##id = __builtin_amdgcn_s_memrealtime()
#define SUB_T1(id, acc) do { if (PROBE_SUB == id) { __syncthreads(); (acc) += __builtin_amdgcn_s_memrealtime() - ts_##id; } } while (0)
#else
#define SUB_T0(id)
#define SUB_T1(id, acc)
#endif
#define LAS __attribute__((address_space(3)))
typedef unsigned short bf16_t;
typedef short bf16x8 __attribute__((ext_vector_type(8)));
typedef short s16x4 __attribute__((ext_vector_type(4)));
typedef float f32x2 __attribute__((ext_vector_type(2)));
typedef float f32x4 __attribute__((ext_vector_type(4)));
typedef float f32x16 __attribute__((ext_vector_type(16)));
typedef unsigned u32x2 __attribute__((ext_vector_type(2)));
typedef unsigned u32x4 __attribute__((ext_vector_type(4)));

constexpr int BATCH = 16, SEQ = 2048, NTOK = BATCH * SEQ, DM = 1024;
constexpr int INC = 1440, INP = 1536, ULD = 512;
constexpr int HEADS = 8, QKD = 96, VD = 64;
constexpr int CCH = 512, CW = 31;
constexpr int MEML = 256, NMEM = BATCH * MEML;
constexpr int XH = 4, XD = 256;
constexpr int NE = 32, TOPK = 4;
constexpr int NSLOT = NTOK * TOPK + NE * 256;
constexpr int NTILE_MAX = NSLOT / 256;
constexpr float EPS = 1e-5f;
constexpr float C2_MLA = 0.14724444602590306f;
constexpr float C2_X = 0.09016844005556021f;
constexpr int RT_TOK = 128, RT_UNITS = NTOK / RT_TOK;

constexpr size_t MiB = 1u << 20;
constexpr size_t WS_CTL = 0;
constexpr size_t WS_RSTD_X = 1 * MiB;
constexpr size_t WS_RSTD_Q = WS_RSTD_X + 128 * 1024;
constexpr size_t WS_RSTD_KV = WS_RSTD_Q + 128 * 1024;
constexpr size_t WS_RSTD_X1 = WS_RSTD_KV + 128 * 1024;
constexpr size_t WS_RSTD_X2 = WS_RSTD_X1 + 128 * 1024;
constexpr size_t WS_RSTD_MEM = WS_RSTD_X2 + 128 * 1024;
constexpr size_t WS_ROPE = 2 * MiB;
constexpr size_t WS_TOPI = 6 * MiB;
constexpr size_t WS_TOPG = WS_TOPI + 512 * 1024;
constexpr size_t WS_INV = WS_TOPG + 512 * 1024;
constexpr size_t WS_SLOT_TOK = WS_INV + 512 * 1024;
constexpr size_t WS_SLOT_GATE = WS_SLOT_TOK + 1 * MiB;
constexpr size_t WS_SLOT_RS = 15 * MiB + 256 * 1024;
constexpr size_t WS_HIST = WS_SLOT_GATE + 1 * MiB;
constexpr size_t WS_TILE_E = WS_HIST + 64 * 1024;
constexpr size_t WS_SSQ_Q = 10 * MiB;
constexpr size_t WS_SSQ_KV = 10 * MiB + 512 * 1024;
constexpr size_t WS_SSQ_X1 = 11 * MiB;
constexpr size_t WS_SSQ_X2 = 13 * MiB;
constexpr size_t WS_WR = 15 * MiB;
constexpr size_t WS_WT_IN = 16 * MiB;
constexpr size_t WS_WT_UQ = 19 * MiB;
constexpr size_t WS_WT_UKV = WS_WT_UQ + 512 * 1024;
constexpr size_t WS_WT_OUT = 20 * MiB;
constexpr size_t WS_WT_XQ = 22 * MiB;
constexpr size_t WS_WT_XKV = 24 * MiB;
constexpr size_t WS_WT_XO = 28 * MiB;
constexpr size_t WS_WT_UP = 32 * MiB;
constexpr size_t WS_WT_DOWN = 160 * MiB;
constexpr size_t WS_X2B = 224 * MiB;
constexpr size_t WS_XB = WS_X2B;
constexpr size_t WS_ACT = 288 * MiB;
constexpr size_t WS_U = 288 * MiB;
constexpr size_t WS_Z = 320 * MiB;
constexpr size_t WS_Q = 384 * MiB;
constexpr size_t WS_KB = 432 * MiB;
constexpr size_t WS_VB = 480 * MiB;
constexpr size_t WS_YCAT = 512 * MiB;
constexpr size_t WS_YB = 560 * MiB;
constexpr size_t WS_XG = WS_YB;
constexpr size_t WS_X1B = 576 * MiB;
constexpr size_t WS_XQ = 640 * MiB;
constexpr size_t WS_P = 704 * MiB;
constexpr size_t WS_OX = 768 * MiB;
constexpr size_t WS_MEMB = 832 * MiB;
constexpr size_t WS_KM = 840 * MiB;
constexpr size_t WS_VMT = 848 * MiB;
constexpr size_t WS_END = 856 * MiB;

struct Params {
    const float* x; const float* mem; const int* pos;
    const float *g_mix, *w_in, *g_q, *w_uq, *g_kv, *w_ukv, *w_dw, *b_dw, *g_cln, *b_cln, *w_out, *g_xattn, *g_mem, *w_xq, *w_xkv, *w_xo, *g_ffn, *w_router, *b_router, *w_up, *b_up, *w_down, *b_down, *g_final;
    float* out; unsigned char* ws;
};

__device__ __forceinline__ float bf2f(bf16_t b) { return __uint_as_float((unsigned)b << 16); }
__device__ __forceinline__ unsigned f2bf(float f) { unsigned u = __float_as_uint(f); return (u + 0x7fffu + ((u >> 16) & 1u)) >> 16; }
typedef __bf16 bf16x2_t __attribute__((ext_vector_type(2)));
__device__ __forceinline__ unsigned pk2(float lo, float hi) { const f32x2 v = {lo, hi}; const bf16x2_t b = __builtin_convertvector(v, bf16x2_t); return __builtin_bit_cast(unsigned, b); }
__device__ __forceinline__ float wave_sum(float v) {
#pragma unroll
    for (int o = 1; o < 64; o <<= 1) v += __shfl_xor(v, o);
    return v;
}
__device__ __forceinline__ int perm32(int rho) { const int n = rho >> 4, i = rho & 15; return 8 * (i >> 2) + 4 * n + (i & 3); }
__device__ __forceinline__ float fast_exp2(float x) { return __builtin_amdgcn_exp2f(x); }
__device__ __forceinline__ float sigmoidf_(float x) { return 1.0f / (1.0f + __expf(-x)); }

struct TrDesc { const float* W; const float* g; bf16_t* WT; int N, K, mode, k0, n0; };
__device__ __forceinline__ void tr_load(const TrDesc& d, float (&v)[32], int lane) {
    const float* src = d.W + (size_t)(d.k0 + (lane >> 3)) * d.N + d.n0 + 4 * (lane & 7);
#pragma unroll
    for (int i = 0; i < 8; ++i) { const f32x4 t = *(const f32x4*)(src + (size_t)(8 * i) * d.N); v[4 * i] = t[0]; v[4 * i + 1] = t[1]; v[4 * i + 2] = t[2]; v[4 * i + 3] = t[3]; }
}
__device__ __forceinline__ void tr_store(const TrDesc& d, const float (&v)[32], LAS float* scr, int lane) {
#pragma unroll
    for (int i = 0; i < 8; ++i)
#pragma unroll
        for (int e = 0; e < 4; ++e) scr[(8 * i + (lane >> 3)) * 33 + 4 * (lane & 7) + e] = v[4 * i + e];
    asm volatile("s_waitcnt lgkmcnt(0)" ::: "memory");
    const int c = lane & 7;
    f32x4 g0 = {1.f, 1.f, 1.f, 1.f}, g1 = {1.f, 1.f, 1.f, 1.f};
    if (d.g) { g0 = *(const f32x4*)(d.g + d.k0 + 8 * c); g1 = *(const f32x4*)(d.g + d.k0 + 8 * c + 4); }
#pragma unroll
    for (int j = 0; j < 4; ++j) { const int n = (lane >> 3) + 8 * j; const LAS float* sp = scr + (8 * c) * 33 + n;
        u32x4 o; o.x = pk2(sp[0 * 33] * g0[0], sp[1 * 33] * g0[1]); o.y = pk2(sp[2 * 33] * g0[2], sp[3 * 33] * g0[3]); o.z = pk2(sp[4 * 33] * g1[0], sp[5 * 33] * g1[1]); o.w = pk2(sp[6 * 33] * g1[2], sp[7 * 33] * g1[3]);
        const int nn = d.n0 + n; int row = nn; if (d.mode == 1) row = (((nn & 1023) >> 7) << 8) + ((nn >> 10) << 7) + (nn & 127);
        if (d.mode == 2 && nn >= 416) { const int c = (nn - 416) & 511, isg = (nn - 416) >> 9; row = 512 + ((c >> 7) << 8) + (isg << 7) + (c & 127); }
        *(u32x4*)(d.WT + (size_t)row * d.K + d.k0 + 8 * c) = o; }
    asm volatile("s_waitcnt lgkmcnt(0)" ::: "memory");
}
__device__ __forceinline__ void rows_bf16_rstd(const float* X, bf16_t* O, float* rstd, int nrows, int gw, int ngw, int lane) {
    if (gw >= nrows) return;
    f32x4 v[4], vn[4];
#pragma unroll
    for (int j = 0; j < 4; ++j) v[j] = ((const f32x4*)(X + (size_t)gw * 1024))[lane + 64 * j];
    for (int m = gw; m < nrows; m += ngw) {
        const int mn = m + ngw;
        if (mn < nrows) {
#pragma unroll
            for (int j = 0; j < 4; ++j) vn[j] = ((const f32x4*)(X + (size_t)mn * 1024))[lane + 64 * j]; }
        float s = 0.f;
#pragma unroll
        for (int j = 0; j < 4; ++j) s += (v[j].x * v[j].x + v[j].y * v[j].y) + (v[j].z * v[j].z + v[j].w * v[j].w);
        s = wave_sum(s);
        if (lane == 0) rstd[m] = 1.0f / sqrtf(s * (1.0f / 1024.0f) + EPS);
#pragma unroll
        for (int j = 0; j < 4; ++j) { u32x2 w; w.x = pk2(v[j].x, v[j].y); w.y = pk2(v[j].z, v[j].w); ((u32x2*)(O + (size_t)m * 1024))[lane + 64 * j] = w; }
#pragma unroll
        for (int j = 0; j < 4; ++j) v[j] = vn[j];
    }
}
__device__ __forceinline__ void sincos_acc(double a, float& s, float& c) {
    const double TWO_PI = 6.283185307179586476925;
    const double n = rint(a * (1.0 / TWO_PI)); const double r = a - n * TWO_PI;
    const double h = 0.5 * r, h2 = h * h;
    const double sh = h * (1.0 + h2 * (-1.0 / 6.0 + h2 * (1.0 / 120.0 + h2 * (-1.0 / 5040.0 + h2 * (1.0 / 362880.0 + h2 * (-1.0 / 39916800.0 + h2 * (1.0 / 6227020800.0 + h2 * (-1.0 / 1307674368000.0 + h2 * (1.0 / 355687428096000.0)))))))));
    const double ch = 1.0 + h2 * (-0.5 + h2 * (1.0 / 24.0 + h2 * (-1.0 / 720.0 + h2 * (1.0 / 40320.0 + h2 * (-1.0 / 3628800.0 + h2 * (1.0 / 479001600.0 + h2 * (-1.0 / 87178291200.0 + h2 * (1.0 / 20922789888000.0 + h2 * (-1.0 / 6402373705728000.0)))))))));
    s = (float)(2.0 * sh * ch); c = (float)(ch * ch - sh * sh);
}
__device__ __forceinline__ double rope_inv(int i) {
    const double t[16] = {1.0, 0.5623413251903491, 0.31622776601683794, 0.1778279410038923, 0.1, 0.05623413251903491, 0.03162277660168379, 0.01778279410038923,
                          0.01, 0.005623413251903491, 0.0031622776601683794, 0.0017782794100389228, 0.001, 0.0005623413251903491, 0.00031622776601683794, 0.00017782794100389227};
    double r = t[0];
#pragma unroll
    for (int k = 1; k < 16; ++k) r = (i == k) ? t[k] : r;
    return r;
}

__device__ __forceinline__ void prep_stage(const Params& p, LAS unsigned char* lds, int vblk, int nblk, int tid, unsigned long long& tsub) {
    const int lane = tid & 63, wid = tid >> 6;
    const int gw = vblk * 8 + wid, ngw = nblk * 8;
    LAS float* scr = (LAS float*)(lds + wid * 8448);
    unsigned char* ws = p.ws;
    constexpr int I_IN = 16 * 45, I_UQ = 4 * 24, I_UKV = 2 * 32, I_SQ = 16 * 32, I_XKV = 16 * 64;
    constexpr int NITEMS = I_IN + I_UQ + I_UKV + 3 * I_SQ + I_XKV;
    auto get_desc = [&](int it) -> TrDesc {
        TrDesc d; int r = it; int item;
        if (r < I_IN) { d.W = p.w_in; d.N = INC; d.K = 1024; d.g = p.g_mix; d.WT = (bf16_t*)(ws + WS_WT_IN); d.mode = 2; item = r; }
        else if ((r -= I_IN) < I_UQ) { d.W = p.w_uq; d.N = 768; d.K = 256; d.g = p.g_q; d.WT = (bf16_t*)(ws + WS_WT_UQ); d.mode = 0; item = r; }
        else if ((r -= I_UQ) < I_UKV) { d.W = p.w_ukv; d.N = 1024; d.K = 128; d.g = p.g_kv; d.WT = (bf16_t*)(ws + WS_WT_UKV); d.mode = 0; item = r; }
        else if ((r -= I_UKV) < I_SQ) { d.W = p.w_out; d.N = 1024; d.K = 1024; d.g = nullptr; d.WT = (bf16_t*)(ws + WS_WT_OUT); d.mode = 0; item = r; }
        else if ((r -= I_SQ) < I_SQ) { d.W = p.w_xq; d.N = 1024; d.K = 1024; d.g = p.g_xattn; d.WT = (bf16_t*)(ws + WS_WT_XQ); d.mode = 0; item = r; }
        else if ((r -= I_SQ) < I_SQ) { d.W = p.w_xo; d.N = 1024; d.K = 1024; d.g = nullptr; d.WT = (bf16_t*)(ws + WS_WT_XO); d.mode = 0; item = r; }
        else { r -= I_SQ; d.W = p.w_xkv; d.N = 2048; d.K = 1024; d.g = p.g_mem; d.WT = (bf16_t*)(ws + WS_WT_XKV); d.mode = 0; item = r; }
        const int nblk = d.N / 32; d.k0 = 64 * (item / nblk); d.n0 = 32 * (item % nblk); return d; };
    SUB_T0(1);
    if (gw < NITEMS) {
        TrDesc d0 = get_desc(gw), d1 = d0, d2 = d0; float v0[32], v1[32], v2[32];
        tr_load(d0, v0, lane);
        if (gw + ngw < NITEMS) { d1 = get_desc(gw + ngw); tr_load(d1, v1, lane); }
        for (int it = gw; it < NITEMS; it += ngw) {
            const int n2 = it + 2 * ngw;
            if (n2 < NITEMS) { d2 = get_desc(n2); tr_load(d2, v2, lane); }
            tr_store(d0, v0, scr, lane);
            d0 = d1; d1 = d2;
#pragma unroll
            for (int i = 0; i < 32; ++i) { v0[i] = v1[i]; v1[i] = v2[i]; }
        }
    }
    SUB_T1(1, tsub);
    SUB_T0(2);
    rows_bf16_rstd(p.x, (bf16_t*)(ws + WS_XB), (float*)(ws + WS_RSTD_X), NTOK, gw, ngw, lane);
    rows_bf16_rstd(p.mem, (bf16_t*)(ws + WS_MEMB), (float*)(ws + WS_RSTD_MEM), NMEM, gw, ngw, lane);
    SUB_T1(2, tsub);
    SUB_T0(3);
    const int gt = vblk * 512 + tid, ngt = nblk * 512;
    for (int i = gt; i < NTOK * 16; i += ngt) { const int row = i >> 4, f = i & 15; float s, c; sincos_acc((double)p.pos[row] * rope_inv(f), s, c);
        float* rt = (float*)(ws + WS_ROPE) + (size_t)row * 32; rt[f] = c; rt[16 + f] = s; }
    for (int i = gt; i < 1024 * 32; i += ngt) { const int k = i >> 5, e = i & 31; const float v = p.g_ffn[k] * p.w_router[i]; const unsigned hb = f2bf(v); const float lo = v - __uint_as_float(hb << 16);
        ((bf16_t*)(ws + WS_WR))[e * 1024 + k] = (bf16_t)hb; ((bf16_t*)(ws + WS_WR))[32768 + e * 1024 + k] = (bf16_t)f2bf(lo); }
    for (int i = gt; i < 96 * 1024 / 8; i += ngt) ((u32x4*)((bf16_t*)(ws + WS_WT_IN) + (size_t)416 * 1024))[i] = (u32x4){0u, 0u, 0u, 0u};
    SUB_T1(3, tsub);
}

__device__ __forceinline__ void moe_weights_stage(const Params& p, LAS unsigned char* lds, int ci, int nconv, int tid) {
    const int lane = tid & 63, wid = tid >> 6; const int gw = ci * 8 + wid, ngw = nconv * 8;
    LAS float* scr = (LAS float*)(lds + wid * 8448);
    unsigned char* ws = p.ws;
    constexpr int I_UP1 = 16 * 64, I_DN1 = 16 * 32, NITEMS = NE * (I_UP1 + I_DN1);
    auto get_desc = [&](int it) -> TrDesc {
        TrDesc d; int r = it; int item;
        if (r < NE * I_UP1) { const int e = r / I_UP1; d.W = p.w_up + (size_t)e * 1024 * 2048; d.N = 2048; d.K = 1024; d.g = p.g_ffn; d.WT = (bf16_t*)(ws + WS_WT_UP) + (size_t)e * 2048 * 1024; d.mode = 1; item = r % I_UP1; }
        else { r -= NE * I_UP1; const int e = r / I_DN1; d.W = p.w_down + (size_t)e * 1024 * 1024; d.N = 1024; d.K = 1024; d.g = nullptr; d.WT = (bf16_t*)(ws + WS_WT_DOWN) + (size_t)e * 1024 * 1024; d.mode = 0; item = r % I_DN1; }
        const int nblk = d.N / 32; d.k0 = 64 * (item / nblk); d.n0 = 32 * (item % nblk); return d; };
    if (gw < NITEMS) {
        TrDesc d0 = get_desc(gw), d1 = d0, d2 = d0; float v0[32], v1[32], v2[32];
        tr_load(d0, v0, lane);
        if (gw + ngw < NITEMS) { d1 = get_desc(gw + ngw); tr_load(d1, v1, lane); }
        for (int it = gw; it < NITEMS; it += ngw) {
            const int n2 = it + 2 * ngw;
            if (n2 < NITEMS) { d2 = get_desc(n2); tr_load(d2, v2, lane); }
            tr_store(d0, v0, scr, lane);
            d0 = d1; d1 = d2;
#pragma unroll
            for (int i = 0; i < 32; ++i) { v0[i] = v1[i]; v1[i] = v2[i]; }
        }
    }
}

struct Unit { int pm, pn, z; };
typedef f32x4 Acc[2][2][4][2];

template <bool PERM, class Prov, class Epi>
__device__ __forceinline__ void gemm_unit_naive(const Prov& P, const Epi& E, const Unit& u, LAS unsigned char* lds, int tid) {
    const int wid = tid >> 6, lane = tid & 63, wr = wid >> 2, wc = wid & 3, fr = lane & 15, fq = lane >> 4;
    const bf16_t* ap[2][4]; const bf16_t* bp[2][2];
#pragma unroll
    for (int ai = 0; ai < 2; ++ai)
#pragma unroll
        for (int m = 0; m < 4; ++m) ap[ai][m] = P.a_row(u, 128 * ai + 64 * wr + 16 * m + fr) + 8 * fq;
#pragma unroll
    for (int bj = 0; bj < 2; ++bj)
#pragma unroll
        for (int n = 0; n < 2; ++n) { const int rho = 16 * n + fr; bp[bj][n] = P.b_row(u, 128 * bj + 32 * wc + (PERM ? perm32(rho) : rho)) + 8 * fq; }
    Acc acc;
#pragma unroll
    for (int a = 0; a < 2; ++a)
#pragma unroll
        for (int b = 0; b < 2; ++b)
#pragma unroll
            for (int m = 0; m < 4; ++m)
#pragma unroll
                for (int n = 0; n < 2; ++n) acc[a][b][m][n] = (f32x4){0.f, 0.f, 0.f, 0.f};
    const int K = P.K;
#pragma unroll 1
    for (int k0 = 0; k0 < K; k0 += 32) {
        bf16x8 a[2][4], b[2][2];
#pragma unroll
        for (int ai = 0; ai < 2; ++ai)
#pragma unroll
            for (int m = 0; m < 4; ++m) a[ai][m] = *(const bf16x8*)(ap[ai][m] + k0);
#pragma unroll
        for (int bj = 0; bj < 2; ++bj)
#pragma unroll
            for (int n = 0; n < 2; ++n) b[bj][n] = *(const bf16x8*)(bp[bj][n] + k0);
#pragma unroll
        for (int ai = 0; ai < 2; ++ai)
#pragma unroll
            for (int bj = 0; bj < 2; ++bj)
#pragma unroll
                for (int m = 0; m < 4; ++m)
#pragma unroll
                    for (int n = 0; n < 2; ++n) acc[ai][bj][m][n] = __builtin_amdgcn_mfma_f32_16x16x32_bf16(b[bj][n], a[ai][m], acc[ai][bj][m][n], 0, 0, 0);
    }
    E(acc, u, wr, wc, fr, fq, lds, (const LAS float*)lds);
}

struct ProvPlain { const bf16_t* A; int lda; const bf16_t* Bt; int ldb; int K;
    __device__ __forceinline__ const bf16_t* a_row(const Unit& u, int r) const { return A + (size_t)(u.pm * 256 + r) * lda; }
    __device__ __forceinline__ const bf16_t* b_row(const Unit& u, int r) const { return Bt + (size_t)(u.pn * 256 + r) * ldb; } };
struct ProvXS { const bf16_t* XQ; const bf16_t* KM; int K;
    __device__ __forceinline__ const bf16_t* a_row(const Unit& u, int r) const { return XQ + (size_t)((u.z >> 2) * 2048 + u.pm * 256 + r) * 1024 + (u.z & 3) * 256; }
    __device__ __forceinline__ const bf16_t* b_row(const Unit& u, int r) const { return KM + (size_t)((u.z >> 2) * 256 + r) * 1024 + (u.z & 3) * 256; } };
struct ProvXPV { const bf16_t* Pm; const bf16_t* VMT; int K;
    __device__ __forceinline__ const bf16_t* a_row(const Unit& u, int r) const { return Pm + ((size_t)u.z * 2048 + u.pm * 256 + r) * 256; }
    __device__ __forceinline__ const bf16_t* b_row(const Unit& u, int r) const { return VMT + ((size_t)u.z * 256 + r) * 256; } };
struct ProvUp { const bf16_t* X2B; const int* slot_tok; const int* tile_e; const bf16_t* WT; int K;
    __device__ __forceinline__ const bf16_t* a_row(const Unit& u, int r) const { return X2B + (size_t)slot_tok[u.pm * 256 + r] * 1024; }
    __device__ __forceinline__ const bf16_t* b_row(const Unit& u, int r) const { return WT + ((size_t)tile_e[u.pm] * 2048 + u.pn * 256 + r) * 1024; } };
struct ProvDown { const bf16_t* ACT; const int* tile_e; const bf16_t* WT; int K;
    __device__ __forceinline__ const bf16_t* a_row(const Unit& u, int r) const { return ACT + (size_t)(u.pm * 256 + r) * 1024; }
    __device__ __forceinline__ const bf16_t* b_row(const Unit& u, int r) const { return WT + ((size_t)tile_e[u.pm] * 1024 + u.pn * 256 + r) * 1024; } };

#define EPI_BAR() do { asm volatile("s_waitcnt lgkmcnt(0)" ::: "memory"); __builtin_amdgcn_s_barrier(); asm volatile("" ::: "memory"); } while (0)
#define EPI_ARGS Acc& acc, const Unit& u, int wr, int wc, int fr, int fq, LAS unsigned char* lds, const LAS float* tab
#define EPI_NOPF __device__ __forceinline__ void prefetch(const Unit&, LAS float*, int) const {}
#define FOR_AI_M _Pragma("unroll") for (int ai = 0; ai < 2; ++ai) _Pragma("unroll") for (int m = 0; m < 4; ++m)
#define FOR_BJ _Pragma("unroll") for (int bj = 0; bj < 2; ++bj)
struct EpiIn { bf16_t* U; bf16_t* Z; const float* rs; float* ssq_q; float* ssq_kv; const float* rope; bf16_t* KB;
    EPI_NOPF
    __device__ __forceinline__ void operator()(EPI_ARGS) const {
        if (u.pn >= 2) {
            FOR_AI_M { const int row = u.pm * 256 + 128 * ai + 64 * wr + 16 * m + fr; const float s = rs[row]; f32x4 o[2];
#pragma unroll
                for (int n = 0; n < 2; ++n) { const f32x4 av = acc[ai][0][m][n] * s, gv = acc[ai][1][m][n] * s; const f32x4 t = gv * (-1.4426950408889634f); f32x4 ex;
#pragma unroll
                    for (int j = 0; j < 4; ++j) ex[j] = __builtin_amdgcn_exp2f(t[j]);
                    ex = ex + 1.0f; f32x4 rc;
#pragma unroll
                    for (int j = 0; j < 4; ++j) rc[j] = __builtin_amdgcn_rcpf(ex[j]);
                    o[n] = av * rc; }
                u32x4 w; w.x = pk2(o[0][0], o[0][1]); w.y = pk2(o[0][2], o[0][3]); w.z = pk2(o[1][0], o[1][1]); w.w = pk2(o[1][2], o[1][3]);
                *(u32x4*)(Z + (size_t)row * 512 + (u.pn - 2) * 128 + 32 * wc + 8 * fq) = w; }
            return; }
        FOR_AI_M { const int row = u.pm * 256 + 128 * ai + 64 * wr + 16 * m + fr; const float s = rs[row]; bf16_t* rowp = U + (size_t)row * ULD + u.pn * 256 + 32 * wc + 8 * fq;
            float q0 = 0.f, q1 = 0.f;
            FOR_BJ { const f32x4 v0 = acc[ai][bj][m][0] * s, v1 = acc[ai][bj][m][1] * s; u32x4 w; w.x = pk2(v0[0], v0[1]); w.y = pk2(v0[2], v0[3]); w.z = pk2(v1[0], v1[1]); w.w = pk2(v1[2], v1[3]);
                *(u32x4*)(rowp + 128 * bj) = w;
                const float qq = (v0[0] * v0[0] + v0[1] * v0[1]) + (v0[2] * v0[2] + v0[3] * v0[3]) + (v1[0] * v1[0] + v1[1] * v1[1]) + (v1[2] * v1[2] + v1[3] * v1[3]);
                if (bj == 0) q0 = qq; else q1 = qq; }
            if (u.pn == 0) { float q = q0 + q1; q += __shfl_xor(q, 16); q += __shfl_xor(q, 32); if (fq == 0) ssq_q[(size_t)row * 4 + wc] = q; }
            if (u.pn == 1) { float q = q0; q += __shfl_xor(q, 16); q += __shfl_xor(q, 32); if (fq == 0) ssq_kv[(size_t)row * 4 + wc] = q;
                if (wc == 0) {
                    const int i0 = 8 * (fq & 1); const f32x4 c0 = *(const f32x4*)(rope + (size_t)row * 32 + i0), c1 = *(const f32x4*)(rope + (size_t)row * 32 + i0 + 4);
                    const f32x4 s0 = *(const f32x4*)(rope + (size_t)row * 32 + 16 + i0), s1 = *(const f32x4*)(rope + (size_t)row * 32 + 16 + i0 + 4);
                    const f32x4 v0 = acc[ai][1][m][0] * s, v1 = acc[ai][1][m][1] * s; f32x4 p0, p1;
#pragma unroll
                    for (int j = 0; j < 4; ++j) { p0[j] = __shfl_xor(v0[j], 32); p1[j] = __shfl_xor(v1[j], 32); }
                    f32x4 o0, o1;
                    if (fq < 2) { o0 = v0 * c0 - p0 * s0; o1 = v1 * c1 - p1 * s1; } else { o0 = p0 * s0 + v0 * c0; o1 = p1 * s1 + v1 * c1; }
                    u32x4 w; w.x = pk2(o0[0], o0[1]); w.y = pk2(o0[2], o0[3]); w.z = pk2(o1[0], o1[1]); w.w = pk2(o1[2], o1[3]);
                    bf16_t* kb = KB + (size_t)row * 768 + 64 + 8 * fq;
#pragma unroll
                    for (int h = 0; h < 8; ++h) *(u32x4*)(kb + h * 96) = w; } } } } };
struct EpiScale16 { bf16_t* O; int ldc; const float* ssq; float mul;
    EPI_NOPF
    __device__ __forceinline__ void operator()(EPI_ARGS) const {
        FOR_AI_M { const int row = u.pm * 256 + 128 * ai + 64 * wr + 16 * m + fr; const f32x4* sp = (const f32x4*)(ssq + (size_t)row * 16); const f32x4 t = (sp[0] + sp[1]) + (sp[2] + sp[3]);
            const float s = mul / sqrtf(((t[0] + t[1]) + (t[2] + t[3])) * (1.0f / 1024.0f) + EPS); bf16_t* rowp = O + (size_t)row * ldc + u.pn * 256 + 32 * wc + 8 * fq;
            FOR_BJ { const f32x4 v0 = acc[ai][bj][m][0] * s, v1 = acc[ai][bj][m][1] * s; u32x4 w; w.x = pk2(v0[0], v0[1]); w.y = pk2(v0[2], v0[3]); w.z = pk2(v1[0], v1[1]); w.w = pk2(v1[2], v1[3]);
                *(u32x4*)(rowp + 128 * bj) = w; } } } };
struct EpiQ { bf16_t* Q; const float* ssq; const float* rope;
    EPI_NOPF
    __device__ __forceinline__ void operator()(EPI_ARGS) const {
        FOR_AI_M { const int row = u.pm * 256 + 128 * ai + 64 * wr + 16 * m + fr; const f32x4 t = *(const f32x4*)(ssq + (size_t)row * 4); const float s = C2_MLA / sqrtf(((t[0] + t[1]) + (t[2] + t[3])) * (1.0f / 256.0f) + EPS);
            const f32x4 cs = *(const f32x4*)(rope + (size_t)row * 32 + 4 * fq), sn = *(const f32x4*)(rope + (size_t)row * 32 + 16 + 4 * fq);
            FOR_BJ { const int colg = u.pn * 256 + 128 * bj + 32 * wc; f32x4 v0 = acc[ai][bj][m][0] * s, v1 = acc[ai][bj][m][1] * s;
                if (((colg >> 5) % 3) == 2) { const f32x4 r0 = v0 * cs - v1 * sn, r1 = v0 * sn + v1 * cs; v0 = r0; v1 = r1; }
                bf16_t* rowp = Q + (size_t)row * 768 + colg + 4 * fq; u32x2 w0, w1; w0.x = pk2(v0[0], v0[1]); w0.y = pk2(v0[2], v0[3]); w1.x = pk2(v1[0], v1[1]); w1.y = pk2(v1[2], v1[3]);
                *(u32x2*)(rowp) = w0; *(u32x2*)(rowp + 16) = w1; } } } };
struct EpiKV { bf16_t* KB; bf16_t* VB; const float* ssq;
    EPI_NOPF
    __device__ __forceinline__ void operator()(EPI_ARGS) const {
        FOR_AI_M { const int row = u.pm * 256 + 128 * ai + 64 * wr + 16 * m + fr; const f32x4 t = *(const f32x4*)(ssq + (size_t)row * 4); const float s = 1.0f / sqrtf(((t[0] + t[1]) + (t[2] + t[3])) * (1.0f / 128.0f) + EPS);
            FOR_BJ { const int h = 2 * u.pn + bj, cl = 32 * wc + 8 * fq; const f32x4 v0 = acc[ai][bj][m][0] * s, v1 = acc[ai][bj][m][1] * s;
                u32x4 w; w.x = pk2(v0[0], v0[1]); w.y = pk2(v0[2], v0[3]); w.z = pk2(v1[0], v1[1]); w.w = pk2(v1[2], v1[3]);
                if (wc < 2) *(u32x4*)(KB + (size_t)row * 768 + h * 96 + cl) = w; else *(u32x4*)(VB + (size_t)row * 512 + h * 64 + cl - 64) = w; } } } };
struct EpiResid { const bf16_t* base; bf16_t* ob; float* ssq;
    EPI_NOPF
    __device__ __forceinline__ void operator()(EPI_ARGS) const {
        FOR_AI_M { const int row = u.pm * 256 + 128 * ai + 64 * wr + 16 * m + fr; float q = 0.f;
            FOR_BJ { const size_t off = (size_t)row * 1024 + u.pn * 256 + 128 * bj + 32 * wc + 8 * fq;
                const u32x4 bw = *(const u32x4*)(base + off);
                f32x4 v0, v1; v0[0] = __uint_as_float(bw.x << 16); v0[1] = __uint_as_float(bw.x & 0xffff0000u); v0[2] = __uint_as_float(bw.y << 16); v0[3] = __uint_as_float(bw.y & 0xffff0000u);
                v1[0] = __uint_as_float(bw.z << 16); v1[1] = __uint_as_float(bw.z & 0xffff0000u); v1[2] = __uint_as_float(bw.w << 16); v1[3] = __uint_as_float(bw.w & 0xffff0000u);
                v0 = v0 + acc[ai][bj][m][0]; v1 = v1 + acc[ai][bj][m][1];
                u32x4 w; w.x = pk2(v0[0], v0[1]); w.y = pk2(v0[2], v0[3]); w.z = pk2(v1[0], v1[1]); w.w = pk2(v1[2], v1[3]); *(u32x4*)(ob + off) = w;
                q += (v0[0] * v0[0] + v0[1] * v0[1]) + (v0[2] * v0[2] + v0[3] * v0[3]) + (v1[0] * v1[0] + v1[1] * v1[1]) + (v1[2] * v1[2] + v1[3] * v1[3]); }
            if (ssq) { q += __shfl_xor(q, 16); q += __shfl_xor(q, 32); if (fq == 0) ssq[(size_t)row * 16 + u.pn * 4 + wc] = q; } } } };
struct EpiKVMem { bf16_t* KM; bf16_t* VMT; const float* rs;
    EPI_NOPF
    __device__ __forceinline__ void operator()(EPI_ARGS) const {
        FOR_AI_M { const int row = u.pm * 256 + 128 * ai + 64 * wr + 16 * m + fr; const float s = rs[row];
            FOR_BJ {
#pragma unroll
                for (int n = 0; n < 2; ++n) { const int col = u.pn * 256 + 128 * bj + 32 * wc + 16 * n + 4 * fq; const f32x4 v = acc[ai][bj][m][n] * s;
                    if (u.pn < 4) { u32x2 w; w.x = pk2(v[0], v[1]); w.y = pk2(v[2], v[3]); *(u32x2*)(KM + (size_t)row * 1024 + col) = w; }
                    else { const int c2 = col - 1024, h = c2 >> 8, d = c2 & 255, b = row >> 8, mm = row & 255; bf16_t* dst = VMT + ((size_t)(b * 4 + h) * 256 + d) * 256 + mm;
#pragma unroll
                        for (int j = 0; j < 4; ++j) dst[(size_t)j * 256] = (bf16_t)f2bf(v[j]); } } } } } };
struct EpiSoftmaxP { bf16_t* Pm;
    EPI_NOPF
    __device__ __forceinline__ void operator()(EPI_ARGS) const {
        LAS float* red = (LAS float*)lds; float rmax[2][4];
        FOR_AI_M { float mx = -3.0e38f;
            FOR_BJ {
#pragma unroll
                for (int n = 0; n < 2; ++n)
#pragma unroll
                    for (int j = 0; j < 4; ++j) mx = fmaxf(mx, acc[ai][bj][m][n][j]); }
            mx = fmaxf(mx, __shfl_xor(mx, 16)); mx = fmaxf(mx, __shfl_xor(mx, 32));
            if (fq == 0) red[(128 * ai + 64 * wr + 16 * m + fr) * 4 + wc] = mx; }
        EPI_BAR();
        FOR_AI_M { const f32x4 t = *(const LAS f32x4*)(red + (128 * ai + 64 * wr + 16 * m + fr) * 4); rmax[ai][m] = fmaxf(fmaxf(t[0], t[1]), fmaxf(t[2], t[3])); }
        EPI_BAR();
        FOR_AI_M { float s = 0.f;
            FOR_BJ {
#pragma unroll
                for (int n = 0; n < 2; ++n)
#pragma unroll
                    for (int j = 0; j < 4; ++j) { const float e = fast_exp2(acc[ai][bj][m][n][j] - rmax[ai][m]); acc[ai][bj][m][n][j] = e; s += e; } }
            s += __shfl_xor(s, 16); s += __shfl_xor(s, 32);
            if (fq == 0) red[(128 * ai + 64 * wr + 16 * m + fr) * 4 + wc] = s; }
        EPI_BAR();
        FOR_AI_M { const int r = 128 * ai + 64 * wr + 16 * m + fr; const f32x4 t = *(const LAS f32x4*)(red + r * 4); const float inv = 1.0f / ((t[0] + t[1]) + (t[2] + t[3]));
            bf16_t* rowp = Pm + ((size_t)u.z * 2048 + u.pm * 256 + r) * 256 + 32 * wc + 8 * fq;
            FOR_BJ { const f32x4 v0 = acc[ai][bj][m][0] * inv, v1 = acc[ai][bj][m][1] * inv; u32x4 w; w.x = pk2(v0[0], v0[1]); w.y = pk2(v0[2], v0[3]); w.z = pk2(v1[0], v1[1]); w.w = pk2(v1[2], v1[3]);
                *(u32x4*)(rowp + 128 * bj) = w; } }
        EPI_BAR();
    } };
struct EpiOX { bf16_t* OX;
    EPI_NOPF
    __device__ __forceinline__ void operator()(EPI_ARGS) const {
        FOR_AI_M { const int r = 128 * ai + 64 * wr + 16 * m + fr; bf16_t* rowp = OX + (size_t)((u.z >> 2) * 2048 + u.pm * 256 + r) * 1024 + (u.z & 3) * 256 + 32 * wc + 8 * fq;
            FOR_BJ { const f32x4 v0 = acc[ai][bj][m][0], v1 = acc[ai][bj][m][1]; u32x4 w; w.x = pk2(v0[0], v0[1]); w.y = pk2(v0[2], v0[3]); w.z = pk2(v1[0], v1[1]); w.w = pk2(v1[2], v1[3]);
                *(u32x4*)(rowp + 128 * bj) = w; } } } };
struct EpiSwiglu { bf16_t* ACT; const float* slot_rs; const int* tile_e; const float* b_up;
    __device__ __forceinline__ void prefetch(const Unit& u, LAS float* t, int tid) const { const int e = tile_e[u.pm];
        t[tid] = slot_rs[u.pm * 256 + tid]; t[256 + tid] = b_up[(size_t)e * 2048 + ((tid >> 7) << 10) + u.pn * 128 + (tid & 127)]; }
    __device__ __forceinline__ void operator()(EPI_ARGS) const {
        const int cl = 32 * wc + 8 * fq;
        f32x4 bgv[2], blv[2]; bgv[0] = *(const LAS f32x4*)(tab + 256 + cl); bgv[1] = *(const LAS f32x4*)(tab + 256 + cl + 4); blv[0] = *(const LAS f32x4*)(tab + 384 + cl); blv[1] = *(const LAS f32x4*)(tab + 384 + cl + 4);
        FOR_AI_M { const int rl = 128 * ai + 64 * wr + 16 * m + fr; const int slot = u.pm * 256 + rl; const float s = tab[rl];
            f32x4 o[2];
#pragma unroll
            for (int n = 0; n < 2; ++n) { f32x4 g = acc[ai][0][m][n] * s + bgv[n], l = acc[ai][1][m][n] * s + blv[n];
                g = __builtin_elementwise_min(g, (f32x4){7.f, 7.f, 7.f, 7.f}); l = __builtin_elementwise_min(__builtin_elementwise_max(l, (f32x4){-7.f, -7.f, -7.f, -7.f}), (f32x4){7.f, 7.f, 7.f, 7.f}) + 1.0f;
                const f32x4 t = g * (-1.702f * 1.4426950408889634f); f32x4 ex;
#pragma unroll
                for (int j = 0; j < 4; ++j) ex[j] = __builtin_amdgcn_exp2f(t[j]);
                ex = ex + 1.0f; f32x4 rc;
#pragma unroll
                for (int j = 0; j < 4; ++j) rc[j] = __builtin_amdgcn_rcpf(ex[j]);
                o[n] = (g * rc) * l; }
            u32x4 w; w.x = pk2(o[0][0], o[0][1]); w.y = pk2(o[0][2], o[0][3]); w.z = pk2(o[1][0], o[1][1]); w.w = pk2(o[1][2], o[1][3]);
            *(u32x4*)(ACT + (size_t)slot * 1024 + u.pn * 128 + cl) = w; } } };
struct EpiDown { bf16_t* YB; const float* gate; const int* tile_e; const float* b_down;
    __device__ __forceinline__ void prefetch(const Unit& u, LAS float* t, int tid) const { const int e = tile_e[u.pm];
        t[tid] = gate[u.pm * 256 + tid]; t[256 + tid] = b_down[(size_t)e * 1024 + u.pn * 256 + tid]; }
    __device__ __forceinline__ void operator()(EPI_ARGS) const {
        const int cl = 32 * wc + 8 * fq; f32x4 bv[2][2];
        FOR_BJ { bv[bj][0] = *(const LAS f32x4*)(tab + 256 + cl + 128 * bj); bv[bj][1] = *(const LAS f32x4*)(tab + 256 + cl + 128 * bj + 4); }
        FOR_AI_M { const int rl = 128 * ai + 64 * wr + 16 * m + fr; const int slot = u.pm * 256 + rl; const float g = tab[rl];
            FOR_BJ { const f32x4 v0 = (acc[ai][bj][m][0] + bv[bj][0]) * g, v1 = (acc[ai][bj][m][1] + bv[bj][1]) * g; u32x4 w; w.x = pk2(v0[0], v0[1]); w.y = pk2(v0[2], v0[3]); w.z = pk2(v1[0], v1[1]); w.w = pk2(v1[2], v1[3]);
                *(u32x4*)(YB + (size_t)slot * 1024 + u.pn * 256 + cl + 128 * bj) = w; } } } };


namespace pg8 {
constexpr int BK = 64, HALF = 128, HTB = HALF * BK * 2, STAGE_BYTES = 8 * HTB;
__device__ __forceinline__ int lds_byte(int r, int c) { const int st = (r >> 4) * 2 + (c >> 5), rr = r & 15, cc = c & 31, ob = rr * 64 + cc * 2; return st * 1024 + (ob ^ (((ob >> 9) & 1) << 5)); }
__device__ __forceinline__ void stage_rc(int b, int& R, int& C) { const int st = b / 1024, sb = b % 1024, swz = sb ^ (((sb >> 9) & 1) << 5); R = (st >> 1) * 16 + swz / 64; C = (st & 1) * 32 + (swz % 64) / 2; }

template <bool PERM, bool GATHER, class Prov, class Sched, class Epi>
__device__ __forceinline__ void gemm_phase(LAS unsigned char* lds, LAS unsigned char* lds_epi, const Prov& P, const Sched& S, const Epi& E, int tid, unsigned long long* tepi = nullptr) {
    const int wid = __builtin_amdgcn_readfirstlane(tid >> 6), lane = tid & 63, wr = wid >> 2, wc = wid & 3, fr = lane & 15, fq = lane >> 4;
    const int K = P.K, nt = K / BK;
    unsigned voffA[2], voffB[2], voffG[2][2]; int Rg[2]; unsigned Cg[2];
#pragma unroll
    for (int i = 0; i < 2; ++i) { int R, C; stage_rc(tid * 16 + i * 8192, R, C); const int Rb = PERM ? ((R & ~31) + perm32(R & 31)) : R;
        voffA[i] = (unsigned)(R * P.lda + C) * 2u; voffB[i] = (unsigned)(Rb * P.ldb + C) * 2u; Rg[i] = R; Cg[i] = (unsigned)C * 2u; }
    LAS int* rtab = (LAS int*)(lds_epi + 8192);
    const size_t kstep = (size_t)(BK * 2);
    const size_t hstepA = GATHER ? 0 : (size_t)HALF * P.lda * 2, hstepB = (size_t)HALF * P.ldb * 2;
    const unsigned ldsw = (unsigned)wid * 1024u;
    const int aoff = lds_byte(wr * 64 + fr, fq * 8), boff = lds_byte(wc * 32 + fr, fq * 8);
#define PG8_SA(b, h) (((b) * 2 + (h)) * HTB)
#define PG8_SB(b, h) ((4 + (b) * 2 + (h)) * HTB)
#define PG8_STAGE(bufoff, gbase, voff) do { _Pragma("unroll") for (int _i = 0; _i < 2; ++_i) \
        __builtin_amdgcn_global_load_lds((const unsigned*)((const char*)(gbase) + (voff)[_i]), (LAS unsigned*)(lds + (bufoff) + ldsw + _i * 8192), 16, 0, 0); } while (0)
#define PG8_STAGE_A(bufoff, gbase, h) do { if constexpr (GATHER) { PG8_STAGE(bufoff, gbase, voffG[h]); } else { PG8_STAGE(bufoff, (gbase) + (h) * hstepA, voffA); } } while (0)
#define PG8_LDA(dst, b, h) do { _Pragma("unroll") for (int m = 0; m < 4; ++m) _Pragma("unroll") for (int k = 0; k < 2; ++k) dst[m][k] = *(const LAS bf16x8*)(lds + PG8_SA(b, h) + aoff + m * 2048 + k * 1024); } while (0)
#define PG8_LDB(dst, b, h) do { _Pragma("unroll") for (int n = 0; n < 2; ++n) _Pragma("unroll") for (int k = 0; k < 2; ++k) dst[n][k] = *(const LAS bf16x8*)(lds + PG8_SB(b, h) + boff + n * 2048 + k * 1024); } while (0)
#define PG8_MMA(ai, bj, At, Bt) do { __builtin_amdgcn_s_setprio(1); _Pragma("unroll") for (int m = 0; m < 4; ++m) _Pragma("unroll") for (int n = 0; n < 2; ++n) _Pragma("unroll") for (int k = 0; k < 2; ++k) \
        acc[ai][bj][m][n] = __builtin_amdgcn_mfma_f32_16x16x32_bf16(Bt[n][k], At[m][k], acc[ai][bj][m][n], 0, 0, 0); __builtin_amdgcn_s_setprio(0); } while (0)
#define PG8_WAIT_V(n) asm volatile("s_waitcnt vmcnt(" #n ")" ::: "memory")
#define PG8_WAIT_L(n) asm volatile("s_waitcnt lgkmcnt(" #n ")" ::: "memory")
#define PG8_BAR __builtin_amdgcn_s_barrier()
#define PG8_SCHED __builtin_amdgcn_sched_barrier(0)
    Unit cur, nxt; int ui = 0;
    if (!S.next(0, cur)) return;
    Acc acc;
#pragma unroll
    for (int a = 0; a < 2; ++a)
#pragma unroll
        for (int b = 0; b < 2; ++b)
#pragma unroll
            for (int m = 0; m < 4; ++m)
#pragma unroll
                for (int n = 0; n < 2; ++n) acc[a][b][m][n] = (f32x4){0.f, 0.f, 0.f, 0.f};
    bf16x8 At[4][2], B0[2][2], B1[2][2];
    const char* cA = (const char*)P.a_base(cur); const char* cB = (const char*)P.b_base(cur);
    if constexpr (GATHER) {
#pragma unroll
        for (int h = 0; h < 2; ++h)
#pragma unroll
            for (int i = 0; i < 2; ++i) voffG[h][i] = (unsigned)P.row_tok(cur, h * HALF + Rg[i]) * (unsigned)(P.lda * 2) + Cg[i];
    }
    PG8_STAGE(PG8_SB(0, 0), cB, voffB); PG8_STAGE(PG8_SB(0, 1), cB + hstepB, voffB); PG8_STAGE_A(PG8_SA(0, 0), cA, 0); PG8_STAGE_A(PG8_SA(0, 1), cA, 1);
    if (wr == 1) PG8_BAR;
    PG8_WAIT_V(2); PG8_BAR;
    PG8_STAGE(PG8_SB(1, 0), cB + kstep, voffB); PG8_STAGE_A(PG8_SA(1, 0), cA + kstep, 0); PG8_STAGE(PG8_SB(1, 1), cB + hstepB + kstep, voffB);
    PG8_WAIT_V(6); PG8_BAR;
    for (;;) {
        const bool has_next = S.next(ui + 1, nxt);
        const char* nA = has_next ? (const char*)P.a_base(nxt) : cA; const char* nB = has_next ? (const char*)P.b_base(nxt) : cB;
        if constexpr (GATHER) { if (has_next && wr == 0) rtab[tid] = P.row_tok(nxt, tid); }
        if (wr == 0) E.prefetch(cur, (LAS float*)(lds_epi + 4096) + (ui & 1) * 512, tid);
        for (int t = 0; t < nt; t += 2) {
            const bool last = (t == nt - 2);
            const char* a1 = cA + (size_t)(t + 1) * kstep;
            const char* a2 = last ? nA : cA + (size_t)(t + 2) * kstep; const char* b2 = last ? nB : cB + (size_t)(t + 2) * kstep;
            const char* a3 = a2 + kstep; const char* b3 = b2 + kstep;
            PG8_LDB(B0, 0, 0); PG8_LDB(B1, 0, 1); PG8_SCHED; PG8_LDA(At, 0, 0); PG8_STAGE_A(PG8_SA(1, 1), a1, 1);
            if constexpr (GATHER) { if (last && has_next) {
#pragma unroll
                for (int h = 0; h < 2; ++h)
#pragma unroll
                    for (int i = 0; i < 2; ++i) voffG[h][i] = (unsigned)rtab[h * HALF + Rg[i]] * (unsigned)(P.lda * 2) + Cg[i]; } }
            PG8_WAIT_V(8); PG8_WAIT_L(0); PG8_BAR; PG8_MMA(0, 0, At, B0); PG8_MMA(0, 1, At, B1); PG8_BAR; PG8_SCHED;
            PG8_LDA(At, 0, 1); PG8_STAGE(PG8_SB(0, 0), b2, voffB); PG8_STAGE(PG8_SB(0, 1), b2 + hstepB, voffB); PG8_STAGE_A(PG8_SA(0, 0), a2, 0);
            PG8_WAIT_V(8); PG8_WAIT_L(0); PG8_BAR; PG8_MMA(1, 0, At, B0); PG8_MMA(1, 1, At, B1); PG8_BAR; PG8_SCHED;
            PG8_LDB(B0, 1, 0); PG8_LDB(B1, 1, 1); PG8_SCHED; PG8_LDA(At, 1, 0); PG8_STAGE_A(PG8_SA(0, 1), a2, 1);
            PG8_WAIT_V(8); PG8_WAIT_L(0); PG8_BAR; PG8_MMA(0, 0, At, B0); PG8_MMA(0, 1, At, B1); PG8_BAR; PG8_SCHED;
            PG8_LDA(At, 1, 1); PG8_STAGE(PG8_SB(1, 0), b3, voffB); PG8_STAGE(PG8_SB(1, 1), b3 + hstepB, voffB); PG8_STAGE_A(PG8_SA(1, 0), a3, 0);
            PG8_WAIT_V(8); PG8_WAIT_L(0); PG8_BAR; PG8_MMA(1, 0, At, B0); PG8_MMA(1, 1, At, B1); PG8_BAR; PG8_SCHED;
        }
#if PROBE_EPI
        const unsigned long long te0_ = __builtin_amdgcn_s_memrealtime();
#endif
        if (wr == 0) PG8_BAR;
        E(acc, cur, wr, wc, fr, fq, lds_epi, (const LAS float*)(lds_epi + 4096) + (ui & 1) * 512);
#if PROBE_EPI
        if (tepi) { asm volatile("s_waitcnt vmcnt(8)" ::: "memory"); *tepi += __builtin_amdgcn_s_memrealtime() - te0_; }
#endif
        if (!has_next) break;
#pragma unroll
        for (int a = 0; a < 2; ++a)
#pragma unroll
            for (int b = 0; b < 2; ++b)
#pragma unroll
                for (int m = 0; m < 4; ++m)
#pragma unroll
                    for (int n = 0; n < 2; ++n) acc[a][b][m][n] = (f32x4){0.f, 0.f, 0.f, 0.f};
        cur = nxt; cA = nA; cB = nB; ++ui;
        if (wr == 1) PG8_BAR;
    }
    PG8_WAIT_V(0);
    PG8_BAR;
#undef PG8_SA
#undef PG8_SB
#undef PG8_STAGE
#undef PG8_STAGE_A
#undef PG8_LDA
#undef PG8_LDB
#undef PG8_MMA
#undef PG8_WAIT_V
#undef PG8_WAIT_L
#undef PG8_BAR
#undef PG8_SCHED
}
struct Order { int nM, nN, nwg, G, c;
    __device__ __forceinline__ void init(int nM_, int nN_, int G_, int c_) { nM = nM_; nN = nN_; nwg = nM * nN; G = G_; c = c_; }
    __device__ __forceinline__ bool next(int i, int& pm, int& pn) const {
        const long L = (long)i * G + c; if (L >= nwg) return false;
        int wgid = (int)L; { const int q = nwg / 8, r = nwg % 8, xcd = wgid % 8, off = wgid / 8; wgid = (xcd < r ? xcd * (q + 1) : r * (q + 1) + (xcd - r) * q) + off; }
        const int nig = 8 * nN, gid = wgid / nig, fm = gid * 8, gsz = (nM - fm) < 8 ? (nM - fm) : 8;
        pm = fm + ((wgid % nig) % gsz); pn = (wgid % nig) / gsz; return true; } };
struct SchedPlain { Order o; __device__ __forceinline__ bool next(int i, Unit& u) const { u.z = 0; return o.next(i, u.pm, u.pn); } };
struct SchedBatch8 { Order o; __device__ __forceinline__ bool next(int i, Unit& u) const { int pm, pn; if (!o.next(i, pm, pn)) return false; u.z = pm >> 3; u.pm = pm & 7; u.pn = 0; return true; } };
}

struct PvUpG { const bf16_t* X; const bf16_t* WT; const int* tile_e; const int* slot_tok; int lda, ldb, K;
    __device__ __forceinline__ const bf16_t* a_base(const Unit&) const { return X; }
    __device__ __forceinline__ const bf16_t* b_base(const Unit& u) const { return WT + ((size_t)tile_e[u.pm] * 2048 + u.pn * 256) * 1024; }
    __device__ __forceinline__ int row_tok(const Unit& u, int r) const { return slot_tok[u.pm * 256 + r]; } };
struct PvPlain { const bf16_t* A; const bf16_t* Bt; int lda, ldb, K;
    __device__ __forceinline__ const bf16_t* a_base(const Unit& u) const { return A + (size_t)u.pm * 256 * lda; }
    __device__ __forceinline__ const bf16_t* b_base(const Unit& u) const { return Bt + (size_t)u.pn * 256 * ldb; } };
struct PvXS { const bf16_t* XQ; const bf16_t* KM; int lda, ldb, K;
    __device__ __forceinline__ const bf16_t* a_base(const Unit& u) const { return XQ + (size_t)((u.z >> 2) * 2048 + u.pm * 256) * 1024 + (u.z & 3) * 256; }
    __device__ __forceinline__ const bf16_t* b_base(const Unit& u) const { return KM + (size_t)((u.z >> 2) * 256) * 1024 + (u.z & 3) * 256; } };
struct PvXPV { const bf16_t* Pm; const bf16_t* VMT; int lda, ldb, K;
    __device__ __forceinline__ const bf16_t* a_base(const Unit& u) const { return Pm + ((size_t)u.z * 2048 + u.pm * 256) * 256; }
    __device__ __forceinline__ const bf16_t* b_base(const Unit& u) const { return VMT + (size_t)u.z * 65536; } };
struct PvExp { const bf16_t* A; const bf16_t* WT; const int* tile_e; int lda, ldb, K, nrow;
    __device__ __forceinline__ const bf16_t* a_base(const Unit& u) const { return A + (size_t)u.pm * 256 * 1024; }
    __device__ __forceinline__ const bf16_t* b_base(const Unit& u) const { return WT + ((size_t)tile_e[u.pm] * nrow + u.pn * 256) * 1024; } };

constexpr int MLA_KT = 12288, MLA_VT = 8192, MLA_KBUF = 2 * MLA_KT, MLA_VBUF = 2 * MLA_VT, MLA_V0 = 2 * MLA_KBUF;
typedef short v4i16_t __attribute__((ext_vector_type(4)));
__device__ __forceinline__ s16x4 lds_tr16(const LAS unsigned char* p) { return __builtin_bit_cast(s16x4, __builtin_amdgcn_ds_read_tr16_b64_v4i16((LAS v4i16_t*)p)); }
__device__ __forceinline__ void mla_unit(const Params& p, LAS unsigned char* lds, int unit, int tid) {
    const int lane = tid & 63, wid = __builtin_amdgcn_readfirstlane(tid >> 6), r32 = lane & 31, hi = lane >> 5;
    const int qb = unit & 7, h = (unit >> 3) & 7, b = unit >> 6;
    const bf16_t* Qg = (const bf16_t*)(p.ws + WS_Q); const bf16_t* Kg = (const bf16_t*)(p.ws + WS_KB); const bf16_t* Vg = (const bf16_t*)(p.ws + WS_VB);
    const size_t rowb = (size_t)b * SEQ;
    const int q0 = qb * 256 + wid * 32;
    int ksrc[3], kdst[3], vsrc[2], vdst[2];
    const bf16_t* Kbh = Kg + rowb * 768 + h * 96; const bf16_t* Vbh = Vg + rowb * 512 + h * 64;
#pragma unroll
    for (int i = 0; i < 3; ++i) { const int pk = tid + 512 * i, r = pk / 12, c = pk % 12; ksrc[i] = r * 768 + c * 8; kdst[i] = (r >> 6) * MLA_KT + c * 1024 + (r & 63) * 16; }
#pragma unroll
    for (int i = 0; i < 2; ++i) { const int pk = tid + 512 * i, r = pk >> 3, c = pk & 7; vsrc[i] = r * 512 + c * 8; vdst[i] = MLA_V0 + (r >> 6) * MLA_VT + (c >> 2) * 4096 + (r & 63) * 64 + (c & 3) * 16; }
    const int kfo = hi * 1024 + r32 * 16;
    const int vfo = MLA_V0 + ((lane >> 4) & 1) * 32 + (lane & 3) * 8 + (4 * hi + ((lane & 15) >> 2)) * 64;
    bf16x8 qf[6];
#pragma unroll
    for (int s = 0; s < 6; ++s) qf[s] = *(const bf16x8*)(Qg + (rowb + q0 + r32) * 768 + h * 96 + 16 * s + 8 * hi);
    const int ns_blk = 2 * qb + 2, nt_me = 4 * qb + (wid >> 1) + 1;
    u32x4 sk[3], sv[2];
#pragma unroll
    for (int i = 0; i < 3; ++i) sk[i] = *(const u32x4*)(Kbh + ksrc[i]);
#pragma unroll
    for (int i = 0; i < 2; ++i) sv[i] = *(const u32x4*)(Vbh + vsrc[i]);
#pragma unroll
    for (int i = 0; i < 3; ++i) *(LAS u32x4*)(lds + kdst[i]) = sk[i];
#pragma unroll
    for (int i = 0; i < 2; ++i) *(LAS u32x4*)(lds + vdst[i]) = sv[i];
    __syncthreads();
    float mrun = -1.0e30f, lrun = 0.f; f32x16 o0 = {}, o1 = {};
    for (int st = 0; st < ns_blk; ++st) {
        const bool pre = (st + 1 < ns_blk);
        if (pre) { const bf16_t* kn = Kbh + (size_t)(st + 1) * 128 * 768; const bf16_t* vn = Vbh + (size_t)(st + 1) * 128 * 512;
#pragma unroll
            for (int i = 0; i < 3; ++i) sk[i] = *(const u32x4*)(kn + ksrc[i]);
#pragma unroll
            for (int i = 0; i < 2; ++i) sv[i] = *(const u32x4*)(vn + vsrc[i]); }
#pragma unroll
        for (int tt = 0; tt < 2; ++tt) {
          const int t = 2 * st + tt;
          if (t < nt_me) {
            const LAS unsigned char* kb_ = lds + (st & 1) * MLA_KBUF + tt * MLA_KT + kfo; const LAS unsigned char* vb_ = lds + (st & 1) * MLA_VBUF + tt * MLA_VT + vfo;
            f32x16 sc[2]; bf16x8 kf[2][6]; s16x4 vlo[8], vhi[8];
#pragma unroll
            for (int kb = 0; kb < 2; ++kb)
#pragma unroll
                for (int s = 0; s < 6; ++s) kf[kb][s] = *(const LAS bf16x8*)(kb_ + s * 2048 + kb * 512);
            __builtin_amdgcn_sched_barrier(0);
#pragma unroll
            for (int kb = 0; kb < 2; ++kb) { f32x16 a = {};
#pragma unroll
                for (int s = 0; s < 6; ++s) a = __builtin_amdgcn_mfma_f32_32x32x16_bf16(kf[kb][s], qf[s], a, 0, 0, 0);
                sc[kb] = a; }
            __builtin_amdgcn_sched_barrier(0);
#pragma unroll
            for (int i = 0; i < 8; ++i) { const LAS unsigned char* vr = vb_ + (i & 1) * 4096 + (i >> 2) * 2048 + ((i >> 1) & 1) * 1024; vlo[i] = lds_tr16(vr); vhi[i] = lds_tr16(vr + 512); }
            __builtin_amdgcn_sched_barrier(0);
            float mx = fmaxf(fmaxf(sc[0][0], sc[0][1]), sc[1][0]);
#pragma unroll
            for (int r = 2; r < 16; r += 2) mx = fmaxf(fmaxf(mx, sc[0][r]), sc[0][r + 1]);
#pragma unroll
            for (int r = 1; r < 15; r += 2) mx = fmaxf(fmaxf(mx, sc[1][r]), sc[1][r + 1]);
            mx = fmaxf(mx, sc[1][15]);
            mx = fmaxf(mx, __shfl_xor(mx, 32));
            if (__any(mx > mrun + 8.0f)) { const float mnew = fmaxf(mrun, mx), alpha = fast_exp2(mrun - mnew); mrun = mnew; lrun *= alpha;
#pragma unroll
                for (int r = 0; r < 16; ++r) { o0[r] *= alpha; o1[r] *= alpha; } }
            float ls = 0.f; unsigned pw[2][8];
#pragma unroll
            for (int kb = 0; kb < 2; ++kb)
#pragma unroll
                for (int r = 0; r < 16; r += 2) { const float e0 = fast_exp2(sc[kb][r] - mrun), e1 = fast_exp2(sc[kb][r + 1] - mrun); pw[kb][r >> 1] = pk2(e0, e1); ls += e0 + e1; }
            lrun += ls;
#pragma unroll
            for (int kb = 0; kb < 2; ++kb)
#pragma unroll
                for (int s2 = 0; s2 < 2; ++s2) {
                    const bf16x8 pf = __builtin_bit_cast(bf16x8, (u32x4){pw[kb][4 * s2 + 0], pw[kb][4 * s2 + 1], pw[kb][4 * s2 + 2], pw[kb][4 * s2 + 3]});
#pragma unroll
                    for (int db = 0; db < 2; ++db) { const int i = 4 * kb + 2 * s2 + db;
                        const bf16x8 vf = (bf16x8){vlo[i][0], vlo[i][1], vlo[i][2], vlo[i][3], vhi[i][0], vhi[i][1], vhi[i][2], vhi[i][3]};
                        if (db == 0) o0 = __builtin_amdgcn_mfma_f32_32x32x16_bf16(vf, pf, o0, 0, 0, 0); else o1 = __builtin_amdgcn_mfma_f32_32x32x16_bf16(vf, pf, o1, 0, 0, 0); } }
          }
        }
        if (pre) { LAS unsigned char* nk = lds + ((st + 1) & 1) * MLA_KBUF; LAS unsigned char* nv = lds + ((st + 1) & 1) * MLA_VBUF;
#pragma unroll
            for (int i = 0; i < 3; ++i) *(LAS u32x4*)(nk + kdst[i]) = sk[i];
#pragma unroll
            for (int i = 0; i < 2; ++i) *(LAS u32x4*)(nv + vdst[i]) = sv[i]; }
        __syncthreads();
    }
    lrun += __shfl_xor(lrun, 32);
    const float inv = 1.0f / lrun;
    bf16_t* yo = (bf16_t*)(p.ws + WS_YCAT) + (rowb + q0 + r32) * 1024 + h * 64;
#pragma unroll
    for (int g = 0; g < 4; ++g) { u32x2 w0, w1; w0.x = pk2(o0[4 * g] * inv, o0[4 * g + 1] * inv); w0.y = pk2(o0[4 * g + 2] * inv, o0[4 * g + 3] * inv);
        w1.x = pk2(o1[4 * g] * inv, o1[4 * g + 1] * inv); w1.y = pk2(o1[4 * g + 2] * inv, o1[4 * g + 3] * inv);
        *(u32x2*)(yo + 8 * g + 4 * hi) = w0; *(u32x2*)(yo + 32 + 8 * g + 4 * hi) = w1; }
}

constexpr int XA_KB = 32768, XA_BUF = 65536;
__device__ __forceinline__ void xattn_range(const Params& p, LAS unsigned char* lds, int u0, int nu, int tid, unsigned long long* tacc = nullptr) {
    const int lane = tid & 63, wid = __builtin_amdgcn_readfirstlane(tid >> 6), fr = lane & 15, fq = lane >> 4;
    const bf16_t* XQ = (const bf16_t*)(p.ws + WS_XQ); const bf16_t* KM = (const bf16_t*)(p.ws + WS_KM); const bf16_t* VMT = (const bf16_t*)(p.ws + WS_VMT); bf16_t* OX = (bf16_t*)(p.ws + WS_OX);
    const int kpos0 = 8 * wid + (lane >> 5);
    const int vrow = 32 * wid + (lane >> 3), vslot = (lane & 7) ^ (vrow & 7);
    const int vsrc = vrow * 256 + vslot * 8;
    const int nstep = nu * 4;
#define XA_DMA(step) do { const int un_ = u0 + ((step) >> 2), t_ = (step) & 3, z_ = un_ >> 4; \
        const bf16_t* kp_ = KM + ((size_t)((z_ >> 2) * 256 + 64 * t_)) * 1024 + (z_ & 3) * 256; const bf16_t* vp_ = VMT + (size_t)z_ * 65536 + 64 * t_ + vsrc; \
        LAS unsigned char* nb_ = lds + ((step) & 1) * XA_BUF + wid * 4096; \
        _Pragma("unroll") for (int i_ = 0; i_ < 4; ++i_) { const int pos_ = kpos0 + 2 * i_; const int key_ = (pos_ & 32) + 8 * ((pos_ >> 2) & 3) + 4 * ((pos_ >> 4) & 1) + (pos_ & 3); \
            __builtin_amdgcn_global_load_lds((const unsigned*)(kp_ + key_ * 1024 + (((lane & 31) ^ (pos_ & 15)) << 3)), (LAS unsigned*)(nb_ + i_ * 1024), 16, 0, 0); \
            __builtin_amdgcn_global_load_lds((const unsigned*)(vp_ + i_ * 8 * 256), (LAS unsigned*)(nb_ + XA_KB + i_ * 1024), 16, 0, 0); } } while (0)
    XA_DMA(0);
    bf16x8 qf[8]; f32x4 oacc[16]; float mrun = -1.0e30f, lrun = 0.f;
    { const int z = u0 >> 4; const size_t qrow = (size_t)(z >> 2) * 2048 + (u0 & 15) * 128 + wid * 16 + fr;
#pragma unroll
      for (int ks = 0; ks < 8; ++ks) qf[ks] = *(const bf16x8*)(XQ + qrow * 1024 + (z & 3) * 256 + 32 * ks + 8 * fq); }
    __syncthreads();
    for (int step = 0; step < nstep; ++step) {
        const int t = step & 3, un = u0 + (step >> 2), z = un >> 4, b = z >> 2, h = z & 3;
        const size_t qrow = (size_t)b * 2048 + (un & 15) * 128 + wid * 16 + fr;
        if (t == 0) {
#pragma unroll
            for (int db = 0; db < 16; ++db) oacc[db] = (f32x4){0.f, 0.f, 0.f, 0.f};
            mrun = -1.0e30f; lrun = 0.f; }
        if (step + 1 < nstep) XA_DMA(step + 1);
        { const LAS unsigned char* kb = lds + (step & 1) * XA_BUF; const LAS unsigned char* vb = kb + XA_KB;
          f32x4 sacc[4]; bf16x8 kfa[8], kfb[8];
#define XA_LDK(dst, kvb) do { _Pragma("unroll") for (int ks = 0; ks < 8; ++ks) dst[ks] = *(const LAS bf16x8*)(kb + (16 * (kvb) + fr) * 512 + (((4 * ks + fq) ^ fr) << 4)); } while (0)
#define XA_QK(src, kvb) do { f32x4 a_ = {0.f, 0.f, 0.f, 0.f}; _Pragma("unroll") for (int ks = 0; ks < 8; ++ks) a_ = __builtin_amdgcn_mfma_f32_16x16x32_bf16(src[ks], qf[ks], a_, 0, 0, 0); sacc[kvb] = a_; } while (0)
          XA_LDK(kfa, 0); XA_LDK(kfb, 1); __builtin_amdgcn_sched_barrier(0);
          XA_QK(kfa, 0); XA_LDK(kfa, 2); __builtin_amdgcn_sched_barrier(0);
          XA_QK(kfb, 1); XA_LDK(kfb, 3); __builtin_amdgcn_sched_barrier(0);
          XA_QK(kfa, 2); __builtin_amdgcn_sched_barrier(0);
          XA_QK(kfb, 3);
#undef XA_LDK
#undef XA_QK
          float mx = fmaxf(fmaxf(sacc[0][0], sacc[0][1]), fmaxf(sacc[0][2], sacc[0][3]));
#pragma unroll
          for (int kvb = 1; kvb < 4; ++kvb) { mx = fmaxf(fmaxf(mx, sacc[kvb][0]), sacc[kvb][1]); mx = fmaxf(fmaxf(mx, sacc[kvb][2]), sacc[kvb][3]); }
          mx = fmaxf(mx, __shfl_xor(mx, 16)); mx = fmaxf(mx, __shfl_xor(mx, 32));
          if (__any(mx > mrun + 8.0f)) { const float mnew = fmaxf(mrun, mx), alpha = fast_exp2(mrun - mnew); mrun = mnew; lrun *= alpha;
#pragma unroll
              for (int db = 0; db < 16; ++db) oacc[db] = oacc[db] * alpha; }
          float ls = 0.f; u32x4 pw[2];
#pragma unroll
          for (int s2 = 0; s2 < 2; ++s2) { unsigned w[4];
#pragma unroll
              for (int hh = 0; hh < 2; ++hh)
#pragma unroll
                  for (int jj = 0; jj < 2; ++jj) { const float e0 = fast_exp2(sacc[2 * s2 + hh][2 * jj] - mrun), e1 = fast_exp2(sacc[2 * s2 + hh][2 * jj + 1] - mrun); w[2 * hh + jj] = pk2(e0, e1); ls += e0 + e1; }
              pw[s2] = (u32x4){w[0], w[1], w[2], w[3]}; }
          lrun += ls;
          { bf16x8 vfa[8], vfb[8];
#define XA_LDV(dst, s2, d0) do { _Pragma("unroll") for (int i = 0; i < 8; ++i) dst[i] = *(const LAS bf16x8*)(vb + (16 * ((d0) + i) + fr) * 128 + (((4 * (s2) + fq) ^ (fr & 7)) << 4)); } while (0)
#define XA_PV(src, s2, d0) do { const bf16x8 pf_ = __builtin_bit_cast(bf16x8, pw[s2]); _Pragma("unroll") for (int i = 0; i < 8; ++i) oacc[(d0) + i] = __builtin_amdgcn_mfma_f32_16x16x32_bf16(src[i], pf_, oacc[(d0) + i], 0, 0, 0); } while (0)
            XA_LDV(vfa, 0, 0); XA_LDV(vfb, 0, 8); __builtin_amdgcn_sched_barrier(0);
            XA_PV(vfa, 0, 0); XA_LDV(vfa, 1, 0); __builtin_amdgcn_sched_barrier(0);
            XA_PV(vfb, 0, 8); XA_LDV(vfb, 1, 8); __builtin_amdgcn_sched_barrier(0);
            XA_PV(vfa, 1, 0); __builtin_amdgcn_sched_barrier(0);
            XA_PV(vfb, 1, 8);
#undef XA_LDV
#undef XA_PV
          } }
        if (t == 3) { float lt = lrun; lt += __shfl_xor(lt, 16); lt += __shfl_xor(lt, 32); const float inv = 1.0f / lt;
            int t3 = threadIdx.x; asm volatile("" : "+v"(t3));
            const size_t qrow3 = (size_t)b * 2048 + (un & 15) * 128 + (t3 >> 6) * 16 + (t3 & 15);
            bf16_t* orow = OX + qrow3 * 1024 + h * 256 + 4 * ((t3 >> 4) & 3);
#pragma unroll
            for (int db = 0; db < 16; ++db) { const f32x4 v = oacc[db] * inv; u32x2 w; w.x = pk2(v[0], v[1]); w.y = pk2(v[2], v[3]); *(u32x2*)(orow + 16 * db) = w; }
            if (step + 1 < nstep) { const int un2 = un + 1, z2 = un2 >> 4; const size_t qr2 = (size_t)(z2 >> 2) * 2048 + (un2 & 15) * 128 + wid * 16 + fr;
#pragma unroll
                for (int ks = 0; ks < 8; ++ks) qf[ks] = *(const bf16x8*)(XQ + qr2 * 1024 + (z2 & 3) * 256 + 32 * ks + 8 * fq); } }
#if PROBE_XA
        const unsigned long long tb0_ = __builtin_amdgcn_s_memrealtime();
#endif
        __syncthreads();
#if PROBE_XA
        if (tacc) *tacc += __builtin_amdgcn_s_memrealtime() - tb0_;
#endif
    }
#undef XA_DMA
}

__device__ __forceinline__ void conv_unit(const Params& p, LAS unsigned char* lds, int unit, int tid) {
    const int lane = tid & 63, wid = tid >> 6, c = tid;
    const int b = unit >> 5, t0 = (unit & 31) * 64;
    LAS float* cl = (LAS float*)lds;
    LAS float* wl = (LAS float*)(lds + 65536);
    const __amdgpu_buffer_rsrc_t wr_ = __builtin_amdgcn_make_buffer_rsrc((void*)p.w_dw, 0, 31 * 512 * 4, 0x00020000);
#pragma unroll
    for (int j = 0; j < 31; ++j) wl[j * 512 + c] = __uint_as_float(__builtin_amdgcn_raw_buffer_load_b32(wr_, c * 4, j * 2048, 0));
    const __amdgpu_buffer_rsrc_t zr = __builtin_amdgcn_make_buffer_rsrc((void*)(p.ws + WS_Z), 0, (int)((size_t)NTOK * 512 * 2), 0x00020000);
    float z[94];
#define CV_BATCH(i0, n) do { unsigned short raw_[n]; \
        _Pragma("unroll") for (int i_ = 0; i_ < (n); ++i_) { const int t_ = t0 - 30 + (i0) + i_; const int tc_ = t_ < 0 ? 0 : t_; raw_[i_] = __builtin_amdgcn_raw_buffer_load_b16(zr, c * 2, (b * SEQ + tc_) * 1024, 0); } \
        __builtin_amdgcn_sched_barrier(0); \
        _Pragma("unroll") for (int i_ = 0; i_ < (n); ++i_) { const int t_ = t0 - 30 + (i0) + i_; z[(i0) + i_] = t_ < 0 ? 0.f : bf2f(raw_[i_]); } \
        __builtin_amdgcn_sched_barrier(0); } while (0)
    CV_BATCH(0, 32); CV_BATCH(32, 32); CV_BATCH(64, 30);
#undef CV_BATCH
    const float bias = p.b_dw[c];
    const f32x4 g0 = *(const f32x4*)(p.g_cln + lane * 8), g1 = *(const f32x4*)(p.g_cln + lane * 8 + 4), b0 = *(const f32x4*)(p.b_cln + lane * 8), b1 = *(const f32x4*)(p.b_cln + lane * 8 + 4);
#pragma unroll
    for (int ps = 0; ps < 2; ++ps) {
        float acc[32];
#pragma unroll
        for (int o = 0; o < 32; ++o) acc[o] = bias;
#pragma unroll
        for (int j = 0; j < 31; ++j) { const float wj = wl[j * 512 + c];
#pragma unroll
            for (int o = 0; o < 32; ++o) acc[o] += wj * z[32 * ps + o + j]; }
#pragma unroll
        for (int o = 0; o < 32; ++o) cl[o * 512 + c] = acc[o];
        __syncthreads();
#pragma unroll
        for (int oo = 0; oo < 4; ++oo) { const int o = wid * 4 + oo; const LAS float* r = cl + o * 512 + lane * 8;
            const f32x4 v0 = *(const LAS f32x4*)r, v1 = *(const LAS f32x4*)(r + 4);
            float s = (v0[0] + v0[1]) + (v0[2] + v0[3]) + (v1[0] + v1[1]) + (v1[2] + v1[3]); s = wave_sum(s); const float mu = s * (1.0f / 512.0f);
            const f32x4 d0 = v0 - mu, d1 = v1 - mu; float q = (d0[0] * d0[0] + d0[1] * d0[1]) + (d0[2] * d0[2] + d0[3] * d0[3]) + (d1[0] * d1[0] + d1[1] * d1[1]) + (d1[2] * d1[2] + d1[3] * d1[3]);
            q = wave_sum(q); const float rstd = 1.0f / sqrtf(q * (1.0f / 512.0f) + EPS);
            float y[8];
#pragma unroll
            for (int j = 0; j < 4; ++j) { const float a0 = d0[j] * rstd * g0[j] + b0[j], a1 = d1[j] * rstd * g1[j] + b1[j]; y[j] = a0 * sigmoidf_(a0); y[4 + j] = a1 * sigmoidf_(a1); }
            u32x4 wv; wv.x = pk2(y[0], y[1]); wv.y = pk2(y[2], y[3]); wv.z = pk2(y[4], y[5]); wv.w = pk2(y[6], y[7]);
            *(u32x4*)((bf16_t*)(p.ws + WS_YCAT) + ((size_t)b * SEQ + t0 + 32 * ps + o) * 1024 + 512 + lane * 8) = wv; }
        __syncthreads();
    }
}

__device__ __forceinline__ void router1_unit(const Params& p, LAS unsigned char* lds, int unit, int tid) {
    const int lane = tid & 63, wid = tid >> 6, r = lane & 15, q = lane >> 4;
    LAS float* lg = (LAS float*)lds + wid * 512;
    LAS int* hist = (LAS int*)(lds + 16384);
    const bf16_t* WH = (const bf16_t*)(p.ws + WS_WR); const bf16_t* WL = WH + 32768;
    if (tid < 32) hist[tid] = 0;
    __syncthreads();
    const int tok0 = unit * RT_TOK + wid * 16;
    const bf16_t* xr = (const bf16_t*)(p.ws + WS_X2B) + (size_t)(tok0 + r) * 1024 + 8 * q;
    f32x4 acc0 = {0.f, 0.f, 0.f, 0.f}, acc1 = {0.f, 0.f, 0.f, 0.f}; float ssq = 0.f;
#pragma unroll 8
    for (int ks = 0; ks < 32; ++ks) {
        const u32x4 xw = *(const u32x4*)(xr + 32 * ks);
        { const float a0 = __uint_as_float(xw.x << 16), a1 = __uint_as_float(xw.x & 0xffff0000u), a2 = __uint_as_float(xw.y << 16), a3 = __uint_as_float(xw.y & 0xffff0000u);
          const float a4 = __uint_as_float(xw.z << 16), a5 = __uint_as_float(xw.z & 0xffff0000u), a6 = __uint_as_float(xw.w << 16), a7 = __uint_as_float(xw.w & 0xffff0000u);
          ssq += (a0 * a0 + a1 * a1) + (a2 * a2 + a3 * a3) + (a4 * a4 + a5 * a5) + (a6 * a6 + a7 * a7); }
        const bf16x8 ah = __builtin_bit_cast(bf16x8, xw);
        const bf16x8 bh0 = *(const bf16x8*)(WH + (size_t)r * 1024 + 32 * ks + 8 * q), bh1 = *(const bf16x8*)(WH + (size_t)(16 + r) * 1024 + 32 * ks + 8 * q);
        const bf16x8 bl0 = *(const bf16x8*)(WL + (size_t)r * 1024 + 32 * ks + 8 * q), bl1 = *(const bf16x8*)(WL + (size_t)(16 + r) * 1024 + 32 * ks + 8 * q);
        acc0 = __builtin_amdgcn_mfma_f32_16x16x32_bf16(ah, bh0, acc0, 0, 0, 0); acc1 = __builtin_amdgcn_mfma_f32_16x16x32_bf16(ah, bh1, acc1, 0, 0, 0);
        acc0 = __builtin_amdgcn_mfma_f32_16x16x32_bf16(ah, bl0, acc0, 0, 0, 0); acc1 = __builtin_amdgcn_mfma_f32_16x16x32_bf16(ah, bl1, acc1, 0, 0, 0);
    }
    ssq += __shfl_xor(ssq, 16); ssq += __shfl_xor(ssq, 32);
    const float rstd_r = 1.0f / sqrtf(ssq * (1.0f / 1024.0f) + EPS);
    if (lane < 16) ((float*)(p.ws + WS_RSTD_X2))[tok0 + lane] = rstd_r;
    const float be0 = p.b_router[r], be1 = p.b_router[16 + r];
#pragma unroll
    for (int j = 0; j < 4; ++j) { const float rs = __shfl(rstd_r, 4 * q + j); lg[(4 * q + j) * 32 + r] = acc0[j] * rs + be0; lg[(4 * q + j) * 32 + 16 + r] = acc1[j] * rs + be1; }
    asm volatile("s_waitcnt lgkmcnt(0)" ::: "memory");
    if (lane < 16) { const int tk = tok0 + lane; unsigned used = 0u; float tv[4]; int ti[4];
#pragma unroll
        for (int k = 0; k < 4; ++k) { float best = -3.0e38f; int bi = 0;
            for (int j = 0; j < 32; ++j) { const float v = lg[lane * 32 + j]; if (!((used >> j) & 1u) && v > best) { best = v; bi = j; } }
            used |= 1u << bi; tv[k] = best; ti[k] = bi; }
        const float e1 = __expf(tv[1] - tv[0]), e2 = __expf(tv[2] - tv[0]), e3 = __expf(tv[3] - tv[0]); const float inv = 1.0f / (1.0f + e1 + e2 + e3);
        int* oi = (int*)(p.ws + WS_TOPI) + (size_t)tk * 4; float* og = (float*)(p.ws + WS_TOPG) + (size_t)tk * 4;
        oi[0] = ti[0]; oi[1] = ti[1]; oi[2] = ti[2]; oi[3] = ti[3]; og[0] = inv; og[1] = e1 * inv; og[2] = e2 * inv; og[3] = e3 * inv;
#pragma unroll
        for (int k = 0; k < 4; ++k) atomicAdd((int*)&hist[ti[k]], 1); }
    __syncthreads();
    if (tid < 32) ((int*)(p.ws + WS_HIST))[unit * 32 + tid] = hist[tid];
    __syncthreads();
}
__device__ __forceinline__ void router2_unit(const Params& p, LAS unsigned char* lds, int unit, int tid) {
    const int lane = tid & 63, wid = tid >> 6;
    LAS int* cnt = (LAS int*)lds;
    LAS int* base = cnt + 32;
    LAS int* pst = cnt + 64;
    LAS int* part = cnt + 128;
    LAS int* wcnt = cnt + 128 + 1024;
    const int* H = (const int*)(p.ws + WS_HIST);
    { const int e = tid & 31, pt = tid >> 5; int tot = 0, bs = 0;
#pragma unroll 4
      for (int j = 0; j < 16; ++j) { const int bq = pt * 16 + j; const int v = H[bq * 32 + e]; tot += v; bs += (bq < unit) ? v : 0; }
      part[pt * 64 + e] = tot; part[pt * 64 + 32 + e] = bs; }
    const int my_e = ((const int*)(p.ws + WS_TOPI))[(size_t)unit * RT_TOK * 4 + tid];
    int my_rank = 0;
#pragma unroll 4
    for (int e = 0; e < 32; ++e) { const unsigned long long m = __ballot(my_e == e); if (my_e == e) my_rank = __popcll(m & ((1ull << lane) - 1ull)); if (lane == 0) wcnt[wid * 32 + e] = __popcll(m); }
    __syncthreads();
    if (tid < 32) { int tot = 0, bs = 0;
#pragma unroll
        for (int pt = 0; pt < 16; ++pt) { tot += part[pt * 64 + tid]; bs += part[pt * 64 + 32 + tid]; }
        cnt[tid] = tot; base[tid] = bs; }
    __syncthreads();
    if (tid == 0) { int sacc = 0; for (int e = 0; e < 32; ++e) { pst[e] = sacc; sacc += (cnt[e] + 255) & ~255; } pst[32] = sacc; }
    __syncthreads();
    { int woff = 0;
#pragma unroll
      for (int w = 0; w < 8; ++w) woff += (w < wid) ? wcnt[w * 32 + my_e] : 0;
      const int d = pst[my_e] + base[my_e] + woff + my_rank; const int tok = unit * RT_TOK + (tid >> 2);
      ((int*)(p.ws + WS_SLOT_TOK))[d] = tok; ((float*)(p.ws + WS_SLOT_GATE))[d] = ((const float*)(p.ws + WS_TOPG))[(size_t)unit * RT_TOK * 4 + tid];
      ((int*)(p.ws + WS_INV))[(size_t)unit * RT_TOK * 4 + tid] = d; ((float*)(p.ws + WS_SLOT_RS))[d] = ((const float*)(p.ws + WS_RSTD_X2))[tok]; }
    if (unit < 32) { const int e = unit, s0 = pst[e] + cnt[e], s1 = pst[e + 1];
        for (int s = s0 + tid; s < s1; s += 512) { ((int*)(p.ws + WS_SLOT_TOK))[s] = 0; ((float*)(p.ws + WS_SLOT_GATE))[s] = 0.f; ((float*)(p.ws + WS_SLOT_RS))[s] = 0.f; } }
    if (unit == 32) { int* te = (int*)(p.ws + WS_TILE_E); const int nt = pst[32] >> 8;
        for (int t = tid; t < NTILE_MAX; t += 512) { int e = 31; for (int k = 31; k >= 0; --k) if (t * 256 < pst[k + 1]) e = k; te[t] = e; }
        if (tid == 0) te[NTILE_MAX] = nt; }
    __syncthreads();
}

struct FinalRows { u32x2 x[4]; u32x2 y[4][4]; };
__device__ __forceinline__ void final_load(const Params& p, int tok, int i0, int i1, int i2, int i3, FinalRows& r, int lane) {
    const u32x2* x2 = (const u32x2*)((const bf16_t*)(p.ws + WS_X2B) + (size_t)tok * 1024); const bf16_t* YB = (const bf16_t*)(p.ws + WS_YB);
    const u32x2* y0 = (const u32x2*)(YB + (size_t)i0 * 1024); const u32x2* y1 = (const u32x2*)(YB + (size_t)i1 * 1024); const u32x2* y2 = (const u32x2*)(YB + (size_t)i2 * 1024); const u32x2* y3 = (const u32x2*)(YB + (size_t)i3 * 1024);
#pragma unroll
    for (int j = 0; j < 4; ++j) { r.x[j] = x2[lane + 64 * j]; r.y[0][j] = y0[lane + 64 * j]; r.y[1][j] = y1[lane + 64 * j]; r.y[2][j] = y2[lane + 64 * j]; r.y[3][j] = y3[lane + 64 * j]; }
}
__device__ __forceinline__ void final_stage(const Params& p, int gw, int ngw, int lane) {
    if (gw >= NTOK) return;
    const int* INV = (const int*)(p.ws + WS_INV);
    FinalRows cur, nxt; int tok = gw;
    { const int* iv = INV + (size_t)tok * 4; final_load(p, tok, iv[0], iv[1], iv[2], iv[3], cur, lane); }
    int n0 = 0, n1 = 0, n2 = 0, n3 = 0;
    if (tok + ngw < NTOK) { const int* iv = INV + (size_t)(tok + ngw) * 4; n0 = iv[0]; n1 = iv[1]; n2 = iv[2]; n3 = iv[3]; }
    const f32x4 g0 = ((const f32x4*)p.g_final)[lane], g1 = ((const f32x4*)p.g_final)[lane + 64], g2 = ((const f32x4*)p.g_final)[lane + 128], g3 = ((const f32x4*)p.g_final)[lane + 192];
    for (; tok < NTOK; tok += ngw) {
        const int tn = tok + ngw;
        if (tn < NTOK) { final_load(p, tn, n0, n1, n2, n3, nxt, lane);
            if (tn + ngw < NTOK) { const int* iv = INV + (size_t)(tn + ngw) * 4; n0 = iv[0]; n1 = iv[1]; n2 = iv[2]; n3 = iv[3]; } }
        f32x4 v[4];
#pragma unroll
        for (int j = 0; j < 4; ++j) { const u32x2 w = cur.x[j]; v[j][0] = __uint_as_float(w.x << 16); v[j][1] = __uint_as_float(w.x & 0xffff0000u); v[j][2] = __uint_as_float(w.y << 16); v[j][3] = __uint_as_float(w.y & 0xffff0000u); }
#pragma unroll
        for (int k = 0; k < 4; ++k)
#pragma unroll
            for (int j = 0; j < 4; ++j) { const u32x2 w = cur.y[k][j]; v[j][0] += __uint_as_float(w.x << 16); v[j][1] += __uint_as_float(w.x & 0xffff0000u); v[j][2] += __uint_as_float(w.y << 16); v[j][3] += __uint_as_float(w.y & 0xffff0000u); }
        float s = 0.f;
#pragma unroll
        for (int j = 0; j < 4; ++j) s += (v[j][0] * v[j][0] + v[j][1] * v[j][1]) + (v[j][2] * v[j][2] + v[j][3] * v[j][3]);
        s = wave_sum(s); const float rstd = 1.0f / sqrtf(s * (1.0f / 1024.0f) + EPS);
        f32x4* xr = (f32x4*)(p.out + (size_t)tok * 1024);
        xr[lane] = v[0] * rstd * g0; xr[lane + 64] = v[1] * rstd * g1; xr[lane + 128] = v[2] * rstd * g2; xr[lane + 192] = v[3] * rstd * g3;
        cur = nxt;
    }
}

#define XB_TMO      128
#define XB_XCNT(j)  (256  + 64 * (j))
#define XB_XSUB(j)  (1280 + 64 * (j))
#define XB_XGEN(j)  (2304 + 64 * (j))
#define XB_TOP      3328
#define XB_TOPGEN   3392
#define XCD_BAR_WORDS 3456
constexpr int CW_MLAQ = 4096;
#define XB_SPIN_CAP (1u << 18)
__device__ __forceinline__ unsigned xb_ld(unsigned* p)              { return __hip_atomic_load(p, __ATOMIC_RELAXED, __HIP_MEMORY_SCOPE_AGENT); }
__device__ __forceinline__ unsigned xb_add(unsigned* p, unsigned v) { return __hip_atomic_fetch_add(p, v, __ATOMIC_RELAXED, __HIP_MEMORY_SCOPE_AGENT); }
__device__ __forceinline__ unsigned xb_xcc_id() { return (unsigned)__builtin_amdgcn_s_getreg((3 << 11) | 20) & 0xFu; }
#define XB_SPIN(cond, bar) do { unsigned _sp = 0; while (cond) { __builtin_amdgcn_s_sleep(1); \
    if ((++_sp & 255u) == 0u) { if (xb_ld(&(bar)[XB_TMO])) break; if (_sp > XB_SPIN_CAP) { atomicAdd(&(bar)[XB_TMO], 1u); break; } } } } while (0)
struct XcdBarrier { unsigned* bar; unsigned x; volatile LAS unsigned* st; };
__device__ __forceinline__ XcdBarrier xcd_barrier_post(unsigned* bar, volatile LAS unsigned* st) {
    XcdBarrier b; b.bar = bar; b.x = xb_xcc_id(); b.st = st;
    if (threadIdx.x == 0) (void)xb_add(&bar[XB_XCNT(b.x)], 1u);
    return b;
}
__device__ __forceinline__ void xcd_barrier_complete(unsigned* bar, unsigned x, unsigned& nloc, unsigned& nx) {
    const unsigned G = gridDim.x * gridDim.y * gridDim.z;
    unsigned sum, cnt, mine, sp = 0u;
    for (;;) {
        sum = 0u; cnt = 0u; mine = 0u;
#pragma unroll
        for (unsigned j = 0; j < 16; ++j) { const unsigned c = xb_ld(&bar[XB_XCNT(j)]); sum += c; cnt += (c > 0u) ? 1u : 0u; mine = (j == x) ? c : mine; }
        if (sum == G) break;
        __builtin_amdgcn_s_sleep(1);
        if ((++sp & 255u) == 0u) { if (xb_ld(&bar[XB_TMO])) break; if (sp > XB_SPIN_CAP) { atomicAdd(&bar[XB_TMO], 1u); break; } }
    }
    nloc = mine > 0u ? mine : 1u; nx = cnt > 0u ? cnt : 1u;
}
__device__ __forceinline__ void xcd_barrier(const XcdBarrier& b) {
    asm volatile("s_waitcnt vmcnt(0)" ::: "memory");
    __syncthreads();
    if (threadIdx.x == 0) {
        unsigned* bar = b.bar;
        __builtin_amdgcn_s_waitcnt(0);
        unsigned nloc = b.st[0], nx = b.st[1];
        if (nloc == 0u) { xcd_barrier_complete(bar, b.x, nloc, nx); b.st[0] = nloc; b.st[1] = nx; }
        const unsigned old = xb_add(&bar[XB_XSUB(b.x)], 1u);
        const unsigned gen = old / nloc;
        if (old + 1u == (gen + 1u) * nloc) {
            __builtin_amdgcn_fence(__ATOMIC_RELEASE, "agent");
            asm volatile("s_waitcnt vmcnt(0)" ::: "memory");
            const unsigned og = xb_add(&bar[XB_TOP], 1u);
            const unsigned tg = og / nx;
            if (og + 1u == (tg + 1u) * nx) xb_add(&bar[XB_TOPGEN], 1u);
            else XB_SPIN(xb_ld(&bar[XB_TOPGEN]) == tg, bar);
            __builtin_amdgcn_fence(__ATOMIC_ACQUIRE, "agent");
            xb_add(&bar[XB_XGEN(b.x)], 1u);
            asm volatile("s_waitcnt vmcnt(0)" ::: "memory");
        } else {
            XB_SPIN(xb_ld(&bar[XB_XGEN(b.x)]) == gen, bar);
            __builtin_amdgcn_fence(__ATOMIC_ACQUIRE, "agent");
            asm volatile("s_waitcnt vmcnt(0)" ::: "memory");
        }
    }
    __syncthreads();
}

constexpr int EPI_LDS = 131072;
constexpr int LDS_BYTES = 155648;

#ifndef USE_CG_SYNC
#define USE_CG_SYNC 0
#endif
#if USE_CG_SYNC
#define GRID_SYNC_() grid.sync()
#else
#define GRID_SYNC_() xcd_barrier(xbar)
#endif
#if PROBE_MASK || PROBE_EPI || PROBE_XA || PROBE_SUB
#define GRID_SYNC() do { GRID_SYNC_(); const unsigned long long tn_ = __builtin_amdgcn_s_memrealtime(); if ((PROBE_MASK >> ph_) & 1) tacc_ += tn_ - tprev_; tprev_ = tn_; ++ph_; } while (0)
#else
#define GRID_SYNC() GRID_SYNC_()
#endif
constexpr int XB_LDS = 155520;

__device__ __forceinline__ void mla_order(int vb, int r, int& unit) {
    const int bh = vb >> 1, s = vb & 1; const int qb = (r == 0) ? s : (r == 1) ? 7 - s : (r == 2) ? 3 - s : 4 + s; unit = bh * 8 + qb;
}

#define GAS __attribute__((address_space(1)))
#define FROM_W(f, T, k) p_.f = (T*)(GAS T*)(w_[k])
__device__ __forceinline__ void params_from_words(Params& p_, const unsigned long long (&w_)[29]) {
    FROM_W(x, const float, 0); FROM_W(mem, const float, 1); FROM_W(pos, const int, 2);
    FROM_W(g_mix, const float, 3); FROM_W(w_in, const float, 4); FROM_W(g_q, const float, 5); FROM_W(w_uq, const float, 6); FROM_W(g_kv, const float, 7); FROM_W(w_ukv, const float, 8); FROM_W(w_dw, const float, 9); FROM_W(b_dw, const float, 10);
    FROM_W(g_cln, const float, 11); FROM_W(b_cln, const float, 12); FROM_W(w_out, const float, 13); FROM_W(g_xattn, const float, 14); FROM_W(g_mem, const float, 15); FROM_W(w_xq, const float, 16); FROM_W(w_xkv, const float, 17); FROM_W(w_xo, const float, 18);
    FROM_W(g_ffn, const float, 19); FROM_W(w_router, const float, 20); FROM_W(b_router, const float, 21); FROM_W(w_up, const float, 22); FROM_W(b_up, const float, 23); FROM_W(w_down, const float, 24); FROM_W(b_down, const float, 25); FROM_W(g_final, const float, 26);
    FROM_W(out, float, 27); FROM_W(ws, unsigned char, 28);
}
static_assert(sizeof(Params) == 29 * 8, "Params = 29 pointers");
typedef const __attribute__((address_space(4))) Params* CParams;
#define PHASE_BEGIN() CParams pp_ = (CParams)__builtin_amdgcn_kernarg_segment_ptr(); asm volatile("" : "+s"(pp_)); Params p; { const __attribute__((address_space(4))) unsigned long long* q_ = (const __attribute__((address_space(4))) unsigned long long*)pp_; unsigned long long w_[29]; _Pragma("unroll") for (int k_ = 0; k_ < 29; ++k_) w_[k_] = q_[k_]; params_from_words(p, w_); } unsigned char* ws = p.ws; int tid = threadIdx.x; asm volatile("" : "+v"(tid)); const int lane = tid & 63; (void)lane; (void)ws;

__global__ void __launch_bounds__(512) mega_kernel(Params p_unused) {
    extern __shared__ __attribute__((aligned(16))) unsigned char lds_raw[];
#if USE_CG_SYNC
    cg::grid_group grid = cg::this_grid();
#endif
    LAS unsigned char* lds = (LAS unsigned char*)lds_raw;
    if (threadIdx.x < 2) ((volatile LAS unsigned*)(lds + XB_LDS))[threadIdx.x] = 0u;
    __syncthreads();
    const XcdBarrier xbar = xcd_barrier_post((unsigned*)(((CParams)__builtin_amdgcn_kernarg_segment_ptr())->ws + WS_CTL), (volatile LAS unsigned*)(lds + XB_LDS)); (void)xbar;
    const int G = gridDim.x, bx = blockIdx.x;
    const int vb = (G % 8 == 0) ? (bx % 8) * (G / 8) + bx / 8 : bx;

#if PROBE_MASK || PROBE_EPI || PROBE_XA || PROBE_SUB
    unsigned long long tprev_ = __builtin_amdgcn_s_memrealtime(), tacc_ = 0; int ph_ = 0;
#endif
#if PROBE_SUB
    { PHASE_BEGIN(); prep_stage(p, lds, vb, G, tid, tacc_); }
#else
    { unsigned long long dummy_ = 0; PHASE_BEGIN(); prep_stage(p, lds, vb, G, tid, dummy_); }
#endif
    GRID_SYNC();
    { PHASE_BEGIN();
      { PvPlain P{(const bf16_t*)(ws + WS_XB), (const bf16_t*)(ws + WS_WT_IN), 1024, 1024, 1024}; pg8::SchedPlain S; S.o.init(128, 6, G, bx);
        EpiIn E{(bf16_t*)(ws + WS_U), (bf16_t*)(ws + WS_Z), (const float*)(ws + WS_RSTD_X), (float*)(ws + WS_SSQ_Q), (float*)(ws + WS_SSQ_KV), (const float*)(ws + WS_ROPE), (bf16_t*)(ws + WS_KB)};
        pg8::gemm_phase<true, false>(lds, lds + EPI_LDS, P, S, E, tid); }
 }
    GRID_SYNC();
    { PHASE_BEGIN();
      SUB_T0(4);
      { PvPlain P{(const bf16_t*)(ws + WS_U), (const bf16_t*)(ws + WS_WT_UQ), ULD, 256, 256}; pg8::SchedPlain S; S.o.init(128, 3, G, bx);
        EpiQ E{(bf16_t*)(ws + WS_Q), (const float*)(ws + WS_SSQ_Q), (const float*)(ws + WS_ROPE)};
        pg8::gemm_phase<false, false>(lds, lds + EPI_LDS, P, S, E, tid); }
      { PvPlain P{(const bf16_t*)(ws + WS_MEMB), (const bf16_t*)(ws + WS_WT_XKV), 1024, 1024, 1024}; pg8::SchedPlain S; S.o.init(16, 8, G, (bx + 128) % G);
        EpiKVMem E{(bf16_t*)(ws + WS_KM), (bf16_t*)(ws + WS_VMT), (const float*)(ws + WS_RSTD_MEM)};
        pg8::gemm_phase<false, false>(lds, lds + EPI_LDS, P, S, E, tid); }
      SUB_T1(4, tacc_);
      SUB_T0(5);
      { PvPlain P{(const bf16_t*)(ws + WS_U) + 256, (const bf16_t*)(ws + WS_WT_UKV), ULD, 128, 128}; pg8::SchedPlain S; S.o.init(128, 4, G, (bx + 128) % G);
        EpiKV E{(bf16_t*)(ws + WS_KB), (bf16_t*)(ws + WS_VB), (const float*)(ws + WS_SSQ_KV)};
        pg8::gemm_phase<true, false>(lds, lds + EPI_LDS, P, S, E, tid); }
      SUB_T1(5, tacc_);
      SUB_T0(6);
      { int tid2 = threadIdx.x; asm volatile("" : "+v"(tid2)); for (int i = vb; i < 512; i += G) conv_unit(p, lds, i, tid2); }
      SUB_T1(6, tacc_); }
    GRID_SYNC();
    { PHASE_BEGIN();
      if (G == 256) {
        const int xq_ = bx & 7, ix_ = bx >> 3;
        if (ix_ < 30 && (ix_ % 3) == 0) moe_weights_stage(p, lds, xq_ * 10 + ix_ / 3, 80, tid);
        else { unsigned* qh = (unsigned*)(ws + WS_CTL) + CW_MLAQ + 64 * xq_; LAS int* nxt_ = (LAS int*)(lds + 98304);
          for (;;) { if (tid == 0) *nxt_ = (int)atomicAdd(qh, 1u);
            __syncthreads(); const int il = *nxt_; __syncthreads();
            if (il >= 128) break;
            const int bh = xq_ * 16 + (il >> 3), qb = 7 - (il & 7); mla_unit(p, lds, bh * 8 + qb, tid); } } }
      else { if (vb == 0) { } moe_weights_stage(p, lds, vb, G, tid); for (int i = vb; i < 1024; i += G) mla_unit(p, lds, i, tid); } }
    GRID_SYNC();
    { PHASE_BEGIN();
      PvPlain P{(const bf16_t*)(ws + WS_YCAT), (const bf16_t*)(ws + WS_WT_OUT), 1024, 1024, 1024}; pg8::SchedPlain S; S.o.init(128, 4, G, bx);
      EpiResid E{(const bf16_t*)(ws + WS_XB), (bf16_t*)(ws + WS_X1B), (float*)(ws + WS_SSQ_X1)};
      pg8::gemm_phase<true, false>(lds, lds + EPI_LDS, P, S, E, tid); }
    GRID_SYNC();
    { PHASE_BEGIN();
      PvPlain P{(const bf16_t*)(ws + WS_X1B), (const bf16_t*)(ws + WS_WT_XQ), 1024, 1024, 1024}; pg8::SchedPlain S; S.o.init(128, 4, G, bx);
      EpiScale16 E{(bf16_t*)(ws + WS_XQ), 1024, (const float*)(ws + WS_SSQ_X1), C2_X};
      pg8::gemm_phase<true, false>(lds, lds + EPI_LDS, P, S, E, tid); }
    GRID_SYNC();
    { PHASE_BEGIN();
#if PROBE_XA
      if (G == 256) xattn_range(p, lds, vb * 4, 4, tid, &tacc_);
#else
      if (G == 256) xattn_range(p, lds, vb * 4, 4, tid);
#endif
      else { for (int i = vb; i < 1024; i += G) xattn_range(p, lds, i, 1, tid); } }
    GRID_SYNC();
    { PHASE_BEGIN();
      PvPlain P{(const bf16_t*)(ws + WS_OX), (const bf16_t*)(ws + WS_WT_XO), 1024, 1024, 1024}; pg8::SchedPlain S; S.o.init(128, 4, G, bx);
      EpiResid E{(const bf16_t*)(ws + WS_X1B), (bf16_t*)(ws + WS_X2B), nullptr};
      pg8::gemm_phase<true, false>(lds, lds + EPI_LDS, P, S, E, tid); }
    GRID_SYNC();
    { PHASE_BEGIN(); for (int i = vb; i < RT_UNITS; i += G) router1_unit(p, lds, i, tid); }
    GRID_SYNC();
    { PHASE_BEGIN(); for (int i = vb; i < RT_UNITS; i += G) router2_unit(p, lds, i, tid); }
    GRID_SYNC();
    { PHASE_BEGIN(); const int* te = (const int*)(ws + WS_TILE_E); const int nt = te[NTILE_MAX];
      PvUpG P{(const bf16_t*)(ws + WS_X2B), (const bf16_t*)(ws + WS_WT_UP), te, (const int*)(ws + WS_SLOT_TOK), 1024, 1024, 1024}; pg8::SchedPlain S; S.o.init(nt, 8, G, bx);
      EpiSwiglu E{(bf16_t*)(ws + WS_ACT), (const float*)(ws + WS_SLOT_RS), te, p.b_up};
#if PROBE_EPI
      pg8::gemm_phase<true, true>(lds, lds + EPI_LDS, P, S, E, tid, &tacc_);
#else
      pg8::gemm_phase<true, true>(lds, lds + EPI_LDS, P, S, E, tid);
#endif
    }
    GRID_SYNC();
    { PHASE_BEGIN(); const int* te = (const int*)(ws + WS_TILE_E); const int nt = te[NTILE_MAX];
      PvExp P{(const bf16_t*)(ws + WS_ACT), (const bf16_t*)(ws + WS_WT_DOWN), te, 1024, 1024, 1024, 1024}; pg8::SchedPlain S; S.o.init(nt, 4, G, bx);
      EpiDown E{(bf16_t*)(ws + WS_YB), (const float*)(ws + WS_SLOT_GATE), te, p.b_down};
      pg8::gemm_phase<true, false>(lds, lds + EPI_LDS, P, S, E, tid); }
    GRID_SYNC();
    { PHASE_BEGIN(); const int gw = vb * 8 + (tid >> 6), ngw = G * 8; final_stage(p, gw, ngw, lane); }
#if PROBE_MASK || PROBE_EPI || PROBE_XA || PROBE_SUB
    { const unsigned long long tn_ = __builtin_amdgcn_s_memrealtime(); if ((PROBE_MASK >> ph_) & 1) tacc_ += tn_ - tprev_;
      const unsigned long long t0_ = __builtin_amdgcn_s_memrealtime(); while (__builtin_amdgcn_s_memrealtime() - t0_ < 4ull * tacc_) __builtin_amdgcn_s_sleep(8); }
#endif
}

extern "C" void kernel_launch(void* const* d_in, const int* in_sizes, int n_in, void* d_out, int out_size, void* d_ws, size_t ws_size, hipStream_t stream) {
    static int grid = 0;
    if (grid == 0) {
        if (n_in != 27 || ws_size < WS_END) { fprintf(stderr, "kernel_launch: unexpected inputs (n_in %d, ws %zu)\n", n_in, ws_size); grid = -1; return; }
        int dev = 0, cus = 0, per_cu = 0;
        (void)hipGetDevice(&dev); (void)hipDeviceGetAttribute(&cus, hipDeviceAttributeMultiprocessorCount, dev);
        (void)hipFuncSetAttribute((const void*)mega_kernel, hipFuncAttributeMaxDynamicSharedMemorySize, LDS_BYTES);
        (void)hipOccupancyMaxActiveBlocksPerMultiprocessor(&per_cu, (const void*)mega_kernel, 512, LDS_BYTES);
        if (per_cu < 1) { fprintf(stderr, "kernel_launch: occupancy query says %d blocks per CU\n", per_cu); per_cu = 1; }
        if (per_cu > 1) per_cu = 1;
        grid = cus * per_cu;
        (void)hipGetLastError();
    }
    if (grid < 0) return;
    (void)hipMemsetAsync((char*)d_ws + WS_CTL, 0, 32768, stream);
    Params p{};
    p.x = (const float*)d_in[0]; p.mem = (const float*)d_in[1]; p.pos = (const int*)d_in[2];
    p.g_mix = (const float*)d_in[3]; p.w_in = (const float*)d_in[4]; p.g_q = (const float*)d_in[5]; p.w_uq = (const float*)d_in[6]; p.g_kv = (const float*)d_in[7]; p.w_ukv = (const float*)d_in[8];
    p.w_dw = (const float*)d_in[9]; p.b_dw = (const float*)d_in[10]; p.g_cln = (const float*)d_in[11]; p.b_cln = (const float*)d_in[12]; p.w_out = (const float*)d_in[13];
    p.g_xattn = (const float*)d_in[14]; p.g_mem = (const float*)d_in[15]; p.w_xq = (const float*)d_in[16]; p.w_xkv = (const float*)d_in[17]; p.w_xo = (const float*)d_in[18];
    p.g_ffn = (const float*)d_in[19]; p.w_router = (const float*)d_in[20]; p.b_router = (const float*)d_in[21]; p.w_up = (const float*)d_in[22]; p.b_up = (const float*)d_in[23];
    p.w_down = (const float*)d_in[24]; p.b_down = (const float*)d_in[25]; p.g_final = (const float*)d_in[26];
    p.out = (float*)d_out; p.ws = (unsigned char*)d_ws;
    void* args[] = {&p};
    hipError_t e = hipLaunchCooperativeKernel((const void*)mega_kernel, dim3(grid), dim3(512), args, LDS_BYTES, stream);
    if (e != hipSuccess) fprintf(stderr, "cooperative launch failed: %s (grid %d)\n", hipGetErrorString(e), grid);
}
```

```cpp
#include <hip/hip_runtime.h>
#include <stdint.h>
#include <stdio.h>
#include <hip/hip_cooperative_groups.h>
namespace cg = cooperative_groups;

#ifndef PROBE_MASK
#define PROBE_MASK 0
#endif
#ifndef PROBE_EPI
#define PROBE_EPI 0
#endif
#ifndef PROBE_XA
#define PROBE_XA 0
#endif
#ifndef PROBE_SUB
#define PROBE_SUB 0
#endif
#if PROBE_SUB
#define SUB_T0(id) unsigned long long ts_##id = __builtin_amdgcn_s_memrealtime()
#define SUB_T1(id, acc) do { if (PROBE_SUB == id) { __syncthreads(); (acc) += __builtin_amdgcn_s_memrealtime() - ts_##id; } } while (0)
#else
#define SUB_T0(id)
#define SUB_T1(id, acc)
#endif
#define LAS __attribute__((address_space(3)))
typedef unsigned short bf16_t;
typedef short bf16x8 __attribute__((ext_vector_type(8)));
typedef short s16x4 __attribute__((ext_vector_type(4)));
typedef float f32x2 __attribute__((ext_vector_type(2)));
typedef float f32x4 __attribute__((ext_vector_type(4)));
typedef float f32x16 __attribute__((ext_vector_type(16)));
typedef unsigned u32x2 __attribute__((ext_vector_type(2)));
typedef unsigned u32x4 __attribute__((ext_vector_type(4)));

constexpr int BATCH = 16, SEQ = 2048, NTOK = BATCH * SEQ, DM = 1024;
constexpr int INC = 1440, INP = 1536, ULD = 512;
constexpr int HEADS = 8, QKD = 96, VD = 64;
constexpr int CCH = 512, CW = 31;
constexpr int MEML = 256, NMEM = BATCH * MEML;
constexpr int XH = 4, XD = 256;
constexpr int NE = 32, TOPK = 4;
constexpr int NSLOT = NTOK * TOPK + NE * 256;
constexpr int NTILE_MAX = NSLOT / 256;
constexpr float EPS = 1e-5f;
constexpr float C2_MLA = 0.14724444602590306f;
constexpr float C2_X = 0.09016844005556021f;
constexpr int RT_TOK = 128, RT_UNITS = NTOK / RT_TOK;

constexpr size_t MiB = 1u << 20;
constexpr size_t WS_CTL = 0;
constexpr size_t WS_RSTD_X = 1 * MiB;
constexpr size_t WS_RSTD_Q = WS_RSTD_X + 128 * 1024;
constexpr size_t WS_RSTD_KV = WS_RSTD_Q + 128 * 1024;
constexpr size_t WS_RSTD_X1 = WS_RSTD_KV + 128 * 1024;
constexpr size_t WS_RSTD_X2 = WS_RSTD_X1 + 128 * 1024;
constexpr size_t WS_RSTD_MEM = WS_RSTD_X2 + 128 * 1024;
constexpr size_t WS_ROPE = 2 * MiB;
constexpr size_t WS_TOPI = 6 * MiB;
constexpr size_t WS_TOPG = WS_TOPI + 512 * 1024;
constexpr size_t WS_INV = WS_TOPG + 512 * 1024;
constexpr size_t WS_SLOT_TOK = WS_INV + 512 * 1024;
constexpr size_t WS_SLOT_GATE = WS_SLOT_TOK + 1 * MiB;
constexpr size_t WS_SLOT_RS = 15 * MiB + 256 * 1024;
constexpr size_t WS_HIST = WS_SLOT_GATE + 1 * MiB;
constexpr size_t WS_TILE_E = WS_HIST + 64 * 1024;
constexpr size_t WS_SSQ_Q = 10 * MiB;
constexpr size_t WS_SSQ_KV = 10 * MiB + 512 * 1024;
constexpr size_t WS_SSQ_X1 = 11 * MiB;
constexpr size_t WS_SSQ_X2 = 13 * MiB;
constexpr size_t WS_WR = 15 * MiB;
constexpr size_t WS_WT_IN = 16 * MiB;
constexpr size_t WS_WT_UQ = 19 * MiB;
constexpr size_t WS_WT_UKV = WS_WT_UQ + 512 * 1024;
constexpr size_t WS_WT_OUT = 20 * MiB;
constexpr size_t WS_WT_XQ = 22 * MiB;
constexpr size_t WS_WT_XKV = 24 * MiB;
constexpr size_t WS_WT_XO = 28 * MiB;
constexpr size_t WS_WT_UP = 32 * MiB;
constexpr size_t WS_WT_DOWN = 160 * MiB;
constexpr size_t WS_X2B = 224 * MiB;
constexpr size_t WS_XB = WS_X2B;
constexpr size_t WS_ACT = 288 * MiB;
constexpr size_t WS_X2F = 432 * MiB;
constexpr size_t WS_U = 288 * MiB;
constexpr size_t WS_Z = 320 * MiB;
constexpr size_t WS_Q = 384 * MiB;
constexpr size_t WS_KB = 432 * MiB;
constexpr size_t WS_VB = 480 * MiB;
constexpr size_t WS_YCAT = 512 * MiB;
constexpr size_t WS_YB = 560 * MiB;
constexpr size_t WS_XG = WS_YB;
constexpr size_t WS_X1B = 576 * MiB;
constexpr size_t WS_XQ = 640 * MiB;
constexpr size_t WS_P = 704 * MiB;
constexpr size_t WS_OX = 768 * MiB;
constexpr size_t WS_MEMB = 832 * MiB;
constexpr size_t WS_KM = 840 * MiB;
constexpr size_t WS_VMT = 848 * MiB;
constexpr size_t WS_END = 856 * MiB;

struct Params {
    const float* x; const float* mem; const int* pos;
    const float *g_mix, *w_in, *g_q, *w_uq, *g_kv, *w_ukv, *w_dw, *b_dw, *g_cln, *b_cln, *w_out, *g_xattn, *g_mem, *w_xq, *w_xkv, *w_xo, *g_ffn, *w_router, *b_router, *w_up, *b_up, *w_down, *b_down, *g_final;
    float* out; unsigned char* ws;
};

__device__ __forceinline__ float bf2f(bf16_t b) { return __uint_as_float((unsigned)b << 16); }
__device__ __forceinline__ unsigned f2bf(float f) { unsigned u = __float_as_uint(f); return (u + 0x7fffu + ((u >> 16) & 1u)) >> 16; }
typedef __bf16 bf16x2_t __attribute__((ext_vector_type(2)));
__device__ __forceinline__ unsigned pk2(float lo, float hi) { const f32x2 v = {lo, hi}; const bf16x2_t b = __builtin_convertvector(v, bf16x2_t); return __builtin_bit_cast(unsigned, b); }
__device__ __forceinline__ unsigned pk4_fp8(float a, float b, float c, float d) { int w = __builtin_amdgcn_cvt_pk_fp8_f32(a, b, 0, false); w = __builtin_amdgcn_cvt_pk_fp8_f32(c, d, w, true); return (unsigned)w; }
constexpr float W8_SCALE = 32.0f, W8_INV = 1.0f / 32.0f;
__device__ __forceinline__ float shflx(float v, int m, int lane) { return __int_as_float(__builtin_amdgcn_ds_bpermute((lane ^ m) << 2, __float_as_int(v))); }
__device__ __forceinline__ float shfli(float v, int src) { return __int_as_float(__builtin_amdgcn_ds_bpermute(src << 2, __float_as_int(v))); }
__device__ __forceinline__ float wave_sum(float v, int lane) {
#pragma unroll
    for (int o = 1; o < 64; o <<= 1) v += shflx(v, o, lane);
    return v;
}
__device__ __forceinline__ int perm32(int rho) { const int n = rho >> 4, i = rho & 15; return 8 * (i >> 2) + 4 * n + (i & 3); }
__device__ __forceinline__ float fast_exp2(float x) { return __builtin_amdgcn_exp2f(x); }
__device__ __forceinline__ float sigmoidf_(float x) { return 1.0f / (1.0f + __expf(-x)); }

struct TrDesc { const float* W; const float* g; bf16_t* WT; int N, K, mode, k0, n0; };
__device__ __forceinline__ void tr_load(const TrDesc& d, float (&v)[32], int lane) {
    const float* src = d.W + (size_t)(d.k0 + (lane >> 3)) * d.N + d.n0 + 4 * (lane & 7);
#pragma unroll
    for (int i = 0; i < 8; ++i) { const f32x4 t = *(const f32x4*)(src + (size_t)(8 * i) * d.N); v[4 * i] = t[0]; v[4 * i + 1] = t[1]; v[4 * i + 2] = t[2]; v[4 * i + 3] = t[3]; }
}
__device__ __forceinline__ void tr_store(const TrDesc& d, const float (&v)[32], LAS float* scr, int lane) {
#pragma unroll
    for (int i = 0; i < 8; ++i)
#pragma unroll
        for (int e = 0; e < 4; ++e) scr[(8 * i + (lane >> 3)) * 33 + 4 * (lane & 7) + e] = v[4 * i + e];
    asm volatile("s_waitcnt lgkmcnt(0)" ::: "memory");
    const int c = lane & 7;
    f32x4 g0 = {1.f, 1.f, 1.f, 1.f}, g1 = {1.f, 1.f, 1.f, 1.f};
    if (d.g) { g0 = *(const f32x4*)(d.g + d.k0 + 8 * c); g1 = *(const f32x4*)(d.g + d.k0 + 8 * c + 4); }
#pragma unroll
    for (int j = 0; j < 4; ++j) { const int n = (lane >> 3) + 8 * j; const LAS float* sp = scr + (8 * c) * 33 + n;
        u32x4 o; o.x = pk2(sp[0 * 33] * g0[0], sp[1 * 33] * g0[1]); o.y = pk2(sp[2 * 33] * g0[2], sp[3 * 33] * g0[3]); o.z = pk2(sp[4 * 33] * g1[0], sp[5 * 33] * g1[1]); o.w = pk2(sp[6 * 33] * g1[2], sp[7 * 33] * g1[3]);
        const int nn = d.n0 + n; int row = nn; if (d.mode == 1 || d.mode == 4) row = (((nn & 1023) >> 7) << 8) + ((nn >> 10) << 7) + (nn & 127);
        if (d.mode == 2 && nn >= 416) { const int c = (nn - 416) & 511, isg = (nn - 416) >> 9; row = 512 + ((c >> 7) << 8) + (isg << 7) + (c & 127); }
        if (d.mode >= 4) { u32x2 o8; o8.x = pk4_fp8(sp[0 * 33] * g0[0] * W8_SCALE, sp[1 * 33] * g0[1] * W8_SCALE, sp[2 * 33] * g0[2] * W8_SCALE, sp[3 * 33] * g0[3] * W8_SCALE);
            o8.y = pk4_fp8(sp[4 * 33] * g1[0] * W8_SCALE, sp[5 * 33] * g1[1] * W8_SCALE, sp[6 * 33] * g1[2] * W8_SCALE, sp[7 * 33] * g1[3] * W8_SCALE);
            *(u32x2*)((unsigned char*)d.WT + (size_t)row * d.K + d.k0 + 8 * c) = o8; }
        else *(u32x4*)(d.WT + (size_t)row * d.K + d.k0 + 8 * c) = o; }
    asm volatile("s_waitcnt lgkmcnt(0)" ::: "memory");
}
__device__ __forceinline__ void rows_bf16_rstd(const float* X, bf16_t* O, float* rstd, int nrows, int gw, int ngw, int lane) {
    if (gw >= nrows) return;
    f32x4 v[4], vn[4];
#pragma unroll
    for (int j = 0; j < 4; ++j) v[j] = ((const f32x4*)(X + (size_t)gw * 1024))[lane + 64 * j];
    for (int m = gw; m < nrows; m += ngw) {
        const int mn = m + ngw;
        if (mn < nrows) {
#pragma unroll
            for (int j = 0; j < 4; ++j) vn[j] = ((const f32x4*)(X + (size_t)mn * 1024))[lane + 64 * j]; }
        float s = 0.f;
#pragma unroll
        for (int j = 0; j < 4; ++j) s += (v[j].x * v[j].x + v[j].y * v[j].y) + (v[j].z * v[j].z + v[j].w * v[j].w);
        s = wave_sum(s, lane);
        if (lane == 0) rstd[m] = 1.0f / sqrtf(s * (1.0f / 1024.0f) + EPS);
#pragma unroll
        for (int j = 0; j < 4; ++j) { u32x2 w; w.x = pk2(v[j].x, v[j].y); w.y = pk2(v[j].z, v[j].w); ((u32x2*)(O + (size_t)m * 1024))[lane + 64 * j] = w; }
#pragma unroll
        for (int j = 0; j < 4; ++j) v[j] = vn[j];
    }
}
__device__ __forceinline__ void sincos_acc(double a, float& s, float& c) {
    const double TWO_PI = 6.283185307179586476925;
    const double n = rint(a * (1.0 / TWO_PI)); const double r = a - n * TWO_PI;
    const double h = 0.5 * r, h2 = h * h;
    const double sh = h * (1.0 + h2 * (-1.0 / 6.0 + h2 * (1.0 / 120.0 + h2 * (-1.0 / 5040.0 + h2 * (1.0 / 362880.0 + h2 * (-1.0 / 39916800.0 + h2 * (1.0 / 6227020800.0 + h2 * (-1.0 / 1307674368000.0 + h2 * (1.0 / 355687428096000.0)))))))));
    const double ch = 1.0 + h2 * (-0.5 + h2 * (1.0 / 24.0 + h2 * (-1.0 / 720.0 + h2 * (1.0 / 40320.0 + h2 * (-1.0 / 3628800.0 + h2 * (1.0 / 479001600.0 + h2 * (-1.0 / 87178291200.0 + h2 * (1.0 / 20922789888000.0 + h2 * (-1.0 / 6402373705728000.0)))))))));
    s = (float)(2.0 * sh * ch); c = (float)(ch * ch - sh * sh);
}
__device__ __forceinline__ double rope_inv(int i) {
    const double t[16] = {1.0, 0.5623413251903491, 0.31622776601683794, 0.1778279410038923, 0.1, 0.05623413251903491, 0.03162277660168379, 0.01778279410038923,
                          0.01, 0.005623413251903491, 0.0031622776601683794, 0.0017782794100389228, 0.001, 0.0005623413251903491, 0.00031622776601683794, 0.00017782794100389227};
    double r = t[0];
#pragma unroll
    for (int k = 1; k < 16; ++k) r = (i == k) ? t[k] : r;
    return r;
}

__device__ __forceinline__ void prep_stage(const Params& p, LAS unsigned char* lds, int vblk, int nblk, int tid, unsigned long long& tsub) {
    const int lane = tid & 63, wid = tid >> 6;
    const int gw = vblk * 8 + wid, ngw = nblk * 8;
    LAS float* scr = (LAS float*)(lds + wid * 8448);
    unsigned char* ws = p.ws;
    constexpr int I_IN = 16 * 45, I_UQ = 4 * 24, I_UKV = 2 * 32, I_SQ = 16 * 32, I_XKV = 16 * 64;
    constexpr int NITEMS = I_IN + I_UQ + I_UKV + 3 * I_SQ + I_XKV;
    auto get_desc = [&](int it) -> TrDesc {
        TrDesc d; int r = it; int item;
        if (r < I_IN) { d.W = p.w_in; d.N = INC; d.K = 1024; d.g = p.g_mix; d.WT = (bf16_t*)(ws + WS_WT_IN); d.mode = 2; item = r; }
        else if ((r -= I_IN) < I_UQ) { d.W = p.w_uq; d.N = 768; d.K = 256; d.g = p.g_q; d.WT = (bf16_t*)(ws + WS_WT_UQ); d.mode = 0; item = r; }
        else if ((r -= I_UQ) < I_UKV) { d.W = p.w_ukv; d.N = 1024; d.K = 128; d.g = p.g_kv; d.WT = (bf16_t*)(ws + WS_WT_UKV); d.mode = 0; item = r; }
        else if ((r -= I_UKV) < I_SQ) { d.W = p.w_out; d.N = 1024; d.K = 1024; d.g = nullptr; d.WT = (bf16_t*)(ws + WS_WT_OUT); d.mode = 0; item = r; }
        else if ((r -= I_SQ) < I_SQ) { d.W = p.w_xq; d.N = 1024; d.K = 1024; d.g = p.g_xattn; d.WT = (bf16_t*)(ws + WS_WT_XQ); d.mode = 0; item = r; }
        else if ((r -= I_SQ) < I_SQ) { d.W = p.w_xo; d.N = 1024; d.K = 1024; d.g = nullptr; d.WT = (bf16_t*)(ws + WS_WT_XO); d.mode = 0; item = r; }
        else { r -= I_SQ; d.W = p.w_xkv; d.N = 2048; d.K = 1024; d.g = p.g_mem; d.WT = (bf16_t*)(ws + WS_WT_XKV); d.mode = 0; item = r; }
        const int nblk = d.N / 32; d.k0 = 64 * (item / nblk); d.n0 = 32 * (item % nblk); return d; };
    SUB_T0(1);
    if (gw < NITEMS) {
        TrDesc d0 = get_desc(gw), d1 = d0, d2 = d0; float v0[32], v1[32], v2[32];
        tr_load(d0, v0, lane);
        if (gw + ngw < NITEMS) { d1 = get_desc(gw + ngw); tr_load(d1, v1, lane); }
        for (int it = gw; it < NITEMS; it += ngw) {
            const int n2 = it + 2 * ngw;
            if (n2 < NITEMS) { d2 = get_desc(n2); tr_load(d2, v2, lane); }
            tr_store(d0, v0, scr, lane);
            d0 = d1; d1 = d2;
#pragma unroll
            for (int i = 0; i < 32; ++i) { v0[i] = v1[i]; v1[i] = v2[i]; }
        }
    }
    SUB_T1(1, tsub);
    SUB_T0(2);
    rows_bf16_rstd(p.x, (bf16_t*)(ws + WS_XB), (float*)(ws + WS_RSTD_X), NTOK, gw, ngw, lane);
    rows_bf16_rstd(p.mem, (bf16_t*)(ws + WS_MEMB), (float*)(ws + WS_RSTD_MEM), NMEM, gw, ngw, lane);
    SUB_T1(2, tsub);
    SUB_T0(3);
    const int gt = vblk * 512 + tid, ngt = nblk * 512;
    for (int i = gt; i < NTOK * 16; i += ngt) { const int row = i >> 4, f = i & 15; float s, c; sincos_acc((double)p.pos[row] * rope_inv(f), s, c);
        float* rt = (float*)(ws + WS_ROPE) + (size_t)row * 32; rt[f] = c; rt[16 + f] = s; }
    for (int i = gt; i < 1024 * 32; i += ngt) { const int k = i >> 5, e = i & 31; const float v = p.g_ffn[k] * p.w_router[i]; const unsigned hb = f2bf(v); const float lo = v - __uint_as_float(hb << 16);
        ((bf16_t*)(ws + WS_WR))[e * 1024 + k] = (bf16_t)hb; ((bf16_t*)(ws + WS_WR))[32768 + e * 1024 + k] = (bf16_t)f2bf(lo); }
    for (int i = gt; i < 96 * 1024 / 8; i += ngt) ((u32x4*)((bf16_t*)(ws + WS_WT_IN) + (size_t)416 * 1024))[i] = (u32x4){0u, 0u, 0u, 0u};
    SUB_T1(3, tsub);
}

__device__ __forceinline__ void moe_weights_stage(const Params& p, LAS unsigned char* lds, int ci, int nconv, int tid) {
    const int lane = tid & 63, wid = tid >> 6; const int gw = ci * 8 + wid, ngw = nconv * 8;
    LAS float* scr = (LAS float*)(lds + wid * 8448);
    unsigned char* ws = p.ws;
    constexpr int I_UP1 = 16 * 64, I_DN1 = 16 * 32, NITEMS = NE * (I_UP1 + I_DN1);
    auto get_desc = [&](int it) -> TrDesc {
        TrDesc d; int r = it; int item;
        if (r < NE * I_UP1) { const int e = r / I_UP1; d.W = p.w_up + (size_t)e * 1024 * 2048; d.N = 2048; d.K = 1024; d.g = p.g_ffn; d.WT = (bf16_t*)(ws + WS_WT_UP + (size_t)e * 2048 * 1024); d.mode = 4; item = r % I_UP1; }
        else { r -= NE * I_UP1; const int e = r / I_DN1; d.W = p.w_down + (size_t)e * 1024 * 1024; d.N = 1024; d.K = 1024; d.g = nullptr; d.WT = (bf16_t*)(ws + WS_WT_DOWN + (size_t)e * 1024 * 1024); d.mode = 5; item = r % I_DN1; }
        const int nblk = d.N / 32; d.k0 = 64 * (item / nblk); d.n0 = 32 * (item % nblk); return d; };
    if (gw < NITEMS) {
        TrDesc d0 = get_desc(gw), d1 = d0, d2 = d0, d3 = d0; float v0[32], v1[32], v2[32], v3[32];
        tr_load(d0, v0, lane);
        if (gw + ngw < NITEMS) { d1 = get_desc(gw + ngw); tr_load(d1, v1, lane); }
        if (gw + 2 * ngw < NITEMS) { d2 = get_desc(gw + 2 * ngw); tr_load(d2, v2, lane); }
        for (int it = gw; it < NITEMS; it += ngw) {
            const int n3 = it + 3 * ngw;
            if (n3 < NITEMS) { d3 = get_desc(n3); tr_load(d3, v3, lane); }
            tr_store(d0, v0, scr, lane);
            d0 = d1; d1 = d2; d2 = d3;
#pragma unroll
            for (int i = 0; i < 32; ++i) { v0[i] = v1[i]; v1[i] = v2[i]; v2[i] = v3[i]; }
        }
    }
}

struct Unit { int pm, pn, z; };
typedef f32x4 Acc[2][2][4][2];

template <bool PERM, class Prov, class Epi>
__device__ __forceinline__ void gemm_unit_naive(const Prov& P, const Epi& E, const Unit& u, LAS unsigned char* lds, int tid) {
    const int wid = tid >> 6, lane = tid & 63, wr = wid >> 2, wc = wid & 3, fr = lane & 15, fq = lane >> 4;
    const bf16_t* ap[2][4]; const bf16_t* bp[2][2];
#pragma unroll
    for (int ai = 0; ai < 2; ++ai)
#pragma unroll
        for (int m = 0; m < 4; ++m) ap[ai][m] = P.a_row(u, 128 * ai + 64 * wr + 16 * m + fr) + 8 * fq;
#pragma unroll
    for (int bj = 0; bj < 2; ++bj)
#pragma unroll
        for (int n = 0; n < 2; ++n) { const int rho = 16 * n + fr; bp[bj][n] = P.b_row(u, 128 * bj + 32 * wc + (PERM ? perm32(rho) : rho)) + 8 * fq; }
    Acc acc;
#pragma unroll
    for (int a = 0; a < 2; ++a)
#pragma unroll
        for (int b = 0; b < 2; ++b)
#pragma unroll
            for (int m = 0; m < 4; ++m)
#pragma unroll
                for (int n = 0; n < 2; ++n) acc[a][b][m][n] = (f32x4){0.f, 0.f, 0.f, 0.f};
    const int K = P.K;
#pragma unroll 1
    for (int k0 = 0; k0 < K; k0 += 32) {
        bf16x8 a[2][4], b[2][2];
#pragma unroll
        for (int ai = 0; ai < 2; ++ai)
#pragma unroll
            for (int m = 0; m < 4; ++m) a[ai][m] = *(const bf16x8*)(ap[ai][m] + k0);
#pragma unroll
        for (int bj = 0; bj < 2; ++bj)
#pragma unroll
            for (int n = 0; n < 2; ++n) b[bj][n] = *(const bf16x8*)(bp[bj][n] + k0);
#pragma unroll
        for (int ai = 0; ai < 2; ++ai)
#pragma unroll
            for (int bj = 0; bj < 2; ++bj)
#pragma unroll
                for (int m = 0; m < 4; ++m)
#pragma unroll
                    for (int n = 0; n < 2; ++n) acc[ai][bj][m][n] = __builtin_amdgcn_mfma_f32_16x16x32_bf16(b[bj][n], a[ai][m], acc[ai][bj][m][n], 0, 0, 0);
    }
    E(acc, u, wr, wc, fr, fq, lds, (const LAS float*)lds);
}

struct ProvPlain { const bf16_t* A; int lda; const bf16_t* Bt; int ldb; int K;
    __device__ __forceinline__ const bf16_t* a_row(const Unit& u, int r) const { return A + (size_t)(u.pm * 256 + r) * lda; }
    __device__ __forceinline__ const bf16_t* b_row(const Unit& u, int r) const { return Bt + (size_t)(u.pn * 256 + r) * ldb; } };
struct ProvXS { const bf16_t* XQ; const bf16_t* KM; int K;
    __device__ __forceinline__ const bf16_t* a_row(const Unit& u, int r) const { return XQ + (size_t)((u.z >> 2) * 2048 + u.pm * 256 + r) * 1024 + (u.z & 3) * 256; }
    __device__ __forceinline__ const bf16_t* b_row(const Unit& u, int r) const { return KM + (size_t)((u.z >> 2) * 256 + r) * 1024 + (u.z & 3) * 256; } };
struct ProvXPV { const bf16_t* Pm; const bf16_t* VMT; int K;
    __device__ __forceinline__ const bf16_t* a_row(const Unit& u, int r) const { return Pm + ((size_t)u.z * 2048 + u.pm * 256 + r) * 256; }
    __device__ __forceinline__ const bf16_t* b_row(const Unit& u, int r) const { return VMT + ((size_t)u.z * 256 + r) * 256; } };
struct ProvUp { const bf16_t* X2B; const int* slot_tok; const int* tile_e; const bf16_t* WT; int K;
    __device__ __forceinline__ const bf16_t* a_row(const Unit& u, int r) const { return X2B + (size_t)slot_tok[u.pm * 256 + r] * 1024; }
    __device__ __forceinline__ const bf16_t* b_row(const Unit& u, int r) const { return WT + ((size_t)tile_e[u.pm] * 2048 + u.pn * 256 + r) * 1024; } };
struct ProvDown { const bf16_t* ACT; const int* tile_e; const bf16_t* WT; int K;
    __device__ __forceinline__ const bf16_t* a_row(const Unit& u, int r) const { return ACT + (size_t)(u.pm * 256 + r) * 1024; }
    __device__ __forceinline__ const bf16_t* b_row(const Unit& u, int r) const { return WT + ((size_t)tile_e[u.pm] * 1024 + u.pn * 256 + r) * 1024; } };

#define EPI_BAR() do { asm volatile("s_waitcnt lgkmcnt(0)" ::: "memory"); __builtin_amdgcn_s_barrier(); asm volatile("" ::: "memory"); } while (0)
#define EPI_ARGS Acc& acc, const Unit& u, int wr, int wc, int fr, int fq, LAS unsigned char* lds, const LAS float* tab
#define EPI_NOPF __device__ __forceinline__ void prefetch(const Unit&, LAS float*, int) const {}
#define FOR_AI_M _Pragma("unroll") for (int ai = 0; ai < 2; ++ai) _Pragma("unroll") for (int m = 0; m < 4; ++m)
#define FOR_BJ _Pragma("unroll") for (int bj = 0; bj < 2; ++bj)
struct EpiIn { bf16_t* U; bf16_t* Z; const float* rs; float* ssq_q; float* ssq_kv; const float* rope; bf16_t* KB;
    EPI_NOPF
    __device__ __forceinline__ void operator()(EPI_ARGS) const {
        if (u.pn >= 2) {
            FOR_AI_M { const int row = u.pm * 256 + 128 * ai + 64 * wr + 16 * m + fr; const float s = rs[row]; f32x4 o[2];
#pragma unroll
                for (int n = 0; n < 2; ++n) { const f32x4 av = acc[ai][0][m][n] * s, gv = acc[ai][1][m][n] * s; const f32x4 t = gv * (-1.4426950408889634f); f32x4 ex;
#pragma unroll
                    for (int j = 0; j < 4; ++j) ex[j] = __builtin_amdgcn_exp2f(t[j]);
                    ex = ex + 1.0f; f32x4 rc;
#pragma unroll
                    for (int j = 0; j < 4; ++j) rc[j] = __builtin_amdgcn_rcpf(ex[j]);
                    o[n] = av * rc; }
                u32x4 w; w.x = pk2(o[0][0], o[0][1]); w.y = pk2(o[0][2], o[0][3]); w.z = pk2(o[1][0], o[1][1]); w.w = pk2(o[1][2], o[1][3]);
                *(u32x4*)(Z + (size_t)row * 512 + (u.pn - 2) * 128 + 32 * wc + 8 * fq) = w; }
            return; }
        FOR_AI_M { const int row = u.pm * 256 + 128 * ai + 64 * wr + 16 * m + fr; const float s = rs[row]; bf16_t* rowp = U + (size_t)row * ULD + u.pn * 256 + 32 * wc + 8 * fq;
            float q0 = 0.f, q1 = 0.f;
            FOR_BJ { const f32x4 v0 = acc[ai][bj][m][0] * s, v1 = acc[ai][bj][m][1] * s; u32x4 w; w.x = pk2(v0[0], v0[1]); w.y = pk2(v0[2], v0[3]); w.z = pk2(v1[0], v1[1]); w.w = pk2(v1[2], v1[3]);
                *(u32x4*)(rowp + 128 * bj) = w;
                const float qq = (v0[0] * v0[0] + v0[1] * v0[1]) + (v0[2] * v0[2] + v0[3] * v0[3]) + (v1[0] * v1[0] + v1[1] * v1[1]) + (v1[2] * v1[2] + v1[3] * v1[3]);
                if (bj == 0) q0 = qq; else q1 = qq; }
            if (u.pn == 0) { float q = q0 + q1; q += shflx(q, 16, fr + 16 * fq); q += shflx(q, 32, fr + 16 * fq); if (fq == 0) ssq_q[(size_t)row * 4 + wc] = q; }
            if (u.pn == 1) { float q = q0; q += shflx(q, 16, fr + 16 * fq); q += shflx(q, 32, fr + 16 * fq); if (fq == 0) ssq_kv[(size_t)row * 4 + wc] = q;
                if (wc == 0) {
                    const int i0 = 8 * (fq & 1); const f32x4 c0 = *(const f32x4*)(rope + (size_t)row * 32 + i0), c1 = *(const f32x4*)(rope + (size_t)row * 32 + i0 + 4);
                    const f32x4 s0 = *(const f32x4*)(rope + (size_t)row * 32 + 16 + i0), s1 = *(const f32x4*)(rope + (size_t)row * 32 + 16 + i0 + 4);
                    const f32x4 v0 = acc[ai][1][m][0] * s, v1 = acc[ai][1][m][1] * s; f32x4 p0, p1;
#pragma unroll
                    for (int j = 0; j < 4; ++j) { p0[j] = shflx(v0[j], 32, fr + 16 * fq); p1[j] = shflx(v1[j], 32, fr + 16 * fq); }
                    f32x4 o0, o1;
                    if (fq < 2) { o0 = v0 * c0 - p0 * s0; o1 = v1 * c1 - p1 * s1; } else { o0 = p0 * s0 + v0 * c0; o1 = p1 * s1 + v1 * c1; }
                    u32x4 w; w.x = pk2(o0[0], o0[1]); w.y = pk2(o0[2], o0[3]); w.z = pk2(o1[0], o1[1]); w.w = pk2(o1[2], o1[3]);
                    bf16_t* kb = KB + (size_t)row * 768 + 64 + 8 * fq;
#pragma unroll
                    for (int h = 0; h < 8; ++h) *(u32x4*)(kb + h * 96) = w; } } } } };
struct EpiScale16 { bf16_t* O; int ldc; const float* ssq; float mul;
    EPI_NOPF
    __device__ __forceinline__ void operator()(EPI_ARGS) const {
        FOR_AI_M { const int row = u.pm * 256 + 128 * ai + 64 * wr + 16 * m + fr; const f32x4* sp = (const f32x4*)(ssq + (size_t)row * 16); const f32x4 t = (sp[0] + sp[1]) + (sp[2] + sp[3]);
            const float s = mul / sqrtf(((t[0] + t[1]) + (t[2] + t[3])) * (1.0f / 1024.0f) + EPS); bf16_t* rowp = O + (size_t)row * ldc + u.pn * 256 + 32 * wc + 8 * fq;
            FOR_BJ { const f32x4 v0 = acc[ai][bj][m][0] * s, v1 = acc[ai][bj][m][1] * s; u32x4 w; w.x = pk2(v0[0], v0[1]); w.y = pk2(v0[2], v0[3]); w.z = pk2(v1[0], v1[1]); w.w = pk2(v1[2], v1[3]);
                *(u32x4*)(rowp + 128 * bj) = w; } } } };
struct EpiQ { bf16_t* Q; const float* ssq; const float* rope;
    EPI_NOPF
    __device__ __forceinline__ void operator()(EPI_ARGS) const {
        FOR_AI_M { const int row = u.pm * 256 + 128 * ai + 64 * wr + 16 * m + fr; const f32x4 t = *(const f32x4*)(ssq + (size_t)row * 4); const float s = C2_MLA / sqrtf(((t[0] + t[1]) + (t[2] + t[3])) * (1.0f / 256.0f) + EPS);
            const f32x4 cs = *(const f32x4*)(rope + (size_t)row * 32 + 4 * fq), sn = *(const f32x4*)(rope + (size_t)row * 32 + 16 + 4 * fq);
            FOR_BJ { const int colg = u.pn * 256 + 128 * bj + 32 * wc; f32x4 v0 = acc[ai][bj][m][0] * s, v1 = acc[ai][bj][m][1] * s;
                if (((colg >> 5) % 3) == 2) { const f32x4 r0 = v0 * cs - v1 * sn, r1 = v0 * sn + v1 * cs; v0 = r0; v1 = r1; }
                bf16_t* rowp = Q + (size_t)row * 768 + colg + 4 * fq; u32x2 w0, w1; w0.x = pk2(v0[0], v0[1]); w0.y = pk2(v0[2], v0[3]); w1.x = pk2(v1[0], v1[1]); w1.y = pk2(v1[2], v1[3]);
                *(u32x2*)(rowp) = w0; *(u32x2*)(rowp + 16) = w1; } } } };
struct EpiKV { bf16_t* KB; bf16_t* VB; const float* ssq;
    EPI_NOPF
    __device__ __forceinline__ void operator()(EPI_ARGS) const {
        FOR_AI_M { const int row = u.pm * 256 + 128 * ai + 64 * wr + 16 * m + fr; const f32x4 t = *(const f32x4*)(ssq + (size_t)row * 4); const float s = 1.0f / sqrtf(((t[0] + t[1]) + (t[2] + t[3])) * (1.0f / 128.0f) + EPS);
            FOR_BJ { const int h = 2 * u.pn + bj, cl = 32 * wc + 8 * fq; const f32x4 v0 = acc[ai][bj][m][0] * s, v1 = acc[ai][bj][m][1] * s;
                u32x4 w; w.x = pk2(v0[0], v0[1]); w.y = pk2(v0[2], v0[3]); w.z = pk2(v1[0], v1[1]); w.w = pk2(v1[2], v1[3]);
                if (wc < 2) *(u32x4*)(KB + (size_t)row * 768 + h * 96 + cl) = w; else *(u32x4*)(VB + (size_t)row * 512 + h * 64 + cl - 64) = w; } } } };
struct EpiResid { const bf16_t* base; bf16_t* ob; float* ssq; unsigned char* o8;
    EPI_NOPF
    __device__ __forceinline__ void operator()(EPI_ARGS) const {
        FOR_AI_M { const int row = u.pm * 256 + 128 * ai + 64 * wr + 16 * m + fr; float q = 0.f;
            FOR_BJ { const size_t off = (size_t)row * 1024 + u.pn * 256 + 128 * bj + 32 * wc + 8 * fq;
                const u32x4 bw = *(const u32x4*)(base + off);
                f32x4 v0, v1; v0[0] = __uint_as_float(bw.x << 16); v0[1] = __uint_as_float(bw.x & 0xffff0000u); v0[2] = __uint_as_float(bw.y << 16); v0[3] = __uint_as_float(bw.y & 0xffff0000u);
                v1[0] = __uint_as_float(bw.z << 16); v1[1] = __uint_as_float(bw.z & 0xffff0000u); v1[2] = __uint_as_float(bw.w << 16); v1[3] = __uint_as_float(bw.w & 0xffff0000u);
                v0 = v0 + acc[ai][bj][m][0]; v1 = v1 + acc[ai][bj][m][1];
                u32x4 w; w.x = pk2(v0[0], v0[1]); w.y = pk2(v0[2], v0[3]); w.z = pk2(v1[0], v1[1]); w.w = pk2(v1[2], v1[3]); *(u32x4*)(ob + off) = w;
                if (o8) { u32x2 w8; w8.x = pk4_fp8(v0[0], v0[1], v0[2], v0[3]); w8.y = pk4_fp8(v1[0], v1[1], v1[2], v1[3]); *(u32x2*)(o8 + off) = w8; }
                q += (v0[0] * v0[0] + v0[1] * v0[1]) + (v0[2] * v0[2] + v0[3] * v0[3]) + (v1[0] * v1[0] + v1[1] * v1[1]) + (v1[2] * v1[2] + v1[3] * v1[3]); }
            if (ssq) { q += shflx(q, 16, fr + 16 * fq); q += shflx(q, 32, fr + 16 * fq); if (fq == 0) ssq[(size_t)row * 16 + u.pn * 4 + wc] = q; } } } };
struct EpiKVMem { bf16_t* KM; bf16_t* VMT; const float* rs;
    EPI_NOPF
    __device__ __forceinline__ void operator()(EPI_ARGS) const {
        FOR_AI_M { const int row = u.pm * 256 + 128 * ai + 64 * wr + 16 * m + fr; const float s = rs[row];
            FOR_BJ {
#pragma unroll
                for (int n = 0; n < 2; ++n) { const int col = u.pn * 256 + 128 * bj + 32 * wc + 16 * n + 4 * fq; const f32x4 v = acc[ai][bj][m][n] * s;
                    if (u.pn < 4) { u32x2 w; w.x = pk2(v[0], v[1]); w.y = pk2(v[2], v[3]); *(u32x2*)(KM + (size_t)row * 1024 + col) = w; }
                    else { const int c2 = col - 1024, h = c2 >> 8, d = c2 & 255, b = row >> 8, mm = row & 255; bf16_t* dst = VMT + ((size_t)(b * 4 + h) * 256 + d) * 256 + mm;
#pragma unroll
                        for (int j = 0; j < 4; ++j) dst[(size_t)j * 256] = (bf16_t)f2bf(v[j]); } } } } } };
struct EpiSoftmaxP { bf16_t* Pm;
    EPI_NOPF
    __device__ __forceinline__ void operator()(EPI_ARGS) const {
        LAS float* red = (LAS float*)lds; float rmax[2][4];
        FOR_AI_M { float mx = -3.0e38f;
            FOR_BJ {
#pragma unroll
                for (int n = 0; n < 2; ++n)
#pragma unroll
                    for (int j = 0; j < 4; ++j) mx = fmaxf(mx, acc[ai][bj][m][n][j]); }
            mx = fmaxf(mx, shflx(mx, 16, fr + 16 * fq)); mx = fmaxf(mx, shflx(mx, 32, fr + 16 * fq));
            if (fq == 0) red[(128 * ai + 64 * wr + 16 * m + fr) * 4 + wc] = mx; }
        EPI_BAR();
        FOR_AI_M { const f32x4 t = *(const LAS f32x4*)(red + (128 * ai + 64 * wr + 16 * m + fr) * 4); rmax[ai][m] = fmaxf(fmaxf(t[0], t[1]), fmaxf(t[2], t[3])); }
        EPI_BAR();
        FOR_AI_M { float s = 0.f;
            FOR_BJ {
#pragma unroll
                for (int n = 0; n < 2; ++n)
#pragma unroll
                    for (int j = 0; j < 4; ++j) { const float e = fast_exp2(acc[ai][bj][m][n][j] - rmax[ai][m]); acc[ai][bj][m][n][j] = e; s += e; } }
            s += shflx(s, 16, fr + 16 * fq); s += shflx(s, 32, fr + 16 * fq);
            if (fq == 0) red[(128 * ai + 64 * wr + 16 * m + fr) * 4 + wc] = s; }
        EPI_BAR();
        FOR_AI_M { const int r = 128 * ai + 64 * wr + 16 * m + fr; const f32x4 t = *(const LAS f32x4*)(red + r * 4); const float inv = 1.0f / ((t[0] + t[1]) + (t[2] + t[3]));
            bf16_t* rowp = Pm + ((size_t)u.z * 2048 + u.pm * 256 + r) * 256 + 32 * wc + 8 * fq;
            FOR_BJ { const f32x4 v0 = acc[ai][bj][m][0] * inv, v1 = acc[ai][bj][m][1] * inv; u32x4 w; w.x = pk2(v0[0], v0[1]); w.y = pk2(v0[2], v0[3]); w.z = pk2(v1[0], v1[1]); w.w = pk2(v1[2], v1[3]);
                *(u32x4*)(rowp + 128 * bj) = w; } }
        EPI_BAR();
    } };
struct EpiOX { bf16_t* OX;
    EPI_NOPF
    __device__ __forceinline__ void operator()(EPI_ARGS) const {
        FOR_AI_M { const int r = 128 * ai + 64 * wr + 16 * m + fr; bf16_t* rowp = OX + (size_t)((u.z >> 2) * 2048 + u.pm * 256 + r) * 1024 + (u.z & 3) * 256 + 32 * wc + 8 * fq;
            FOR_BJ { const f32x4 v0 = acc[ai][bj][m][0], v1 = acc[ai][bj][m][1]; u32x4 w; w.x = pk2(v0[0], v0[1]); w.y = pk2(v0[2], v0[3]); w.z = pk2(v1[0], v1[1]); w.w = pk2(v1[2], v1[3]);
                *(u32x4*)(rowp + 128 * bj) = w; } } } };
struct EpiSwiglu { bf16_t* ACT; const float* slot_rs; const int* tile_e; const float* b_up;
    __device__ __forceinline__ void prefetch(const Unit& u, LAS float* t, int tid) const { const int e = tile_e[u.pm];
        t[tid] = slot_rs[u.pm * 256 + tid] * W8_INV; t[256 + tid] = b_up[(size_t)e * 2048 + ((tid >> 7) << 10) + u.pn * 128 + (tid & 127)]; }
    __device__ __forceinline__ void operator()(EPI_ARGS) const {
        const int cl = 32 * wc + 8 * fq;
        f32x4 bgv[2], blv[2]; bgv[0] = *(const LAS f32x4*)(tab + 256 + cl); bgv[1] = *(const LAS f32x4*)(tab + 256 + cl + 4); blv[0] = *(const LAS f32x4*)(tab + 384 + cl); blv[1] = *(const LAS f32x4*)(tab + 384 + cl + 4);
        FOR_AI_M { const int rl = 128 * ai + 64 * wr + 16 * m + fr; const int slot = u.pm * 256 + rl; const float s = tab[rl];
            f32x4 o[2];
#pragma unroll
            for (int n = 0; n < 2; ++n) { f32x4 g = acc[ai][0][m][n] * s + bgv[n], l = acc[ai][1][m][n] * s + blv[n];
                g = __builtin_elementwise_min(g, (f32x4){7.f, 7.f, 7.f, 7.f}); l = __builtin_elementwise_min(__builtin_elementwise_max(l, (f32x4){-7.f, -7.f, -7.f, -7.f}), (f32x4){7.f, 7.f, 7.f, 7.f}) + 1.0f;
                const f32x4 t = g * (-1.702f * 1.4426950408889634f); f32x4 ex;
#pragma unroll
                for (int j = 0; j < 4; ++j) ex[j] = __builtin_amdgcn_exp2f(t[j]);
                ex = ex + 1.0f; f32x4 rc;
#pragma unroll
                for (int j = 0; j < 4; ++j) rc[j] = __builtin_amdgcn_rcpf(ex[j]);
                o[n] = (g * rc) * l; }
            u32x2 w; w.x = pk4_fp8(o[0][0], o[0][1], o[0][2], o[0][3]); w.y = pk4_fp8(o[1][0], o[1][1], o[1][2], o[1][3]);
            *(u32x2*)((unsigned char*)ACT + (size_t)slot * 1024 + u.pn * 128 + cl) = w; } } };
struct EpiDown { bf16_t* YB; const float* gate; const int* tile_e; const float* b_down;
    __device__ __forceinline__ void prefetch(const Unit& u, LAS float* t, int tid) const { const int e = tile_e[u.pm];
        t[tid] = gate[u.pm * 256 + tid]; t[256 + tid] = b_down[(size_t)e * 1024 + u.pn * 256 + tid]; }
    __device__ __forceinline__ void operator()(EPI_ARGS) const {
        const int cl = 32 * wc + 8 * fq;
        FOR_AI_M { const int rl = 128 * ai + 64 * wr + 16 * m + fr; const int slot = u.pm * 256 + rl; const float g = tab[rl]; const float g8 = g * W8_INV;
            FOR_BJ { const f32x4 b0 = *(const LAS f32x4*)(tab + 256 + cl + 128 * bj), b1 = *(const LAS f32x4*)(tab + 256 + cl + 128 * bj + 4);
                const f32x4 v0 = acc[ai][bj][m][0] * g8 + b0 * g, v1 = acc[ai][bj][m][1] * g8 + b1 * g; u32x4 w; w.x = pk2(v0[0], v0[1]); w.y = pk2(v0[2], v0[3]); w.z = pk2(v1[0], v1[1]); w.w = pk2(v1[2], v1[3]);
                *(u32x4*)(YB + (size_t)slot * 1024 + u.pn * 256 + cl + 128 * bj) = w; } } } };

namespace pg8 {
typedef int v4i_t __attribute__((ext_vector_type(4)));
typedef int v8i_t __attribute__((ext_vector_type(8)));
constexpr int BK = 64, HALF = 128, HTB = HALF * BK * 2, STAGE_BYTES = 8 * HTB;
__device__ __forceinline__ int lds_byte(int r, int c) { const int st = (r >> 4) * 2 + (c >> 5), rr = r & 15, cc = c & 31, ob = rr * 64 + cc * 2; return st * 1024 + (ob ^ (((ob >> 9) & 1) << 5)); }
__device__ __forceinline__ void stage_rc(int b, int& R, int& C) { const int st = b / 1024, sb = b % 1024, swz = sb ^ (((sb >> 9) & 1) << 5); R = (st >> 1) * 16 + swz / 64; C = (st & 1) * 32 + (swz % 64) / 2; }

template <bool PERM, bool GATHER, bool FP8, class Prov, class Sched, class Epi>
__device__ __forceinline__ void gemm_phase(LAS unsigned char* lds, LAS unsigned char* lds_epi, const Prov& P, const Sched& S, const Epi& E, int tid, unsigned long long* tepi = nullptr) {
    const int wid = __builtin_amdgcn_readfirstlane(tid >> 6), lane = tid & 63, wr = wid >> 2, wc = wid & 3, fr = lane & 15, fq = lane >> 4;
    const int K = P.K, nt = K / BK;
    unsigned voffA[2], voffB[2], voffG[2][2]; int Rg[2]; unsigned Cg[2];
#pragma unroll
    for (int i = 0; i < 2; ++i) { int R, C; stage_rc(tid * 16 + i * 8192, R, C); const int Rb = PERM ? ((R & ~31) + perm32(R & 31)) : R;
        voffA[i] = (unsigned)(R * P.lda + C) * 2u; voffB[i] = (unsigned)(Rb * P.ldb + C) * 2u; Rg[i] = R; Cg[i] = (unsigned)C * 2u; }
    LAS int* rtab = (LAS int*)(lds_epi + 8192);
    const unsigned kstep = (unsigned)(BK * 2);
    const unsigned hstepA = GATHER ? 0u : (unsigned)(HALF * P.lda * 2), hstepB = (unsigned)(HALF * P.ldb * 2);
    const __amdgpu_buffer_rsrc_t rsA = __builtin_amdgcn_make_buffer_rsrc((void*)P.a_root(), 0, -1, 0x00020000), rsB = __builtin_amdgcn_make_buffer_rsrc((void*)P.b_root(), 0, -1, 0x00020000);
#define PG8_AOFF(u_) ((unsigned)((const char*)P.a_base(u_) - (const char*)P.a_root()))
#define PG8_BOFF(u_) ((unsigned)((const char*)P.b_base(u_) - (const char*)P.b_root()))
    const unsigned ldsw = (unsigned)wid * 1024u;
    const int aoff = lds_byte(wr * 64 + fr, fq * 8), boff = lds_byte(wc * 32 + fr, fq * 8);
#define PG8_SA(b, h) (((b) * 2 + (h)) * HTB)
#define PG8_SB(b, h) ((4 + (b) * 2 + (h)) * HTB)
#define PG8_STAGE(bufoff, rs, soff, voff) do { _Pragma("unroll") for (int _i = 0; _i < 2; ++_i) \
        __builtin_amdgcn_raw_ptr_buffer_load_lds(rs, (LAS void*)(lds + (bufoff) + ldsw + _i * 8192), 16, (int)(voff)[_i], (int)(soff), 0, 0); } while (0)
#define PG8_STAGE_A(bufoff, soff, h) do { if constexpr (GATHER) { PG8_STAGE(bufoff, rsA, soff, voffG[h]); } else { PG8_STAGE(bufoff, rsA, (soff) + (h) * hstepA, voffA); } } while (0)
#define PG8_STAGE_B(bufoff, soff) PG8_STAGE(bufoff, rsB, soff, voffB)
#define PG8_LDA(dst, b, h) do { _Pragma("unroll") for (int m = 0; m < 4; ++m) { const v4i_t l0_ = *(const LAS v4i_t*)(lds + PG8_SA(b, h) + aoff + m * 2048), l1_ = *(const LAS v4i_t*)(lds + PG8_SA(b, h) + aoff + m * 2048 + 1024); dst[m] = __builtin_shufflevector(l0_, l1_, 0, 1, 2, 3, 4, 5, 6, 7); } } while (0)
#define PG8_LDB(dst, b, h) do { _Pragma("unroll") for (int n = 0; n < 2; ++n) { const v4i_t l0_ = *(const LAS v4i_t*)(lds + PG8_SB(b, h) + boff + n * 2048), l1_ = *(const LAS v4i_t*)(lds + PG8_SB(b, h) + boff + n * 2048 + 1024); dst[n] = __builtin_shufflevector(l0_, l1_, 0, 1, 2, 3, 4, 5, 6, 7); } } while (0)
#define PG8_MMA(ai, bj, At, Bt) do { __builtin_amdgcn_s_setprio(1); _Pragma("unroll") for (int m = 0; m < 4; ++m) _Pragma("unroll") for (int n = 0; n < 2; ++n) { if constexpr (FP8) { \
            acc[ai][bj][m][n] = __builtin_amdgcn_mfma_scale_f32_16x16x128_f8f6f4(Bt[n], At[m], acc[ai][bj][m][n], 0, 0, 0, 0x7f7f7f7f, 0, 0x7f7f7f7f); } \
        else { acc[ai][bj][m][n] = __builtin_amdgcn_mfma_f32_16x16x32_bf16(__builtin_bit_cast(bf16x8, __builtin_shufflevector(Bt[n], Bt[n], 0, 1, 2, 3)), __builtin_bit_cast(bf16x8, __builtin_shufflevector(At[m], At[m], 0, 1, 2, 3)), acc[ai][bj][m][n], 0, 0, 0); \
               acc[ai][bj][m][n] = __builtin_amdgcn_mfma_f32_16x16x32_bf16(__builtin_bit_cast(bf16x8, __builtin_shufflevector(Bt[n], Bt[n], 4, 5, 6, 7)), __builtin_bit_cast(bf16x8, __builtin_shufflevector(At[m], At[m], 4, 5, 6, 7)), acc[ai][bj][m][n], 0, 0, 0); } } \
        __builtin_amdgcn_s_setprio(0); } while (0)
#define PG8_WAIT_V(n) asm volatile("s_waitcnt vmcnt(" #n ")" ::: "memory")
#define PG8_WAIT_L(n) asm volatile("s_waitcnt lgkmcnt(" #n ")" ::: "memory")
#define PG8_BAR __builtin_amdgcn_s_barrier()
#define PG8_SCHED __builtin_amdgcn_sched_barrier(0)
    Unit cur, nxt; int ui = 0;
    if (!S.next(0, cur)) return;
    Acc acc;
#pragma unroll
    for (int a = 0; a < 2; ++a)
#pragma unroll
        for (int b = 0; b < 2; ++b)
#pragma unroll
            for (int m = 0; m < 4; ++m)
#pragma unroll
                for (int n = 0; n < 2; ++n) acc[a][b][m][n] = (f32x4){0.f, 0.f, 0.f, 0.f};
    v8i_t At[4], B0[2], B1[2];
    unsigned cA = PG8_AOFF(cur), cB = PG8_BOFF(cur);
    if constexpr (GATHER) {
#pragma unroll
        for (int h = 0; h < 2; ++h)
#pragma unroll
            for (int i = 0; i < 2; ++i) voffG[h][i] = (unsigned)P.row_tok(cur, h * HALF + Rg[i]) * (unsigned)(P.lda * 2) + Cg[i];
    }
    PG8_STAGE_B(PG8_SB(0, 0), cB); PG8_STAGE_B(PG8_SB(0, 1), cB + hstepB); PG8_STAGE_A(PG8_SA(0, 0), cA, 0); PG8_STAGE_A(PG8_SA(0, 1), cA, 1);
    if (wr == 1) PG8_BAR;
    PG8_WAIT_V(2); PG8_BAR;
    PG8_STAGE_B(PG8_SB(1, 0), cB + kstep); PG8_STAGE_A(PG8_SA(1, 0), cA + kstep, 0); PG8_STAGE_B(PG8_SB(1, 1), cB + hstepB + kstep);
    PG8_WAIT_V(6); PG8_BAR;
    for (;;) {
        const bool has_next = S.next(ui + 1, nxt);
        const unsigned nA = has_next ? PG8_AOFF(nxt) : cA, nB = has_next ? PG8_BOFF(nxt) : cB;
        if constexpr (GATHER) { if (has_next && wr == 0) { int tg_ = tid; asm volatile("" : "+v"(tg_)); rtab[tg_] = P.row_tok(nxt, tg_); } }
        if (wr == 0) { int tp_ = tid; asm volatile("" : "+v"(tp_)); E.prefetch(cur, (LAS float*)(lds_epi + 4096) + (ui & 1) * 512, tp_); }
        for (int t = 0; t < nt; t += 2) {
            const bool last = (t == nt - 2);
            const unsigned a1 = cA + (unsigned)(t + 1) * kstep;
            const unsigned a2 = last ? nA : cA + (unsigned)(t + 2) * kstep, b2 = last ? nB : cB + (unsigned)(t + 2) * kstep;
            const unsigned a3 = a2 + kstep, b3 = b2 + kstep;
            PG8_LDB(B0, 0, 0); PG8_LDB(B1, 0, 1); PG8_SCHED; PG8_LDA(At, 0, 0); PG8_STAGE_A(PG8_SA(1, 1), a1, 1);
            if constexpr (GATHER) { if (last && has_next) {
#pragma unroll
                for (int h = 0; h < 2; ++h)
#pragma unroll
                    for (int i = 0; i < 2; ++i) voffG[h][i] = (unsigned)rtab[h * HALF + Rg[i]] * (unsigned)(P.lda * 2) + Cg[i]; } }
            PG8_WAIT_V(8); PG8_WAIT_L(0); PG8_BAR; PG8_MMA(0, 0, At, B0); PG8_MMA(0, 1, At, B1); PG8_BAR; PG8_SCHED;
            PG8_LDA(At, 0, 1); PG8_STAGE_B(PG8_SB(0, 0), b2); PG8_STAGE_B(PG8_SB(0, 1), b2 + hstepB); PG8_STAGE_A(PG8_SA(0, 0), a2, 0);
            PG8_WAIT_V(8); PG8_WAIT_L(0); PG8_BAR; PG8_MMA(1, 0, At, B0); PG8_MMA(1, 1, At, B1); PG8_BAR; PG8_SCHED;
            PG8_LDB(B0, 1, 0); PG8_LDB(B1, 1, 1); PG8_SCHED; PG8_LDA(At, 1, 0); PG8_STAGE_A(PG8_SA(0, 1), a2, 1);
            PG8_WAIT_V(8); PG8_WAIT_L(0); PG8_BAR; PG8_MMA(0, 0, At, B0); PG8_MMA(0, 1, At, B1); PG8_BAR; PG8_SCHED;
            PG8_LDA(At, 1, 1); PG8_STAGE_B(PG8_SB(1, 0), b3); PG8_STAGE_B(PG8_SB(1, 1), b3 + hstepB); PG8_STAGE_A(PG8_SA(1, 0), a3, 0);
            PG8_WAIT_V(8); PG8_WAIT_L(0); PG8_BAR; PG8_MMA(1, 0, At, B0); PG8_MMA(1, 1, At, B1); PG8_BAR; PG8_SCHED;
        }
#if PROBE_EPI
        const unsigned long long te0_ = __builtin_amdgcn_s_memrealtime();
#endif
        if (wr == 0) PG8_BAR;
        { int fr_ = fr, fq_ = fq; asm volatile("" : "+v"(fr_), "+v"(fq_));
          E(acc, cur, wr, wc, fr_, fq_, lds_epi, (const LAS float*)(lds_epi + 4096) + (ui & 1) * 512); }
#if PROBE_EPI
        if (tepi) { asm volatile("s_waitcnt vmcnt(8)" ::: "memory"); *tepi += __builtin_amdgcn_s_memrealtime() - te0_; }
#endif
        if (!has_next) break;
#pragma unroll
        for (int a = 0; a < 2; ++a)
#pragma unroll
            for (int b = 0; b < 2; ++b)
#pragma unroll
                for (int m = 0; m < 4; ++m)
#pragma unroll
                    for (int n = 0; n < 2; ++n) acc[a][b][m][n] = (f32x4){0.f, 0.f, 0.f, 0.f};
        cur = nxt; cA = nA; cB = nB; ++ui;
        if (wr == 1) PG8_BAR;
    }
    PG8_WAIT_V(0);
    PG8_BAR;
#undef PG8_SA
#undef PG8_SB
#undef PG8_STAGE
#undef PG8_STAGE_A
#undef PG8_STAGE_B
#undef PG8_AOFF
#undef PG8_BOFF
#undef PG8_LDA
#undef PG8_LDB
#undef PG8_MMA
#undef PG8_WAIT_V
#undef PG8_WAIT_L
#undef PG8_BAR
#undef PG8_SCHED
}
struct Order { int nM, nN, nwg, G, c;
    __device__ __forceinline__ void init(int nM_, int nN_, int G_, int c_) { nM = nM_; nN = nN_; nwg = nM * nN; G = G_; c = c_; }
    __device__ __forceinline__ bool next(int i, int& pm, int& pn) const {
        const long L = (long)i * G + c; if (L >= nwg) return false;
        int wgid = (int)L; { const int q = nwg / 8, r = nwg % 8, xcd = wgid % 8, off = wgid / 8; wgid = (xcd < r ? xcd * (q + 1) : r * (q + 1) + (xcd - r) * q) + off; }
        const int nig = 8 * nN, gid = wgid / nig, fm = gid * 8, gsz = (nM - fm) < 8 ? (nM - fm) : 8;
        pm = fm + ((wgid % nig) % gsz); pn = (wgid % nig) / gsz; return true; } };
struct SchedPlain { Order o; __device__ __forceinline__ bool next(int i, Unit& u) const { u.z = 0; return o.next(i, u.pm, u.pn); } };
struct SchedBatch8 { Order o; __device__ __forceinline__ bool next(int i, Unit& u) const { int pm, pn; if (!o.next(i, pm, pn)) return false; u.z = pm >> 3; u.pm = pm & 7; u.pn = 0; return true; } };
}

struct PvUpG { const bf16_t* X; const bf16_t* WT; const int* tile_e; const int* slot_tok; int lda, ldb, K;
    __device__ __forceinline__ const bf16_t* a_root() const { return X; }
    __device__ __forceinline__ const bf16_t* b_root() const { return WT; }
    __device__ __forceinline__ const bf16_t* a_base(const Unit&) const { return X; }
    __device__ __forceinline__ const bf16_t* b_base(const Unit& u) const { return WT + ((size_t)tile_e[u.pm] * 2048 + u.pn * 256) * ldb; }
    __device__ __forceinline__ int row_tok(const Unit& u, int r) const { return slot_tok[u.pm * 256 + r]; } };
struct PvPlain { const bf16_t* A; const bf16_t* Bt; int lda, ldb, K;
    __device__ __forceinline__ const bf16_t* a_root() const { return A; }
    __device__ __forceinline__ const bf16_t* b_root() const { return Bt; }
    __device__ __forceinline__ const bf16_t* a_base(const Unit& u) const { return A + (size_t)u.pm * 256 * lda; }
    __device__ __forceinline__ const bf16_t* b_base(const Unit& u) const { return Bt + (size_t)u.pn * 256 * ldb; } };
struct PvXS { const bf16_t* XQ; const bf16_t* KM; int lda, ldb, K;
    __device__ __forceinline__ const bf16_t* a_base(const Unit& u) const { return XQ + (size_t)((u.z >> 2) * 2048 + u.pm * 256) * 1024 + (u.z & 3) * 256; }
    __device__ __forceinline__ const bf16_t* b_base(const Unit& u) const { return KM + (size_t)((u.z >> 2) * 256) * 1024 + (u.z & 3) * 256; } };
struct PvXPV { const bf16_t* Pm; const bf16_t* VMT; int lda, ldb, K;
    __device__ __forceinline__ const bf16_t* a_base(const Unit& u) const { return Pm + ((size_t)u.z * 2048 + u.pm * 256) * 256; }
    __device__ __forceinline__ const bf16_t* b_base(const Unit& u) const { return VMT + (size_t)u.z * 65536; } };
struct PvExp { const bf16_t* A; const bf16_t* WT; const int* tile_e; int lda, ldb, K, nrow;
    __device__ __forceinline__ const bf16_t* a_root() const { return A; }
    __device__ __forceinline__ const bf16_t* b_root() const { return WT; }
    __device__ __forceinline__ const bf16_t* a_base(const Unit& u) const { return A + (size_t)u.pm * 256 * lda; }
    __device__ __forceinline__ const bf16_t* b_base(const Unit& u) const { return WT + ((size_t)tile_e[u.pm] * nrow + u.pn * 256) * ldb; } };

constexpr int MLA_KT = 12288, MLA_VT = 8192, MLA_KBUF = 2 * MLA_KT, MLA_VBUF = 2 * MLA_VT, MLA_V0 = 2 * MLA_KBUF;
typedef short v4i16_t __attribute__((ext_vector_type(4)));
__device__ __forceinline__ s16x4 lds_tr16(const LAS unsigned char* p) { return __builtin_bit_cast(s16x4, __builtin_amdgcn_ds_read_tr16_b64_v4i16((LAS v4i16_t*)p)); }
__device__ __forceinline__ void mla_unit(const Params& p, LAS unsigned char* lds, int unit, int tid) {
    const int lane = tid & 63, wid = __builtin_amdgcn_readfirstlane(tid >> 6), r32 = lane & 31, hi = lane >> 5;
    const int qb = unit & 7, h = (unit >> 3) & 7, b = unit >> 6;
    const bf16_t* Qg = (const bf16_t*)(p.ws + WS_Q); const bf16_t* Kg = (const bf16_t*)(p.ws + WS_KB); const bf16_t* Vg = (const bf16_t*)(p.ws + WS_VB);
    const size_t rowb = (size_t)b * SEQ;
    const int q0 = qb * 256 + wid * 32;
    int ksrc[3], kdst[3], vsrc[2], vdst[2];
    const bf16_t* Kbh = Kg + rowb * 768 + h * 96; const bf16_t* Vbh = Vg + rowb * 512 + h * 64;
#pragma unroll
    for (int i = 0; i < 3; ++i) { const int pk = tid + 512 * i, r = pk / 12, c = pk % 12; ksrc[i] = r * 768 + c * 8; kdst[i] = (r >> 6) * MLA_KT + c * 1024 + (r & 63) * 16; }
#pragma unroll
    for (int i = 0; i < 2; ++i) { const int pk = tid + 512 * i, r = pk >> 3, c = pk & 7; vsrc[i] = r * 512 + c * 8; vdst[i] = MLA_V0 + (r >> 6) * MLA_VT + (c >> 2) * 4096 + (r & 63) * 64 + (c & 3) * 16; }
    const int kfo = hi * 1024 + r32 * 16;
    const int vfo = MLA_V0 + ((lane >> 4) & 1) * 32 + (lane & 3) * 8 + (4 * hi + ((lane & 15) >> 2)) * 64;
    bf16x8 qf[6];
#pragma unroll
    for (int s = 0; s < 6; ++s) qf[s] = *(const bf16x8*)(Qg + (rowb + q0 + r32) * 768 + h * 96 + 16 * s + 8 * hi);
    const int ns_blk = 2 * qb + 2, nt_me = 4 * qb + (wid >> 1) + 1;
    u32x4 sk[3], sv[2];
#pragma unroll
    for (int i = 0; i < 3; ++i) sk[i] = *(const u32x4*)(Kbh + ksrc[i]);
#pragma unroll
    for (int i = 0; i < 2; ++i) sv[i] = *(const u32x4*)(Vbh + vsrc[i]);
#pragma unroll
    for (int i = 0; i < 3; ++i) *(LAS u32x4*)(lds + kdst[i]) = sk[i];
#pragma unroll
    for (int i = 0; i < 2; ++i) *(LAS u32x4*)(lds + vdst[i]) = sv[i];
    __syncthreads();
    float mrun = -1.0e30f, lrun = 0.f; f32x16 o0 = {}, o1 = {};
    for (int st = 0; st < ns_blk; ++st) {
        const bool pre = (st + 1 < ns_blk);
        if (pre) { const bf16_t* kn = Kbh + (size_t)(st + 1) * 128 * 768; const bf16_t* vn = Vbh + (size_t)(st + 1) * 128 * 512;
#pragma unroll
            for (int i = 0; i < 3; ++i) sk[i] = *(const u32x4*)(kn + ksrc[i]);
#pragma unroll
            for (int i = 0; i < 2; ++i) sv[i] = *(const u32x4*)(vn + vsrc[i]); }
#pragma unroll
        for (int tt = 0; tt < 2; ++tt) {
          const int t = 2 * st + tt;
          if (t < nt_me) {
            const LAS unsigned char* kb_ = lds + (st & 1) * MLA_KBUF + tt * MLA_KT + kfo; const LAS unsigned char* vb_ = lds + (st & 1) * MLA_VBUF + tt * MLA_VT + vfo;
            f32x16 sc[2]; bf16x8 kf[2][6]; s16x4 vlo[8], vhi[8];
#pragma unroll
            for (int kb = 0; kb < 2; ++kb)
#pragma unroll
                for (int s = 0; s < 6; ++s) kf[kb][s] = *(const LAS bf16x8*)(kb_ + s * 2048 + kb * 512);
            __builtin_amdgcn_sched_barrier(0);
#pragma unroll
            for (int kb = 0; kb < 2; ++kb) { f32x16 a = {};
#pragma unroll
                for (int s = 0; s < 6; ++s) a = __builtin_amdgcn_mfma_f32_32x32x16_bf16(kf[kb][s], qf[s], a, 0, 0, 0);
                sc[kb] = a; }
            __builtin_amdgcn_sched_barrier(0);
#pragma unroll
            for (int i = 0; i < 8; ++i) { const LAS unsigned char* vr = vb_ + (i & 1) * 4096 + (i >> 2) * 2048 + ((i >> 1) & 1) * 1024; vlo[i] = lds_tr16(vr); vhi[i] = lds_tr16(vr + 512); }
            __builtin_amdgcn_sched_barrier(0);
            float mx = fmaxf(fmaxf(sc[0][0], sc[0][1]), sc[1][0]);
#pragma unroll
            for (int r = 2; r < 16; r += 2) mx = fmaxf(fmaxf(mx, sc[0][r]), sc[0][r + 1]);
#pragma unroll
            for (int r = 1; r < 15; r += 2) mx = fmaxf(fmaxf(mx, sc[1][r]), sc[1][r + 1]);
            mx = fmaxf(mx, sc[1][15]);
            mx = fmaxf(mx, shflx(mx, 32, lane));
            if (__any(mx > mrun + 8.0f)) { const float mnew = fmaxf(mrun, mx), alpha = fast_exp2(mrun - mnew); mrun = mnew; lrun *= alpha;
#pragma unroll
                for (int r = 0; r < 16; ++r) { o0[r] *= alpha; o1[r] *= alpha; } }
            float ls = 0.f; unsigned pw[2][8];
#pragma unroll
            for (int kb = 0; kb < 2; ++kb)
#pragma unroll
                for (int r = 0; r < 16; r += 2) { const float e0 = fast_exp2(sc[kb][r] - mrun), e1 = fast_exp2(sc[kb][r + 1] - mrun); pw[kb][r >> 1] = pk2(e0, e1); ls += e0 + e1; }
            lrun += ls;
#pragma unroll
            for (int kb = 0; kb < 2; ++kb)
#pragma unroll
                for (int s2 = 0; s2 < 2; ++s2) {
                    const bf16x8 pf = __builtin_bit_cast(bf16x8, (u32x4){pw[kb][4 * s2 + 0], pw[kb][4 * s2 + 1], pw[kb][4 * s2 + 2], pw[kb][4 * s2 + 3]});
#pragma unroll
                    for (int db = 0; db < 2; ++db) { const int i = 4 * kb + 2 * s2 + db;
                        const bf16x8 vf = (bf16x8){vlo[i][0], vlo[i][1], vlo[i][2], vlo[i][3], vhi[i][0], vhi[i][1], vhi[i][2], vhi[i][3]};
                        if (db == 0) o0 = __builtin_amdgcn_mfma_f32_32x32x16_bf16(vf, pf, o0, 0, 0, 0); else o1 = __builtin_amdgcn_mfma_f32_32x32x16_bf16(vf, pf, o1, 0, 0, 0); } }
          }
        }
        if (pre) { LAS unsigned char* nk = lds + ((st + 1) & 1) * MLA_KBUF; LAS unsigned char* nv = lds + ((st + 1) & 1) * MLA_VBUF;
#pragma unroll
            for (int i = 0; i < 3; ++i) *(LAS u32x4*)(nk + kdst[i]) = sk[i];
#pragma unroll
            for (int i = 0; i < 2; ++i) *(LAS u32x4*)(nv + vdst[i]) = sv[i]; }
        __syncthreads();
    }
    lrun += shflx(lrun, 32, lane);
    const float inv = 1.0f / lrun;
    bf16_t* yo = (bf16_t*)(p.ws + WS_YCAT) + (rowb + q0 + r32) * 1024 + h * 64;
#pragma unroll
    for (int g = 0; g < 4; ++g) { u32x2 w0, w1; w0.x = pk2(o0[4 * g] * inv, o0[4 * g + 1] * inv); w0.y = pk2(o0[4 * g + 2] * inv, o0[4 * g + 3] * inv);
        w1.x = pk2(o1[4 * g] * inv, o1[4 * g + 1] * inv); w1.y = pk2(o1[4 * g + 2] * inv, o1[4 * g + 3] * inv);
        *(u32x2*)(yo + 8 * g + 4 * hi) = w0; *(u32x2*)(yo + 32 + 8 * g + 4 * hi) = w1; }
}

constexpr int XA_KB = 32768, XA_BUF = 65536;
__device__ __forceinline__ void xattn_range(const Params& p, LAS unsigned char* lds, int u0, int nu, int tid, unsigned long long* tacc = nullptr) {
    const int lane = tid & 63, wid = __builtin_amdgcn_readfirstlane(tid >> 6), fr = lane & 15, fq = lane >> 4;
    const bf16_t* XQ = (const bf16_t*)(p.ws + WS_XQ); const bf16_t* KM = (const bf16_t*)(p.ws + WS_KM); const bf16_t* VMT = (const bf16_t*)(p.ws + WS_VMT); bf16_t* OX = (bf16_t*)(p.ws + WS_OX);
    const int kpos0 = 8 * wid + (lane >> 5);
    const int vrow = 32 * wid + (lane >> 3), vslot = (lane & 7) ^ (vrow & 7);
    const int vsrc = vrow * 256 + vslot * 8;
    const int nstep = nu * 4;
#define XA_DMA(step) do { const int un_ = u0 + ((step) >> 2), t_ = (step) & 3, z_ = un_ >> 4; \
        const bf16_t* kp_ = KM + ((size_t)((z_ >> 2) * 256 + 64 * t_)) * 1024 + (z_ & 3) * 256; const bf16_t* vp_ = VMT + (size_t)z_ * 65536 + 64 * t_ + vsrc; \
        LAS unsigned char* nb_ = lds + ((step) & 1) * XA_BUF + wid * 4096; \
        _Pragma("unroll") for (int i_ = 0; i_ < 4; ++i_) { const int pos_ = kpos0 + 2 * i_; const int key_ = (pos_ & 32) + 8 * ((pos_ >> 2) & 3) + 4 * ((pos_ >> 4) & 1) + (pos_ & 3); \
            __builtin_amdgcn_global_load_lds((const unsigned*)(kp_ + key_ * 1024 + (((lane & 31) ^ (pos_ & 15)) << 3)), (LAS unsigned*)(nb_ + i_ * 1024), 16, 0, 0); \
            __builtin_amdgcn_global_load_lds((const unsigned*)(vp_ + i_ * 8 * 256), (LAS unsigned*)(nb_ + XA_KB + i_ * 1024), 16, 0, 0); } } while (0)
    XA_DMA(0);
    bf16x8 qf[8]; f32x4 oacc[16]; float mrun = -1.0e30f, lrun = 0.f;
    { const int z = u0 >> 4; const size_t qrow = (size_t)(z >> 2) * 2048 + (u0 & 15) * 128 + wid * 16 + fr;
#pragma unroll
      for (int ks = 0; ks < 8; ++ks) qf[ks] = *(const bf16x8*)(XQ + qrow * 1024 + (z & 3) * 256 + 32 * ks + 8 * fq); }
    __syncthreads();
    for (int step = 0; step < nstep; ++step) {
        const int t = step & 3, un = u0 + (step >> 2), z = un >> 4, b = z >> 2, h = z & 3;
        const size_t qrow = (size_t)b * 2048 + (un & 15) * 128 + wid * 16 + fr;
        if (t == 0) {
#pragma unroll
            for (int db = 0; db < 16; ++db) oacc[db] = (f32x4){0.f, 0.f, 0.f, 0.f};
            mrun = -1.0e30f; lrun = 0.f; }
        if (step + 1 < nstep) XA_DMA(step + 1);
        { const LAS unsigned char* kb = lds + (step & 1) * XA_BUF; const LAS unsigned char* vb = kb + XA_KB;
          f32x4 sacc[4]; bf16x8 kfa[8], kfb[8];
#define XA_LDK(dst, kvb) do { _Pragma("unroll") for (int ks = 0; ks < 8; ++ks) dst[ks] = *(const LAS bf16x8*)(kb + (16 * (kvb) + fr) * 512 + (((4 * ks + fq) ^ fr) << 4)); } while (0)
#define XA_QK(src, kvb) do { f32x4 a_ = {0.f, 0.f, 0.f, 0.f}; _Pragma("unroll") for (int ks = 0; ks < 8; ++ks) a_ = __builtin_amdgcn_mfma_f32_16x16x32_bf16(src[ks], qf[ks], a_, 0, 0, 0); sacc[kvb] = a_; } while (0)
          XA_LDK(kfa, 0); XA_LDK(kfb, 1); __builtin_amdgcn_sched_barrier(0);
          XA_QK(kfa, 0); XA_LDK(kfa, 2); __builtin_amdgcn_sched_barrier(0);
          XA_QK(kfb, 1); XA_LDK(kfb, 3); __builtin_amdgcn_sched_barrier(0);
          XA_QK(kfa, 2); __builtin_amdgcn_sched_barrier(0);
          XA_QK(kfb, 3);
#undef XA_LDK
#undef XA_QK
          float mx = fmaxf(fmaxf(sacc[0][0], sacc[0][1]), fmaxf(sacc[0][2], sacc[0][3]));
#pragma unroll
          for (int kvb = 1; kvb < 4; ++kvb) { mx = fmaxf(fmaxf(mx, sacc[kvb][0]), sacc[kvb][1]); mx = fmaxf(fmaxf(mx, sacc[kvb][2]), sacc[kvb][3]); }
          mx = fmaxf(mx, shflx(mx, 16, fr + 16 * fq)); mx = fmaxf(mx, shflx(mx, 32, fr + 16 * fq));
          if (__any(mx > mrun + 8.0f)) { const float mnew = fmaxf(mrun, mx), alpha = fast_exp2(mrun - mnew); mrun = mnew; lrun *= alpha;
#pragma unroll
              for (int db = 0; db < 16; ++db) oacc[db] = oacc[db] * alpha; }
          float ls = 0.f; u32x4 pw[2];
#pragma unroll
          for (int s2 = 0; s2 < 2; ++s2) { unsigned w[4];
#pragma unroll
              for (int hh = 0; hh < 2; ++hh)
#pragma unroll
                  for (int jj = 0; jj < 2; ++jj) { const float e0 = fast_exp2(sacc[2 * s2 + hh][2 * jj] - mrun), e1 = fast_exp2(sacc[2 * s2 + hh][2 * jj + 1] - mrun); w[2 * hh + jj] = pk2(e0, e1); ls += e0 + e1; }
              pw[s2] = (u32x4){w[0], w[1], w[2], w[3]}; }
          lrun += ls;
          { bf16x8 vfa[8], vfb[8];
#define XA_LDV(dst, s2, d0) do { _Pragma("unroll") for (int i = 0; i < 8; ++i) dst[i] = *(const LAS bf16x8*)(vb + (16 * ((d0) + i) + fr) * 128 + (((4 * (s2) + fq) ^ (fr & 7)) << 4)); } while (0)
#define XA_PV(src, s2, d0) do { const bf16x8 pf_ = __builtin_bit_cast(bf16x8, pw[s2]); _Pragma("unroll") for (int i = 0; i < 8; ++i) oacc[(d0) + i] = __builtin_amdgcn_mfma_f32_16x16x32_bf16(src[i], pf_, oacc[(d0) + i], 0, 0, 0); } while (0)
            XA_LDV(vfa, 0, 0); XA_LDV(vfb, 0, 8); __builtin_amdgcn_sched_barrier(0);
            XA_PV(vfa, 0, 0); XA_LDV(vfa, 1, 0); __builtin_amdgcn_sched_barrier(0);
            XA_PV(vfb, 0, 8); XA_LDV(vfb, 1, 8); __builtin_amdgcn_sched_barrier(0);
            XA_PV(vfa, 1, 0); __builtin_amdgcn_sched_barrier(0);
            XA_PV(vfb, 1, 8);
#undef XA_LDV
#undef XA_PV
          } }
        if (t == 3) { float lt = lrun; lt += shflx(lt, 16, lane); lt += shflx(lt, 32, lane); const float inv = 1.0f / lt;
            int t3; asm volatile("v_mbcnt_lo_u32_b32 %0, -1, 0\n\tv_mbcnt_hi_u32_b32 %0, -1, %0" : "=v"(t3)); t3 += wid << 6;
            const size_t qrow3 = (size_t)b * 2048 + (un & 15) * 128 + (t3 >> 6) * 16 + (t3 & 15);
            bf16_t* orow = OX + qrow3 * 1024 + h * 256 + 4 * ((t3 >> 4) & 3);
#pragma unroll
            for (int db = 0; db < 16; ++db) { const f32x4 v = oacc[db] * inv; u32x2 w; w.x = pk2(v[0], v[1]); w.y = pk2(v[2], v[3]); *(u32x2*)(orow + 16 * db) = w; }
            if (step + 1 < nstep) { const int un2 = un + 1, z2 = un2 >> 4; const size_t qr2 = (size_t)(z2 >> 2) * 2048 + (un2 & 15) * 128 + wid * 16 + fr;
#pragma unroll
                for (int ks = 0; ks < 8; ++ks) qf[ks] = *(const bf16x8*)(XQ + qr2 * 1024 + (z2 & 3) * 256 + 32 * ks + 8 * fq); } }
#if PROBE_XA
        const unsigned long long tb0_ = __builtin_amdgcn_s_memrealtime();
#endif
        __syncthreads();
#if PROBE_XA
        if (tacc) *tacc += __builtin_amdgcn_s_memrealtime() - tb0_;
#endif
    }
#undef XA_DMA
}

__device__ __forceinline__ void conv_unit(const Params& p, LAS unsigned char* lds, int unit, int tid) {
    const int lane = tid & 63, wid = tid >> 6, c = tid;
    const int b = unit >> 5, t0 = (unit & 31) * 64;
    LAS float* cl = (LAS float*)lds;
    LAS float* wl = (LAS float*)(lds + 65536);
    const __amdgpu_buffer_rsrc_t wr_ = __builtin_amdgcn_make_buffer_rsrc((void*)p.w_dw, 0, 31 * 512 * 4, 0x00020000);
#pragma unroll
    for (int j = 0; j < 31; ++j) wl[j * 512 + c] = __uint_as_float(__builtin_amdgcn_raw_buffer_load_b32(wr_, c * 4, j * 2048, 0));
    const __amdgpu_buffer_rsrc_t zr = __builtin_amdgcn_make_buffer_rsrc((void*)(p.ws + WS_Z), 0, (int)((size_t)NTOK * 512 * 2), 0x00020000);
    float z[94];
#define CV_BATCH(i0, n) do { unsigned short raw_[n]; \
        _Pragma("unroll") for (int i_ = 0; i_ < (n); ++i_) { const int t_ = t0 - 30 + (i0) + i_; const int tc_ = t_ < 0 ? 0 : t_; raw_[i_] = __builtin_amdgcn_raw_buffer_load_b16(zr, c * 2, (b * SEQ + tc_) * 1024, 0); } \
        __builtin_amdgcn_sched_barrier(0); \
        _Pragma("unroll") for (int i_ = 0; i_ < (n); ++i_) { const int t_ = t0 - 30 + (i0) + i_; z[(i0) + i_] = t_ < 0 ? 0.f : bf2f(raw_[i_]); } \
        __builtin_amdgcn_sched_barrier(0); } while (0)
    CV_BATCH(0, 32); CV_BATCH(32, 32); CV_BATCH(64, 30);
#undef CV_BATCH
    const float bias = p.b_dw[c];
    const f32x4 g0 = *(const f32x4*)(p.g_cln + lane * 8), g1 = *(const f32x4*)(p.g_cln + lane * 8 + 4), b0 = *(const f32x4*)(p.b_cln + lane * 8), b1 = *(const f32x4*)(p.b_cln + lane * 8 + 4);
#pragma unroll
    for (int ps = 0; ps < 2; ++ps) {
        float acc[32];
#pragma unroll
        for (int o = 0; o < 32; ++o) acc[o] = bias;
#pragma unroll
        for (int j = 0; j < 31; ++j) { const float wj = wl[j * 512 + c];
#pragma unroll
            for (int o = 0; o < 32; ++o) acc[o] += wj * z[32 * ps + o + j]; }
#pragma unroll
        for (int o = 0; o < 32; ++o) cl[o * 512 + c] = acc[o];
        __syncthreads();
#pragma unroll
        for (int oo = 0; oo < 4; ++oo) { const int o = wid * 4 + oo; const LAS float* r = cl + o * 512 + lane * 8;
            const f32x4 v0 = *(const LAS f32x4*)r, v1 = *(const LAS f32x4*)(r + 4);
            float s = (v0[0] + v0[1]) + (v0[2] + v0[3]) + (v1[0] + v1[1]) + (v1[2] + v1[3]); s = wave_sum(s, lane); const float mu = s * (1.0f / 512.0f);
            const f32x4 d0 = v0 - mu, d1 = v1 - mu; float q = (d0[0] * d0[0] + d0[1] * d0[1]) + (d0[2] * d0[2] + d0[3] * d0[3]) + (d1[0] * d1[0] + d1[1] * d1[1]) + (d1[2] * d1[2] + d1[3] * d1[3]);
            q = wave_sum(q, lane); const float rstd = 1.0f / sqrtf(q * (1.0f / 512.0f) + EPS);
            float y[8];
#pragma unroll
            for (int j = 0; j < 4; ++j) { const float a0 = d0[j] * rstd * g0[j] + b0[j], a1 = d1[j] * rstd * g1[j] + b1[j]; y[j] = a0 * sigmoidf_(a0); y[4 + j] = a1 * sigmoidf_(a1); }
            u32x4 wv; wv.x = pk2(y[0], y[1]); wv.y = pk2(y[2], y[3]); wv.z = pk2(y[4], y[5]); wv.w = pk2(y[6], y[7]);
            *(u32x4*)((bf16_t*)(p.ws + WS_YCAT) + ((size_t)b * SEQ + t0 + 32 * ps + o) * 1024 + 512 + lane * 8) = wv; }
        __syncthreads();
    }
}

constexpr int R1_LD = 2064;
constexpr int R1_LG = 2 * 32 * R1_LD;
__device__ __forceinline__ void router1_stage_weights(const Params& p, LAS unsigned char* lds, int tid) {
    const u32x4* W = (const u32x4*)(p.ws + WS_WR);
#pragma unroll 4
    for (int i = tid; i < 64 * 128; i += 512) { const int row = i >> 7, c = i & 127; *(LAS u32x4*)(lds + row * R1_LD + c * 16) = W[i]; }
    __syncthreads();
}
__device__ __forceinline__ void router1_unit(const Params& p, LAS unsigned char* lds, int unit, int tid) {
    const int lane = tid & 63, wid = tid >> 6, r = lane & 15, q = lane >> 4;
    LAS float* lg = (LAS float*)(lds + R1_LG) + wid * 512;
    LAS int* hist = (LAS int*)(lds + R1_LG + 16384);
    if (tid < 32) hist[tid] = 0;
    __syncthreads();
    const int tok0 = unit * RT_TOK + wid * 16;
    const bf16_t* xr = (const bf16_t*)(p.ws + WS_X2B) + (size_t)(tok0 + r) * 1024 + 8 * q;
    const LAS unsigned char* wh0 = lds + r * R1_LD + 16 * q;
    u32x4 xw[32];
#pragma unroll
    for (int ks = 0; ks < 32; ++ks) xw[ks] = *(const u32x4*)(xr + 32 * ks);
    f32x4 acc0 = {0.f, 0.f, 0.f, 0.f}, acc1 = {0.f, 0.f, 0.f, 0.f}; float ssq = 0.f;
#pragma unroll
    for (int ks = 0; ks < 32; ++ks) {
        const u32x4 w = xw[ks];
        { const float a0 = __uint_as_float(w.x << 16), a1 = __uint_as_float(w.x & 0xffff0000u), a2 = __uint_as_float(w.y << 16), a3 = __uint_as_float(w.y & 0xffff0000u);
          const float a4 = __uint_as_float(w.z << 16), a5 = __uint_as_float(w.z & 0xffff0000u), a6 = __uint_as_float(w.w << 16), a7 = __uint_as_float(w.w & 0xffff0000u);
          ssq += (a0 * a0 + a1 * a1) + (a2 * a2 + a3 * a3) + (a4 * a4 + a5 * a5) + (a6 * a6 + a7 * a7); }
        const bf16x8 ah = __builtin_bit_cast(bf16x8, w);
        const bf16x8 bh0 = *(const LAS bf16x8*)(wh0 + 64 * ks), bh1 = *(const LAS bf16x8*)(wh0 + 16 * R1_LD + 64 * ks);
        const bf16x8 bl0 = *(const LAS bf16x8*)(wh0 + 32 * R1_LD + 64 * ks), bl1 = *(const LAS bf16x8*)(wh0 + 48 * R1_LD + 64 * ks);
        acc0 = __builtin_amdgcn_mfma_f32_16x16x32_bf16(ah, bh0, acc0, 0, 0, 0); acc1 = __builtin_amdgcn_mfma_f32_16x16x32_bf16(ah, bh1, acc1, 0, 0, 0);
        acc0 = __builtin_amdgcn_mfma_f32_16x16x32_bf16(ah, bl0, acc0, 0, 0, 0); acc1 = __builtin_amdgcn_mfma_f32_16x16x32_bf16(ah, bl1, acc1, 0, 0, 0);
    }
    ssq += shflx(ssq, 16, lane); ssq += shflx(ssq, 32, lane);
    const float rstd_r = 1.0f / sqrtf(ssq * (1.0f / 1024.0f) + EPS);
    if (lane < 16) ((float*)(p.ws + WS_RSTD_X2))[tok0 + lane] = rstd_r;
    const float be0 = p.b_router[r], be1 = p.b_router[16 + r];
#pragma unroll
    for (int j = 0; j < 4; ++j) { const float rs = shfli(rstd_r, 4 * q + j); lg[(4 * q + j) * 32 + r] = acc0[j] * rs + be0; lg[(4 * q + j) * 32 + 16 + r] = acc1[j] * rs + be1; }
    asm volatile("s_waitcnt lgkmcnt(0)" ::: "memory");
    if (lane < 16) { const int tk = tok0 + lane; unsigned used = 0u; float tv[4]; int ti[4];
#pragma unroll
        for (int k = 0; k < 4; ++k) { float best = -3.0e38f; int bi = 0;
            for (int j = 0; j < 32; ++j) { const float v = lg[lane * 32 + j]; if (!((used >> j) & 1u) && v > best) { best = v; bi = j; } }
            used |= 1u << bi; tv[k] = best; ti[k] = bi; }
        const float e1 = __expf(tv[1] - tv[0]), e2 = __expf(tv[2] - tv[0]), e3 = __expf(tv[3] - tv[0]); const float inv = 1.0f / (1.0f + e1 + e2 + e3);
        int* oi = (int*)(p.ws + WS_TOPI) + (size_t)tk * 4; float* og = (float*)(p.ws + WS_TOPG) + (size_t)tk * 4;
        oi[0] = ti[0]; oi[1] = ti[1]; oi[2] = ti[2]; oi[3] = ti[3]; og[0] = inv; og[1] = e1 * inv; og[2] = e2 * inv; og[3] = e3 * inv;
#pragma unroll
        for (int k = 0; k < 4; ++k) atomicAdd((int*)&hist[ti[k]], 1); }
    __syncthreads();
    if (tid < 32) ((int*)(p.ws + WS_HIST))[unit * 32 + tid] = hist[tid];
    __syncthreads();
}
__device__ __forceinline__ void router2_unit(const Params& p, LAS unsigned char* lds, int unit, int tid) {
    const int lane = tid & 63, wid = tid >> 6;
    LAS int* cnt = (LAS int*)lds;
    LAS int* base = cnt + 32;
    LAS int* pst = cnt + 64;
    LAS int* part = cnt + 128;
    LAS int* wcnt = cnt + 128 + 1024;
    const int* H = (const int*)(p.ws + WS_HIST);
    { const int e = tid & 31, pt = tid >> 5; int tot = 0, bs = 0;
#pragma unroll 4
      for (int j = 0; j < 16; ++j) { const int bq = pt * 16 + j; const int v = H[bq * 32 + e]; tot += v; bs += (bq < unit) ? v : 0; }
      part[pt * 64 + e] = tot; part[pt * 64 + 32 + e] = bs; }
    const int my_e = ((const int*)(p.ws + WS_TOPI))[(size_t)unit * RT_TOK * 4 + tid];
    int my_rank = 0;
#pragma unroll 4
    for (int e = 0; e < 32; ++e) { const unsigned long long m = __ballot(my_e == e); if (my_e == e) my_rank = __popcll(m & ((1ull << lane) - 1ull)); if (lane == 0) wcnt[wid * 32 + e] = __popcll(m); }
    __syncthreads();
    if (tid < 32) { int tot = 0, bs = 0;
#pragma unroll
        for (int pt = 0; pt < 16; ++pt) { tot += part[pt * 64 + tid]; bs += part[pt * 64 + 32 + tid]; }
        cnt[tid] = tot; base[tid] = bs; }
    __syncthreads();
    if (tid == 0) { int sacc = 0; for (int e = 0; e < 32; ++e) { pst[e] = sacc; sacc += (cnt[e] + 255) & ~255; } pst[32] = sacc; }
    __syncthreads();
    { int woff = 0;
#pragma unroll
      for (int w = 0; w < 8; ++w) woff += (w < wid) ? wcnt[w * 32 + my_e] : 0;
      const int d = pst[my_e] + base[my_e] + woff + my_rank; const int tok = unit * RT_TOK + (tid >> 2);
      ((int*)(p.ws + WS_SLOT_TOK))[d] = tok; ((float*)(p.ws + WS_SLOT_GATE))[d] = ((const float*)(p.ws + WS_TOPG))[(size_t)unit * RT_TOK * 4 + tid];
      ((int*)(p.ws + WS_INV))[(size_t)unit * RT_TOK * 4 + tid] = d; ((float*)(p.ws + WS_SLOT_RS))[d] = ((const float*)(p.ws + WS_RSTD_X2))[tok]; }
    if (unit < 32) { const int e = unit, s0 = pst[e] + cnt[e], s1 = pst[e + 1];
        for (int s = s0 + tid; s < s1; s += 512) { ((int*)(p.ws + WS_SLOT_TOK))[s] = 0; ((float*)(p.ws + WS_SLOT_GATE))[s] = 0.f; ((float*)(p.ws + WS_SLOT_RS))[s] = 0.f; } }
    if (unit == 32) { int* te = (int*)(p.ws + WS_TILE_E); const int nt = pst[32] >> 8;
        for (int t = tid; t < NTILE_MAX; t += 512) { int e = 31; for (int k = 31; k >= 0; --k) if (t * 256 < pst[k + 1]) e = k; te[t] = e; }
        if (tid == 0) te[NTILE_MAX] = nt; }
    __syncthreads();
}

struct FinalRows { u32x2 x[4]; u32x2 y[4][4]; };
__device__ __forceinline__ void final_load(const Params& p, int tok, int i0, int i1, int i2, int i3, FinalRows& r, int lane) {
    const u32x2* x2 = (const u32x2*)((const bf16_t*)(p.ws + WS_X2B) + (size_t)tok * 1024); const bf16_t* YB = (const bf16_t*)(p.ws + WS_YB);
    const u32x2* y0 = (const u32x2*)(YB + (size_t)i0 * 1024); const u32x2* y1 = (const u32x2*)(YB + (size_t)i1 * 1024); const u32x2* y2 = (const u32x2*)(YB + (size_t)i2 * 1024); const u32x2* y3 = (const u32x2*)(YB + (size_t)i3 * 1024);
#pragma unroll
    for (int j = 0; j < 4; ++j) { r.x[j] = x2[lane + 64 * j]; r.y[0][j] = y0[lane + 64 * j]; r.y[1][j] = y1[lane + 64 * j]; r.y[2][j] = y2[lane + 64 * j]; r.y[3][j] = y3[lane + 64 * j]; }
}
__device__ __forceinline__ void final_stage(const Params& p, int gw, int ngw, int lane) {
    if (gw >= NTOK) return;
    const int* INV = (const int*)(p.ws + WS_INV);
    FinalRows cur, nxt; int tok = gw;
    { const int* iv = INV + (size_t)tok * 4; final_load(p, tok, iv[0], iv[1], iv[2], iv[3], cur, lane); }
    int n0 = 0, n1 = 0, n2 = 0, n3 = 0;
    if (tok + ngw < NTOK) { const int* iv = INV + (size_t)(tok + ngw) * 4; n0 = iv[0]; n1 = iv[1]; n2 = iv[2]; n3 = iv[3]; }
    const f32x4 g0 = ((const f32x4*)p.g_final)[lane], g1 = ((const f32x4*)p.g_final)[lane + 64], g2 = ((const f32x4*)p.g_final)[lane + 128], g3 = ((const f32x4*)p.g_final)[lane + 192];
    for (; tok < NTOK; tok += ngw) {
        const int tn = tok + ngw;
        if (tn < NTOK) { final_load(p, tn, n0, n1, n2, n3, nxt, lane);
            if (tn + ngw < NTOK) { const int* iv = INV + (size_t)(tn + ngw) * 4; n0 = iv[0]; n1 = iv[1]; n2 = iv[2]; n3 = iv[3]; } }
        f32x4 v[4];
#pragma unroll
        for (int j = 0; j < 4; ++j) { const u32x2 w = cur.x[j]; v[j][0] = __uint_as_float(w.x << 16); v[j][1] = __uint_as_float(w.x & 0xffff0000u); v[j][2] = __uint_as_float(w.y << 16); v[j][3] = __uint_as_float(w.y & 0xffff0000u); }
#pragma unroll
        for (int k = 0; k < 4; ++k)
#pragma unroll
            for (int j = 0; j < 4; ++j) { const u32x2 w = cur.y[k][j]; v[j][0] += __uint_as_float(w.x << 16); v[j][1] += __uint_as_float(w.x & 0xffff0000u); v[j][2] += __uint_as_float(w.y << 16); v[j][3] += __uint_as_float(w.y & 0xffff0000u); }
        float s = 0.f;
#pragma unroll
        for (int j = 0; j < 4; ++j) s += (v[j][0] * v[j][0] + v[j][1] * v[j][1]) + (v[j][2] * v[j][2] + v[j][3] * v[j][3]);
        s = wave_sum(s, lane); const float rstd = 1.0f / sqrtf(s * (1.0f / 1024.0f) + EPS);
        f32x4* xr = (f32x4*)(p.out + (size_t)tok * 1024);
        xr[lane] = v[0] * rstd * g0; xr[lane + 64] = v[1] * rstd * g1; xr[lane + 128] = v[2] * rstd * g2; xr[lane + 192] = v[3] * rstd * g3;
        cur = nxt;
    }
}

#define XB_TMO      128
#define XB_XCNT(j)  (256  + 64 * (j))
#define XB_XSUB(j)  (1280 + 64 * (j))
#define XB_XGEN(j)  (2304 + 64 * (j))
#define XB_TOP      3328
#define XB_TOPGEN   3392
#define XCD_BAR_WORDS 3456
constexpr int CW_MLAQ = 4096;
#define XB_SPIN_CAP (1u << 18)
__device__ __forceinline__ unsigned xb_ld(unsigned* p)              { return __hip_atomic_load(p, __ATOMIC_RELAXED, __HIP_MEMORY_SCOPE_AGENT); }
__device__ __forceinline__ unsigned xb_add(unsigned* p, unsigned v) { return __hip_atomic_fetch_add(p, v, __ATOMIC_RELAXED, __HIP_MEMORY_SCOPE_AGENT); }
__device__ __forceinline__ unsigned xb_xcc_id() { return (unsigned)__builtin_amdgcn_s_getreg((3 << 11) | 20) & 0xFu; }
#define XB_SPIN(cond, bar) do { unsigned _sp = 0; while (cond) { __builtin_amdgcn_s_sleep(1); \
    if ((++_sp & 255u) == 0u) { if (xb_ld(&(bar)[XB_TMO])) break; if (_sp > XB_SPIN_CAP) { atomicAdd(&(bar)[XB_TMO], 1u); break; } } } } while (0)
struct XcdBarrier { unsigned* bar; unsigned x; volatile LAS unsigned* st; };
__device__ __forceinline__ XcdBarrier xcd_barrier_post(unsigned* bar, volatile LAS unsigned* st, bool leader) {
    XcdBarrier b; b.bar = bar; b.x = xb_xcc_id(); b.st = st;
    if (leader) (void)xb_add(&bar[XB_XCNT(b.x)], 1u);
    return b;
}
__device__ __forceinline__ void xcd_barrier_complete(unsigned* bar, unsigned x, unsigned& nloc, unsigned& nx) {
    const unsigned G = gridDim.x * gridDim.y * gridDim.z;
    unsigned sum, cnt, mine, sp = 0u;
    for (;;) {
        sum = 0u; cnt = 0u; mine = 0u;
#pragma unroll
        for (unsigned j = 0; j < 16; ++j) { const unsigned c = xb_ld(&bar[XB_XCNT(j)]); sum += c; cnt += (c > 0u) ? 1u : 0u; mine = (j == x) ? c : mine; }
        if (sum == G) break;
        __builtin_amdgcn_s_sleep(1);
        if ((++sp & 255u) == 0u) { if (xb_ld(&bar[XB_TMO])) break; if (sp > XB_SPIN_CAP) { atomicAdd(&bar[XB_TMO], 1u); break; } }
    }
    nloc = mine > 0u ? mine : 1u; nx = cnt > 0u ? cnt : 1u;
}
__device__ __forceinline__ void xcd_barrier(const XcdBarrier& b, bool leader) {
    asm volatile("s_waitcnt vmcnt(0)" ::: "memory");
    __syncthreads();
    if (leader) {
        unsigned* bar = b.bar;
        __builtin_amdgcn_s_waitcnt(0);
        unsigned nloc = b.st[0], nx = b.st[1];
        if (nloc == 0u) { xcd_barrier_complete(bar, b.x, nloc, nx); b.st[0] = nloc; b.st[1] = nx; }
        const unsigned old = xb_add(&bar[XB_XSUB(b.x)], 1u);
        const unsigned gen = old / nloc;
        if (old + 1u == (gen + 1u) * nloc) {
            __builtin_amdgcn_fence(__ATOMIC_RELEASE, "agent");
            asm volatile("s_waitcnt vmcnt(0)" ::: "memory");
            const unsigned og = xb_add(&bar[XB_TOP], 1u);
            const unsigned tg = og / nx;
            if (og + 1u == (tg + 1u) * nx) xb_add(&bar[XB_TOPGEN], 1u);
            else XB_SPIN(xb_ld(&bar[XB_TOPGEN]) == tg, bar);
            __builtin_amdgcn_fence(__ATOMIC_ACQUIRE, "agent");
            xb_add(&bar[XB_XGEN(b.x)], 1u);
            asm volatile("s_waitcnt vmcnt(0)" ::: "memory");
        } else {
            XB_SPIN(xb_ld(&bar[XB_XGEN(b.x)]) == gen, bar);
            __builtin_amdgcn_fence(__ATOMIC_ACQUIRE, "agent");
            asm volatile("s_waitcnt vmcnt(0)" ::: "memory");
        }
    }
    __syncthreads();
}

constexpr int EPI_LDS = 131072;
constexpr int LDS_BYTES = 155648;

#ifndef USE_CG_SYNC
#define USE_CG_SYNC 0
#endif
#if USE_CG_SYNC
#define GRID_SYNC_() grid.sync()
#else
#define GRID_SYNC_() xcd_barrier(xbar, wave_s_ == 0 && __builtin_amdgcn_mbcnt_hi(~0u, __builtin_amdgcn_mbcnt_lo(~0u, 0u)) == 0u)
#endif
#if PROBE_MASK || PROBE_EPI || PROBE_XA || PROBE_SUB
#define GRID_SYNC() do { GRID_SYNC_(); const unsigned long long tn_ = __builtin_amdgcn_s_memrealtime(); if ((PROBE_MASK >> ph_) & 1) tacc_ += tn_ - tprev_; tprev_ = tn_; ++ph_; } while (0)
#else
#define GRID_SYNC() GRID_SYNC_()
#endif
constexpr int XB_LDS = 155520;

__device__ __forceinline__ void mla_order(int vb, int r, int& unit) {
    const int bh = vb >> 1, s = vb & 1; const int qb = (r == 0) ? s : (r == 1) ? 7 - s : (r == 2) ? 3 - s : 4 + s; unit = bh * 8 + qb;
}

#define GAS __attribute__((address_space(1)))
#define FROM_W(f, T, k) p_.f = (T*)(GAS T*)(w_[k])
__device__ __forceinline__ void params_from_words(Params& p_, const unsigned long long (&w_)[29]) {
    FROM_W(x, const float, 0); FROM_W(mem, const float, 1); FROM_W(pos, const int, 2);
    FROM_W(g_mix, const float, 3); FROM_W(w_in, const float, 4); FROM_W(g_q, const float, 5); FROM_W(w_uq, const float, 6); FROM_W(g_kv, const float, 7); FROM_W(w_ukv, const float, 8); FROM_W(w_dw, const float, 9); FROM_W(b_dw, const float, 10);
    FROM_W(g_cln, const float, 11); FROM_W(b_cln, const float, 12); FROM_W(w_out, const float, 13); FROM_W(g_xattn, const float, 14); FROM_W(g_mem, const float, 15); FROM_W(w_xq, const float, 16); FROM_W(w_xkv, const float, 17); FROM_W(w_xo, const float, 18);
    FROM_W(g_ffn, const float, 19); FROM_W(w_router, const float, 20); FROM_W(b_router, const float, 21); FROM_W(w_up, const float, 22); FROM_W(b_up, const float, 23); FROM_W(w_down, const float, 24); FROM_W(b_down, const float, 25); FROM_W(g_final, const float, 26);
    FROM_W(out, float, 27); FROM_W(ws, unsigned char, 28);
}
static_assert(sizeof(Params) == 29 * 8, "Params = 29 pointers");
typedef const __attribute__((address_space(4))) Params* CParams;
#define PHASE_BEGIN() CParams pp_ = (CParams)__builtin_amdgcn_kernarg_segment_ptr(); asm volatile("" : "+s"(pp_)); Params p; { const __attribute__((address_space(4))) unsigned long long* q_ = (const __attribute__((address_space(4))) unsigned long long*)pp_; unsigned long long w_[29]; _Pragma("unroll") for (int k_ = 0; k_ < 29; ++k_) w_[k_] = q_[k_]; params_from_words(p, w_); } unsigned char* ws = p.ws; int tid; asm volatile("v_mbcnt_lo_u32_b32 %0, -1, 0\n\tv_mbcnt_hi_u32_b32 %0, -1, %0" : "=v"(tid)); tid += wave_s_ << 6; const int lane = tid & 63; (void)lane; (void)ws;

__global__ void __launch_bounds__(512) mega_kernel(Params p_unused) {
    extern __shared__ __attribute__((aligned(16))) unsigned char lds_raw[];
#if USE_CG_SYNC
    cg::grid_group grid = cg::this_grid();
#endif
    LAS unsigned char* lds = (LAS unsigned char*)lds_raw;
    const int wave_s_ = __builtin_amdgcn_readfirstlane(threadIdx.x >> 6);
    if (threadIdx.x < 2) ((volatile LAS unsigned*)(lds + XB_LDS))[threadIdx.x] = 0u;
    __syncthreads();
    const XcdBarrier xbar = xcd_barrier_post((unsigned*)(((CParams)__builtin_amdgcn_kernarg_segment_ptr())->ws + WS_CTL), (volatile LAS unsigned*)(lds + XB_LDS), threadIdx.x == 0); (void)xbar;
    const int G = gridDim.x, bx = blockIdx.x;
    const int vb = (G % 8 == 0) ? (bx % 8) * (G / 8) + bx / 8 : bx;

#if PROBE_MASK || PROBE_EPI || PROBE_XA || PROBE_SUB
    unsigned long long tprev_ = __builtin_amdgcn_s_memrealtime(), tacc_ = 0; int ph_ = 0;
#endif
#if PROBE_SUB
    { PHASE_BEGIN(); prep_stage(p, lds, vb, G, tid, tacc_); }
#else
    { unsigned long long dummy_ = 0; PHASE_BEGIN(); prep_stage(p, lds, vb, G, tid, dummy_); }
#endif
    GRID_SYNC();
    { PHASE_BEGIN();
      { PvPlain P{(const bf16_t*)(ws + WS_XB), (const bf16_t*)(ws + WS_WT_IN), 1024, 1024, 1024}; pg8::SchedPlain S; S.o.init(128, 6, G, bx);
        EpiIn E{(bf16_t*)(ws + WS_U), (bf16_t*)(ws + WS_Z), (const float*)(ws + WS_RSTD_X), (float*)(ws + WS_SSQ_Q), (float*)(ws + WS_SSQ_KV), (const float*)(ws + WS_ROPE), (bf16_t*)(ws + WS_KB)};
        pg8::gemm_phase<true, false, false>(lds, lds + EPI_LDS, P, S, E, tid); }
 }
    GRID_SYNC();
    { PHASE_BEGIN();
      SUB_T0(4);
      { PvPlain P{(const bf16_t*)(ws + WS_U), (const bf16_t*)(ws + WS_WT_UQ), ULD, 256, 256}; pg8::SchedPlain S; S.o.init(128, 3, G, bx);
        EpiQ E{(bf16_t*)(ws + WS_Q), (const float*)(ws + WS_SSQ_Q), (const float*)(ws + WS_ROPE)};
        pg8::gemm_phase<false, false, false>(lds, lds + EPI_LDS, P, S, E, tid); }
      { PvPlain P{(const bf16_t*)(ws + WS_MEMB), (const bf16_t*)(ws + WS_WT_XKV), 1024, 1024, 1024}; pg8::SchedPlain S; S.o.init(16, 8, G, (bx + 128) % G);
        EpiKVMem E{(bf16_t*)(ws + WS_KM), (bf16_t*)(ws + WS_VMT), (const float*)(ws + WS_RSTD_MEM)};
        pg8::gemm_phase<false, false, false>(lds, lds + EPI_LDS, P, S, E, tid); }
      SUB_T1(4, tacc_);
      SUB_T0(5);
      { PvPlain P{(const bf16_t*)(ws + WS_U) + 256, (const bf16_t*)(ws + WS_WT_UKV), ULD, 128, 128}; pg8::SchedPlain S; S.o.init(128, 4, G, (bx + 128) % G);
        EpiKV E{(bf16_t*)(ws + WS_KB), (bf16_t*)(ws + WS_VB), (const float*)(ws + WS_SSQ_KV)};
        pg8::gemm_phase<true, false, false>(lds, lds + EPI_LDS, P, S, E, tid); }
      SUB_T1(5, tacc_);
      SUB_T0(6);
      { int tid2; asm volatile("v_mbcnt_lo_u32_b32 %0, -1, 0\n\tv_mbcnt_hi_u32_b32 %0, -1, %0" : "=v"(tid2)); tid2 += wave_s_ << 6; for (int i = vb; i < 512; i += G) conv_unit(p, lds, i, tid2); }
      SUB_T1(6, tacc_); }
    GRID_SYNC();
    { PHASE_BEGIN();
      if (G == 256) {
        const int xq_ = bx & 7, ix_ = bx >> 3;
        if (ix_ < 30 && (ix_ % 3) == 0) moe_weights_stage(p, lds, xq_ * 10 + ix_ / 3, 80, tid);
        else { unsigned* qh = (unsigned*)(ws + WS_CTL) + CW_MLAQ + 64 * xq_; LAS int* nxt_ = (LAS int*)(lds + 98304);
          for (;;) { if (tid == 0) *nxt_ = (int)atomicAdd(qh, 1u);
            __syncthreads(); const int il = *nxt_; __syncthreads();
            if (il >= 128) break;
            const int bh = xq_ * 16 + (il >> 3), qb = 7 - (il & 7); mla_unit(p, lds, bh * 8 + qb, tid); } } }
      else { if (vb == 0) { } moe_weights_stage(p, lds, vb, G, tid); for (int i = vb; i < 1024; i += G) mla_unit(p, lds, i, tid); } }
    GRID_SYNC();
    { PHASE_BEGIN();
      PvPlain P{(const bf16_t*)(ws + WS_YCAT), (const bf16_t*)(ws + WS_WT_OUT), 1024, 1024, 1024}; pg8::SchedPlain S; S.o.init(128, 4, G, bx);
      EpiResid E{(const bf16_t*)(ws + WS_XB), (bf16_t*)(ws + WS_X1B), (float*)(ws + WS_SSQ_X1), nullptr};
      pg8::gemm_phase<true, false, false>(lds, lds + EPI_LDS, P, S, E, tid); }
    GRID_SYNC();
    { PHASE_BEGIN();
      PvPlain P{(const bf16_t*)(ws + WS_X1B), (const bf16_t*)(ws + WS_WT_XQ), 1024, 1024, 1024}; pg8::SchedPlain S; S.o.init(128, 4, G, bx);
      EpiScale16 E{(bf16_t*)(ws + WS_XQ), 1024, (const float*)(ws + WS_SSQ_X1), C2_X};
      pg8::gemm_phase<true, false, false>(lds, lds + EPI_LDS, P, S, E, tid); }
    GRID_SYNC();
    { PHASE_BEGIN();
#if PROBE_XA
      if (G == 256) xattn_range(p, lds, vb * 4, 4, tid, &tacc_);
#else
      if (G == 256) xattn_range(p, lds, vb * 4, 4, tid);
#endif
      else { for (int i = vb; i < 1024; i += G) xattn_range(p, lds, i, 1, tid); } }
    GRID_SYNC();
    { PHASE_BEGIN();
      PvPlain P{(const bf16_t*)(ws + WS_OX), (const bf16_t*)(ws + WS_WT_XO), 1024, 1024, 1024}; pg8::SchedPlain S; S.o.init(128, 4, G, bx);
      EpiResid E{(const bf16_t*)(ws + WS_X1B), (bf16_t*)(ws + WS_X2B), nullptr, ws + WS_X2F};
      pg8::gemm_phase<true, false, false>(lds, lds + EPI_LDS, P, S, E, tid); }
    GRID_SYNC();
    { PHASE_BEGIN(); if (vb < RT_UNITS) router1_stage_weights(p, lds, tid); for (int i = vb; i < RT_UNITS; i += G) router1_unit(p, lds, i, tid); }
    GRID_SYNC();
    { PHASE_BEGIN(); for (int i = vb; i < RT_UNITS; i += G) router2_unit(p, lds, i, tid); }
    GRID_SYNC();
    { PHASE_BEGIN(); const int* te = (const int*)(ws + WS_TILE_E); const int nt = te[NTILE_MAX];
      PvUpG P{(const bf16_t*)(ws + WS_X2F), (const bf16_t*)(ws + WS_WT_UP), te, (const int*)(ws + WS_SLOT_TOK), 512, 512, 512}; pg8::SchedPlain S; S.o.init(nt, 8, G, bx);
      EpiSwiglu E{(bf16_t*)(ws + WS_ACT), (const float*)(ws + WS_SLOT_RS), te, p.b_up};
#if PROBE_EPI
      pg8::gemm_phase<true, true, true>(lds, lds + EPI_LDS, P, S, E, tid, &tacc_);
#else
      pg8::gemm_phase<true, true, true>(lds, lds + EPI_LDS, P, S, E, tid);
#endif
    }
    GRID_SYNC();
    { PHASE_BEGIN(); const int* te = (const int*)(ws + WS_TILE_E); const int nt = te[NTILE_MAX];
      PvExp P{(const bf16_t*)(ws + WS_ACT), (const bf16_t*)(ws + WS_WT_DOWN), te, 512, 512, 512, 1024}; pg8::SchedPlain S; S.o.init(nt, 4, G, bx);
      EpiDown E{(bf16_t*)(ws + WS_YB), (const float*)(ws + WS_SLOT_GATE), te, p.b_down};
      pg8::gemm_phase<true, false, true>(lds, lds + EPI_LDS, P, S, E, tid); }
    GRID_SYNC();
    { PHASE_BEGIN(); const int gw = vb * 8 + (tid >> 6), ngw = G * 8; final_stage(p, gw, ngw, lane); }
#if PROBE_MASK || PROBE_EPI || PROBE_XA || PROBE_SUB
    { const unsigned long long tn_ = __builtin_amdgcn_s_memrealtime(); if ((PROBE_MASK >> ph_) & 1) tacc_ += tn_ - tprev_;
      const unsigned long long t0_ = __builtin_amdgcn_s_memrealtime(); while (__builtin_amdgcn_s_memrealtime() - t0_ < 4ull * tacc_) __builtin_amdgcn_s_sleep(8); }
#endif
}

extern "C" void kernel_launch(void* const* d_in, const int* in_sizes, int n_in, void* d_out, int out_size, void* d_ws, size_t ws_size, hipStream_t stream) {
    static int grid = 0;
    if (grid == 0) {
        if (n_in != 27 || ws_size < WS_END) { fprintf(stderr, "kernel_launch: unexpected inputs (n_in %d, ws %zu)\n", n_in, ws_size); grid = -1; return; }
        int dev = 0, cus = 0, per_cu = 0;
        (void)hipGetDevice(&dev); (void)hipDeviceGetAttribute(&cus, hipDeviceAttributeMultiprocessorCount, dev);
        (void)hipFuncSetAttribute((const void*)mega_kernel, hipFuncAttributeMaxDynamicSharedMemorySize, LDS_BYTES);
        (void)hipOccupancyMaxActiveBlocksPerMultiprocessor(&per_cu, (const void*)mega_kernel, 512, LDS_BYTES);
        if (per_cu < 1) { fprintf(stderr, "kernel_launch: occupancy query says %d blocks per CU\n", per_cu); per_cu = 1; }
        if (per_cu > 1) per_cu = 1;
        grid = cus * per_cu;
        (void)hipGetLastError();
    }
    if (grid < 0) return;
    (void)hipMemsetAsync((char*)d_ws + WS_CTL, 0, 32768, stream);
    Params p{};
    p.x = (const float*)d_in[0]; p.mem = (const float*)d_in[1]; p.pos = (const int*)d_in[2];
    p.g_mix = (const float*)d_in[3]; p.w_in = (const float*)d_in[4]; p.g_q = (const float*)d_in[5]; p.w_uq = (const float*)d_in[6]; p.g_kv = (const float*)d_in[7]; p.w_ukv = (const float*)d_in[8];
    p.w_dw = (const float*)d_in[9]; p.b_dw = (const float*)d_in[10]; p.g_cln = (const float*)d_in[11]; p.b_cln = (const float*)d_in[12]; p.w_out = (const float*)d_in[13];
    p.g_xattn = (const float*)d_in[14]; p.g_mem = (const float*)d_in[15]; p.w_xq = (const float*)d_in[16]; p.w_xkv = (const float*)d_in[17]; p.w_xo = (const float*)d_in[18];
    p.g_ffn = (const float*)d_in[19]; p.w_router = (const float*)d_in[20]; p.b_router = (const float*)d_in[21]; p.w_up = (const float*)d_in[22]; p.b_up = (const float*)d_in[23];
    p.w_down = (const float*)d_in[24]; p.b_down = (const float*)d_in[25]; p.g_final = (const float*)d_in[26];
    p.out = (float*)d_out; p.ws = (unsigned char*)d_ws;
    void* args[] = {&p};
    hipError_t e = hipLaunchCooperativeKernel((const void*)mega_kernel, dim3(grid), dim3(512), args, LDS_BYTES, stream);
    if (e != hipSuccess) fprintf(stderr, "cooperative launch failed: %s (grid %d)\n", hipGetErrorString(e), grid);
}
```

```cpp
#include <hip/hip_runtime.h>
#include <stdint.h>
#include <stdio.h>
#include <hip/hip_cooperative_groups.h>
namespace cg = cooperative_groups;

#ifndef PROBE_MASK
#define PROBE_MASK 0
#endif
#ifndef PROBE_EPI
#define PROBE_EPI 0
#endif
#ifndef PROBE_XA
#define PROBE_XA 0
#endif
#ifndef PROBE_SUB
#define PROBE_SUB 0
#endif
#if PROBE_SUB
#define SUB_T0(id) unsigned long long ts_##id = __builtin_amdgcn_s_memrealtime()
#define SUB_T1(id, acc) do { if (PROBE_SUB == id) { __syncthreads(); (acc) += __builtin_amdgcn_s_memrealtime() - ts_##id; } } while (0)
#else
#define SUB_T0(id)
#define SUB_T1(id, acc)
#endif
#define LAS __attribute__((address_space(3)))
typedef unsigned short bf16_t;
typedef short bf16x8 __attribute__((ext_vector_type(8)));
typedef short s16x4 __attribute__((ext_vector_type(4)));
typedef float f32x2 __attribute__((ext_vector_type(2)));
typedef float f32x4 __attribute__((ext_vector_type(4)));
typedef float f32x16 __attribute__((ext_vector_type(16)));
typedef unsigned u32x2 __attribute__((ext_vector_type(2)));
typedef unsigned u32x4 __attribute__((ext_vector_type(4)));

constexpr int BATCH = 16, SEQ = 2048, NTOK = BATCH * SEQ, DM = 1024;
constexpr int INC = 1440, INP = 1536, ULD = 512;
constexpr int HEADS = 8, QKD = 96, VD = 64;
constexpr int CCH = 512, CW = 31;
constexpr int MEML = 256, NMEM = BATCH * MEML;
constexpr int XH = 4, XD = 256;
constexpr int NE = 32, TOPK = 4;
constexpr int NSLOT = NTOK * TOPK + NE * 256;
constexpr int NTILE_MAX = NSLOT / 256;
constexpr float EPS = 1e-5f;
constexpr float C2_MLA = 0.14724444602590306f;
constexpr float C2_X = 0.09016844005556021f;
constexpr int RT_TOK = 128, RT_UNITS = NTOK / RT_TOK;

constexpr size_t MiB = 1u << 20;
constexpr size_t WS_CTL = 0;
constexpr size_t WS_RSTD_X = 1 * MiB;
constexpr size_t WS_RSTD_Q = WS_RSTD_X + 128 * 1024;
constexpr size_t WS_RSTD_KV = WS_RSTD_Q + 128 * 1024;
constexpr size_t WS_RSTD_X1 = WS_RSTD_KV + 128 * 1024;
constexpr size_t WS_RSTD_X2 = WS_RSTD_X1 + 128 * 1024;
constexpr size_t WS_RSTD_MEM = WS_RSTD_X2 + 128 * 1024;
constexpr size_t WS_ROPE = 2 * MiB;
constexpr size_t WS_TOPI = 6 * MiB;
constexpr size_t WS_TOPG = WS_TOPI + 512 * 1024;
constexpr size_t WS_INV = WS_TOPG + 512 * 1024;
constexpr size_t WS_SLOT_TOK = WS_INV + 512 * 1024;
constexpr size_t WS_SLOT_GATE = WS_SLOT_TOK + 1 * MiB;
constexpr size_t WS_SLOT_RS = 15 * MiB + 256 * 1024;
constexpr size_t WS_HIST = WS_SLOT_GATE + 1 * MiB;
constexpr size_t WS_TILE_E = WS_HIST + 64 * 1024;
constexpr size_t WS_SSQ_Q = 10 * MiB;
constexpr size_t WS_SSQ_KV = 10 * MiB + 512 * 1024;
constexpr size_t WS_SSQ_X1 = 11 * MiB;
constexpr size_t WS_SSQ_X2 = 13 * MiB;
constexpr size_t WS_WR = 15 * MiB;
constexpr size_t WS_WT_IN = 16 * MiB;
constexpr size_t WS_WT_UQ = 19 * MiB;
constexpr size_t WS_WT_UKV = WS_WT_UQ + 512 * 1024;
constexpr size_t WS_WT_OUT = 20 * MiB;
constexpr size_t WS_WT_XQ = 22 * MiB;
constexpr size_t WS_WT_XKV = 24 * MiB;
constexpr size_t WS_WT_XO = 28 * MiB;
constexpr size_t WS_WT_UP = 32 * MiB;
constexpr size_t WS_WT_DOWN = 160 * MiB;
constexpr size_t WS_X2B = 224 * MiB;
constexpr size_t WS_XB = WS_X2B;
constexpr size_t WS_ACT = 288 * MiB;
constexpr size_t WS_X2F = 432 * MiB;
constexpr size_t WS_U = 288 * MiB;
constexpr size_t WS_Z = 320 * MiB;
constexpr size_t WS_Q = 384 * MiB;
constexpr size_t WS_KB = 432 * MiB;
constexpr size_t WS_VB = 480 * MiB;
constexpr size_t WS_YCAT = 512 * MiB;
constexpr size_t WS_YB = 560 * MiB;
constexpr size_t WS_XG = WS_YB;
constexpr size_t WS_X1B = 576 * MiB;
constexpr size_t WS_XQ = 640 * MiB;
constexpr size_t WS_P = 704 * MiB;
constexpr size_t WS_OX = 768 * MiB;
constexpr size_t WS_MEMB = 832 * MiB;
constexpr size_t WS_KM = 840 * MiB;
constexpr size_t WS_VMT = 848 * MiB;
constexpr size_t WS_END = 856 * MiB;

struct Params {
    const float* x; const float* mem; const int* pos;
    const float *g_mix, *w_in, *g_q, *w_uq, *g_kv, *w_ukv, *w_dw, *b_dw, *g_cln, *b_cln, *w_out, *g_xattn, *g_mem, *w_xq, *w_xkv, *w_xo, *g_ffn, *w_router, *b_router, *w_up, *b_up, *w_down, *b_down, *g_final;
    float* out; unsigned char* ws;
};

__device__ __forceinline__ float bf2f(bf16_t b) { return __uint_as_float((unsigned)b << 16); }
__device__ __forceinline__ unsigned f2bf(float f) { unsigned u = __float_as_uint(f); return (u + 0x7fffu + ((u >> 16) & 1u)) >> 16; }
typedef __bf16 bf16x2_t __attribute__((ext_vector_type(2)));
__device__ __forceinline__ unsigned pk2(float lo, float hi) { const f32x2 v = {lo, hi}; const bf16x2_t b = __builtin_convertvector(v, bf16x2_t); return __builtin_bit_cast(unsigned, b); }
__device__ __forceinline__ unsigned pk4_fp8(float a, float b, float c, float d) { int w = __builtin_amdgcn_cvt_pk_fp8_f32(a, b, 0, false); w = __builtin_amdgcn_cvt_pk_fp8_f32(c, d, w, true); return (unsigned)w; }
constexpr float W8_SCALE = 32.0f, W8_INV = 1.0f / 32.0f;
__device__ __forceinline__ float shflx(float v, int m, int lane) { return __int_as_float(__builtin_amdgcn_ds_bpermute((lane ^ m) << 2, __float_as_int(v))); }
__device__ __forceinline__ float shfli(float v, int src) { return __int_as_float(__builtin_amdgcn_ds_bpermute(src << 2, __float_as_int(v))); }
__device__ __forceinline__ float wave_sum(float v, int lane) {
#pragma unroll
    for (int o = 1; o < 64; o <<= 1) v += shflx(v, o, lane);
    return v;
}
__device__ __forceinline__ int perm32(int rho) { const int n = rho >> 4, i = rho & 15; return 8 * (i >> 2) + 4 * n + (i & 3); }
__device__ __forceinline__ float fast_exp2(float x) { return __builtin_amdgcn_exp2f(x); }
__device__ __forceinline__ float sigmoidf_(float x) { return 1.0f / (1.0f + __expf(-x)); }

struct TrDesc { const float* W; const float* g; bf16_t* WT; int N, K, mode, k0, n0; };
__device__ __forceinline__ void tr_load(const TrDesc& d, float (&v)[40], int lane) {
    const float* src = d.W + (size_t)(d.k0 + (lane >> 3)) * d.N + d.n0 + 4 * (lane & 7);
#pragma unroll
    for (int i = 0; i < 8; ++i) { const f32x4 t = *(const f32x4*)(src + (size_t)(8 * i) * d.N); v[4 * i] = t[0]; v[4 * i + 1] = t[1]; v[4 * i + 2] = t[2]; v[4 * i + 3] = t[3]; }
    f32x4 g0 = {1.f, 1.f, 1.f, 1.f}, g1 = {1.f, 1.f, 1.f, 1.f};
    if (d.g) { g0 = *(const f32x4*)(d.g + d.k0 + 8 * (lane & 7)); g1 = *(const f32x4*)(d.g + d.k0 + 8 * (lane & 7) + 4); }
    v[32] = g0[0]; v[33] = g0[1]; v[34] = g0[2]; v[35] = g0[3]; v[36] = g1[0]; v[37] = g1[1]; v[38] = g1[2]; v[39] = g1[3];
}
__device__ __forceinline__ void tr_store(const TrDesc& d, const float (&v)[40], LAS float* scr, int lane) {
#pragma unroll
    for (int i = 0; i < 8; ++i)
#pragma unroll
        for (int e = 0; e < 4; ++e) scr[(8 * i + (lane >> 3)) * 33 + 4 * (lane & 7) + e] = v[4 * i + e];
    asm volatile("s_waitcnt lgkmcnt(0)" ::: "memory");
    const int c = lane & 7;
    const f32x4 g0 = {v[32], v[33], v[34], v[35]}, g1 = {v[36], v[37], v[38], v[39]};
#pragma unroll
    for (int j = 0; j < 4; ++j) { const int n = (lane >> 3) + 8 * j; const LAS float* sp = scr + (8 * c) * 33 + n;
        u32x4 o; o.x = pk2(sp[0 * 33] * g0[0], sp[1 * 33] * g0[1]); o.y = pk2(sp[2 * 33] * g0[2], sp[3 * 33] * g0[3]); o.z = pk2(sp[4 * 33] * g1[0], sp[5 * 33] * g1[1]); o.w = pk2(sp[6 * 33] * g1[2], sp[7 * 33] * g1[3]);
        const int nn = d.n0 + n; int row = nn; if (d.mode == 1 || d.mode == 4) row = (((nn & 1023) >> 7) << 8) + ((nn >> 10) << 7) + (nn & 127);
        if (d.mode == 2 && nn >= 416) { const int c = (nn - 416) & 511, isg = (nn - 416) >> 9; row = 512 + ((c >> 7) << 8) + (isg << 7) + (c & 127); }
        if (d.mode >= 4) { u32x2 o8; o8.x = pk4_fp8(sp[0 * 33] * g0[0] * W8_SCALE, sp[1 * 33] * g0[1] * W8_SCALE, sp[2 * 33] * g0[2] * W8_SCALE, sp[3 * 33] * g0[3] * W8_SCALE);
            o8.y = pk4_fp8(sp[4 * 33] * g1[0] * W8_SCALE, sp[5 * 33] * g1[1] * W8_SCALE, sp[6 * 33] * g1[2] * W8_SCALE, sp[7 * 33] * g1[3] * W8_SCALE);
            *(u32x2*)((unsigned char*)d.WT + (size_t)row * d.K + d.k0 + 8 * c) = o8; }
        else *(u32x4*)(d.WT + (size_t)row * d.K + d.k0 + 8 * c) = o; }
    asm volatile("s_waitcnt lgkmcnt(0)" ::: "memory");
}
__device__ __forceinline__ void rows_bf16_rstd(const float* X, bf16_t* O, float* rstd, int nrows, int gw, int ngw, int lane) {
    if (gw >= nrows) return;
    f32x4 v[4], vn[4];
#pragma unroll
    for (int j = 0; j < 4; ++j) v[j] = ((const f32x4*)(X + (size_t)gw * 1024))[lane + 64 * j];
    for (int m = gw; m < nrows; m += ngw) {
        const int mn = m + ngw;
        if (mn < nrows) {
#pragma unroll
            for (int j = 0; j < 4; ++j) vn[j] = ((const f32x4*)(X + (size_t)mn * 1024))[lane + 64 * j]; }
        float s = 0.f;
#pragma unroll
        for (int j = 0; j < 4; ++j) s += (v[j].x * v[j].x + v[j].y * v[j].y) + (v[j].z * v[j].z + v[j].w * v[j].w);
        s = wave_sum(s, lane);
        if (lane == 0) rstd[m] = 1.0f / sqrtf(s * (1.0f / 1024.0f) + EPS);
#pragma unroll
        for (int j = 0; j < 4; ++j) { u32x2 w; w.x = pk2(v[j].x, v[j].y); w.y = pk2(v[j].z, v[j].w); ((u32x2*)(O + (size_t)m * 1024))[lane + 64 * j] = w; }
#pragma unroll
        for (int j = 0; j < 4; ++j) v[j] = vn[j];
    }
}
__device__ __forceinline__ void sincos_acc(double a, float& s, float& c) {
    const double TWO_PI = 6.283185307179586476925;
    const double n = rint(a * (1.0 / TWO_PI)); const double r = a - n * TWO_PI;
    const double h = 0.5 * r, h2 = h * h;
    const double sh = h * (1.0 + h2 * (-1.0 / 6.0 + h2 * (1.0 / 120.0 + h2 * (-1.0 / 5040.0 + h2 * (1.0 / 362880.0 + h2 * (-1.0 / 39916800.0 + h2 * (1.0 / 6227020800.0 + h2 * (-1.0 / 1307674368000.0 + h2 * (1.0 / 355687428096000.0)))))))));
    const double ch = 1.0 + h2 * (-0.5 + h2 * (1.0 / 24.0 + h2 * (-1.0 / 720.0 + h2 * (1.0 / 40320.0 + h2 * (-1.0 / 3628800.0 + h2 * (1.0 / 479001600.0 + h2 * (-1.0 / 87178291200.0 + h2 * (1.0 / 20922789888000.0 + h2 * (-1.0 / 6402373705728000.0)))))))));
    s = (float)(2.0 * sh * ch); c = (float)(ch * ch - sh * sh);
}
__device__ __forceinline__ double rope_inv(int i) {
    const double t[16] = {1.0, 0.5623413251903491, 0.31622776601683794, 0.1778279410038923, 0.1, 0.05623413251903491, 0.03162277660168379, 0.01778279410038923,
                          0.01, 0.005623413251903491, 0.0031622776601683794, 0.0017782794100389228, 0.001, 0.0005623413251903491, 0.00031622776601683794, 0.00017782794100389227};
    double r = t[0];
#pragma unroll
    for (int k = 1; k < 16; ++k) r = (i == k) ? t[k] : r;
    return r;
}

__device__ __forceinline__ void prep_stage(const Params& p, LAS unsigned char* lds, int vblk, int nblk, int tid, unsigned long long& tsub) {
    const int lane = tid & 63, wid = tid >> 6;
    const int gw = vblk * 8 + wid, ngw = nblk * 8;
    LAS float* scr = (LAS float*)(lds + wid * 8448);
    unsigned char* ws = p.ws;
    constexpr int I_IN = 16 * 45, I_UQ = 4 * 24, I_UKV = 2 * 32, I_SQ = 16 * 32, I_XKV = 16 * 64;
    constexpr int NITEMS = I_IN + I_UQ + I_UKV + 3 * I_SQ + I_XKV;
    auto get_desc = [&](int it) -> TrDesc {
        TrDesc d; int r = it; int item;
        if (r < I_IN) { d.W = p.w_in; d.N = INC; d.K = 1024; d.g = p.g_mix; d.WT = (bf16_t*)(ws + WS_WT_IN); d.mode = 2; item = r; }
        else if ((r -= I_IN) < I_UQ) { d.W = p.w_uq; d.N = 768; d.K = 256; d.g = p.g_q; d.WT = (bf16_t*)(ws + WS_WT_UQ); d.mode = 0; item = r; }
        else if ((r -= I_UQ) < I_UKV) { d.W = p.w_ukv; d.N = 1024; d.K = 128; d.g = p.g_kv; d.WT = (bf16_t*)(ws + WS_WT_UKV); d.mode = 0; item = r; }
        else if ((r -= I_UKV) < I_SQ) { d.W = p.w_out; d.N = 1024; d.K = 1024; d.g = nullptr; d.WT = (bf16_t*)(ws + WS_WT_OUT); d.mode = 0; item = r; }
        else if ((r -= I_SQ) < I_SQ) { d.W = p.w_xq; d.N = 1024; d.K = 1024; d.g = p.g_xattn; d.WT = (bf16_t*)(ws + WS_WT_XQ); d.mode = 0; item = r; }
        else if ((r -= I_SQ) < I_SQ) { d.W = p.w_xo; d.N = 1024; d.K = 1024; d.g = nullptr; d.WT = (bf16_t*)(ws + WS_WT_XO); d.mode = 0; item = r; }
        else { r -= I_SQ; d.W = p.w_xkv; d.N = 2048; d.K = 1024; d.g = p.g_mem; d.WT = (bf16_t*)(ws + WS_WT_XKV); d.mode = 0; item = r; }
        const int nblk = d.N / 32; d.k0 = 64 * (item / nblk); d.n0 = 32 * (item % nblk); return d; };
    SUB_T0(1);
    if (gw < NITEMS) {
        TrDesc d0 = get_desc(gw), d1 = d0, d2 = d0; float v0[40], v1[40], v2[40];
        tr_load(d0, v0, lane);
        if (gw + ngw < NITEMS) { d1 = get_desc(gw + ngw); tr_load(d1, v1, lane); }
        for (int it = gw; it < NITEMS; it += ngw) {
            const int n2 = it + 2 * ngw;
            if (n2 < NITEMS) { d2 = get_desc(n2); tr_load(d2, v2, lane); }
            tr_store(d0, v0, scr, lane);
            d0 = d1; d1 = d2;
#pragma unroll
            for (int i = 0; i < 40; ++i) { v0[i] = v1[i]; v1[i] = v2[i]; }
        }
    }
    SUB_T1(1, tsub);
    SUB_T0(2);
    rows_bf16_rstd(p.x, (bf16_t*)(ws + WS_XB), (float*)(ws + WS_RSTD_X), NTOK, gw, ngw, lane);
    rows_bf16_rstd(p.mem, (bf16_t*)(ws + WS_MEMB), (float*)(ws + WS_RSTD_MEM), NMEM, gw, ngw, lane);
    SUB_T1(2, tsub);
    SUB_T0(3);
    const int gt = vblk * 512 + tid, ngt = nblk * 512;
    for (int i = gt; i < NTOK * 16; i += ngt) { const int row = i >> 4, f = i & 15; float s, c; sincos_acc((double)p.pos[row] * rope_inv(f), s, c);
        float* rt = (float*)(ws + WS_ROPE) + (size_t)row * 32; rt[f] = c; rt[16 + f] = s; }
    for (int i = gt; i < 1024 * 32; i += ngt) { const int k = i >> 5, e = i & 31; const float v = p.g_ffn[k] * p.w_router[i]; const unsigned hb = f2bf(v); const float lo = v - __uint_as_float(hb << 16);
        ((bf16_t*)(ws + WS_WR))[e * 1024 + k] = (bf16_t)hb; ((bf16_t*)(ws + WS_WR))[32768 + e * 1024 + k] = (bf16_t)f2bf(lo); }
    for (int i = gt; i < 96 * 1024 / 8; i += ngt) ((u32x4*)((bf16_t*)(ws + WS_WT_IN) + (size_t)416 * 1024))[i] = (u32x4){0u, 0u, 0u, 0u};
    SUB_T1(3, tsub);
}

__device__ __forceinline__ void moe_weights_stage(const Params& p, LAS unsigned char* lds, int ci, int nconv, int tid) {
    const int lane = tid & 63, wid = tid >> 6; const int gw = ci * 8 + wid, ngw = nconv * 8;
    LAS float* scr = (LAS float*)(lds + wid * 8448);
    unsigned char* ws = p.ws;
    constexpr int I_UP1 = 16 * 64, I_DN1 = 16 * 32, NITEMS = NE * (I_UP1 + I_DN1);
    auto get_desc = [&](int it) -> TrDesc {
        TrDesc d; int r = it; int item;
        if (r < NE * I_UP1) { const int e = r / I_UP1; d.W = p.w_up + (size_t)e * 1024 * 2048; d.N = 2048; d.K = 1024; d.g = p.g_ffn; d.WT = (bf16_t*)(ws + WS_WT_UP + (size_t)e * 2048 * 1024); d.mode = 4; item = r % I_UP1; }
        else { r -= NE * I_UP1; const int e = r / I_DN1; d.W = p.w_down + (size_t)e * 1024 * 1024; d.N = 1024; d.K = 1024; d.g = nullptr; d.WT = (bf16_t*)(ws + WS_WT_DOWN + (size_t)e * 1024 * 1024); d.mode = 5; item = r % I_DN1; }
        const int nblk = d.N / 32; d.k0 = 64 * (item / nblk); d.n0 = 32 * (item % nblk); return d; };
    if (gw < NITEMS) {
        TrDesc d0 = get_desc(gw), d1 = d0, d2 = d0, d3 = d0; float v0[40], v1[40], v2[40], v3[40];
        tr_load(d0, v0, lane);
        if (gw + ngw < NITEMS) { d1 = get_desc(gw + ngw); tr_load(d1, v1, lane); }
        if (gw + 2 * ngw < NITEMS) { d2 = get_desc(gw + 2 * ngw); tr_load(d2, v2, lane); }
        for (int it = gw; it < NITEMS; it += ngw) {
            const int n3 = it + 3 * ngw;
            if (n3 < NITEMS) { d3 = get_desc(n3); tr_load(d3, v3, lane); }
            tr_store(d0, v0, scr, lane);
            d0 = d1; d1 = d2; d2 = d3;
#pragma unroll
            for (int i = 0; i < 40; ++i) { v0[i] = v1[i]; v1[i] = v2[i]; v2[i] = v3[i]; }
        }
    }
}

struct Unit { int pm, pn, z; };
typedef f32x4 Acc[2][2][4][2];

template <bool PERM, class Prov, class Epi>
__device__ __forceinline__ void gemm_unit_naive(const Prov& P, const Epi& E, const Unit& u, LAS unsigned char* lds, int tid) {
    const int wid = tid >> 6, lane = tid & 63, wr = wid >> 2, wc = wid & 3, fr = lane & 15, fq = lane >> 4;
    const bf16_t* ap[2][4]; const bf16_t* bp[2][2];
#pragma unroll
    for (int ai = 0; ai < 2; ++ai)
#pragma unroll
        for (int m = 0; m < 4; ++m) ap[ai][m] = P.a_row(u, 128 * ai + 64 * wr + 16 * m + fr) + 8 * fq;
#pragma unroll
    for (int bj = 0; bj < 2; ++bj)
#pragma unroll
        for (int n = 0; n < 2; ++n) { const int rho = 16 * n + fr; bp[bj][n] = P.b_row(u, 128 * bj + 32 * wc + (PERM ? perm32(rho) : rho)) + 8 * fq; }
    Acc acc;
#pragma unroll
    for (int a = 0; a < 2; ++a)
#pragma unroll
        for (int b = 0; b < 2; ++b)
#pragma unroll
            for (int m = 0; m < 4; ++m)
#pragma unroll
                for (int n = 0; n < 2; ++n) acc[a][b][m][n] = (f32x4){0.f, 0.f, 0.f, 0.f};
    const int K = P.K;
#pragma unroll 1
    for (int k0 = 0; k0 < K; k0 += 32) {
        bf16x8 a[2][4], b[2][2];
#pragma unroll
        for (int ai = 0; ai < 2; ++ai)
#pragma unroll
            for (int m = 0; m < 4; ++m) a[ai][m] = *(const bf16x8*)(ap[ai][m] + k0);
#pragma unroll
        for (int bj = 0; bj < 2; ++bj)
#pragma unroll
            for (int n = 0; n < 2; ++n) b[bj][n] = *(const bf16x8*)(bp[bj][n] + k0);
#pragma unroll
        for (int ai = 0; ai < 2; ++ai)
#pragma unroll
            for (int bj = 0; bj < 2; ++bj)
#pragma unroll
                for (int m = 0; m < 4; ++m)
#pragma unroll
                    for (int n = 0; n < 2; ++n) acc[ai][bj][m][n] = __builtin_amdgcn_mfma_f32_16x16x32_bf16(b[bj][n], a[ai][m], acc[ai][bj][m][n], 0, 0, 0);
    }
    E(acc, u, wr, wc, fr, fq, lds, (const LAS float*)lds);
}

struct ProvPlain { const bf16_t* A; int lda; const bf16_t* Bt; int ldb; int K;
    __device__ __forceinline__ const bf16_t* a_row(const Unit& u, int r) const { return A + (size_t)(u.pm * 256 + r) * lda; }
    __device__ __forceinline__ const bf16_t* b_row(const Unit& u, int r) const { return Bt + (size_t)(u.pn * 256 + r) * ldb; } };
struct ProvXS { const bf16_t* XQ; const bf16_t* KM; int K;
    __device__ __forceinline__ const bf16_t* a_row(const Unit& u, int r) const { return XQ + (size_t)((u.z >> 2) * 2048 + u.pm * 256 + r) * 1024 + (u.z & 3) * 256; }
    __device__ __forceinline__ const bf16_t* b_row(const Unit& u, int r) const { return KM + (size_t)((u.z >> 2) * 256 + r) * 1024 + (u.z & 3) * 256; } };
struct ProvXPV { const bf16_t* Pm; const bf16_t* VMT; int K;
    __device__ __forceinline__ const bf16_t* a_row(const Unit& u, int r) const { return Pm + ((size_t)u.z * 2048 + u.pm * 256 + r) * 256; }
    __device__ __forceinline__ const bf16_t* b_row(const Unit& u, int r) const { return VMT + ((size_t)u.z * 256 + r) * 256; } };
struct ProvUp { const bf16_t* X2B; const int* slot_tok; const int* tile_e; const bf16_t* WT; int K;
    __device__ __forceinline__ const bf16_t* a_row(const Unit& u, int r) const { return X2B + (size_t)slot_tok[u.pm * 256 + r] * 1024; }
    __device__ __forceinline__ const bf16_t* b_row(const Unit& u, int r) const { return WT + ((size_t)tile_e[u.pm] * 2048 + u.pn * 256 + r) * 1024; } };
struct ProvDown { const bf16_t* ACT; const int* tile_e; const bf16_t* WT; int K;
    __device__ __forceinline__ const bf16_t* a_row(const Unit& u, int r) const { return ACT + (size_t)(u.pm * 256 + r) * 1024; }
    __device__ __forceinline__ const bf16_t* b_row(const Unit& u, int r) const { return WT + ((size_t)tile_e[u.pm] * 1024 + u.pn * 256 + r) * 1024; } };

#define EPI_BAR() do { asm volatile("s_waitcnt lgkmcnt(0)" ::: "memory"); __builtin_amdgcn_s_barrier(); asm volatile("" ::: "memory"); } while (0)
#define EPI_ARGS Acc& acc, const Unit& u, int wr, int wc, int fr, int fq, LAS unsigned char* lds, const LAS float* tab
#define EPI_NOPF __device__ __forceinline__ void prefetch(const Unit&, LAS float*, int) const {}
#define FOR_AI_M _Pragma("unroll") for (int ai = 0; ai < 2; ++ai) _Pragma("unroll") for (int m = 0; m < 4; ++m)
#define FOR_BJ _Pragma("unroll") for (int bj = 0; bj < 2; ++bj)
struct EpiIn { bf16_t* U; bf16_t* Z; const float* rs; float* ssq_q; float* ssq_kv; const float* rope; bf16_t* KB;
    EPI_NOPF
    __device__ __forceinline__ void operator()(EPI_ARGS) const {
        if (u.pn >= 2) {
            FOR_AI_M { const int row = u.pm * 256 + 128 * ai + 64 * wr + 16 * m + fr; const float s = rs[row]; f32x4 o[2];
#pragma unroll
                for (int n = 0; n < 2; ++n) { const f32x4 av = acc[ai][0][m][n] * s, gv = acc[ai][1][m][n] * s; const f32x4 t = gv * (-1.4426950408889634f); f32x4 ex;
#pragma unroll
                    for (int j = 0; j < 4; ++j) ex[j] = __builtin_amdgcn_exp2f(t[j]);
                    ex = ex + 1.0f; f32x4 rc;
#pragma unroll
                    for (int j = 0; j < 4; ++j) rc[j] = __builtin_amdgcn_rcpf(ex[j]);
                    o[n] = av * rc; }
                u32x4 w; w.x = pk2(o[0][0], o[0][1]); w.y = pk2(o[0][2], o[0][3]); w.z = pk2(o[1][0], o[1][1]); w.w = pk2(o[1][2], o[1][3]);
                *(u32x4*)(Z + (size_t)row * 512 + (u.pn - 2) * 128 + 32 * wc + 8 * fq) = w; }
            return; }
        FOR_AI_M { const int row = u.pm * 256 + 128 * ai + 64 * wr + 16 * m + fr; const float s = rs[row]; bf16_t* rowp = U + (size_t)row * ULD + u.pn * 256 + 32 * wc + 8 * fq;
            float q0 = 0.f, q1 = 0.f;
            FOR_BJ { const f32x4 v0 = acc[ai][bj][m][0] * s, v1 = acc[ai][bj][m][1] * s; u32x4 w; w.x = pk2(v0[0], v0[1]); w.y = pk2(v0[2], v0[3]); w.z = pk2(v1[0], v1[1]); w.w = pk2(v1[2], v1[3]);
                *(u32x4*)(rowp + 128 * bj) = w;
                const float qq = (v0[0] * v0[0] + v0[1] * v0[1]) + (v0[2] * v0[2] + v0[3] * v0[3]) + (v1[0] * v1[0] + v1[1] * v1[1]) + (v1[2] * v1[2] + v1[3] * v1[3]);
                if (bj == 0) q0 = qq; else q1 = qq; }
            if (u.pn == 0) { float q = q0 + q1; q += shflx(q, 16, fr + 16 * fq); q += shflx(q, 32, fr + 16 * fq); if (fq == 0) ssq_q[(size_t)row * 4 + wc] = q; }
            if (u.pn == 1) { float q = q0; q += shflx(q, 16, fr + 16 * fq); q += shflx(q, 32, fr + 16 * fq); if (fq == 0) ssq_kv[(size_t)row * 4 + wc] = q;
                if (wc == 0) {
                    const int i0 = 8 * (fq & 1); const f32x4 c0 = *(const f32x4*)(rope + (size_t)row * 32 + i0), c1 = *(const f32x4*)(rope + (size_t)row * 32 + i0 + 4);
                    const f32x4 s0 = *(const f32x4*)(rope + (size_t)row * 32 + 16 + i0), s1 = *(const f32x4*)(rope + (size_t)row * 32 + 16 + i0 + 4);
                    const f32x4 v0 = acc[ai][1][m][0] * s, v1 = acc[ai][1][m][1] * s; f32x4 p0, p1;
#pragma unroll
                    for (int j = 0; j < 4; ++j) { p0[j] = shflx(v0[j], 32, fr + 16 * fq); p1[j] = shflx(v1[j], 32, fr + 16 * fq); }
                    f32x4 o0, o1;
                    if (fq < 2) { o0 = v0 * c0 - p0 * s0; o1 = v1 * c1 - p1 * s1; } else { o0 = p0 * s0 + v0 * c0; o1 = p1 * s1 + v1 * c1; }
                    u32x4 w; w.x = pk2(o0[0], o0[1]); w.y = pk2(o0[2], o0[3]); w.z = pk2(o1[0], o1[1]); w.w = pk2(o1[2], o1[3]);
                    bf16_t* kb = KB + (size_t)row * 768 + 64 + 8 * fq;
#pragma unroll
                    for (int h = 0; h < 8; ++h) *(u32x4*)(kb + h * 96) = w; } } } } };
struct EpiScale16 { bf16_t* O; int ldc; const float* ssq; float mul;
    EPI_NOPF
    __device__ __forceinline__ void operator()(EPI_ARGS) const {
        FOR_AI_M { const int row = u.pm * 256 + 128 * ai + 64 * wr + 16 * m + fr; const f32x4* sp = (const f32x4*)(ssq + (size_t)row * 16); const f32x4 t = (sp[0] + sp[1]) + (sp[2] + sp[3]);
            const float s = mul / sqrtf(((t[0] + t[1]) + (t[2] + t[3])) * (1.0f / 1024.0f) + EPS); bf16_t* rowp = O + (size_t)row * ldc + u.pn * 256 + 32 * wc + 8 * fq;
            FOR_BJ { const f32x4 v0 = acc[ai][bj][m][0] * s, v1 = acc[ai][bj][m][1] * s; u32x4 w; w.x = pk2(v0[0], v0[1]); w.y = pk2(v0[2], v0[3]); w.z = pk2(v1[0], v1[1]); w.w = pk2(v1[2], v1[3]);
                *(u32x4*)(rowp + 128 * bj) = w; } } } };
struct EpiQ { bf16_t* Q; const float* ssq; const float* rope;
    EPI_NOPF
    __device__ __forceinline__ void operator()(EPI_ARGS) const {
        FOR_AI_M { const int row = u.pm * 256 + 128 * ai + 64 * wr + 16 * m + fr; const f32x4 t = *(const f32x4*)(ssq + (size_t)row * 4); const float s = C2_MLA / sqrtf(((t[0] + t[1]) + (t[2] + t[3])) * (1.0f / 256.0f) + EPS);
            const f32x4 cs = *(const f32x4*)(rope + (size_t)row * 32 + 4 * fq), sn = *(const f32x4*)(rope + (size_t)row * 32 + 16 + 4 * fq);
            FOR_BJ { const int colg = u.pn * 256 + 128 * bj + 32 * wc; f32x4 v0 = acc[ai][bj][m][0] * s, v1 = acc[ai][bj][m][1] * s;
                if (((colg >> 5) % 3) == 2) { const f32x4 r0 = v0 * cs - v1 * sn, r1 = v0 * sn + v1 * cs; v0 = r0; v1 = r1; }
                bf16_t* rowp = Q + (size_t)row * 768 + colg + 4 * fq; u32x2 w0, w1; w0.x = pk2(v0[0], v0[1]); w0.y = pk2(v0[2], v0[3]); w1.x = pk2(v1[0], v1[1]); w1.y = pk2(v1[2], v1[3]);
                *(u32x2*)(rowp) = w0; *(u32x2*)(rowp + 16) = w1; } } } };
struct EpiKV { bf16_t* KB; bf16_t* VB; const float* ssq;
    EPI_NOPF
    __device__ __forceinline__ void operator()(EPI_ARGS) const {
        FOR_AI_M { const int row = u.pm * 256 + 128 * ai + 64 * wr + 16 * m + fr; const f32x4 t = *(const f32x4*)(ssq + (size_t)row * 4); const float s = 1.0f / sqrtf(((t[0] + t[1]) + (t[2] + t[3])) * (1.0f / 128.0f) + EPS);
            FOR_BJ { const int h = 2 * u.pn + bj, cl = 32 * wc + 8 * fq; const f32x4 v0 = acc[ai][bj][m][0] * s, v1 = acc[ai][bj][m][1] * s;
                u32x4 w; w.x = pk2(v0[0], v0[1]); w.y = pk2(v0[2], v0[3]); w.z = pk2(v1[0], v1[1]); w.w = pk2(v1[2], v1[3]);
                if (wc < 2) *(u32x4*)(KB + (size_t)row * 768 + h * 96 + cl) = w; else *(u32x4*)(VB + (size_t)row * 512 + h * 64 + cl - 64) = w; } } } };
struct EpiResid { const bf16_t* base; bf16_t* ob; float* ssq; unsigned char* o8;
    EPI_NOPF
    __device__ __forceinline__ void operator()(EPI_ARGS) const {
        FOR_AI_M { const int row = u.pm * 256 + 128 * ai + 64 * wr + 16 * m + fr; float q = 0.f;
            FOR_BJ { const size_t off = (size_t)row * 1024 + u.pn * 256 + 128 * bj + 32 * wc + 8 * fq;
                const u32x4 bw = *(const u32x4*)(base + off);
                f32x4 v0, v1; v0[0] = __uint_as_float(bw.x << 16); v0[1] = __uint_as_float(bw.x & 0xffff0000u); v0[2] = __uint_as_float(bw.y << 16); v0[3] = __uint_as_float(bw.y & 0xffff0000u);
                v1[0] = __uint_as_float(bw.z << 16); v1[1] = __uint_as_float(bw.z & 0xffff0000u); v1[2] = __uint_as_float(bw.w << 16); v1[3] = __uint_as_float(bw.w & 0xffff0000u);
                v0 = v0 + acc[ai][bj][m][0]; v1 = v1 + acc[ai][bj][m][1];
                u32x4 w; w.x = pk2(v0[0], v0[1]); w.y = pk2(v0[2], v0[3]); w.z = pk2(v1[0], v1[1]); w.w = pk2(v1[2], v1[3]); *(u32x4*)(ob + off) = w;
                if (o8) { u32x2 w8; w8.x = pk4_fp8(v0[0], v0[1], v0[2], v0[3]); w8.y = pk4_fp8(v1[0], v1[1], v1[2], v1[3]); *(u32x2*)(o8 + off) = w8; }
                q += (v0[0] * v0[0] + v0[1] * v0[1]) + (v0[2] * v0[2] + v0[3] * v0[3]) + (v1[0] * v1[0] + v1[1] * v1[1]) + (v1[2] * v1[2] + v1[3] * v1[3]); }
            if (ssq) { q += shflx(q, 16, fr + 16 * fq); q += shflx(q, 32, fr + 16 * fq); if (fq == 0) ssq[(size_t)row * 16 + u.pn * 4 + wc] = q; } } } };
struct EpiKVMem { bf16_t* KM; bf16_t* VMT; const float* rs;
    EPI_NOPF
    __device__ __forceinline__ void operator()(EPI_ARGS) const {
        FOR_AI_M { const int row = u.pm * 256 + 128 * ai + 64 * wr + 16 * m + fr; const float s = rs[row];
            FOR_BJ {
#pragma unroll
                for (int n = 0; n < 2; ++n) { const int col = u.pn * 256 + 128 * bj + 32 * wc + 16 * n + 4 * fq; const f32x4 v = acc[ai][bj][m][n] * s;
                    if (u.pn < 4) { u32x2 w; w.x = pk2(v[0], v[1]); w.y = pk2(v[2], v[3]); *(u32x2*)(KM + (size_t)row * 1024 + col) = w; }
                    else { const int c2 = col - 1024, h = c2 >> 8, d = c2 & 255, b = row >> 8, mm = row & 255; bf16_t* dst = VMT + ((size_t)(b * 4 + h) * 256 + d) * 256 + mm;
#pragma unroll
                        for (int j = 0; j < 4; ++j) dst[(size_t)j * 256] = (bf16_t)f2bf(v[j]); } } } } } };
struct EpiSoftmaxP { bf16_t* Pm;
    EPI_NOPF
    __device__ __forceinline__ void operator()(EPI_ARGS) const {
        LAS float* red = (LAS float*)lds; float rmax[2][4];
        FOR_AI_M { float mx = -3.0e38f;
            FOR_BJ {
#pragma unroll
                for (int n = 0; n < 2; ++n)
#pragma unroll
                    for (int j = 0; j < 4; ++j) mx = fmaxf(mx, acc[ai][bj][m][n][j]); }
            mx = fmaxf(mx, shflx(mx, 16, fr + 16 * fq)); mx = fmaxf(mx, shflx(mx, 32, fr + 16 * fq));
            if (fq == 0) red[(128 * ai + 64 * wr + 16 * m + fr) * 4 + wc] = mx; }
        EPI_BAR();
        FOR_AI_M { const f32x4 t = *(const LAS f32x4*)(red + (128 * ai + 64 * wr + 16 * m + fr) * 4); rmax[ai][m] = fmaxf(fmaxf(t[0], t[1]), fmaxf(t[2], t[3])); }
        EPI_BAR();
        FOR_AI_M { float s = 0.f;
            FOR_BJ {
#pragma unroll
                for (int n = 0; n < 2; ++n)
#pragma unroll
                    for (int j = 0; j < 4; ++j) { const float e = fast_exp2(acc[ai][bj][m][n][j] - rmax[ai][m]); acc[ai][bj][m][n][j] = e; s += e; } }
            s += shflx(s, 16, fr + 16 * fq); s += shflx(s, 32, fr + 16 * fq);
            if (fq == 0) red[(128 * ai + 64 * wr + 16 * m + fr) * 4 + wc] = s; }
        EPI_BAR();
        FOR_AI_M { const int r = 128 * ai + 64 * wr + 16 * m + fr; const f32x4 t = *(const LAS f32x4*)(red + r * 4); const float inv = 1.0f / ((t[0] + t[1]) + (t[2] + t[3]));
            bf16_t* rowp = Pm + ((size_t)u.z * 2048 + u.pm * 256 + r) * 256 + 32 * wc + 8 * fq;
            FOR_BJ { const f32x4 v0 = acc[ai][bj][m][0] * inv, v1 = acc[ai][bj][m][1] * inv; u32x4 w; w.x = pk2(v0[0], v0[1]); w.y = pk2(v0[2], v0[3]); w.z = pk2(v1[0], v1[1]); w.w = pk2(v1[2], v1[3]);
                *(u32x4*)(rowp + 128 * bj) = w; } }
        EPI_BAR();
    } };
struct EpiOX { bf16_t* OX;
    EPI_NOPF
    __device__ __forceinline__ void operator()(EPI_ARGS) const {
        FOR_AI_M { const int r = 128 * ai + 64 * wr + 16 * m + fr; bf16_t* rowp = OX + (size_t)((u.z >> 2) * 2048 + u.pm * 256 + r) * 1024 + (u.z & 3) * 256 + 32 * wc + 8 * fq;
            FOR_BJ { const f32x4 v0 = acc[ai][bj][m][0], v1 = acc[ai][bj][m][1]; u32x4 w; w.x = pk2(v0[0], v0[1]); w.y = pk2(v0[2], v0[3]); w.z = pk2(v1[0], v1[1]); w.w = pk2(v1[2], v1[3]);
                *(u32x4*)(rowp + 128 * bj) = w; } } } };
struct EpiSwiglu { bf16_t* ACT; const float* slot_rs; const int* tile_e; const float* b_up;
    __device__ __forceinline__ void prefetch(const Unit& u, LAS float* t, int tid) const { const int e = tile_e[u.pm];
        t[tid] = slot_rs[u.pm * 256 + tid] * W8_INV; t[256 + tid] = b_up[(size_t)e * 2048 + ((tid >> 7) << 10) + u.pn * 128 + (tid & 127)]; }
    __device__ __forceinline__ void operator()(EPI_ARGS) const {
        const int cl = 32 * wc + 8 * fq;
        f32x4 bgv[2], blv[2]; bgv[0] = *(const LAS f32x4*)(tab + 256 + cl); bgv[1] = *(const LAS f32x4*)(tab + 256 + cl + 4); blv[0] = *(const LAS f32x4*)(tab + 384 + cl); blv[1] = *(const LAS f32x4*)(tab + 384 + cl + 4);
        FOR_AI_M { const int rl = 128 * ai + 64 * wr + 16 * m + fr; const int slot = u.pm * 256 + rl; const float s = tab[rl];
            f32x4 o[2];
#pragma unroll
            for (int n = 0; n < 2; ++n) { f32x4 g = acc[ai][0][m][n] * s + bgv[n], l = acc[ai][1][m][n] * s + blv[n];
                g = __builtin_elementwise_min(g, (f32x4){7.f, 7.f, 7.f, 7.f}); l = __builtin_elementwise_min(__builtin_elementwise_max(l, (f32x4){-7.f, -7.f, -7.f, -7.f}), (f32x4){7.f, 7.f, 7.f, 7.f}) + 1.0f;
                const f32x4 t = g * (-1.702f * 1.4426950408889634f); f32x4 ex;
#pragma unroll
                for (int j = 0; j < 4; ++j) ex[j] = __builtin_amdgcn_exp2f(t[j]);
                ex = ex + 1.0f; f32x4 rc;
#pragma unroll
                for (int j = 0; j < 4; ++j) rc[j] = __builtin_amdgcn_rcpf(ex[j]);
                o[n] = (g * rc) * l; }
            u32x2 w; w.x = pk4_fp8(o[0][0], o[0][1], o[0][2], o[0][3]); w.y = pk4_fp8(o[1][0], o[1][1], o[1][2], o[1][3]);
            *(u32x2*)((unsigned char*)ACT + (size_t)slot * 1024 + u.pn * 128 + cl) = w; } } };
struct EpiDown { bf16_t* YB; const float* gate; const int* tile_e; const float* b_down;
    __device__ __forceinline__ void prefetch(const Unit& u, LAS float* t, int tid) const { const int e = tile_e[u.pm];
        t[tid] = gate[u.pm * 256 + tid]; t[256 + tid] = b_down[(size_t)e * 1024 + u.pn * 256 + tid]; }
    __device__ __forceinline__ void operator()(EPI_ARGS) const {
        const int cl = 32 * wc + 8 * fq;
        FOR_AI_M { const int rl = 128 * ai + 64 * wr + 16 * m + fr; const int slot = u.pm * 256 + rl; const float g = tab[rl]; const float g8 = g * W8_INV;
            FOR_BJ { const f32x4 b0 = *(const LAS f32x4*)(tab + 256 + cl + 128 * bj), b1 = *(const LAS f32x4*)(tab + 256 + cl + 128 * bj + 4);
                const f32x4 v0 = acc[ai][bj][m][0] * g8 + b0 * g, v1 = acc[ai][bj][m][1] * g8 + b1 * g; u32x4 w; w.x = pk2(v0[0], v0[1]); w.y = pk2(v0[2], v0[3]); w.z = pk2(v1[0], v1[1]); w.w = pk2(v1[2], v1[3]);
                *(u32x4*)(YB + (size_t)slot * 1024 + u.pn * 256 + cl + 128 * bj) = w; } } } };

namespace pg8 {
typedef int v4i_t __attribute__((ext_vector_type(4)));
typedef int v8i_t __attribute__((ext_vector_type(8)));
constexpr int BK = 64, HALF = 128, HTB = HALF * BK * 2, STAGE_BYTES = 8 * HTB;
__device__ __forceinline__ int lds_byte(int r, int c) { const int st = (r >> 4) * 2 + (c >> 5), rr = r & 15, cc = c & 31, ob = rr * 64 + cc * 2; return st * 1024 + (ob ^ (((ob >> 9) & 1) << 5)); }
__device__ __forceinline__ void stage_rc(int b, int& R, int& C) { const int st = b / 1024, sb = b % 1024, swz = sb ^ (((sb >> 9) & 1) << 5); R = (st >> 1) * 16 + swz / 64; C = (st & 1) * 32 + (swz % 64) / 2; }

template <bool PERM, bool GATHER, bool FP8, class Prov, class Sched, class Epi>
__device__ __forceinline__ void gemm_phase(LAS unsigned char* lds, LAS unsigned char* lds_epi, const Prov& P, const Sched& S, const Epi& E, int tid, unsigned long long* tepi = nullptr) {
    const int wid = __builtin_amdgcn_readfirstlane(tid >> 6), lane = tid & 63, wr = wid >> 2, wc = wid & 3, fr = lane & 15, fq = lane >> 4;
    const int K = P.K, nt = K / BK;
    unsigned voffA[2], voffB[2], voffG[2][2]; int Rg[2]; unsigned Cg[2];
#pragma unroll
    for (int i = 0; i < 2; ++i) { int R, C; stage_rc(tid * 16 + i * 8192, R, C); const int Rb = PERM ? ((R & ~31) + perm32(R & 31)) : R;
        voffA[i] = (unsigned)(R * P.lda + C) * 2u; voffB[i] = (unsigned)(Rb * P.ldb + C) * 2u; Rg[i] = R; Cg[i] = (unsigned)C * 2u; }
    LAS int* rtab = (LAS int*)(lds_epi + 8192);
    const unsigned kstep = (unsigned)(BK * 2);
    const unsigned hstepA = GATHER ? 0u : (unsigned)(HALF * P.lda * 2), hstepB = (unsigned)(HALF * P.ldb * 2);
    const __amdgpu_buffer_rsrc_t rsA = __builtin_amdgcn_make_buffer_rsrc((void*)P.a_root(), 0, -1, 0x00020000), rsB = __builtin_amdgcn_make_buffer_rsrc((void*)P.b_root(), 0, -1, 0x00020000);
#define PG8_AOFF(u_) ((unsigned)((const char*)P.a_base(u_) - (const char*)P.a_root()))
#define PG8_BOFF(u_) ((unsigned)((const char*)P.b_base(u_) - (const char*)P.b_root()))
    const unsigned ldsw = (unsigned)wid * 1024u;
    const int aoff = lds_byte(wr * 64 + fr, fq * 8), boff = lds_byte(wc * 32 + fr, fq * 8);
#define PG8_SA(b, h) (((b) * 2 + (h)) * HTB)
#define PG8_SB(b, h) ((4 + (b) * 2 + (h)) * HTB)
#define PG8_STAGE(bufoff, rs, soff, voff) do { _Pragma("unroll") for (int _i = 0; _i < 2; ++_i) \
        __builtin_amdgcn_raw_ptr_buffer_load_lds(rs, (LAS void*)(lds + (bufoff) + ldsw + _i * 8192), 16, (int)(voff)[_i], (int)(soff), 0, 0); } while (0)
#define PG8_STAGE_A(bufoff, soff, h) do { if constexpr (GATHER) { PG8_STAGE(bufoff, rsA, soff, voffG[h]); } else { PG8_STAGE(bufoff, rsA, (soff) + (h) * hstepA, voffA); } } while (0)
#define PG8_STAGE_B(bufoff, soff) PG8_STAGE(bufoff, rsB, soff, voffB)
#define PG8_LDA(dst, b, h) do { _Pragma("unroll") for (int m = 0; m < 4; ++m) { const v4i_t l0_ = *(const LAS v4i_t*)(lds + PG8_SA(b, h) + aoff + m * 2048), l1_ = *(const LAS v4i_t*)(lds + PG8_SA(b, h) + aoff + m * 2048 + 1024); dst[m] = __builtin_shufflevector(l0_, l1_, 0, 1, 2, 3, 4, 5, 6, 7); } } while (0)
#define PG8_LDB(dst, b, h) do { _Pragma("unroll") for (int n = 0; n < 2; ++n) { const v4i_t l0_ = *(const LAS v4i_t*)(lds + PG8_SB(b, h) + boff + n * 2048), l1_ = *(const LAS v4i_t*)(lds + PG8_SB(b, h) + boff + n * 2048 + 1024); dst[n] = __builtin_shufflevector(l0_, l1_, 0, 1, 2, 3, 4, 5, 6, 7); } } while (0)
#define PG8_MMA(ai, bj, At, Bt) do { __builtin_amdgcn_s_setprio(1); _Pragma("unroll") for (int m = 0; m < 4; ++m) _Pragma("unroll") for (int n = 0; n < 2; ++n) { if constexpr (FP8) { \
            acc[ai][bj][m][n] = __builtin_amdgcn_mfma_scale_f32_16x16x128_f8f6f4(Bt[n], At[m], acc[ai][bj][m][n], 0, 0, 0, 0x7f7f7f7f, 0, 0x7f7f7f7f); } \
        else { acc[ai][bj][m][n] = __builtin_amdgcn_mfma_f32_16x16x32_bf16(__builtin_bit_cast(bf16x8, __builtin_shufflevector(Bt[n], Bt[n], 0, 1, 2, 3)), __builtin_bit_cast(bf16x8, __builtin_shufflevector(At[m], At[m], 0, 1, 2, 3)), acc[ai][bj][m][n], 0, 0, 0); \
               acc[ai][bj][m][n] = __builtin_amdgcn_mfma_f32_16x16x32_bf16(__builtin_bit_cast(bf16x8, __builtin_shufflevector(Bt[n], Bt[n], 4, 5, 6, 7)), __builtin_bit_cast(bf16x8, __builtin_shufflevector(At[m], At[m], 4, 5, 6, 7)), acc[ai][bj][m][n], 0, 0, 0); } } \
        __builtin_amdgcn_s_setprio(0); } while (0)
#define PG8_WAIT_V(n) asm volatile("s_waitcnt vmcnt(" #n ")" ::: "memory")
#define PG8_WAIT_L(n) asm volatile("s_waitcnt lgkmcnt(" #n ")" ::: "memory")
#define PG8_BAR __builtin_amdgcn_s_barrier()
#define PG8_SCHED __builtin_amdgcn_sched_barrier(0)
    Unit cur, nxt; int ui = 0;
    if (!S.next(0, cur)) return;
    Acc acc;
#pragma unroll
    for (int a = 0; a < 2; ++a)
#pragma unroll
        for (int b = 0; b < 2; ++b)
#pragma unroll
            for (int m = 0; m < 4; ++m)
#pragma unroll
                for (int n = 0; n < 2; ++n) acc[a][b][m][n] = (f32x4){0.f, 0.f, 0.f, 0.f};
    v8i_t At[4], B0[2], B1[2];
    unsigned cA = PG8_AOFF(cur), cB = PG8_BOFF(cur);
    if constexpr (GATHER) {
#pragma unroll
        for (int h = 0; h < 2; ++h)
#pragma unroll
            for (int i = 0; i < 2; ++i) voffG[h][i] = (unsigned)P.row_tok(cur, h * HALF + Rg[i]) * (unsigned)(P.lda * 2) + Cg[i];
    }
    PG8_STAGE_B(PG8_SB(0, 0), cB); PG8_STAGE_B(PG8_SB(0, 1), cB + hstepB); PG8_STAGE_A(PG8_SA(0, 0), cA, 0); PG8_STAGE_A(PG8_SA(0, 1), cA, 1);
    if (wr == 1) PG8_BAR;
    PG8_WAIT_V(2); PG8_BAR;
    PG8_STAGE_B(PG8_SB(1, 0), cB + kstep); PG8_STAGE_A(PG8_SA(1, 0), cA + kstep, 0); PG8_STAGE_B(PG8_SB(1, 1), cB + hstepB + kstep);
    PG8_WAIT_V(6); PG8_BAR;
    for (;;) {
        const bool has_next = S.next(ui + 1, nxt);
        const unsigned nA = has_next ? PG8_AOFF(nxt) : cA, nB = has_next ? PG8_BOFF(nxt) : cB;
        if constexpr (GATHER) { if (has_next && wr == 0) { int tg_ = tid; asm volatile("" : "+v"(tg_)); rtab[tg_] = P.row_tok(nxt, tg_); } }
        if (wr == 0) { int tp_ = tid; asm volatile("" : "+v"(tp_)); E.prefetch(cur, (LAS float*)(lds_epi + 4096) + (ui & 1) * 512, tp_); }
        for (int t = 0; t < nt; t += 2) {
            const bool last = (t == nt - 2);
            const unsigned a1 = cA + (unsigned)(t + 1) * kstep;
            const unsigned a2 = last ? nA : cA + (unsigned)(t + 2) * kstep, b2 = last ? nB : cB + (unsigned)(t + 2) * kstep;
            const unsigned a3 = a2 + kstep, b3 = b2 + kstep;
            PG8_LDB(B0, 0, 0); PG8_LDB(B1, 0, 1); PG8_SCHED; PG8_LDA(At, 0, 0); PG8_STAGE_A(PG8_SA(1, 1), a1, 1);
            if constexpr (GATHER) { if (last && has_next) {
#pragma unroll
                for (int h = 0; h < 2; ++h)
#pragma unroll
                    for (int i = 0; i < 2; ++i) voffG[h][i] = (unsigned)rtab[h * HALF + Rg[i]] * (unsigned)(P.lda * 2) + Cg[i]; } }
            PG8_WAIT_V(8); PG8_WAIT_L(0); PG8_BAR; PG8_MMA(0, 0, At, B0); PG8_MMA(0, 1, At, B1); PG8_BAR; PG8_SCHED;
            PG8_LDA(At, 0, 1); PG8_STAGE_B(PG8_SB(0, 0), b2); PG8_STAGE_B(PG8_SB(0, 1), b2 + hstepB); PG8_STAGE_A(PG8_SA(0, 0), a2, 0);
            PG8_WAIT_V(8); PG8_WAIT_L(0); PG8_BAR; PG8_MMA(1, 0, At, B0); PG8_MMA(1, 1, At, B1); PG8_BAR; PG8_SCHED;
            PG8_LDB(B0, 1, 0); PG8_LDB(B1, 1, 1); PG8_SCHED; PG8_LDA(At, 1, 0); PG8_STAGE_A(PG8_SA(0, 1), a2, 1);
            PG8_WAIT_V(8); PG8_WAIT_L(0); PG8_BAR; PG8_MMA(0, 0, At, B0); PG8_MMA(0, 1, At, B1); PG8_BAR; PG8_SCHED;
            PG8_LDA(At, 1, 1); PG8_STAGE_B(PG8_SB(1, 0), b3); PG8_STAGE_B(PG8_SB(1, 1), b3 + hstepB); PG8_STAGE_A(PG8_SA(1, 0), a3, 0);
            PG8_WAIT_V(8); PG8_WAIT_L(0); PG8_BAR; PG8_MMA(1, 0, At, B0); PG8_MMA(1, 1, At, B1); PG8_BAR; PG8_SCHED;
        }
#if PROBE_EPI
        const unsigned long long te0_ = __builtin_amdgcn_s_memrealtime();
#endif
        if (wr == 0) PG8_BAR;
        { int fr_ = fr, fq_ = fq; asm volatile("" : "+v"(fr_), "+v"(fq_));
          E(acc, cur, wr, wc, fr_, fq_, lds_epi, (const LAS float*)(lds_epi + 4096) + (ui & 1) * 512); }
#if PROBE_EPI
        if (tepi) { asm volatile("s_waitcnt vmcnt(8)" ::: "memory"); *tepi += __builtin_amdgcn_s_memrealtime() - te0_; }
#endif
        if (!has_next) break;
#pragma unroll
        for (int a = 0; a < 2; ++a)
#pragma unroll
            for (int b = 0; b < 2; ++b)
#pragma unroll
                for (int m = 0; m < 4; ++m)
#pragma unroll
                    for (int n = 0; n < 2; ++n) acc[a][b][m][n] = (f32x4){0.f, 0.f, 0.f, 0.f};
        cur = nxt; cA = nA; cB = nB; ++ui;
        if (wr == 1) PG8_BAR;
    }
    PG8_WAIT_V(0);
    PG8_BAR;
#undef PG8_SA
#undef PG8_SB
#undef PG8_STAGE
#undef PG8_STAGE_A
#undef PG8_STAGE_B
#undef PG8_AOFF
#undef PG8_BOFF
#undef PG8_LDA
#undef PG8_LDB
#undef PG8_MMA
#undef PG8_WAIT_V
#undef PG8_WAIT_L
#undef PG8_BAR
#undef PG8_SCHED
}
struct Order { int nM, nN, nwg, G, c;
    __device__ __forceinline__ void init(int nM_, int nN_, int G_, int c_) { nM = nM_; nN = nN_; nwg = nM * nN; G = G_; c = c_; }
    __device__ __forceinline__ bool next(int i, int& pm, int& pn) const {
        const long L = (long)i * G + c; if (L >= nwg) return false;
        int wgid = (int)L; { const int q = nwg / 8, r = nwg % 8, xcd = wgid % 8, off = wgid / 8; wgid = (xcd < r ? xcd * (q + 1) : r * (q + 1) + (xcd - r) * q) + off; }
        const int nig = 8 * nN, gid = wgid / nig, fm = gid * 8, gsz = (nM - fm) < 8 ? (nM - fm) : 8;
        pm = fm + ((wgid % nig) % gsz); pn = (wgid % nig) / gsz; return true; } };
struct SchedPlain { Order o; __device__ __forceinline__ bool next(int i, Unit& u) const { u.z = 0; return o.next(i, u.pm, u.pn); } };
struct SchedBatch8 { Order o; __device__ __forceinline__ bool next(int i, Unit& u) const { int pm, pn; if (!o.next(i, pm, pn)) return false; u.z = pm >> 3; u.pm = pm & 7; u.pn = 0; return true; } };
}

struct PvUpG { const bf16_t* X; const bf16_t* WT; const int* tile_e; const int* slot_tok; int lda, ldb, K;
    __device__ __forceinline__ const bf16_t* a_root() const { return X; }
    __device__ __forceinline__ const bf16_t* b_root() const { return WT; }
    __device__ __forceinline__ const bf16_t* a_base(const Unit&) const { return X; }
    __device__ __forceinline__ const bf16_t* b_base(const Unit& u) const { return WT + ((size_t)tile_e[u.pm] * 2048 + u.pn * 256) * ldb; }
    __device__ __forceinline__ int row_tok(const Unit& u, int r) const { return slot_tok[u.pm * 256 + r]; } };
struct PvPlain { const bf16_t* A; const bf16_t* Bt; int lda, ldb, K;
    __device__ __forceinline__ const bf16_t* a_root() const { return A; }
    __device__ __forceinline__ const bf16_t* b_root() const { return Bt; }
    __device__ __forceinline__ const bf16_t* a_base(const Unit& u) const { return A + (size_t)u.pm * 256 * lda; }
    __device__ __forceinline__ const bf16_t* b_base(const Unit& u) const { return Bt + (size_t)u.pn * 256 * ldb; } };
struct PvXS { const bf16_t* XQ; const bf16_t* KM; int lda, ldb, K;
    __device__ __forceinline__ const bf16_t* a_base(const Unit& u) const { return XQ + (size_t)((u.z >> 2) * 2048 + u.pm * 256) * 1024 + (u.z & 3) * 256; }
    __device__ __forceinline__ const bf16_t* b_base(const Unit& u) const { return KM + (size_t)((u.z >> 2) * 256) * 1024 + (u.z & 3) * 256; } };
struct PvXPV { const bf16_t* Pm; const bf16_t* VMT; int lda, ldb, K;
    __device__ __forceinline__ const bf16_t* a_base(const Unit& u) const { return Pm + ((size_t)u.z * 2048 + u.pm * 256) * 256; }
    __device__ __forceinline__ const bf16_t* b_base(const Unit& u) const { return VMT + (size_t)u.z * 65536; } };
struct PvExp { const bf16_t* A; const bf16_t* WT; const int* tile_e; int lda, ldb, K, nrow;
    __device__ __forceinline__ const bf16_t* a_root() const { return A; }
    __device__ __forceinline__ const bf16_t* b_root() const { return WT; }
    __device__ __forceinline__ const bf16_t* a_base(const Unit& u) const { return A + (size_t)u.pm * 256 * lda; }
    __device__ __forceinline__ const bf16_t* b_base(const Unit& u) const { return WT + ((size_t)tile_e[u.pm] * nrow + u.pn * 256) * ldb; } };

constexpr int MLA_KT = 12288, MLA_VT = 8192, MLA_KBUF = 2 * MLA_KT, MLA_VBUF = 2 * MLA_VT, MLA_V0 = 2 * MLA_KBUF;
typedef short v4i16_t __attribute__((ext_vector_type(4)));
__device__ __forceinline__ s16x4 lds_tr16(const LAS unsigned char* p) { return __builtin_bit_cast(s16x4, __builtin_amdgcn_ds_read_tr16_b64_v4i16((LAS v4i16_t*)p)); }
__device__ __forceinline__ void mla_unit(const Params& p, LAS unsigned char* lds, int unit, int tid) {
    const int lane = tid & 63, wid = __builtin_amdgcn_readfirstlane(tid >> 6), r32 = lane & 31, hi = lane >> 5;
    const int qb = unit & 7, h = (unit >> 3) & 7, b = unit >> 6;
    const bf16_t* Qg = (const bf16_t*)(p.ws + WS_Q); const bf16_t* Kg = (const bf16_t*)(p.ws + WS_KB); const bf16_t* Vg = (const bf16_t*)(p.ws + WS_VB);
    const size_t rowb = (size_t)b * SEQ;
    const int q0 = qb * 256 + wid * 32;
    int ksrc[3], kdst[3], vsrc[2], vdst[2];
    const bf16_t* Kbh = Kg + rowb * 768 + h * 96; const bf16_t* Vbh = Vg + rowb * 512 + h * 64;
#pragma unroll
    for (int i = 0; i < 3; ++i) { const int pk = tid + 512 * i, r = pk / 12, c = pk % 12; ksrc[i] = r * 768 + c * 8; kdst[i] = (r >> 6) * MLA_KT + c * 1024 + (r & 63) * 16; }
#pragma unroll
    for (int i = 0; i < 2; ++i) { const int pk = tid + 512 * i, r = pk >> 3, c = pk & 7; vsrc[i] = r * 512 + c * 8; vdst[i] = MLA_V0 + (r >> 6) * MLA_VT + (c >> 2) * 4096 + (r & 63) * 64 + (c & 3) * 16; }
    const int kfo = hi * 1024 + r32 * 16;
    const int vfo = MLA_V0 + ((lane >> 4) & 1) * 32 + (lane & 3) * 8 + (4 * hi + ((lane & 15) >> 2)) * 64;
    bf16x8 qf[6];
#pragma unroll
    for (int s = 0; s < 6; ++s) qf[s] = *(const bf16x8*)(Qg + (rowb + q0 + r32) * 768 + h * 96 + 16 * s + 8 * hi);
    const int ns_blk = 2 * qb + 2, nt_me = 4 * qb + (wid >> 1) + 1;
    u32x4 sk[3], sv[2];
#pragma unroll
    for (int i = 0; i < 3; ++i) sk[i] = *(const u32x4*)(Kbh + ksrc[i]);
#pragma unroll
    for (int i = 0; i < 2; ++i) sv[i] = *(const u32x4*)(Vbh + vsrc[i]);
#pragma unroll
    for (int i = 0; i < 3; ++i) *(LAS u32x4*)(lds + kdst[i]) = sk[i];
#pragma unroll
    for (int i = 0; i < 2; ++i) *(LAS u32x4*)(lds + vdst[i]) = sv[i];
    __syncthreads();
    float mrun = -1.0e30f, lrun = 0.f; f32x16 o0 = {}, o1 = {};
    for (int st = 0; st < ns_blk; ++st) {
        const bool pre = (st + 1 < ns_blk);
        if (pre) { const bf16_t* kn = Kbh + (size_t)(st + 1) * 128 * 768; const bf16_t* vn = Vbh + (size_t)(st + 1) * 128 * 512;
#pragma unroll
            for (int i = 0; i < 3; ++i) sk[i] = *(const u32x4*)(kn + ksrc[i]);
#pragma unroll
            for (int i = 0; i < 2; ++i) sv[i] = *(const u32x4*)(vn + vsrc[i]); }
#pragma unroll
        for (int tt = 0; tt < 2; ++tt) {
          const int t = 2 * st + tt;
          if (t < nt_me) {
            const LAS unsigned char* kb_ = lds + (st & 1) * MLA_KBUF + tt * MLA_KT + kfo; const LAS unsigned char* vb_ = lds + (st & 1) * MLA_VBUF + tt * MLA_VT + vfo;
            f32x16 sc[2]; bf16x8 kf[2][6]; s16x4 vlo[8], vhi[8];
#pragma unroll
            for (int kb = 0; kb < 2; ++kb)
#pragma unroll
                for (int s = 0; s < 6; ++s) kf[kb][s] = *(const LAS bf16x8*)(kb_ + s * 2048 + kb * 512);
            __builtin_amdgcn_sched_barrier(0);
#pragma unroll
            for (int kb = 0; kb < 2; ++kb) { f32x16 a = {};
#pragma unroll
                for (int s = 0; s < 6; ++s) a = __builtin_amdgcn_mfma_f32_32x32x16_bf16(kf[kb][s], qf[s], a, 0, 0, 0);
                sc[kb] = a; }
            __builtin_amdgcn_sched_barrier(0);
#pragma unroll
            for (int i = 0; i < 8; ++i) { const LAS unsigned char* vr = vb_ + (i & 1) * 4096 + (i >> 2) * 2048 + ((i >> 1) & 1) * 1024; vlo[i] = lds_tr16(vr); vhi[i] = lds_tr16(vr + 512); }
            __builtin_amdgcn_sched_barrier(0);
            float mx = fmaxf(fmaxf(sc[0][0], sc[0][1]), sc[1][0]);
#pragma unroll
            for (int r = 2; r < 16; r += 2) mx = fmaxf(fmaxf(mx, sc[0][r]), sc[0][r + 1]);
#pragma unroll
            for (int r = 1; r < 15; r += 2) mx = fmaxf(fmaxf(mx, sc[1][r]), sc[1][r + 1]);
            mx = fmaxf(mx, sc[1][15]);
            mx = fmaxf(mx, shflx(mx, 32, lane));
            if (__any(mx > mrun + 8.0f)) { const float mnew = fmaxf(mrun, mx), alpha = fast_exp2(mrun - mnew); mrun = mnew; lrun *= alpha;
#pragma unroll
                for (int r = 0; r < 16; ++r) { o0[r] *= alpha; o1[r] *= alpha; } }
            float ls = 0.f; unsigned pw[2][8];
#pragma unroll
            for (int kb = 0; kb < 2; ++kb)
#pragma unroll
                for (int r = 0; r < 16; r += 2) { const float e0 = fast_exp2(sc[kb][r] - mrun), e1 = fast_exp2(sc[kb][r + 1] - mrun); pw[kb][r >> 1] = pk2(e0, e1); ls += e0 + e1; }
            lrun += ls;
#pragma unroll
            for (int kb = 0; kb < 2; ++kb)
#pragma unroll
                for (int s2 = 0; s2 < 2; ++s2) {
                    const bf16x8 pf = __builtin_bit_cast(bf16x8, (u32x4){pw[kb][4 * s2 + 0], pw[kb][4 * s2 + 1], pw[kb][4 * s2 + 2], pw[kb][4 * s2 + 3]});
#pragma unroll
                    for (int db = 0; db < 2; ++db) { const int i = 4 * kb + 2 * s2 + db;
                        const bf16x8 vf = (bf16x8){vlo[i][0], vlo[i][1], vlo[i][2], vlo[i][3], vhi[i][0], vhi[i][1], vhi[i][2], vhi[i][3]};
                        if (db == 0) o0 = __builtin_amdgcn_mfma_f32_32x32x16_bf16(vf, pf, o0, 0, 0, 0); else o1 = __builtin_amdgcn_mfma_f32_32x32x16_bf16(vf, pf, o1, 0, 0, 0); } }
          }
        }
        if (pre) { LAS unsigned char* nk = lds + ((st + 1) & 1) * MLA_KBUF; LAS unsigned char* nv = lds + ((st + 1) & 1) * MLA_VBUF;
#pragma unroll
            for (int i = 0; i < 3; ++i) *(LAS u32x4*)(nk + kdst[i]) = sk[i];
#pragma unroll
            for (int i = 0; i < 2; ++i) *(LAS u32x4*)(nv + vdst[i]) = sv[i]; }
        __syncthreads();
    }
    lrun += shflx(lrun, 32, lane);
    const float inv = 1.0f / lrun;
    bf16_t* yo = (bf16_t*)(p.ws + WS_YCAT) + (rowb + q0 + r32) * 1024 + h * 64;
#pragma unroll
    for (int g = 0; g < 4; ++g) { u32x2 w0, w1; w0.x = pk2(o0[4 * g] * inv, o0[4 * g + 1] * inv); w0.y = pk2(o0[4 * g + 2] * inv, o0[4 * g + 3] * inv);
        w1.x = pk2(o1[4 * g] * inv, o1[4 * g + 1] * inv); w1.y = pk2(o1[4 * g + 2] * inv, o1[4 * g + 3] * inv);
        *(u32x2*)(yo + 8 * g + 4 * hi) = w0; *(u32x2*)(yo + 32 + 8 * g + 4 * hi) = w1; }
}

constexpr int XA_KB = 32768, XA_BUF = 65536;
__device__ __forceinline__ void xattn_range(const Params& p, LAS unsigned char* lds, int u0, int nu, int tid, unsigned long long* tacc = nullptr) {
    const int lane = tid & 63, wid = __builtin_amdgcn_readfirstlane(tid >> 6), fr = lane & 15, fq = lane >> 4;
    const bf16_t* XQ = (const bf16_t*)(p.ws + WS_XQ); const bf16_t* KM = (const bf16_t*)(p.ws + WS_KM); const bf16_t* VMT = (const bf16_t*)(p.ws + WS_VMT); bf16_t* OX = (bf16_t*)(p.ws + WS_OX);
    const int kpos0 = 8 * wid + (lane >> 5);
    const int vrow = 32 * wid + (lane >> 3), vslot = (lane & 7) ^ (vrow & 7);
    const int vsrc = vrow * 256 + vslot * 8;
    const int nstep = nu * 4;
#define XA_DMA(step) do { const int un_ = u0 + ((step) >> 2), t_ = (step) & 3, z_ = un_ >> 4; \
        const bf16_t* kp_ = KM + ((size_t)((z_ >> 2) * 256 + 64 * t_)) * 1024 + (z_ & 3) * 256; const bf16_t* vp_ = VMT + (size_t)z_ * 65536 + 64 * t_ + vsrc; \
        LAS unsigned char* nb_ = lds + ((step) & 1) * XA_BUF + wid * 4096; \
        _Pragma("unroll") for (int i_ = 0; i_ < 4; ++i_) { const int pos_ = kpos0 + 2 * i_; const int key_ = (pos_ & 32) + 8 * ((pos_ >> 2) & 3) + 4 * ((pos_ >> 4) & 1) + (pos_ & 3); \
            __builtin_amdgcn_global_load_lds((const unsigned*)(kp_ + key_ * 1024 + (((lane & 31) ^ (pos_ & 15)) << 3)), (LAS unsigned*)(nb_ + i_ * 1024), 16, 0, 0); \
            __builtin_amdgcn_global_load_lds((const unsigned*)(vp_ + i_ * 8 * 256), (LAS unsigned*)(nb_ + XA_KB + i_ * 1024), 16, 0, 0); } } while (0)
    XA_DMA(0);
    bf16x8 qf[8]; f32x4 oacc[16]; float mrun = -1.0e30f, lrun = 0.f;
    { const int z = u0 >> 4; const size_t qrow = (size_t)(z >> 2) * 2048 + (u0 & 15) * 128 + wid * 16 + fr;
#pragma unroll
      for (int ks = 0; ks < 8; ++ks) qf[ks] = *(const bf16x8*)(XQ + qrow * 1024 + (z & 3) * 256 + 32 * ks + 8 * fq); }
    __syncthreads();
    for (int step = 0; step < nstep; ++step) {
        const int t = step & 3, un = u0 + (step >> 2), z = un >> 4, b = z >> 2, h = z & 3;
        const size_t qrow = (size_t)b * 2048 + (un & 15) * 128 + wid * 16 + fr;
        if (t == 0) {
#pragma unroll
            for (int db = 0; db < 16; ++db) oacc[db] = (f32x4){0.f, 0.f, 0.f, 0.f};
            mrun = -1.0e30f; lrun = 0.f; }
        if (step + 1 < nstep) XA_DMA(step + 1);
        { const LAS unsigned char* kb = lds + (step & 1) * XA_BUF; const LAS unsigned char* vb = kb + XA_KB;
          f32x4 sacc[4]; bf16x8 kfa[8], kfb[8];
#define XA_LDK(dst, kvb) do { _Pragma("unroll") for (int ks = 0; ks < 8; ++ks) dst[ks] = *(const LAS bf16x8*)(kb + (16 * (kvb) + fr) * 512 + (((4 * ks + fq) ^ fr) << 4)); } while (0)
#define XA_QK(src, kvb) do { f32x4 a_ = {0.f, 0.f, 0.f, 0.f}; _Pragma("unroll") for (int ks = 0; ks < 8; ++ks) a_ = __builtin_amdgcn_mfma_f32_16x16x32_bf16(src[ks], qf[ks], a_, 0, 0, 0); sacc[kvb] = a_; } while (0)
          XA_LDK(kfa, 0); XA_LDK(kfb, 1); __builtin_amdgcn_sched_barrier(0);
          XA_QK(kfa, 0); XA_LDK(kfa, 2); __builtin_amdgcn_sched_barrier(0);
          XA_QK(kfb, 1); XA_LDK(kfb, 3); __builtin_amdgcn_sched_barrier(0);
          XA_QK(kfa, 2); __builtin_amdgcn_sched_barrier(0);
          XA_QK(kfb, 3);
#undef XA_LDK
#undef XA_QK
          float mx = fmaxf(fmaxf(sacc[0][0], sacc[0][1]), fmaxf(sacc[0][2], sacc[0][3]));
#pragma unroll
          for (int kvb = 1; kvb < 4; ++kvb) { mx = fmaxf(fmaxf(mx, sacc[kvb][0]), sacc[kvb][1]); mx = fmaxf(fmaxf(mx, sacc[kvb][2]), sacc[kvb][3]); }
          mx = fmaxf(mx, shflx(mx, 16, fr + 16 * fq)); mx = fmaxf(mx, shflx(mx, 32, fr + 16 * fq));
          if (__any(mx > mrun + 8.0f)) { const float mnew = fmaxf(mrun, mx), alpha = fast_exp2(mrun - mnew); mrun = mnew; lrun *= alpha;
#pragma unroll
              for (int db = 0; db < 16; ++db) oacc[db] = oacc[db] * alpha; }
          float ls = 0.f; u32x4 pw[2];
#pragma unroll
          for (int s2 = 0; s2 < 2; ++s2) { unsigned w[4];
#pragma unroll
              for (int hh = 0; hh < 2; ++hh)
#pragma unroll
                  for (int jj = 0; jj < 2; ++jj) { const float e0 = fast_exp2(sacc[2 * s2 + hh][2 * jj] - mrun), e1 = fast_exp2(sacc[2 * s2 + hh][2 * jj + 1] - mrun); w[2 * hh + jj] = pk2(e0, e1); ls += e0 + e1; }
              pw[s2] = (u32x4){w[0], w[1], w[2], w[3]}; }
          lrun += ls;
          { bf16x8 vfa[8], vfb[8];
#define XA_LDV(dst, s2, d0) do { _Pragma("unroll") for (int i = 0; i < 8; ++i) dst[i] = *(const LAS bf16x8*)(vb + (16 * ((d0) + i) + fr) * 128 + (((4 * (s2) + fq) ^ (fr & 7)) << 4)); } while (0)
#define XA_PV(src, s2, d0) do { const bf16x8 pf_ = __builtin_bit_cast(bf16x8, pw[s2]); _Pragma("unroll") for (int i = 0; i < 8; ++i) oacc[(d0) + i] = __builtin_amdgcn_mfma_f32_16x16x32_bf16(src[i], pf_, oacc[(d0) + i], 0, 0, 0); } while (0)
            XA_LDV(vfa, 0, 0); XA_LDV(vfb, 0, 8); __builtin_amdgcn_sched_barrier(0);
            XA_PV(vfa, 0, 0); XA_LDV(vfa, 1, 0); __builtin_amdgcn_sched_barrier(0);
            XA_PV(vfb, 0, 8); XA_LDV(vfb, 1, 8); __builtin_amdgcn_sched_barrier(0);
            XA_PV(vfa, 1, 0); __builtin_amdgcn_sched_barrier(0);
            XA_PV(vfb, 1, 8);
#undef XA_LDV
#undef XA_PV
          } }
        if (t == 3) { float lt = lrun; lt += shflx(lt, 16, lane); lt += shflx(lt, 32, lane); const float inv = 1.0f / lt;
            int t3; asm volatile("v_mbcnt_lo_u32_b32 %0, -1, 0\n\tv_mbcnt_hi_u32_b32 %0, -1, %0" : "=v"(t3)); t3 += wid << 6;
            const size_t qrow3 = (size_t)b * 2048 + (un & 15) * 128 + (t3 >> 6) * 16 + (t3 & 15);
            bf16_t* orow = OX + qrow3 * 1024 + h * 256 + 4 * ((t3 >> 4) & 3);
#pragma unroll
            for (int db = 0; db < 16; ++db) { const f32x4 v = oacc[db] * inv; u32x2 w; w.x = pk2(v[0], v[1]); w.y = pk2(v[2], v[3]); *(u32x2*)(orow + 16 * db) = w; }
            if (step + 1 < nstep) { const int un2 = un + 1, z2 = un2 >> 4; const size_t qr2 = (size_t)(z2 >> 2) * 2048 + (un2 & 15) * 128 + wid * 16 + fr;
#pragma unroll
                for (int ks = 0; ks < 8; ++ks) qf[ks] = *(const bf16x8*)(XQ + qr2 * 1024 + (z2 & 3) * 256 + 32 * ks + 8 * fq); } }
#if PROBE_XA
        const unsigned long long tb0_ = __builtin_amdgcn_s_memrealtime();
#endif
        __syncthreads();
#if PROBE_XA
        if (tacc) *tacc += __builtin_amdgcn_s_memrealtime() - tb0_;
#endif
    }
#undef XA_DMA
}

__device__ __forceinline__ void conv_unit(const Params& p, LAS unsigned char* lds, int unit, int tid) {
    const int lane = tid & 63, wid = tid >> 6, c = tid;
    const int b = unit >> 5, t0 = (unit & 31) * 64;
    LAS float* cl = (LAS float*)lds;
    LAS float* wl = (LAS float*)(lds + 65536);
    const __amdgpu_buffer_rsrc_t wr_ = __builtin_amdgcn_make_buffer_rsrc((void*)p.w_dw, 0, 31 * 512 * 4, 0x00020000);
#pragma unroll
    for (int j = 0; j < 31; ++j) wl[j * 512 + c] = __uint_as_float(__builtin_amdgcn_raw_buffer_load_b32(wr_, c * 4, j * 2048, 0));
    const __amdgpu_buffer_rsrc_t zr = __builtin_amdgcn_make_buffer_rsrc((void*)(p.ws + WS_Z), 0, (int)((size_t)NTOK * 512 * 2), 0x00020000);
    float z[94];
#define CV_BATCH(i0, n) do { unsigned short raw_[n]; \
        _Pragma("unroll") for (int i_ = 0; i_ < (n); ++i_) { const int t_ = t0 - 30 + (i0) + i_; const int tc_ = t_ < 0 ? 0 : t_; raw_[i_] = __builtin_amdgcn_raw_buffer_load_b16(zr, c * 2, (b * SEQ + tc_) * 1024, 0); } \
        __builtin_amdgcn_sched_barrier(0); \
        _Pragma("unroll") for (int i_ = 0; i_ < (n); ++i_) { const int t_ = t0 - 30 + (i0) + i_; z[(i0) + i_] = t_ < 0 ? 0.f : bf2f(raw_[i_]); } \
        __builtin_amdgcn_sched_barrier(0); } while (0)
    CV_BATCH(0, 32); CV_BATCH(32, 32); CV_BATCH(64, 30);
#undef CV_BATCH
    const float bias = p.b_dw[c];
    const f32x4 g0 = *(const f32x4*)(p.g_cln + lane * 8), g1 = *(const f32x4*)(p.g_cln + lane * 8 + 4), b0 = *(const f32x4*)(p.b_cln + lane * 8), b1 = *(const f32x4*)(p.b_cln + lane * 8 + 4);
#pragma unroll
    for (int ps = 0; ps < 2; ++ps) {
        float acc[32];
#pragma unroll
        for (int o = 0; o < 32; ++o) acc[o] = bias;
#pragma unroll
        for (int j = 0; j < 31; ++j) { const float wj = wl[j * 512 + c];
#pragma unroll
            for (int o = 0; o < 32; ++o) acc[o] += wj * z[32 * ps + o + j]; }
#pragma unroll
        for (int o = 0; o < 32; ++o) cl[o * 512 + c] = acc[o];
        __syncthreads();
#pragma unroll
        for (int oo = 0; oo < 4; ++oo) { const int o = wid * 4 + oo; const LAS float* r = cl + o * 512 + lane * 8;
            const f32x4 v0 = *(const LAS f32x4*)r, v1 = *(const LAS f32x4*)(r + 4);
            float s = (v0[0] + v0[1]) + (v0[2] + v0[3]) + (v1[0] + v1[1]) + (v1[2] + v1[3]); s = wave_sum(s, lane); const float mu = s * (1.0f / 512.0f);
            const f32x4 d0 = v0 - mu, d1 = v1 - mu; float q = (d0[0] * d0[0] + d0[1] * d0[1]) + (d0[2] * d0[2] + d0[3] * d0[3]) + (d1[0] * d1[0] + d1[1] * d1[1]) + (d1[2] * d1[2] + d1[3] * d1[3]);
            q = wave_sum(q, lane); const float rstd = 1.0f / sqrtf(q * (1.0f / 512.0f) + EPS);
            float y[8];
#pragma unroll
            for (int j = 0; j < 4; ++j) { const float a0 = d0[j] * rstd * g0[j] + b0[j], a1 = d1[j] * rstd * g1[j] + b1[j]; y[j] = a0 * sigmoidf_(a0); y[4 + j] = a1 * sigmoidf_(a1); }
            u32x4 wv; wv.x = pk2(y[0], y[1]); wv.y = pk2(y[2], y[3]); wv.z = pk2(y[4], y[5]); wv.w = pk2(y[6], y[7]);
            *(u32x4*)((bf16_t*)(p.ws + WS_YCAT) + ((size_t)b * SEQ + t0 + 32 * ps + o) * 1024 + 512 + lane * 8) = wv; }
        __syncthreads();
    }
}

constexpr int R1_LD = 2064;
constexpr int R1_LG = 2 * 32 * R1_LD;
__device__ __forceinline__ void router1_stage_weights(const Params& p, LAS unsigned char* lds, int tid) {
    const u32x4* W = (const u32x4*)(p.ws + WS_WR);
#pragma unroll 4
    for (int i = tid; i < 64 * 128; i += 512) { const int row = i >> 7, c = i & 127; *(LAS u32x4*)(lds + row * R1_LD + c * 16) = W[i]; }
    __syncthreads();
}
__device__ __forceinline__ void router1_unit(const Params& p, LAS unsigned char* lds, int unit, int tid) {
    const int lane = tid & 63, wid = tid >> 6, r = lane & 15, q = lane >> 4;
    LAS float* lg = (LAS float*)(lds + R1_LG) + wid * 512;
    LAS int* hist = (LAS int*)(lds + R1_LG + 16384);
    if (tid < 32) hist[tid] = 0;
    __syncthreads();
    const int tok0 = unit * RT_TOK + wid * 16;
    const bf16_t* xr = (const bf16_t*)(p.ws + WS_X2B) + (size_t)(tok0 + r) * 1024 + 8 * q;
    const LAS unsigned char* wh0 = lds + r * R1_LD + 16 * q;
    u32x4 xw[32];
#pragma unroll
    for (int ks = 0; ks < 32; ++ks) xw[ks] = *(const u32x4*)(xr + 32 * ks);
    f32x4 acc0 = {0.f, 0.f, 0.f, 0.f}, acc1 = {0.f, 0.f, 0.f, 0.f}; float ssq = 0.f;
#pragma unroll
    for (int ks = 0; ks < 32; ++ks) {
        const u32x4 w = xw[ks];
        { const float a0 = __uint_as_float(w.x << 16), a1 = __uint_as_float(w.x & 0xffff0000u), a2 = __uint_as_float(w.y << 16), a3 = __uint_as_float(w.y & 0xffff0000u);
          const float a4 = __uint_as_float(w.z << 16), a5 = __uint_as_float(w.z & 0xffff0000u), a6 = __uint_as_float(w.w << 16), a7 = __uint_as_float(w.w & 0xffff0000u);
          ssq += (a0 * a0 + a1 * a1) + (a2 * a2 + a3 * a3) + (a4 * a4 + a5 * a5) + (a6 * a6 + a7 * a7); }
        const bf16x8 ah = __builtin_bit_cast(bf16x8, w);
        const bf16x8 bh0 = *(const LAS bf16x8*)(wh0 + 64 * ks), bh1 = *(const LAS bf16x8*)(wh0 + 16 * R1_LD + 64 * ks);
        const bf16x8 bl0 = *(const LAS bf16x8*)(wh0 + 32 * R1_LD + 64 * ks), bl1 = *(const LAS bf16x8*)(wh0 + 48 * R1_LD + 64 * ks);
        acc0 = __builtin_amdgcn_mfma_f32_16x16x32_bf16(ah, bh0, acc0, 0, 0, 0); acc1 = __builtin_amdgcn_mfma_f32_16x16x32_bf16(ah, bh1, acc1, 0, 0, 0);
        acc0 = __builtin_amdgcn_mfma_f32_16x16x32_bf16(ah, bl0, acc0, 0, 0, 0); acc1 = __builtin_amdgcn_mfma_f32_16x16x32_bf16(ah, bl1, acc1, 0, 0, 0);
    }
    ssq += shflx(ssq, 16, lane); ssq += shflx(ssq, 32, lane);
    const float rstd_r = 1.0f / sqrtf(ssq * (1.0f / 1024.0f) + EPS);
    if (lane < 16) ((float*)(p.ws + WS_RSTD_X2))[tok0 + lane] = rstd_r;
    const float be0 = p.b_router[r], be1 = p.b_router[16 + r];
#pragma unroll
    for (int j = 0; j < 4; ++j) { const float rs = shfli(rstd_r, 4 * q + j); lg[(4 * q + j) * 32 + r] = acc0[j] * rs + be0; lg[(4 * q + j) * 32 + 16 + r] = acc1[j] * rs + be1; }
    asm volatile("s_waitcnt lgkmcnt(0)" ::: "memory");
    if (lane < 16) { const int tk = tok0 + lane; unsigned used = 0u; float tv[4]; int ti[4];
#pragma unroll
        for (int k = 0; k < 4; ++k) { float best = -3.0e38f; int bi = 0;
            for (int j = 0; j < 32; ++j) { const float v = lg[lane * 32 + j]; if (!((used >> j) & 1u) && v > best) { best = v; bi = j; } }
            used |= 1u << bi; tv[k] = best; ti[k] = bi; }
        const float e1 = __expf(tv[1] - tv[0]), e2 = __expf(tv[2] - tv[0]), e3 = __expf(tv[3] - tv[0]); const float inv = 1.0f / (1.0f + e1 + e2 + e3);
        int* oi = (int*)(p.ws + WS_TOPI) + (size_t)tk * 4; float* og = (float*)(p.ws + WS_TOPG) + (size_t)tk * 4;
        oi[0] = ti[0]; oi[1] = ti[1]; oi[2] = ti[2]; oi[3] = ti[3]; og[0] = inv; og[1] = e1 * inv; og[2] = e2 * inv; og[3] = e3 * inv;
#pragma unroll
        for (int k = 0; k < 4; ++k) atomicAdd((int*)&hist[ti[k]], 1); }
    __syncthreads();
    if (tid < 32) ((int*)(p.ws + WS_HIST))[unit * 32 + tid] = hist[tid];
    __syncthreads();
}
__device__ __forceinline__ void router2_unit(const Params& p, LAS unsigned char* lds, int unit, int tid) {
    const int lane = tid & 63, wid = tid >> 6;
    LAS int* cnt = (LAS int*)lds;
    LAS int* base = cnt + 32;
    LAS int* pst = cnt + 64;
    LAS int* part = cnt + 128;
    LAS int* wcnt = cnt + 128 + 1024;
    const int* H = (const int*)(p.ws + WS_HIST);
    { const int e = tid & 31, pt = tid >> 5; int tot = 0, bs = 0;
#pragma unroll 4
      for (int j = 0; j < 16; ++j) { const int bq = pt * 16 + j; const int v = H[bq * 32 + e]; tot += v; bs += (bq < unit) ? v : 0; }
      part[pt * 64 + e] = tot; part[pt * 64 + 32 + e] = bs; }
    const int my_e = ((const int*)(p.ws + WS_TOPI))[(size_t)unit * RT_TOK * 4 + tid];
    int my_rank = 0;
#pragma unroll 4
    for (int e = 0; e < 32; ++e) { const unsigned long long m = __ballot(my_e == e); if (my_e == e) my_rank = __popcll(m & ((1ull << lane) - 1ull)); if (lane == 0) wcnt[wid * 32 + e] = __popcll(m); }
    __syncthreads();
    if (tid < 32) { int tot = 0, bs = 0;
#pragma unroll
        for (int pt = 0; pt < 16; ++pt) { tot += part[pt * 64 + tid]; bs += part[pt * 64 + 32 + tid]; }
        cnt[tid] = tot; base[tid] = bs; }
    __syncthreads();
    if (tid == 0) { int sacc = 0; for (int e = 0; e < 32; ++e) { pst[e] = sacc; sacc += (cnt[e] + 255) & ~255; } pst[32] = sacc; }
    __syncthreads();
    { int woff = 0;
#pragma unroll
      for (int w = 0; w < 8; ++w) woff += (w < wid) ? wcnt[w * 32 + my_e] : 0;
      const int d = pst[my_e] + base[my_e] + woff + my_rank; const int tok = unit * RT_TOK + (tid >> 2);
      ((int*)(p.ws + WS_SLOT_TOK))[d] = tok; ((float*)(p.ws + WS_SLOT_GATE))[d] = ((const float*)(p.ws + WS_TOPG))[(size_t)unit * RT_TOK * 4 + tid];
      ((int*)(p.ws + WS_INV))[(size_t)unit * RT_TOK * 4 + tid] = d; ((float*)(p.ws + WS_SLOT_RS))[d] = ((const float*)(p.ws + WS_RSTD_X2))[tok]; }
    if (unit < 32) { const int e = unit, s0 = pst[e] + cnt[e], s1 = pst[e + 1];
        for (int s = s0 + tid; s < s1; s += 512) { ((int*)(p.ws + WS_SLOT_TOK))[s] = 0; ((float*)(p.ws + WS_SLOT_GATE))[s] = 0.f; ((float*)(p.ws + WS_SLOT_RS))[s] = 0.f; } }
    if (unit == 32) { int* te = (int*)(p.ws + WS_TILE_E); const int nt = pst[32] >> 8;
        for (int t = tid; t < NTILE_MAX; t += 512) { int e = 31; for (int k = 31; k >= 0; --k) if (t * 256 < pst[k + 1]) e = k; te[t] = e; }
        if (tid == 0) te[NTILE_MAX] = nt; }
    __syncthreads();
}

struct FinalRows { u32x2 x[4]; u32x2 y[4][4]; };
__device__ __forceinline__ void final_load(const Params& p, int tok, int i0, int i1, int i2, int i3, FinalRows& r, int lane) {
    const u32x2* x2 = (const u32x2*)((const bf16_t*)(p.ws + WS_X2B) + (size_t)tok * 1024); const bf16_t* YB = (const bf16_t*)(p.ws + WS_YB);
    const u32x2* y0 = (const u32x2*)(YB + (size_t)i0 * 1024); const u32x2* y1 = (const u32x2*)(YB + (size_t)i1 * 1024); const u32x2* y2 = (const u32x2*)(YB + (size_t)i2 * 1024); const u32x2* y3 = (const u32x2*)(YB + (size_t)i3 * 1024);
#pragma unroll
    for (int j = 0; j < 4; ++j) { r.x[j] = x2[lane + 64 * j]; r.y[0][j] = y0[lane + 64 * j]; r.y[1][j] = y1[lane + 64 * j]; r.y[2][j] = y2[lane + 64 * j]; r.y[3][j] = y3[lane + 64 * j]; }
}
__device__ __forceinline__ void final_stage(const Params& p, int gw, int ngw, int lane) {
    if (gw >= NTOK) return;
    const int* INV = (const int*)(p.ws + WS_INV);
    FinalRows cur, nxt; int tok = gw;
    { const int* iv = INV + (size_t)tok * 4; final_load(p, tok, iv[0], iv[1], iv[2], iv[3], cur, lane); }
    int n0 = 0, n1 = 0, n2 = 0, n3 = 0;
    if (tok + ngw < NTOK) { const int* iv = INV + (size_t)(tok + ngw) * 4; n0 = iv[0]; n1 = iv[1]; n2 = iv[2]; n3 = iv[3]; }
    const f32x4 g0 = ((const f32x4*)p.g_final)[lane], g1 = ((const f32x4*)p.g_final)[lane + 64], g2 = ((const f32x4*)p.g_final)[lane + 128], g3 = ((const f32x4*)p.g_final)[lane + 192];
    for (; tok < NTOK; tok += ngw) {
        const int tn = tok + ngw;
        if (tn < NTOK) { final_load(p, tn, n0, n1, n2, n3, nxt, lane);
            if (tn + ngw < NTOK) { const int* iv = INV + (size_t)(tn + ngw) * 4; n0 = iv[0]; n1 = iv[1]; n2 = iv[2]; n3 = iv[3]; } }
        f32x4 v[4];
#pragma unroll
        for (int j = 0; j < 4; ++j) { const u32x2 w = cur.x[j]; v[j][0] = __uint_as_float(w.x << 16); v[j][1] = __uint_as_float(w.x & 0xffff0000u); v[j][2] = __uint_as_float(w.y << 16); v[j][3] = __uint_as_float(w.y & 0xffff0000u); }
#pragma unroll
        for (int k = 0; k < 4; ++k)
#pragma unroll
            for (int j = 0; j < 4; ++j) { const u32x2 w = cur.y[k][j]; v[j][0] += __uint_as_float(w.x << 16); v[j][1] += __uint_as_float(w.x & 0xffff0000u); v[j][2] += __uint_as_float(w.y << 16); v[j][3] += __uint_as_float(w.y & 0xffff0000u); }
        float s = 0.f;
#pragma unroll
        for (int j = 0; j < 4; ++j) s += (v[j][0] * v[j][0] + v[j][1] * v[j][1]) + (v[j][2] * v[j][2] + v[j][3] * v[j][3]);
        s = wave_sum(s, lane); const float rstd = 1.0f / sqrtf(s * (1.0f / 1024.0f) + EPS);
        f32x4* xr = (f32x4*)(p.out + (size_t)tok * 1024);
        xr[lane] = v[0] * rstd * g0; xr[lane + 64] = v[1] * rstd * g1; xr[lane + 128] = v[2] * rstd * g2; xr[lane + 192] = v[3] * rstd * g3;
        cur = nxt;
    }
}

#define XB_TMO      128
#define XB_XCNT(j)  (256  + 64 * (j))
#define XB_XSUB(j)  (1280 + 64 * (j))
#define XB_XGEN(j)  (2304 + 64 * (j))
#define XB_TOP      3328
#define XB_TOPGEN   3392
#define XCD_BAR_WORDS 3456
constexpr int CW_MLAQ = 4096;
#define XB_SPIN_CAP (1u << 18)
__device__ __forceinline__ unsigned xb_ld(unsigned* p)              { return __hip_atomic_load(p, __ATOMIC_RELAXED, __HIP_MEMORY_SCOPE_AGENT); }
__device__ __forceinline__ unsigned xb_add(unsigned* p, unsigned v) { return __hip_atomic_fetch_add(p, v, __ATOMIC_RELAXED, __HIP_MEMORY_SCOPE_AGENT); }
__device__ __forceinline__ unsigned xb_xcc_id() { return (unsigned)__builtin_amdgcn_s_getreg((3 << 11) | 20) & 0xFu; }
#define XB_SPIN(cond, bar) do { unsigned _sp = 0; while (cond) { __builtin_amdgcn_s_sleep(1); \
    if ((++_sp & 255u) == 0u) { if (xb_ld(&(bar)[XB_TMO])) break; if (_sp > XB_SPIN_CAP) { atomicAdd(&(bar)[XB_TMO], 1u); break; } } } } while (0)
struct XcdBarrier { unsigned* bar; unsigned x; volatile LAS unsigned* st; };
__device__ __forceinline__ XcdBarrier xcd_barrier_post(unsigned* bar, volatile LAS unsigned* st, bool leader) {
    XcdBarrier b; b.bar = bar; b.x = xb_xcc_id(); b.st = st;
    if (leader) (void)xb_add(&bar[XB_XCNT(b.x)], 1u);
    return b;
}
__device__ __forceinline__ void xcd_barrier_complete(unsigned* bar, unsigned x, unsigned& nloc, unsigned& nx) {
    const unsigned G = gridDim.x * gridDim.y * gridDim.z;
    unsigned sum, cnt, mine, sp = 0u;
    for (;;) {
        sum = 0u; cnt = 0u; mine = 0u;
#pragma unroll
        for (unsigned j = 0; j < 16; ++j) { const unsigned c = xb_ld(&bar[XB_XCNT(j)]); sum += c; cnt += (c > 0u) ? 1u : 0u; mine = (j == x) ? c : mine; }
        if (sum == G) break;
        __builtin_amdgcn_s_sleep(1);
        if ((++sp & 255u) == 0u) { if (xb_ld(&bar[XB_TMO])) break; if (sp > XB_SPIN_CAP) { atomicAdd(&bar[XB_TMO], 1u); break; } }
    }
    nloc = mine > 0u ? mine : 1u; nx = cnt > 0u ? cnt : 1u;
}
__device__ __forceinline__ void xcd_barrier(const XcdBarrier& b, bool leader) {
    asm volatile("s_waitcnt vmcnt(0)" ::: "memory");
    __syncthreads();
    if (leader) {
        unsigned* bar = b.bar;
        __builtin_amdgcn_s_waitcnt(0);
        unsigned nloc = b.st[0], nx = b.st[1];
        if (nloc == 0u) { xcd_barrier_complete(bar, b.x, nloc, nx); b.st[0] = nloc; b.st[1] = nx; }
        const unsigned old = xb_add(&bar[XB_XSUB(b.x)], 1u);
        const unsigned gen = old / nloc;
        if (old + 1u == (gen + 1u) * nloc) {
            __builtin_amdgcn_fence(__ATOMIC_RELEASE, "agent");
            asm volatile("s_waitcnt vmcnt(0)" ::: "memory");
            const unsigned og = xb_add(&bar[XB_TOP], 1u);
            const unsigned tg = og / nx;
            if (og + 1u == (tg + 1u) * nx) xb_add(&bar[XB_TOPGEN], 1u);
            else XB_SPIN(xb_ld(&bar[XB_TOPGEN]) == tg, bar);
            __builtin_amdgcn_fence(__ATOMIC_ACQUIRE, "agent");
            xb_add(&bar[XB_XGEN(b.x)], 1u);
            asm volatile("s_waitcnt vmcnt(0)" ::: "memory");
        } else {
            XB_SPIN(xb_ld(&bar[XB_XGEN(b.x)]) == gen, bar);
            __builtin_amdgcn_fence(__ATOMIC_ACQUIRE, "agent");
            asm volatile("s_waitcnt vmcnt(0)" ::: "memory");
        }
    }
    __syncthreads();
}

constexpr int EPI_LDS = 131072;
constexpr int LDS_BYTES = 155648;

#ifndef USE_CG_SYNC
#define USE_CG_SYNC 0
#endif
#if USE_CG_SYNC
#define GRID_SYNC_() grid.sync()
#else
#define GRID_SYNC_() xcd_barrier(xbar, wave_s_ == 0 && __builtin_amdgcn_mbcnt_hi(~0u, __builtin_amdgcn_mbcnt_lo(~0u, 0u)) == 0u)
#endif
#if PROBE_MASK || PROBE_EPI || PROBE_XA || PROBE_SUB
#define GRID_SYNC() do { GRID_SYNC_(); const unsigned long long tn_ = __builtin_amdgcn_s_memrealtime(); if ((PROBE_MASK >> ph_) & 1) tacc_ += tn_ - tprev_; tprev_ = tn_; ++ph_; } while (0)
#else
#define GRID_SYNC() GRID_SYNC_()
#endif
constexpr int XB_LDS = 155520;

__device__ __forceinline__ void mla_order(int vb, int r, int& unit) {
    const int bh = vb >> 1, s = vb & 1; const int qb = (r == 0) ? s : (r == 1) ? 7 - s : (r == 2) ? 3 - s : 4 + s; unit = bh * 8 + qb;
}

#define GAS __attribute__((address_space(1)))
#define FROM_W(f, T, k) p_.f = (T*)(GAS T*)(w_[k])
__device__ __forceinline__ void params_from_words(Params& p_, const unsigned long long (&w_)[29]) {
    FROM_W(x, const float, 0); FROM_W(mem, const float, 1); FROM_W(pos, const int, 2);
    FROM_W(g_mix, const float, 3); FROM_W(w_in, const float, 4); FROM_W(g_q, const float, 5); FROM_W(w_uq, const float, 6); FROM_W(g_kv, const float, 7); FROM_W(w_ukv, const float, 8); FROM_W(w_dw, const float, 9); FROM_W(b_dw, const float, 10);
    FROM_W(g_cln, const float, 11); FROM_W(b_cln, const float, 12); FROM_W(w_out, const float, 13); FROM_W(g_xattn, const float, 14); FROM_W(g_mem, const float, 15); FROM_W(w_xq, const float, 16); FROM_W(w_xkv, const float, 17); FROM_W(w_xo, const float, 18);
    FROM_W(g_ffn, const float, 19); FROM_W(w_router, const float, 20); FROM_W(b_router, const float, 21); FROM_W(w_up, const float, 22); FROM_W(b_up, const float, 23); FROM_W(w_down, const float, 24); FROM_W(b_down, const float, 25); FROM_W(g_final, const float, 26);
    FROM_W(out, float, 27); FROM_W(ws, unsigned char, 28);
}
static_assert(sizeof(Params) == 29 * 8, "Params = 29 pointers");
typedef const __attribute__((address_space(4))) Params* CParams;
#define PHASE_BEGIN() CParams pp_ = (CParams)__builtin_amdgcn_kernarg_segment_ptr(); asm volatile("" : "+s"(pp_)); Params p; { const __attribute__((address_space(4))) unsigned long long* q_ = (const __attribute__((address_space(4))) unsigned long long*)pp_; unsigned long long w_[29]; _Pragma("unroll") for (int k_ = 0; k_ < 29; ++k_) w_[k_] = q_[k_]; params_from_words(p, w_); } unsigned char* ws = p.ws; int tid; asm volatile("v_mbcnt_lo_u32_b32 %0, -1, 0\n\tv_mbcnt_hi_u32_b32 %0, -1, %0" : "=v"(tid)); tid += wave_s_ << 6; const int lane = tid & 63; (void)lane; (void)ws;

__global__ void __launch_bounds__(512) mega_kernel(Params p_unused) {
    extern __shared__ __attribute__((aligned(16))) unsigned char lds_raw[];
#if USE_CG_SYNC
    cg::grid_group grid = cg::this_grid();
#endif
    LAS unsigned char* lds = (LAS unsigned char*)lds_raw;
    const int wave_s_ = __builtin_amdgcn_readfirstlane(threadIdx.x >> 6);
    if (threadIdx.x < 2) ((volatile LAS unsigned*)(lds + XB_LDS))[threadIdx.x] = 0u;
    __syncthreads();
    const XcdBarrier xbar = xcd_barrier_post((unsigned*)(((CParams)__builtin_amdgcn_kernarg_segment_ptr())->ws + WS_CTL), (volatile LAS unsigned*)(lds + XB_LDS), threadIdx.x == 0); (void)xbar;
    const int G = gridDim.x, bx = blockIdx.x;
    const int vb = (G % 8 == 0) ? (bx % 8) * (G / 8) + bx / 8 : bx;

#if PROBE_MASK || PROBE_EPI || PROBE_XA || PROBE_SUB
    unsigned long long tprev_ = __builtin_amdgcn_s_memrealtime(), tacc_ = 0; int ph_ = 0;
#endif
#if PROBE_SUB
    { PHASE_BEGIN(); prep_stage(p, lds, vb, G, tid, tacc_); }
#else
    { unsigned long long dummy_ = 0; PHASE_BEGIN(); prep_stage(p, lds, vb, G, tid, dummy_); }
#endif
    GRID_SYNC();
    { PHASE_BEGIN();
      { PvPlain P{(const bf16_t*)(ws + WS_XB), (const bf16_t*)(ws + WS_WT_IN), 1024, 1024, 1024}; pg8::SchedPlain S; S.o.init(128, 6, G, bx);
        EpiIn E{(bf16_t*)(ws + WS_U), (bf16_t*)(ws + WS_Z), (const float*)(ws + WS_RSTD_X), (float*)(ws + WS_SSQ_Q), (float*)(ws + WS_SSQ_KV), (const float*)(ws + WS_ROPE), (bf16_t*)(ws + WS_KB)};
        pg8::gemm_phase<true, false, false>(lds, lds + EPI_LDS, P, S, E, tid); }
 }
    GRID_SYNC();
    { PHASE_BEGIN();
      SUB_T0(4);
      { PvPlain P{(const bf16_t*)(ws + WS_U), (const bf16_t*)(ws + WS_WT_UQ), ULD, 256, 256}; pg8::SchedPlain S; S.o.init(128, 3, G, bx);
        EpiQ E{(bf16_t*)(ws + WS_Q), (const float*)(ws + WS_SSQ_Q), (const float*)(ws + WS_ROPE)};
        pg8::gemm_phase<false, false, false>(lds, lds + EPI_LDS, P, S, E, tid); }
      { PvPlain P{(const bf16_t*)(ws + WS_MEMB), (const bf16_t*)(ws + WS_WT_XKV), 1024, 1024, 1024}; pg8::SchedPlain S; S.o.init(16, 8, G, (bx + 128) % G);
        EpiKVMem E{(bf16_t*)(ws + WS_KM), (bf16_t*)(ws + WS_VMT), (const float*)(ws + WS_RSTD_MEM)};
        pg8::gemm_phase<false, false, false>(lds, lds + EPI_LDS, P, S, E, tid); }
      SUB_T1(4, tacc_);
      SUB_T0(5);
      { PvPlain P{(const bf16_t*)(ws + WS_U) + 256, (const bf16_t*)(ws + WS_WT_UKV), ULD, 128, 128}; pg8::SchedPlain S; S.o.init(128, 4, G, (bx + 128) % G);
        EpiKV E{(bf16_t*)(ws + WS_KB), (bf16_t*)(ws + WS_VB), (const float*)(ws + WS_SSQ_KV)};
        pg8::gemm_phase<true, false, false>(lds, lds + EPI_LDS, P, S, E, tid); }
      SUB_T1(5, tacc_);
      SUB_T0(6);
      { int tid2; asm volatile("v_mbcnt_lo_u32_b32 %0, -1, 0\n\tv_mbcnt_hi_u32_b32 %0, -1, %0" : "=v"(tid2)); tid2 += wave_s_ << 6; for (int i = vb; i < 512; i += G) conv_unit(p, lds, i, tid2); }
      SUB_T1(6, tacc_); }
    GRID_SYNC();
    { PHASE_BEGIN();
      if (G == 256) {
        const int xq_ = bx & 7, ix_ = bx >> 3;
        if ((ix_ % 3) == 0) moe_weights_stage(p, lds, xq_ * 11 + ix_ / 3, 88, tid);
        else { unsigned* qh = (unsigned*)(ws + WS_CTL) + CW_MLAQ + 64 * xq_; LAS int* nxt_ = (LAS int*)(lds + 98304);
          for (;;) { if (tid == 0) *nxt_ = (int)atomicAdd(qh, 1u);
            __syncthreads(); const int il = *nxt_; __syncthreads();
            if (il >= 128) break;
            const int bh = xq_ * 16 + (il >> 3), qb = 7 - (il & 7); mla_unit(p, lds, bh * 8 + qb, tid); } } }
      else { if (vb == 0) { } moe_weights_stage(p, lds, vb, G, tid); for (int i = vb; i < 1024; i += G) mla_unit(p, lds, i, tid); } }
    GRID_SYNC();
    { PHASE_BEGIN();
      PvPlain P{(const bf16_t*)(ws + WS_YCAT), (const bf16_t*)(ws + WS_WT_OUT), 1024, 1024, 1024}; pg8::SchedPlain S; S.o.init(128, 4, G, bx);
      EpiResid E{(const bf16_t*)(ws + WS_XB), (bf16_t*)(ws + WS_X1B), (float*)(ws + WS_SSQ_X1), nullptr};
      pg8::gemm_phase<true, false, false>(lds, lds + EPI_LDS, P, S, E, tid); }
    GRID_SYNC();
    { PHASE_BEGIN();
      PvPlain P{(const bf16_t*)(ws + WS_X1B), (const bf16_t*)(ws + WS_WT_XQ), 1024, 1024, 1024}; pg8::SchedPlain S; S.o.init(128, 4, G, bx);
      EpiScale16 E{(bf16_t*)(ws + WS_XQ), 1024, (const float*)(ws + WS_SSQ_X1), C2_X};
      pg8::gemm_phase<true, false, false>(lds, lds + EPI_LDS, P, S, E, tid); }
    GRID_SYNC();
    { PHASE_BEGIN();
#if PROBE_XA
      if (G == 256) xattn_range(p, lds, vb * 4, 4, tid, &tacc_);
#else
      if (G == 256) xattn_range(p, lds, vb * 4, 4, tid);
#endif
      else { for (int i = vb; i < 1024; i += G) xattn_range(p, lds, i, 1, tid); } }
    GRID_SYNC();
    { PHASE_BEGIN();
      PvPlain P{(const bf16_t*)(ws + WS_OX), (const bf16_t*)(ws + WS_WT_XO), 1024, 1024, 1024}; pg8::SchedPlain S; S.o.init(128, 4, G, bx);
      EpiResid E{(const bf16_t*)(ws + WS_X1B), (bf16_t*)(ws + WS_X2B), nullptr, ws + WS_X2F};
      pg8::gemm_phase<true, false, false>(lds, lds + EPI_LDS, P, S, E, tid); }
    GRID_SYNC();
    { PHASE_BEGIN(); if (vb < RT_UNITS) router1_stage_weights(p, lds, tid); for (int i = vb; i < RT_UNITS; i += G) router1_unit(p, lds, i, tid); }
    GRID_SYNC();
    { PHASE_BEGIN(); for (int i = vb; i < RT_UNITS; i += G) router2_unit(p, lds, i, tid); }
    GRID_SYNC();
    { PHASE_BEGIN(); const int* te = (const int*)(ws + WS_TILE_E); const int nt = te[NTILE_MAX];
      PvUpG P{(const bf16_t*)(ws + WS_X2F), (const bf16_t*)(ws + WS_WT_UP), te, (const int*)(ws + WS_SLOT_TOK), 512, 512, 512}; pg8::SchedPlain S; S.o.init(nt, 8, G, bx);
      EpiSwiglu E{(bf16_t*)(ws + WS_ACT), (const float*)(ws + WS_SLOT_RS), te, p.b_up};
#if PROBE_EPI
      pg8::gemm_phase<true, true, true>(lds, lds + EPI_LDS, P, S, E, tid, &tacc_);
#else
      pg8::gemm_phase<true, true, true>(lds, lds + EPI_LDS, P, S, E, tid);
#endif
    }
    GRID_SYNC();
    { PHASE_BEGIN(); const int* te = (const int*)(ws + WS_TILE_E); const int nt = te[NTILE_MAX];
      PvExp P{(const bf16_t*)(ws + WS_ACT), (const bf16_t*)(ws + WS_WT_DOWN), te, 512, 512, 512, 1024}; pg8::SchedPlain S; S.o.init(nt, 4, G, bx);
      EpiDown E{(bf16_t*)(ws + WS_YB), (const float*)(ws + WS_SLOT_GATE), te, p.b_down};
      pg8::gemm_phase<true, false, true>(lds, lds + EPI_LDS, P, S, E, tid); }
    GRID_SYNC();
    { PHASE_BEGIN(); const int gw = vb * 8 + (tid >> 6), ngw = G * 8; final_stage(p, gw, ngw, lane); }
#if PROBE_MASK || PROBE_EPI || PROBE_XA || PROBE_SUB
    { const unsigned long long tn_ = __builtin_amdgcn_s_memrealtime(); if ((PROBE_MASK >> ph_) & 1) tacc_ += tn_ - tprev_;
      const unsigned long long t0_ = __builtin_amdgcn_s_memrealtime(); while (__builtin_amdgcn_s_memrealtime() - t0_ < 4ull * tacc_) __builtin_amdgcn_s_sleep(8); }
#endif
}

extern "C" void kernel_launch(void* const* d_in, const int* in_sizes, int n_in, void* d_out, int out_size, void* d_ws, size_t ws_size, hipStream_t stream) {
    static int grid = 0;
    if (grid == 0) {
        if (n_in != 27 || ws_size < WS_END) { fprintf(stderr, "kernel_launch: unexpected inputs (n_in %d, ws %zu)\n", n_in, ws_size); grid = -1; return; }
        int dev = 0, cus = 0, per_cu = 0;
        (void)hipGetDevice(&dev); (void)hipDeviceGetAttribute(&cus, hipDeviceAttributeMultiprocessorCount, dev);
        (void)hipFuncSetAttribute((const void*)mega_kernel, hipFuncAttributeMaxDynamicSharedMemorySize, LDS_BYTES);
        (void)hipOccupancyMaxActiveBlocksPerMultiprocessor(&per_cu, (const void*)mega_kernel, 512, LDS_BYTES);
        if (per_cu < 1) { fprintf(stderr, "kernel_launch: occupancy query says %d blocks per CU\n", per_cu); per_cu = 1; }
        if (per_cu > 1) per_cu = 1;
        grid = cus * per_cu;
        (void)hipGetLastError();
    }
    if (grid < 0) return;
    (void)hipMemsetAsync((char*)d_ws + WS_CTL, 0, 32768, stream);
    Params p{};
    p.x = (const float*)d_in[0]; p.mem = (const float*)d_in[1]; p.pos = (const int*)d_in[2];
    p.g_mix = (const float*)d_in[3]; p.w_in = (const float*)d_in[4]; p.g_q = (const float*)d_in[5]; p.w_uq = (const float*)d_in[6]; p.g_kv = (const float*)d_in[7]; p.w_ukv = (const float*)d_in[8];
    p.w_dw = (const float*)d_in[9]; p.b_dw = (const float*)d_in[10]; p.g_cln = (const float*)d_in[11]; p.b_cln = (const float*)d_in[12]; p.w_out = (const float*)d_in[13];
    p.g_xattn = (const float*)d_in[14]; p.g_mem = (const float*)d_in[15]; p.w_xq = (const float*)d_in[16]; p.w_xkv = (const float*)d_in[17]; p.w_xo = (const float*)d_in[18];
    p.g_ffn = (const float*)d_in[19]; p.w_router = (const float*)d_in[20]; p.b_router = (const float*)d_in[21]; p.w_up = (const float*)d_in[22]; p.b_up = (const float*)d_in[23];
    p.w_down = (const float*)d_in[24]; p.b_down = (const float*)d_in[25]; p.g_final = (const float*)d_in[26];
    p.out = (float*)d_out; p.ws = (unsigned char*)d_ws;
    void* args[] = {&p};
    hipError_t e = hipLaunchCooperativeKernel((const void*)mega_kernel, dim3(grid), dim3(512), args, LDS_BYTES, stream);
    if (e != hipSuccess) fprintf(stderr, "cooperative launch failed: %s (grid %d)\n", hipGetErrorString(e), grid);
}
```

```cpp
#include <hip/hip_runtime.h>
#include <stdint.h>
#include <stdio.h>
#include <hip/hip_cooperative_groups.h>
namespace cg = cooperative_groups;

#ifndef PROBE_MASK
#define PROBE_MASK 0
#endif
#ifndef PROBE_EPI
#define PROBE_EPI 0
#endif
#ifndef PROBE_XA
#define PROBE_XA 0
#endif
#ifndef PROBE_SUB
#define PROBE_SUB 0
#endif
#if PROBE_SUB
#define SUB_T0(id) unsigned long long ts_##id = __builtin_amdgcn_s_memrealtime()
#define SUB_T1(id, acc) do { if (PROBE_SUB == id) { __syncthreads(); (acc) += __builtin_amdgcn_s_memrealtime() - ts_##id; } } while (0)
#else
#define SUB_T0(id)
#define SUB_T1(id, acc)
#endif
#define LAS __attribute__((address_space(3)))
typedef unsigned short bf16_t;
typedef short bf16x8 __attribute__((ext_vector_type(8)));
typedef short s16x4 __attribute__((ext_vector_type(4)));
typedef float f32x2 __attribute__((ext_vector_type(2)));
typedef float f32x4 __attribute__((ext_vector_type(4)));
typedef float f32x16 __attribute__((ext_vector_type(16)));
typedef unsigned u32x2 __attribute__((ext_vector_type(2)));
typedef unsigned u32x4 __attribute__((ext_vector_type(4)));

constexpr int BATCH = 16, SEQ = 2048, NTOK = BATCH * SEQ, DM = 1024;
constexpr int INC = 1440, INP = 1536, ULD = 512;
constexpr int HEADS = 8, QKD = 96, VD = 64;
constexpr int CCH = 512, CW = 31;
constexpr int MEML = 256, NMEM = BATCH * MEML;
constexpr int XH = 4, XD = 256;
constexpr int NE = 32, TOPK = 4;
constexpr int NSLOT = NTOK * TOPK + NE * 256;
constexpr int NTILE_MAX = NSLOT / 256;
constexpr float EPS = 1e-5f;
constexpr float C2_MLA = 0.14724444602590306f;
constexpr float C2_X = 0.09016844005556021f;
constexpr int RT_TOK = 128, RT_UNITS = NTOK / RT_TOK;

constexpr size_t MiB = 1u << 20;
constexpr size_t WS_CTL = 0;
constexpr size_t WS_RSTD_X = 1 * MiB;
constexpr size_t WS_RSTD_Q = WS_RSTD_X + 128 * 1024;
constexpr size_t WS_RSTD_KV = WS_RSTD_Q + 128 * 1024;
constexpr size_t WS_RSTD_X1 = WS_RSTD_KV + 128 * 1024;
constexpr size_t WS_RSTD_X2 = WS_RSTD_X1 + 128 * 1024;
constexpr size_t WS_RSTD_MEM = WS_RSTD_X2 + 128 * 1024;
constexpr size_t WS_ROPE = 2 * MiB;
constexpr size_t WS_TOPI = 6 * MiB;
constexpr size_t WS_TOPG = WS_TOPI + 512 * 1024;
constexpr size_t WS_INV = WS_TOPG + 512 * 1024;
constexpr size_t WS_SLOT_TOK = WS_INV + 512 * 1024;
constexpr size_t WS_SLOT_GATE = WS_SLOT_TOK + 1 * MiB;
constexpr size_t WS_SLOT_RS = 15 * MiB + 256 * 1024;
constexpr size_t WS_HIST = WS_SLOT_GATE + 1 * MiB;
constexpr size_t WS_TILE_E = WS_HIST + 64 * 1024;
constexpr size_t WS_SSQ_Q = 10 * MiB;
constexpr size_t WS_SSQ_KV = 10 * MiB + 512 * 1024;
constexpr size_t WS_SSQ_X1 = 11 * MiB;
constexpr size_t WS_SSQ_X2 = 13 * MiB;
constexpr size_t WS_WR = 15 * MiB;
constexpr size_t WS_WT_IN = 16 * MiB;
constexpr size_t WS_WT_UQ = 19 * MiB;
constexpr size_t WS_WT_UKV = WS_WT_UQ + 512 * 1024;
constexpr size_t WS_WT_OUT = 20 * MiB;
constexpr size_t WS_WT_XQ = 22 * MiB;
constexpr size_t WS_WT_XKV = 24 * MiB;
constexpr size_t WS_WT_XO = 28 * MiB;
constexpr size_t WS_WT_UP = 32 * MiB;
constexpr size_t WS_WT_DOWN = 160 * MiB;
constexpr size_t WS_X2B = 224 * MiB;
constexpr size_t WS_XB = WS_X2B;
constexpr size_t WS_ACT = 288 * MiB;
constexpr size_t WS_X2F = 432 * MiB;
constexpr size_t WS_U = 288 * MiB;
constexpr size_t WS_Z = 320 * MiB;
constexpr size_t WS_Q = 384 * MiB;
constexpr size_t WS_KB = 432 * MiB;
constexpr size_t WS_VB = 480 * MiB;
constexpr size_t WS_YCAT = 512 * MiB;
constexpr size_t WS_YB = 560 * MiB;
constexpr size_t WS_XG = WS_YB;
constexpr size_t WS_X1B = 576 * MiB;
constexpr size_t WS_XQ = 640 * MiB;
constexpr size_t WS_P = 704 * MiB;
constexpr size_t WS_OX = 768 * MiB;
constexpr size_t WS_MEMB = 832 * MiB;
constexpr size_t WS_KM = 840 * MiB;
constexpr size_t WS_VMT = 848 * MiB;
constexpr size_t WS_END = 856 * MiB;

struct Params {
    const float* x; const float* mem; const int* pos;
    const float *g_mix, *w_in, *g_q, *w_uq, *g_kv, *w_ukv, *w_dw, *b_dw, *g_cln, *b_cln, *w_out, *g_xattn, *g_mem, *w_xq, *w_xkv, *w_xo, *g_ffn, *w_router, *b_router, *w_up, *b_up, *w_down, *b_down, *g_final;
    float* out; unsigned char* ws;
};

__device__ __forceinline__ float bf2f(bf16_t b) { return __uint_as_float((unsigned)b << 16); }
__device__ __forceinline__ unsigned f2bf(float f) { unsigned u = __float_as_uint(f); return (u + 0x7fffu + ((u >> 16) & 1u)) >> 16; }
typedef __bf16 bf16x2_t __attribute__((ext_vector_type(2)));
__device__ __forceinline__ unsigned pk2(float lo, float hi) { const f32x2 v = {lo, hi}; const bf16x2_t b = __builtin_convertvector(v, bf16x2_t); return __builtin_bit_cast(unsigned, b); }
__device__ __forceinline__ unsigned pk4_fp8(float a, float b, float c, float d) { int w = __builtin_amdgcn_cvt_pk_fp8_f32(a, b, 0, false); w = __builtin_amdgcn_cvt_pk_fp8_f32(c, d, w, true); return (unsigned)w; }
constexpr float W8_SCALE = 32.0f, W8_INV = 1.0f / 32.0f;
__device__ __forceinline__ float shflx(float v, int m, int lane) { return __int_as_float(__builtin_amdgcn_ds_bpermute((lane ^ m) << 2, __float_as_int(v))); }
__device__ __forceinline__ float shfli(float v, int src) { return __int_as_float(__builtin_amdgcn_ds_bpermute(src << 2, __float_as_int(v))); }
__device__ __forceinline__ float wave_sum(float v, int lane) {
#pragma unroll
    for (int o = 1; o < 64; o <<= 1) v += shflx(v, o, lane);
    return v;
}
__device__ __forceinline__ int perm32(int rho) { const int n = rho >> 4, i = rho & 15; return 8 * (i >> 2) + 4 * n + (i & 3); }
__device__ __forceinline__ float fast_exp2(float x) { return __builtin_amdgcn_exp2f(x); }
__device__ __forceinline__ float sigmoidf_(float x) { return 1.0f / (1.0f + __expf(-x)); }

struct TrDesc { const float* W; const float* g; bf16_t* WT; int N, K, mode, k0, n0; };
__device__ __forceinline__ void tr_load(const TrDesc& d, float (&v)[40], int lane) {
    const float* src = d.W + (size_t)(d.k0 + (lane >> 3)) * d.N + d.n0 + 4 * (lane & 7);
#pragma unroll
    for (int i = 0; i < 8; ++i) { const f32x4 t = *(const f32x4*)(src + (size_t)(8 * i) * d.N); v[4 * i] = t[0]; v[4 * i + 1] = t[1]; v[4 * i + 2] = t[2]; v[4 * i + 3] = t[3]; }
    f32x4 g0 = {1.f, 1.f, 1.f, 1.f}, g1 = {1.f, 1.f, 1.f, 1.f};
    if (d.g) { g0 = *(const f32x4*)(d.g + d.k0 + 8 * (lane & 7)); g1 = *(const f32x4*)(d.g + d.k0 + 8 * (lane & 7) + 4); }
    v[32] = g0[0]; v[33] = g0[1]; v[34] = g0[2]; v[35] = g0[3]; v[36] = g1[0]; v[37] = g1[1]; v[38] = g1[2]; v[39] = g1[3];
}
__device__ __forceinline__ void tr_store(const TrDesc& d, const float (&v)[40], LAS float* scr, int lane) {
#pragma unroll
    for (int i = 0; i < 8; ++i)
#pragma unroll
        for (int e = 0; e < 4; ++e) scr[(8 * i + (lane >> 3)) * 33 + 4 * (lane & 7) + e] = v[4 * i + e];
    asm volatile("s_waitcnt lgkmcnt(0)" ::: "memory");
    const int c = lane & 7;
    const f32x4 g0 = {v[32], v[33], v[34], v[35]}, g1 = {v[36], v[37], v[38], v[39]};
#pragma unroll
    for (int j = 0; j < 4; ++j) { const int n = (lane >> 3) + 8 * j; const LAS float* sp = scr + (8 * c) * 33 + n;
        u32x4 o; o.x = pk2(sp[0 * 33] * g0[0], sp[1 * 33] * g0[1]); o.y = pk2(sp[2 * 33] * g0[2], sp[3 * 33] * g0[3]); o.z = pk2(sp[4 * 33] * g1[0], sp[5 * 33] * g1[1]); o.w = pk2(sp[6 * 33] * g1[2], sp[7 * 33] * g1[3]);
        const int nn = d.n0 + n; int row = nn; if (d.mode == 1 || d.mode == 4) row = (((nn & 1023) >> 7) << 8) + ((nn >> 10) << 7) + (nn & 127);
        if (d.mode == 2 && nn >= 416) { const int c = (nn - 416) & 511, isg = (nn - 416) >> 9; row = 512 + ((c >> 7) << 8) + (isg << 7) + (c & 127); }
        if (d.mode >= 4) { u32x2 o8; o8.x = pk4_fp8(sp[0 * 33] * g0[0] * W8_SCALE, sp[1 * 33] * g0[1] * W8_SCALE, sp[2 * 33] * g0[2] * W8_SCALE, sp[3 * 33] * g0[3] * W8_SCALE);
            o8.y = pk4_fp8(sp[4 * 33] * g1[0] * W8_SCALE, sp[5 * 33] * g1[1] * W8_SCALE, sp[6 * 33] * g1[2] * W8_SCALE, sp[7 * 33] * g1[3] * W8_SCALE);
            *(u32x2*)((unsigned char*)d.WT + (size_t)row * d.K + d.k0 + 8 * c) = o8; }
        else *(u32x4*)(d.WT + (size_t)row * d.K + d.k0 + 8 * c) = o; }
    asm volatile("s_waitcnt lgkmcnt(0)" ::: "memory");
}
__device__ __forceinline__ void rows_bf16_rstd(const float* X, bf16_t* O, float* rstd, int nrows, int gw, int ngw, int lane) {
    if (gw >= nrows) return;
    f32x4 v[4], vn[4];
#pragma unroll
    for (int j = 0; j < 4; ++j) v[j] = ((const f32x4*)(X + (size_t)gw * 1024))[lane + 64 * j];
    for (int m = gw; m < nrows; m += ngw) {
        const int mn = m + ngw;
        if (mn < nrows) {
#pragma unroll
            for (int j = 0; j < 4; ++j) vn[j] = ((const f32x4*)(X + (size_t)mn * 1024))[lane + 64 * j]; }
        float s = 0.f;
#pragma unroll
        for (int j = 0; j < 4; ++j) s += (v[j].x * v[j].x + v[j].y * v[j].y) + (v[j].z * v[j].z + v[j].w * v[j].w);
        s = wave_sum(s, lane);
        if (lane == 0) rstd[m] = 1.0f / sqrtf(s * (1.0f / 1024.0f) + EPS);
#pragma unroll
        for (int j = 0; j < 4; ++j) { u32x2 w; w.x = pk2(v[j].x, v[j].y); w.y = pk2(v[j].z, v[j].w); ((u32x2*)(O + (size_t)m * 1024))[lane + 64 * j] = w; }
#pragma unroll
        for (int j = 0; j < 4; ++j) v[j] = vn[j];
    }
}
__device__ __forceinline__ void sincos_acc(double a, float& s, float& c) {
    const double TWO_PI = 6.283185307179586476925;
    const double n = rint(a * (1.0 / TWO_PI)); const double r = a - n * TWO_PI;
    const double h = 0.5 * r, h2 = h * h;
    const double sh = h * (1.0 + h2 * (-1.0 / 6.0 + h2 * (1.0 / 120.0 + h2 * (-1.0 / 5040.0 + h2 * (1.0 / 362880.0 + h2 * (-1.0 / 39916800.0 + h2 * (1.0 / 6227020800.0 + h2 * (-1.0 / 1307674368000.0 + h2 * (1.0 / 355687428096000.0)))))))));
    const double ch = 1.0 + h2 * (-0.5 + h2 * (1.0 / 24.0 + h2 * (-1.0 / 720.0 + h2 * (1.0 / 40320.0 + h2 * (-1.0 / 3628800.0 + h2 * (1.0 / 479001600.0 + h2 * (-1.0 / 87178291200.0 + h2 * (1.0 / 20922789888000.0 + h2 * (-1.0 / 6402373705728000.0)))))))));
    s = (float)(2.0 * sh * ch); c = (float)(ch * ch - sh * sh);
}
__device__ __forceinline__ double rope_inv(int i) {
    const double t[16] = {1.0, 0.5623413251903491, 0.31622776601683794, 0.1778279410038923, 0.1, 0.05623413251903491, 0.03162277660168379, 0.01778279410038923,
                          0.01, 0.005623413251903491, 0.0031622776601683794, 0.0017782794100389228, 0.001, 0.0005623413251903491, 0.00031622776601683794, 0.00017782794100389227};
    double r = t[0];
#pragma unroll
    for (int k = 1; k < 16; ++k) r = (i == k) ? t[k] : r;
    return r;
}

__device__ __forceinline__ void prep_stage(const Params& p, LAS unsigned char* lds, int vblk, int nblk, int tid, unsigned long long& tsub) {
    const int lane = tid & 63, wid = tid >> 6;
    const int gw = vblk * 8 + wid, ngw = nblk * 8;
    LAS float* scr = (LAS float*)(lds + wid * 8448);
    unsigned char* ws = p.ws;
    constexpr int I_IN = 16 * 45, I_UQ = 4 * 24, I_UKV = 2 * 32, I_SQ = 16 * 32, I_XKV = 16 * 64;
    constexpr int NITEMS = I_IN + I_UQ + I_UKV + 3 * I_SQ + I_XKV;
    auto get_desc = [&](int it) -> TrDesc {
        TrDesc d; int r = it; int item;
        if (r < I_IN) { d.W = p.w_in; d.N = INC; d.K = 1024; d.g = p.g_mix; d.WT = (bf16_t*)(ws + WS_WT_IN); d.mode = 2; item = r; }
        else if ((r -= I_IN) < I_UQ) { d.W = p.w_uq; d.N = 768; d.K = 256; d.g = p.g_q; d.WT = (bf16_t*)(ws + WS_WT_UQ); d.mode = 0; item = r; }
        else if ((r -= I_UQ) < I_UKV) { d.W = p.w_ukv; d.N = 1024; d.K = 128; d.g = p.g_kv; d.WT = (bf16_t*)(ws + WS_WT_UKV); d.mode = 0; item = r; }
        else if ((r -= I_UKV) < I_SQ) { d.W = p.w_out; d.N = 1024; d.K = 1024; d.g = nullptr; d.WT = (bf16_t*)(ws + WS_WT_OUT); d.mode = 0; item = r; }
        else if ((r -= I_SQ) < I_SQ) { d.W = p.w_xq; d.N = 1024; d.K = 1024; d.g = p.g_xattn; d.WT = (bf16_t*)(ws + WS_WT_XQ); d.mode = 0; item = r; }
        else if ((r -= I_SQ) < I_SQ) { d.W = p.w_xo; d.N = 1024; d.K = 1024; d.g = nullptr; d.WT = (bf16_t*)(ws + WS_WT_XO); d.mode = 0; item = r; }
        else { r -= I_SQ; d.W = p.w_xkv; d.N = 2048; d.K = 1024; d.g = p.g_mem; d.WT = (bf16_t*)(ws + WS_WT_XKV); d.mode = 0; item = r; }
        const int nblk = d.N / 32; d.k0 = 64 * (item / nblk); d.n0 = 32 * (item % nblk); return d; };
    SUB_T0(1);
    if (gw < NITEMS) {
        TrDesc d0 = get_desc(gw), d1 = d0, d2 = d0; float v0[40], v1[40], v2[40];
        tr_load(d0, v0, lane);
        if (gw + ngw < NITEMS) { d1 = get_desc(gw + ngw); tr_load(d1, v1, lane); }
        for (int it = gw; it < NITEMS; it += ngw) {
            const int n2 = it + 2 * ngw;
            if (n2 < NITEMS) { d2 = get_desc(n2); tr_load(d2, v2, lane); }
            tr_store(d0, v0, scr, lane);
            d0 = d1; d1 = d2;
#pragma unroll
            for (int i = 0; i < 40; ++i) { v0[i] = v1[i]; v1[i] = v2[i]; }
        }
    }
    SUB_T1(1, tsub);
    SUB_T0(2);
    rows_bf16_rstd(p.x, (bf16_t*)(ws + WS_XB), (float*)(ws + WS_RSTD_X), NTOK, gw, ngw, lane);
    rows_bf16_rstd(p.mem, (bf16_t*)(ws + WS_MEMB), (float*)(ws + WS_RSTD_MEM), NMEM, gw, ngw, lane);
    SUB_T1(2, tsub);
    SUB_T0(3);
    const int gt = vblk * 512 + tid, ngt = nblk * 512;
    for (int i = gt; i < NTOK * 16; i += ngt) { const int row = i >> 4, f = i & 15; float s, c; sincos_acc((double)p.pos[row] * rope_inv(f), s, c);
        float* rt = (float*)(ws + WS_ROPE) + (size_t)row * 32; rt[f] = c; rt[16 + f] = s; }
    for (int i = gt; i < 1024 * 32; i += ngt) { const int k = i >> 5, e = i & 31; const float v = p.g_ffn[k] * p.w_router[i]; const unsigned hb = f2bf(v); const float lo = v - __uint_as_float(hb << 16);
        ((bf16_t*)(ws + WS_WR))[e * 1024 + k] = (bf16_t)hb; ((bf16_t*)(ws + WS_WR))[32768 + e * 1024 + k] = (bf16_t)f2bf(lo); }
    for (int i = gt; i < 96 * 1024 / 8; i += ngt) ((u32x4*)((bf16_t*)(ws + WS_WT_IN) + (size_t)416 * 1024))[i] = (u32x4){0u, 0u, 0u, 0u};
    SUB_T1(3, tsub);
}

__device__ __forceinline__ void moe_weights_stage(const Params& p, LAS unsigned char* lds, int ci, int nconv, int tid) {
    const int lane = tid & 63, wid = tid >> 6; const int gw = ci * 8 + wid, ngw = nconv * 8;
    LAS float* scr = (LAS float*)(lds + wid * 8448);
    unsigned char* ws = p.ws;
    constexpr int I_UP1 = 16 * 64, I_DN1 = 16 * 32, NITEMS = NE * (I_UP1 + I_DN1);
    auto get_desc = [&](int it) -> TrDesc {
        TrDesc d; int r = it; int item;
        if (r < NE * I_UP1) { const int e = r / I_UP1; d.W = p.w_up + (size_t)e * 1024 * 2048; d.N = 2048; d.K = 1024; d.g = p.g_ffn; d.WT = (bf16_t*)(ws + WS_WT_UP + (size_t)e * 2048 * 1024); d.mode = 4; item = r % I_UP1; }
        else { r -= NE * I_UP1; const int e = r / I_DN1; d.W = p.w_down + (size_t)e * 1024 * 1024; d.N = 1024; d.K = 1024; d.g = nullptr; d.WT = (bf16_t*)(ws + WS_WT_DOWN + (size_t)e * 1024 * 1024); d.mode = 5; item = r % I_DN1; }
        const int nblk = d.N / 32; d.k0 = 64 * (item / nblk); d.n0 = 32 * (item % nblk); return d; };
    if (gw < NITEMS) {
        TrDesc d0 = get_desc(gw), d1 = d0, d2 = d0, d3 = d0; float v0[40], v1[40], v2[40], v3[40];
        tr_load(d0, v0, lane);
        if (gw + ngw < NITEMS) { d1 = get_desc(gw + ngw); tr_load(d1, v1, lane); }
        if (gw + 2 * ngw < NITEMS) { d2 = get_desc(gw + 2 * ngw); tr_load(d2, v2, lane); }
        for (int it = gw; it < NITEMS; it += ngw) {
            const int n3 = it + 3 * ngw;
            if (n3 < NITEMS) { d3 = get_desc(n3); tr_load(d3, v3, lane); }
            tr_store(d0, v0, scr, lane);
            d0 = d1; d1 = d2; d2 = d3;
#pragma unroll
            for (int i = 0; i < 40; ++i) { v0[i] = v1[i]; v1[i] = v2[i]; v2[i] = v3[i]; }
        }
    }
}

struct Unit { int pm, pn, z; };
typedef f32x4 Acc[2][2][4][2];

template <bool PERM, class Prov, class Epi>
__device__ __forceinline__ void gemm_unit_naive(const Prov& P, const Epi& E, const Unit& u, LAS unsigned char* lds, int tid) {
    const int wid = tid >> 6, lane = tid & 63, wr = wid >> 2, wc = wid & 3, fr = lane & 15, fq = lane >> 4;
    const bf16_t* ap[2][4]; const bf16_t* bp[2][2];
#pragma unroll
    for (int ai = 0; ai < 2; ++ai)
#pragma unroll
        for (int m = 0; m < 4; ++m) ap[ai][m] = P.a_row(u, 128 * ai + 64 * wr + 16 * m + fr) + 8 * fq;
#pragma unroll
    for (int bj = 0; bj < 2; ++bj)
#pragma unroll
        for (int n = 0; n < 2; ++n) { const int rho = 16 * n + fr; bp[bj][n] = P.b_row(u, 128 * bj + 32 * wc + (PERM ? perm32(rho) : rho)) + 8 * fq; }
    Acc acc;
#pragma unroll
    for (int a = 0; a < 2; ++a)
#pragma unroll
        for (int b = 0; b < 2; ++b)
#pragma unroll
            for (int m = 0; m < 4; ++m)
#pragma unroll
                for (int n = 0; n < 2; ++n) acc[a][b][m][n] = (f32x4){0.f, 0.f, 0.f, 0.f};
    const int K = P.K;
#pragma unroll 1
    for (int k0 = 0; k0 < K; k0 += 32) {
        bf16x8 a[2][4], b[2][2];
#pragma unroll
        for (int ai = 0; ai < 2; ++ai)
#pragma unroll
            for (int m = 0; m < 4; ++m) a[ai][m] = *(const bf16x8*)(ap[ai][m] + k0);
#pragma unroll
        for (int bj = 0; bj < 2; ++bj)
#pragma unroll
            for (int n = 0; n < 2; ++n) b[bj][n] = *(const bf16x8*)(bp[bj][n] + k0);
#pragma unroll
        for (int ai = 0; ai < 2; ++ai)
#pragma unroll
            for (int bj = 0; bj < 2; ++bj)
#pragma unroll
                for (int m = 0; m < 4; ++m)
#pragma unroll
                    for (int n = 0; n < 2; ++n) acc[ai][bj][m][n] = __builtin_amdgcn_mfma_f32_16x16x32_bf16(b[bj][n], a[ai][m], acc[ai][bj][m][n], 0, 0, 0);
    }
    E(acc, u, wr, wc, fr, fq, lds, (const LAS float*)lds);
}

struct ProvPlain { const bf16_t* A; int lda; const bf16_t* Bt; int ldb; int K;
    __device__ __forceinline__ const bf16_t* a_row(const Unit& u, int r) const { return A + (size_t)(u.pm * 256 + r) * lda; }
    __device__ __forceinline__ const bf16_t* b_row(const Unit& u, int r) const { return Bt + (size_t)(u.pn * 256 + r) * ldb; } };
struct ProvXS { const bf16_t* XQ; const bf16_t* KM; int K;
    __device__ __forceinline__ const bf16_t* a_row(const Unit& u, int r) const { return XQ + (size_t)((u.z >> 2) * 2048 + u.pm * 256 + r) * 1024 + (u.z & 3) * 256; }
    __device__ __forceinline__ const bf16_t* b_row(const Unit& u, int r) const { return KM + (size_t)((u.z >> 2) * 256 + r) * 1024 + (u.z & 3) * 256; } };
struct ProvXPV { const bf16_t* Pm; const bf16_t* VMT; int K;
    __device__ __forceinline__ const bf16_t* a_row(const Unit& u, int r) const { return Pm + ((size_t)u.z * 2048 + u.pm * 256 + r) * 256; }
    __device__ __forceinline__ const bf16_t* b_row(const Unit& u, int r) const { return VMT + ((size_t)u.z * 256 + r) * 256; } };
struct ProvUp { const bf16_t* X2B; const int* slot_tok; const int* tile_e; const bf16_t* WT; int K;
    __device__ __forceinline__ const bf16_t* a_row(const Unit& u, int r) const { return X2B + (size_t)slot_tok[u.pm * 256 + r] * 1024; }
    __device__ __forceinline__ const bf16_t* b_row(const Unit& u, int r) const { return WT + ((size_t)tile_e[u.pm] * 2048 + u.pn * 256 + r) * 1024; } };
struct ProvDown { const bf16_t* ACT; const int* tile_e; const bf16_t* WT; int K;
    __device__ __forceinline__ const bf16_t* a_row(const Unit& u, int r) const { return ACT + (size_t)(u.pm * 256 + r) * 1024; }
    __device__ __forceinline__ const bf16_t* b_row(const Unit& u, int r) const { return WT + ((size_t)tile_e[u.pm] * 1024 + u.pn * 256 + r) * 1024; } };

#define EPI_BAR() do { asm volatile("s_waitcnt lgkmcnt(0)" ::: "memory"); __builtin_amdgcn_s_barrier(); asm volatile("" ::: "memory"); } while (0)
#define EPI_ARGS Acc& acc, const Unit& u, int wr, int wc, int fr, int fq, LAS unsigned char* lds, const LAS float* tab
#define EPI_NOPF __device__ __forceinline__ void prefetch(const Unit&, LAS float*, int) const {}
#define FOR_AI_M _Pragma("unroll") for (int ai = 0; ai < 2; ++ai) _Pragma("unroll") for (int m = 0; m < 4; ++m)
#define FOR_BJ _Pragma("unroll") for (int bj = 0; bj < 2; ++bj)
struct EpiIn { bf16_t* U; bf16_t* Z; const float* rs; float* ssq_q; float* ssq_kv; const float* rope; bf16_t* KB;
    EPI_NOPF
    __device__ __forceinline__ void operator()(EPI_ARGS) const {
        if (u.pn >= 2) {
            FOR_AI_M { const int row = u.pm * 256 + 128 * ai + 64 * wr + 16 * m + fr; const float s = rs[row]; f32x4 o[2];
#pragma unroll
                for (int n = 0; n < 2; ++n) { const f32x4 av = acc[ai][0][m][n] * s, gv = acc[ai][1][m][n] * s; const f32x4 t = gv * (-1.4426950408889634f); f32x4 ex;
#pragma unroll
                    for (int j = 0; j < 4; ++j) ex[j] = __builtin_amdgcn_exp2f(t[j]);
                    ex = ex + 1.0f; f32x4 rc;
#pragma unroll
                    for (int j = 0; j < 4; ++j) rc[j] = __builtin_amdgcn_rcpf(ex[j]);
                    o[n] = av * rc; }
                u32x4 w; w.x = pk2(o[0][0], o[0][1]); w.y = pk2(o[0][2], o[0][3]); w.z = pk2(o[1][0], o[1][1]); w.w = pk2(o[1][2], o[1][3]);
                *(u32x4*)(Z + (size_t)row * 512 + (u.pn - 2) * 128 + 32 * wc + 8 * fq) = w; }
            return; }
        FOR_AI_M { const int row = u.pm * 256 + 128 * ai + 64 * wr + 16 * m + fr; const float s = rs[row]; bf16_t* rowp = U + (size_t)row * ULD + u.pn * 256 + 32 * wc + 8 * fq;
            float q0 = 0.f, q1 = 0.f;
            FOR_BJ { const f32x4 v0 = acc[ai][bj][m][0] * s, v1 = acc[ai][bj][m][1] * s; u32x4 w; w.x = pk2(v0[0], v0[1]); w.y = pk2(v0[2], v0[3]); w.z = pk2(v1[0], v1[1]); w.w = pk2(v1[2], v1[3]);
                *(u32x4*)(rowp + 128 * bj) = w;
                const float qq = (v0[0] * v0[0] + v0[1] * v0[1]) + (v0[2] * v0[2] + v0[3] * v0[3]) + (v1[0] * v1[0] + v1[1] * v1[1]) + (v1[2] * v1[2] + v1[3] * v1[3]);
                if (bj == 0) q0 = qq; else q1 = qq; }
            if (u.pn == 0) { float q = q0 + q1; q += shflx(q, 16, fr + 16 * fq); q += shflx(q, 32, fr + 16 * fq); if (fq == 0) ssq_q[(size_t)row * 4 + wc] = q; }
            if (u.pn == 1) { float q = q0; q += shflx(q, 16, fr + 16 * fq); q += shflx(q, 32, fr + 16 * fq); if (fq == 0) ssq_kv[(size_t)row * 4 + wc] = q;
                if (wc == 0) {
                    const int i0 = 8 * (fq & 1); const f32x4 c0 = *(const f32x4*)(rope + (size_t)row * 32 + i0), c1 = *(const f32x4*)(rope + (size_t)row * 32 + i0 + 4);
                    const f32x4 s0 = *(const f32x4*)(rope + (size_t)row * 32 + 16 + i0), s1 = *(const f32x4*)(rope + (size_t)row * 32 + 16 + i0 + 4);
                    const f32x4 v0 = acc[ai][1][m][0] * s, v1 = acc[ai][1][m][1] * s; f32x4 p0, p1;
#pragma unroll
                    for (int j = 0; j < 4; ++j) { p0[j] = shflx(v0[j], 32, fr + 16 * fq); p1[j] = shflx(v1[j], 32, fr + 16 * fq); }
                    f32x4 o0, o1;
                    if (fq < 2) { o0 = v0 * c0 - p0 * s0; o1 = v1 * c1 - p1 * s1; } else { o0 = p0 * s0 + v0 * c0; o1 = p1 * s1 + v1 * c1; }
                    u32x4 w; w.x = pk2(o0[0], o0[1]); w.y = pk2(o0[2], o0[3]); w.z = pk2(o1[0], o1[1]); w.w = pk2(o1[2], o1[3]);
                    bf16_t* kb = KB + (size_t)row * 768 + 64 + 8 * fq;
#pragma unroll
                    for (int h = 0; h < 8; ++h) *(u32x4*)(kb + h * 96) = w; } } } } };
struct EpiScale16 { bf16_t* O; int ldc; const float* ssq; float mul;
    EPI_NOPF
    __device__ __forceinline__ void operator()(EPI_ARGS) const {
        FOR_AI_M { const int row = u.pm * 256 + 128 * ai + 64 * wr + 16 * m + fr; const f32x4* sp = (const f32x4*)(ssq + (size_t)row * 16); const f32x4 t = (sp[0] + sp[1]) + (sp[2] + sp[3]);
            const float s = mul / sqrtf(((t[0] + t[1]) + (t[2] + t[3])) * (1.0f / 1024.0f) + EPS); bf16_t* rowp = O + (size_t)row * ldc + u.pn * 256 + 32 * wc + 8 * fq;
            FOR_BJ { const f32x4 v0 = acc[ai][bj][m][0] * s, v1 = acc[ai][bj][m][1] * s; u32x4 w; w.x = pk2(v0[0], v0[1]); w.y = pk2(v0[2], v0[3]); w.z = pk2(v1[0], v1[1]); w.w = pk2(v1[2], v1[3]);
                *(u32x4*)(rowp + 128 * bj) = w; } } } };
struct EpiQ { bf16_t* Q; const float* ssq; const float* rope;
    EPI_NOPF
    __device__ __forceinline__ void operator()(EPI_ARGS) const {
        FOR_AI_M { const int row = u.pm * 256 + 128 * ai + 64 * wr + 16 * m + fr; const f32x4 t = *(const f32x4*)(ssq + (size_t)row * 4); const float s = C2_MLA / sqrtf(((t[0] + t[1]) + (t[2] + t[3])) * (1.0f / 256.0f) + EPS);
            const f32x4 cs = *(const f32x4*)(rope + (size_t)row * 32 + 4 * fq), sn = *(const f32x4*)(rope + (size_t)row * 32 + 16 + 4 * fq);
            FOR_BJ { const int colg = u.pn * 256 + 128 * bj + 32 * wc; f32x4 v0 = acc[ai][bj][m][0] * s, v1 = acc[ai][bj][m][1] * s;
                if (((colg >> 5) % 3) == 2) { const f32x4 r0 = v0 * cs - v1 * sn, r1 = v0 * sn + v1 * cs; v0 = r0; v1 = r1; }
                bf16_t* rowp = Q + (size_t)row * 768 + colg + 4 * fq; u32x2 w0, w1; w0.x = pk2(v0[0], v0[1]); w0.y = pk2(v0[2], v0[3]); w1.x = pk2(v1[0], v1[1]); w1.y = pk2(v1[2], v1[3]);
                *(u32x2*)(rowp) = w0; *(u32x2*)(rowp + 16) = w1; } } } };
struct EpiKV { bf16_t* KB; bf16_t* VB; const float* ssq;
    EPI_NOPF
    __device__ __forceinline__ void operator()(EPI_ARGS) const {
        FOR_AI_M { const int row = u.pm * 256 + 128 * ai + 64 * wr + 16 * m + fr; const f32x4 t = *(const f32x4*)(ssq + (size_t)row * 4); const float s = 1.0f / sqrtf(((t[0] + t[1]) + (t[2] + t[3])) * (1.0f / 128.0f) + EPS);
            FOR_BJ { const int h = 2 * u.pn + bj, cl = 32 * wc + 8 * fq; const f32x4 v0 = acc[ai][bj][m][0] * s, v1 = acc[ai][bj][m][1] * s;
                u32x4 w; w.x = pk2(v0[0], v0[1]); w.y = pk2(v0[2], v0[3]); w.z = pk2(v1[0], v1[1]); w.w = pk2(v1[2], v1[3]);
                if (wc < 2) *(u32x4*)(KB + (size_t)row * 768 + h * 96 + cl) = w; else *(u32x4*)(VB + (size_t)row * 512 + h * 64 + cl - 64) = w; } } } };
struct EpiResid { const bf16_t* base; bf16_t* ob; float* ssq; unsigned char* o8;
    EPI_NOPF
    __device__ __forceinline__ void operator()(EPI_ARGS) const {
        FOR_AI_M { const int row = u.pm * 256 + 128 * ai + 64 * wr + 16 * m + fr; float q = 0.f;
            FOR_BJ { const size_t off = (size_t)row * 1024 + u.pn * 256 + 128 * bj + 32 * wc + 8 * fq;
                const u32x4 bw = *(const u32x4*)(base + off);
                f32x4 v0, v1; v0[0] = __uint_as_float(bw.x << 16); v0[1] = __uint_as_float(bw.x & 0xffff0000u); v0[2] = __uint_as_float(bw.y << 16); v0[3] = __uint_as_float(bw.y & 0xffff0000u);
                v1[0] = __uint_as_float(bw.z << 16); v1[1] = __uint_as_float(bw.z & 0xffff0000u); v1[2] = __uint_as_float(bw.w << 16); v1[3] = __uint_as_float(bw.w & 0xffff0000u);
                v0 = v0 + acc[ai][bj][m][0]; v1 = v1 + acc[ai][bj][m][1];
                u32x4 w; w.x = pk2(v0[0], v0[1]); w.y = pk2(v0[2], v0[3]); w.z = pk2(v1[0], v1[1]); w.w = pk2(v1[2], v1[3]); *(u32x4*)(ob + off) = w;
                if (o8) { u32x2 w8; w8.x = pk4_fp8(v0[0], v0[1], v0[2], v0[3]); w8.y = pk4_fp8(v1[0], v1[1], v1[2], v1[3]); *(u32x2*)(o8 + off) = w8; }
                q += (v0[0] * v0[0] + v0[1] * v0[1]) + (v0[2] * v0[2] + v0[3] * v0[3]) + (v1[0] * v1[0] + v1[1] * v1[1]) + (v1[2] * v1[2] + v1[3] * v1[3]); }
            if (ssq) { q += shflx(q, 16, fr + 16 * fq); q += shflx(q, 32, fr + 16 * fq); if (fq == 0) ssq[(size_t)row * 16 + u.pn * 4 + wc] = q; } } } };
struct EpiKVMem { bf16_t* KM; bf16_t* VMT; const float* rs;
    EPI_NOPF
    __device__ __forceinline__ void operator()(EPI_ARGS) const {
        FOR_AI_M { const int row = u.pm * 256 + 128 * ai + 64 * wr + 16 * m + fr; const float s = rs[row];
            FOR_BJ {
#pragma unroll
                for (int n = 0; n < 2; ++n) { const int col = u.pn * 256 + 128 * bj + 32 * wc + 16 * n + 4 * fq; const f32x4 v = acc[ai][bj][m][n] * s;
                    if (u.pn < 4) { u32x2 w; w.x = pk2(v[0], v[1]); w.y = pk2(v[2], v[3]); *(u32x2*)(KM + (size_t)row * 1024 + col) = w; }
                    else { const int c2 = col - 1024, h = c2 >> 8, d = c2 & 255, b = row >> 8, mm = row & 255; bf16_t* dst = VMT + ((size_t)(b * 4 + h) * 256 + d) * 256 + mm;
#pragma unroll
                        for (int j = 0; j < 4; ++j) dst[(size_t)j * 256] = (bf16_t)f2bf(v[j]); } } } } } };
struct EpiSoftmaxP { bf16_t* Pm;
    EPI_NOPF
    __device__ __forceinline__ void operator()(EPI_ARGS) const {
        LAS float* red = (LAS float*)lds; float rmax[2][4];
        FOR_AI_M { float mx = -3.0e38f;
            FOR_BJ {
#pragma unroll
                for (int n = 0; n < 2; ++n)
#pragma unroll
                    for (int j = 0; j < 4; ++j) mx = fmaxf(mx, acc[ai][bj][m][n][j]); }
            mx = fmaxf(mx, shflx(mx, 16, fr + 16 * fq)); mx = fmaxf(mx, shflx(mx, 32, fr + 16 * fq));
            if (fq == 0) red[(128 * ai + 64 * wr + 16 * m + fr) * 4 + wc] = mx; }
        EPI_BAR();
        FOR_AI_M { const f32x4 t = *(const LAS f32x4*)(red + (128 * ai + 64 * wr + 16 * m + fr) * 4); rmax[ai][m] = fmaxf(fmaxf(t[0], t[1]), fmaxf(t[2], t[3])); }
        EPI_BAR();
        FOR_AI_M { float s = 0.f;
            FOR_BJ {
#pragma unroll
                for (int n = 0; n < 2; ++n)
#pragma unroll
                    for (int j = 0; j < 4; ++j) { const float e = fast_exp2(acc[ai][bj][m][n][j] - rmax[ai][m]); acc[ai][bj][m][n][j] = e; s += e; } }
            s += shflx(s, 16, fr + 16 * fq); s += shflx(s, 32, fr + 16 * fq);
            if (fq == 0) red[(128 * ai + 64 * wr + 16 * m + fr) * 4 + wc] = s; }
        EPI_BAR();
        FOR_AI_M { const int r = 128 * ai + 64 * wr + 16 * m + fr; const f32x4 t = *(const LAS f32x4*)(red + r * 4); const float inv = 1.0f / ((t[0] + t[1]) + (t[2] + t[3]));
            bf16_t* rowp = Pm + ((size_t)u.z * 2048 + u.pm * 256 + r) * 256 + 32 * wc + 8 * fq;
            FOR_BJ { const f32x4 v0 = acc[ai][bj][m][0] * inv, v1 = acc[ai][bj][m][1] * inv; u32x4 w; w.x = pk2(v0[0], v0[1]); w.y = pk2(v0[2], v0[3]); w.z = pk2(v1[0], v1[1]); w.w = pk2(v1[2], v1[3]);
                *(u32x4*)(rowp + 128 * bj) = w; } }
        EPI_BAR();
    } };
struct EpiOX { bf16_t* OX;
    EPI_NOPF
    __device__ __forceinline__ void operator()(EPI_ARGS) const {
        FOR_AI_M { const int r = 128 * ai + 64 * wr + 16 * m + fr; bf16_t* rowp = OX + (size_t)((u.z >> 2) * 2048 + u.pm * 256 + r) * 1024 + (u.z & 3) * 256 + 32 * wc + 8 * fq;
            FOR_BJ { const f32x4 v0 = acc[ai][bj][m][0], v1 = acc[ai][bj][m][1]; u32x4 w; w.x = pk2(v0[0], v0[1]); w.y = pk2(v0[2], v0[3]); w.z = pk2(v1[0], v1[1]); w.w = pk2(v1[2], v1[3]);
                *(u32x4*)(rowp + 128 * bj) = w; } } } };
struct EpiSwiglu { bf16_t* ACT; const float* slot_rs; const int* tile_e; const float* b_up;
    __device__ __forceinline__ void prefetch(const Unit& u, LAS float* t, int tid) const { const int e = tile_e[u.pm];
        t[tid] = slot_rs[u.pm * 256 + tid] * W8_INV; t[256 + tid] = b_up[(size_t)e * 2048 + ((tid >> 7) << 10) + u.pn * 128 + (tid & 127)]; }
    __device__ __forceinline__ void operator()(EPI_ARGS) const {
        const int cl = 32 * wc + 8 * fq;
        f32x4 bgv[2], blv[2]; bgv[0] = *(const LAS f32x4*)(tab + 256 + cl); bgv[1] = *(const LAS f32x4*)(tab + 256 + cl + 4); blv[0] = *(const LAS f32x4*)(tab + 384 + cl); blv[1] = *(const LAS f32x4*)(tab + 384 + cl + 4);
        FOR_AI_M { const int rl = 128 * ai + 64 * wr + 16 * m + fr; const int slot = u.pm * 256 + rl; const float s = tab[rl];
            f32x4 o[2];
#pragma unroll
            for (int n = 0; n < 2; ++n) { f32x4 g = acc[ai][0][m][n] * s + bgv[n], l = acc[ai][1][m][n] * s + blv[n];
                g = __builtin_elementwise_min(g, (f32x4){7.f, 7.f, 7.f, 7.f}); l = __builtin_elementwise_min(__builtin_elementwise_max(l, (f32x4){-7.f, -7.f, -7.f, -7.f}), (f32x4){7.f, 7.f, 7.f, 7.f}) + 1.0f;
                const f32x4 t = g * (-1.702f * 1.4426950408889634f); f32x4 ex;
#pragma unroll
                for (int j = 0; j < 4; ++j) ex[j] = __builtin_amdgcn_exp2f(t[j]);
                ex = ex + 1.0f; f32x4 rc;
#pragma unroll
                for (int j = 0; j < 4; ++j) rc[j] = __builtin_amdgcn_rcpf(ex[j]);
                o[n] = (g * rc) * l; }
            u32x2 w; w.x = pk4_fp8(o[0][0], o[0][1], o[0][2], o[0][3]); w.y = pk4_fp8(o[1][0], o[1][1], o[1][2], o[1][3]);
            *(u32x2*)((unsigned char*)ACT + (size_t)slot * 1024 + u.pn * 128 + cl) = w; } } };
constexpr float Y8_SCALE = 64.0f, Y8_INV = 1.0f / 64.0f;
struct EpiDown { unsigned char* YB; const float* gate; const int* tile_e; const float* b_down;
    __device__ __forceinline__ void prefetch(const Unit& u, LAS float* t, int tid) const { const int e = tile_e[u.pm];
        t[tid] = gate[u.pm * 256 + tid] * Y8_SCALE; t[256 + tid] = b_down[(size_t)e * 1024 + u.pn * 256 + tid]; }
    __device__ __forceinline__ void operator()(EPI_ARGS) const {
        const int cl = 32 * wc + 8 * fq;
        FOR_AI_M { const int rl = 128 * ai + 64 * wr + 16 * m + fr; const int slot = u.pm * 256 + rl; const float g = tab[rl]; const float g8 = g * W8_INV;
            FOR_BJ { const f32x4 b0 = *(const LAS f32x4*)(tab + 256 + cl + 128 * bj), b1 = *(const LAS f32x4*)(tab + 256 + cl + 128 * bj + 4);
                const f32x4 v0 = acc[ai][bj][m][0] * g8 + b0 * g, v1 = acc[ai][bj][m][1] * g8 + b1 * g; u32x2 w; w.x = pk4_fp8(v0[0], v0[1], v0[2], v0[3]); w.y = pk4_fp8(v1[0], v1[1], v1[2], v1[3]);
                *(u32x2*)(YB + (size_t)slot * 1024 + u.pn * 256 + cl + 128 * bj) = w; } } } };

namespace pg8 {
typedef int v4i_t __attribute__((ext_vector_type(4)));
typedef int v8i_t __attribute__((ext_vector_type(8)));
constexpr int BK = 64, HALF = 128, HTB = HALF * BK * 2, STAGE_BYTES = 8 * HTB;
__device__ __forceinline__ int lds_byte(int r, int c) { const int st = (r >> 4) * 2 + (c >> 5), rr = r & 15, cc = c & 31, ob = rr * 64 + cc * 2; return st * 1024 + (ob ^ (((ob >> 9) & 1) << 5)); }
__device__ __forceinline__ void stage_rc(int b, int& R, int& C) { const int st = b / 1024, sb = b % 1024, swz = sb ^ (((sb >> 9) & 1) << 5); R = (st >> 1) * 16 + swz / 64; C = (st & 1) * 32 + (swz % 64) / 2; }

template <bool PERM, bool GATHER, bool FP8, class Prov, class Sched, class Epi>
__device__ __forceinline__ void gemm_phase(LAS unsigned char* lds, LAS unsigned char* lds_epi, const Prov& P, const Sched& S, const Epi& E, int tid, unsigned long long* tepi = nullptr) {
    const int wid = __builtin_amdgcn_readfirstlane(tid >> 6), lane = tid & 63, wr = wid >> 2, wc = wid & 3, fr = lane & 15, fq = lane >> 4;
    const int K = P.K, nt = K / BK;
    unsigned voffA[2], voffB[2], voffG[2][2]; int Rg[2]; unsigned Cg[2];
#pragma unroll
    for (int i = 0; i < 2; ++i) { int R, C; stage_rc(tid * 16 + i * 8192, R, C); const int Rb = PERM ? ((R & ~31) + perm32(R & 31)) : R;
        voffA[i] = (unsigned)(R * P.lda + C) * 2u; voffB[i] = (unsigned)(Rb * P.ldb + C) * 2u; Rg[i] = R; Cg[i] = (unsigned)C * 2u; }
    LAS int* rtab = (LAS int*)(lds_epi + 8192);
    const unsigned kstep = (unsigned)(BK * 2);
    const unsigned hstepA = GATHER ? 0u : (unsigned)(HALF * P.lda * 2), hstepB = (unsigned)(HALF * P.ldb * 2);
    const __amdgpu_buffer_rsrc_t rsA = __builtin_amdgcn_make_buffer_rsrc((void*)P.a_root(), 0, -1, 0x00020000), rsB = __builtin_amdgcn_make_buffer_rsrc((void*)P.b_root(), 0, -1, 0x00020000);
#define PG8_AOFF(u_) ((unsigned)((const char*)P.a_base(u_) - (const char*)P.a_root()))
#define PG8_BOFF(u_) ((unsigned)((const char*)P.b_base(u_) - (const char*)P.b_root()))
    const unsigned ldsw = (unsigned)wid * 1024u;
    const int aoff = lds_byte(wr * 64 + fr, fq * 8), boff = lds_byte(wc * 32 + fr, fq * 8);
#define PG8_SA(b, h) (((b) * 2 + (h)) * HTB)
#define PG8_SB(b, h) ((4 + (b) * 2 + (h)) * HTB)
#define PG8_STAGE(bufoff, rs, soff, voff) do { _Pragma("unroll") for (int _i = 0; _i < 2; ++_i) \
        __builtin_amdgcn_raw_ptr_buffer_load_lds(rs, (LAS void*)(lds + (bufoff) + ldsw + _i * 8192), 16, (int)(voff)[_i], (int)(soff), 0, 0); } while (0)
#define PG8_STAGE_A(bufoff, soff, h) do { if constexpr (GATHER) { PG8_STAGE(bufoff, rsA, soff, voffG[h]); } else { PG8_STAGE(bufoff, rsA, (soff) + (h) * hstepA, voffA); } } while (0)
#define PG8_STAGE_B(bufoff, soff) PG8_STAGE(bufoff, rsB, soff, voffB)
#define PG8_LDA(dst, b, h) do { _Pragma("unroll") for (int m = 0; m < 4; ++m) { const v4i_t l0_ = *(const LAS v4i_t*)(lds + PG8_SA(b, h) + aoff + m * 2048), l1_ = *(const LAS v4i_t*)(lds + PG8_SA(b, h) + aoff + m * 2048 + 1024); dst[m] = __builtin_shufflevector(l0_, l1_, 0, 1, 2, 3, 4, 5, 6, 7); } } while (0)
#define PG8_LDB(dst, b, h) do { _Pragma("unroll") for (int n = 0; n < 2; ++n) { const v4i_t l0_ = *(const LAS v4i_t*)(lds + PG8_SB(b, h) + boff + n * 2048), l1_ = *(const LAS v4i_t*)(lds + PG8_SB(b, h) + boff + n * 2048 + 1024); dst[n] = __builtin_shufflevector(l0_, l1_, 0, 1, 2, 3, 4, 5, 6, 7); } } while (0)
#define PG8_MMA(ai, bj, At, Bt) do { __builtin_amdgcn_s_setprio(1); _Pragma("unroll") for (int m = 0; m < 4; ++m) _Pragma("unroll") for (int n = 0; n < 2; ++n) { if constexpr (FP8) { \
            acc[ai][bj][m][n] = __builtin_amdgcn_mfma_scale_f32_16x16x128_f8f6f4(Bt[n], At[m], acc[ai][bj][m][n], 0, 0, 0, 0x7f7f7f7f, 0, 0x7f7f7f7f); } \
        else { acc[ai][bj][m][n] = __builtin_amdgcn_mfma_f32_16x16x32_bf16(__builtin_bit_cast(bf16x8, __builtin_shufflevector(Bt[n], Bt[n], 0, 1, 2, 3)), __builtin_bit_cast(bf16x8, __builtin_shufflevector(At[m], At[m], 0, 1, 2, 3)), acc[ai][bj][m][n], 0, 0, 0); \
               acc[ai][bj][m][n] = __builtin_amdgcn_mfma_f32_16x16x32_bf16(__builtin_bit_cast(bf16x8, __builtin_shufflevector(Bt[n], Bt[n], 4, 5, 6, 7)), __builtin_bit_cast(bf16x8, __builtin_shufflevector(At[m], At[m], 4, 5, 6, 7)), acc[ai][bj][m][n], 0, 0, 0); } } \
        __builtin_amdgcn_s_setprio(0); } while (0)
#define PG8_WAIT_V(n) asm volatile("s_waitcnt vmcnt(" #n ")" ::: "memory")
#define PG8_WAIT_L(n) asm volatile("s_waitcnt lgkmcnt(" #n ")" ::: "memory")
#define PG8_BAR __builtin_amdgcn_s_barrier()
#define PG8_SCHED __builtin_amdgcn_sched_barrier(0)
    Unit cur, nxt; int ui = 0;
    if (!S.next(0, cur)) return;
    Acc acc;
#pragma unroll
    for (int a = 0; a < 2; ++a)
#pragma unroll
        for (int b = 0; b < 2; ++b)
#pragma unroll
            for (int m = 0; m < 4; ++m)
#pragma unroll
                for (int n = 0; n < 2; ++n) acc[a][b][m][n] = (f32x4){0.f, 0.f, 0.f, 0.f};
    v8i_t At[4], B0[2], B1[2];
    unsigned cA = PG8_AOFF(cur), cB = PG8_BOFF(cur);
    if constexpr (GATHER) {
#pragma unroll
        for (int h = 0; h < 2; ++h)
#pragma unroll
            for (int i = 0; i < 2; ++i) voffG[h][i] = (unsigned)P.row_tok(cur, h * HALF + Rg[i]) * (unsigned)(P.lda * 2) + Cg[i];
    }
    PG8_STAGE_B(PG8_SB(0, 0), cB); PG8_STAGE_B(PG8_SB(0, 1), cB + hstepB); PG8_STAGE_A(PG8_SA(0, 0), cA, 0); PG8_STAGE_A(PG8_SA(0, 1), cA, 1);
    if (wr == 1) PG8_BAR;
    PG8_WAIT_V(2); PG8_BAR;
    PG8_STAGE_B(PG8_SB(1, 0), cB + kstep); PG8_STAGE_A(PG8_SA(1, 0), cA + kstep, 0); PG8_STAGE_B(PG8_SB(1, 1), cB + hstepB + kstep);
    PG8_WAIT_V(6); PG8_BAR;
    for (;;) {
        const bool has_next = S.next(ui + 1, nxt);
        const unsigned nA = has_next ? PG8_AOFF(nxt) : cA, nB = has_next ? PG8_BOFF(nxt) : cB;
        if constexpr (GATHER) { if (has_next && wr == 0) { int tg_ = tid; asm volatile("" : "+v"(tg_)); rtab[tg_] = P.row_tok(nxt, tg_); } }
        if (wr == 0) { int tp_ = tid; asm volatile("" : "+v"(tp_)); E.prefetch(cur, (LAS float*)(lds_epi + 4096) + (ui & 1) * 512, tp_); }
        for (int t = 0; t < nt; t += 2) {
            const bool last = (t == nt - 2);
            const unsigned a1 = cA + (unsigned)(t + 1) * kstep;
            const unsigned a2 = last ? nA : cA + (unsigned)(t + 2) * kstep, b2 = last ? nB : cB + (unsigned)(t + 2) * kstep;
            const unsigned a3 = a2 + kstep, b3 = b2 + kstep;
            PG8_LDB(B0, 0, 0); PG8_LDB(B1, 0, 1); PG8_SCHED; PG8_LDA(At, 0, 0); PG8_STAGE_A(PG8_SA(1, 1), a1, 1);
            if constexpr (GATHER) { if (last && has_next) {
#pragma unroll
                for (int h = 0; h < 2; ++h)
#pragma unroll
                    for (int i = 0; i < 2; ++i) voffG[h][i] = (unsigned)rtab[h * HALF + Rg[i]] * (unsigned)(P.lda * 2) + Cg[i]; } }
            PG8_WAIT_V(8); PG8_WAIT_L(0); PG8_BAR; PG8_MMA(0, 0, At, B0); PG8_MMA(0, 1, At, B1); PG8_BAR; PG8_SCHED;
            PG8_LDA(At, 0, 1); PG8_STAGE_B(PG8_SB(0, 0), b2); PG8_STAGE_B(PG8_SB(0, 1), b2 + hstepB); PG8_STAGE_A(PG8_SA(0, 0), a2, 0);
            PG8_WAIT_V(8); PG8_WAIT_L(0); PG8_BAR; PG8_MMA(1, 0, At, B0); PG8_MMA(1, 1, At, B1); PG8_BAR; PG8_SCHED;
            PG8_LDB(B0, 1, 0); PG8_LDB(B1, 1, 1); PG8_SCHED; PG8_LDA(At, 1, 0); PG8_STAGE_A(PG8_SA(0, 1), a2, 1);
            PG8_WAIT_V(8); PG8_WAIT_L(0); PG8_BAR; PG8_MMA(0, 0, At, B0); PG8_MMA(0, 1, At, B1); PG8_BAR; PG8_SCHED;
            PG8_LDA(At, 1, 1); PG8_STAGE_B(PG8_SB(1, 0), b3); PG8_STAGE_B(PG8_SB(1, 1), b3 + hstepB); PG8_STAGE_A(PG8_SA(1, 0), a3, 0);
            PG8_WAIT_V(8); PG8_WAIT_L(0); PG8_BAR; PG8_MMA(1, 0, At, B0); PG8_MMA(1, 1, At, B1); PG8_BAR; PG8_SCHED;
        }
#if PROBE_EPI
        const unsigned long long te0_ = __builtin_amdgcn_s_memrealtime();
#endif
        if (wr == 0) PG8_BAR;
        { int fr_ = fr, fq_ = fq; asm volatile("" : "+v"(fr_), "+v"(fq_));
          E(acc, cur, wr, wc, fr_, fq_, lds_epi, (const LAS float*)(lds_epi + 4096) + (ui & 1) * 512); }
#if PROBE_EPI
        if (tepi) { asm volatile("s_waitcnt vmcnt(8)" ::: "memory"); *tepi += __builtin_amdgcn_s_memrealtime() - te0_; }
#endif
        if (!has_next) break;
#pragma unroll
        for (int a = 0; a < 2; ++a)
#pragma unroll
            for (int b = 0; b < 2; ++b)
#pragma unroll
                for (int m = 0; m < 4; ++m)
#pragma unroll
                    for (int n = 0; n < 2; ++n) acc[a][b][m][n] = (f32x4){0.f, 0.f, 0.f, 0.f};
        cur = nxt; cA = nA; cB = nB; ++ui;
        if (wr == 1) PG8_BAR;
    }
    PG8_WAIT_V(0);
    PG8_BAR;
#undef PG8_SA
#undef PG8_SB
#undef PG8_STAGE
#undef PG8_STAGE_A
#undef PG8_STAGE_B
#undef PG8_AOFF
#undef PG8_BOFF
#undef PG8_LDA
#undef PG8_LDB
#undef PG8_MMA
#undef PG8_WAIT_V
#undef PG8_WAIT_L
#undef PG8_BAR
#undef PG8_SCHED
}
struct Order { int nM, nN, nwg, G, c;
    __device__ __forceinline__ void init(int nM_, int nN_, int G_, int c_) { nM = nM_; nN = nN_; nwg = nM * nN; G = G_; c = c_; }
    __device__ __forceinline__ bool next(int i, int& pm, int& pn) const {
        const long L = (long)i * G + c; if (L >= nwg) return false;
        int wgid = (int)L; { const int q = nwg / 8, r = nwg % 8, xcd = wgid % 8, off = wgid / 8; wgid = (xcd < r ? xcd * (q + 1) : r * (q + 1) + (xcd - r) * q) + off; }
        const int nig = 8 * nN, gid = wgid / nig, fm = gid * 8, gsz = (nM - fm) < 8 ? (nM - fm) : 8;
        pm = fm + ((wgid % nig) % gsz); pn = (wgid % nig) / gsz; return true; } };
struct SchedPlain { Order o; __device__ __forceinline__ bool next(int i, Unit& u) const { u.z = 0; return o.next(i, u.pm, u.pn); } };
struct SchedBatch8 { Order o; __device__ __forceinline__ bool next(int i, Unit& u) const { int pm, pn; if (!o.next(i, pm, pn)) return false; u.z = pm >> 3; u.pm = pm & 7; u.pn = 0; return true; } };
}

struct PvUpG { const bf16_t* X; const bf16_t* WT; const int* tile_e; const int* slot_tok; int lda, ldb, K;
    __device__ __forceinline__ const bf16_t* a_root() const { return X; }
    __device__ __forceinline__ const bf16_t* b_root() const { return WT; }
    __device__ __forceinline__ const bf16_t* a_base(const Unit&) const { return X; }
    __device__ __forceinline__ const bf16_t* b_base(const Unit& u) const { return WT + ((size_t)tile_e[u.pm] * 2048 + u.pn * 256) * ldb; }
    __device__ __forceinline__ int row_tok(const Unit& u, int r) const { return slot_tok[u.pm * 256 + r]; } };
struct PvPlain { const bf16_t* A; const bf16_t* Bt; int lda, ldb, K;
    __device__ __forceinline__ const bf16_t* a_root() const { return A; }
    __device__ __forceinline__ const bf16_t* b_root() const { return Bt; }
    __device__ __forceinline__ const bf16_t* a_base(const Unit& u) const { return A + (size_t)u.pm * 256 * lda; }
    __device__ __forceinline__ const bf16_t* b_base(const Unit& u) const { return Bt + (size_t)u.pn * 256 * ldb; } };
struct PvXS { const bf16_t* XQ; const bf16_t* KM; int lda, ldb, K;
    __device__ __forceinline__ const bf16_t* a_base(const Unit& u) const { return XQ + (size_t)((u.z >> 2) * 2048 + u.pm * 256) * 1024 + (u.z & 3) * 256; }
    __device__ __forceinline__ const bf16_t* b_base(const Unit& u) const { return KM + (size_t)((u.z >> 2) * 256) * 1024 + (u.z & 3) * 256; } };
struct PvXPV { const bf16_t* Pm; const bf16_t* VMT; int lda, ldb, K;
    __device__ __forceinline__ const bf16_t* a_base(const Unit& u) const { return Pm + ((size_t)u.z * 2048 + u.pm * 256) * 256; }
    __device__ __forceinline__ const bf16_t* b_base(const Unit& u) const { return VMT + (size_t)u.z * 65536; } };
struct PvExp { const bf16_t* A; const bf16_t* WT; const int* tile_e; int lda, ldb, K, nrow;
    __device__ __forceinline__ const bf16_t* a_root() const { return A; }
    __device__ __forceinline__ const bf16_t* b_root() const { return WT; }
    __device__ __forceinline__ const bf16_t* a_base(const Unit& u) const { return A + (size_t)u.pm * 256 * lda; }
    __device__ __forceinline__ const bf16_t* b_base(const Unit& u) const { return WT + ((size_t)tile_e[u.pm] * nrow + u.pn * 256) * ldb; } };

constexpr int MLA_KT = 12288, MLA_VT = 8192, MLA_KBUF = 2 * MLA_KT, MLA_VBUF = 2 * MLA_VT, MLA_V0 = 2 * MLA_KBUF;
typedef short v4i16_t __attribute__((ext_vector_type(4)));
__device__ __forceinline__ s16x4 lds_tr16(const LAS unsigned char* p) { return __builtin_bit_cast(s16x4, __builtin_amdgcn_ds_read_tr16_b64_v4i16((LAS v4i16_t*)p)); }
__device__ __forceinline__ void mla_unit(const Params& p, LAS unsigned char* lds, int unit, int tid) {
    const int lane = tid & 63, wid = __builtin_amdgcn_readfirstlane(tid >> 6), r32 = lane & 31, hi = lane >> 5;
    const int qb = unit & 7, h = (unit >> 3) & 7, b = unit >> 6;
    const bf16_t* Qg = (const bf16_t*)(p.ws + WS_Q); const bf16_t* Kg = (const bf16_t*)(p.ws + WS_KB); const bf16_t* Vg = (const bf16_t*)(p.ws + WS_VB);
    const size_t rowb = (size_t)b * SEQ;
    const int q0 = qb * 256 + wid * 32;
    int ksrc[3], kdst[3], vsrc[2], vdst[2];
    const bf16_t* Kbh = Kg + rowb * 768 + h * 96; const bf16_t* Vbh = Vg + rowb * 512 + h * 64;
#pragma unroll
    for (int i = 0; i < 3; ++i) { const int pk = tid + 512 * i, r = pk / 12, c = pk % 12; ksrc[i] = r * 768 + c * 8; kdst[i] = (r >> 6) * MLA_KT + c * 1024 + (r & 63) * 16; }
#pragma unroll
    for (int i = 0; i < 2; ++i) { const int pk = tid + 512 * i, r = pk >> 3, c = pk & 7; vsrc[i] = r * 512 + c * 8; vdst[i] = MLA_V0 + (r >> 6) * MLA_VT + (c >> 2) * 4096 + (r & 63) * 64 + (c & 3) * 16; }
    const int kfo = hi * 1024 + r32 * 16;
    const int vfo = MLA_V0 + ((lane >> 4) & 1) * 32 + (lane & 3) * 8 + (4 * hi + ((lane & 15) >> 2)) * 64;
    bf16x8 qf[6];
#pragma unroll
    for (int s = 0; s < 6; ++s) qf[s] = *(const bf16x8*)(Qg + (rowb + q0 + r32) * 768 + h * 96 + 16 * s + 8 * hi);
    const int ns_blk = 2 * qb + 2, nt_me = 4 * qb + (wid >> 1) + 1;
    u32x4 sk[3], sv[2];
#pragma unroll
    for (int i = 0; i < 3; ++i) sk[i] = *(const u32x4*)(Kbh + ksrc[i]);
#pragma unroll
    for (int i = 0; i < 2; ++i) sv[i] = *(const u32x4*)(Vbh + vsrc[i]);
#pragma unroll
    for (int i = 0; i < 3; ++i) *(LAS u32x4*)(lds + kdst[i]) = sk[i];
#pragma unroll
    for (int i = 0; i < 2; ++i) *(LAS u32x4*)(lds + vdst[i]) = sv[i];
    __syncthreads();
    float mrun = -1.0e30f, lrun = 0.f; f32x16 o0 = {}, o1 = {};
    for (int st = 0; st < ns_blk; ++st) {
        const bool pre = (st + 1 < ns_blk);
        if (pre) { const bf16_t* kn = Kbh + (size_t)(st + 1) * 128 * 768; const bf16_t* vn = Vbh + (size_t)(st + 1) * 128 * 512;
#pragma unroll
            for (int i = 0; i < 3; ++i) sk[i] = *(const u32x4*)(kn + ksrc[i]);
#pragma unroll
            for (int i = 0; i < 2; ++i) sv[i] = *(const u32x4*)(vn + vsrc[i]); }
#pragma unroll
        for (int tt = 0; tt < 2; ++tt) {
          const int t = 2 * st + tt;
          if (t < nt_me) {
            const LAS unsigned char* kb_ = lds + (st & 1) * MLA_KBUF + tt * MLA_KT + kfo; const LAS unsigned char* vb_ = lds + (st & 1) * MLA_VBUF + tt * MLA_VT + vfo;
            f32x16 sc[2]; bf16x8 kf[2][6]; s16x4 vlo[8], vhi[8];
#pragma unroll
            for (int kb = 0; kb < 2; ++kb)
#pragma unroll
                for (int s = 0; s < 6; ++s) kf[kb][s] = *(const LAS bf16x8*)(kb_ + s * 2048 + kb * 512);
            __builtin_amdgcn_sched_barrier(0);
#pragma unroll
            for (int kb = 0; kb < 2; ++kb) { f32x16 a = {};
#pragma unroll
                for (int s = 0; s < 6; ++s) a = __builtin_amdgcn_mfma_f32_32x32x16_bf16(kf[kb][s], qf[s], a, 0, 0, 0);
                sc[kb] = a; }
            __builtin_amdgcn_sched_barrier(0);
#pragma unroll
            for (int i = 0; i < 8; ++i) { const LAS unsigned char* vr = vb_ + (i & 1) * 4096 + (i >> 2) * 2048 + ((i >> 1) & 1) * 1024; vlo[i] = lds_tr16(vr); vhi[i] = lds_tr16(vr + 512); }
            __builtin_amdgcn_sched_barrier(0);
            float mx = fmaxf(fmaxf(sc[0][0], sc[0][1]), sc[1][0]);
#pragma unroll
            for (int r = 2; r < 16; r += 2) mx = fmaxf(fmaxf(mx, sc[0][r]), sc[0][r + 1]);
#pragma unroll
            for (int r = 1; r < 15; r += 2) mx = fmaxf(fmaxf(mx, sc[1][r]), sc[1][r + 1]);
            mx = fmaxf(mx, sc[1][15]);
            mx = fmaxf(mx, shflx(mx, 32, lane));
            if (__any(mx > mrun + 8.0f)) { const float mnew = fmaxf(mrun, mx), alpha = fast_exp2(mrun - mnew); mrun = mnew; lrun *= alpha;
#pragma unroll
                for (int r = 0; r < 16; ++r) { o0[r] *= alpha; o1[r] *= alpha; } }
            float ls = 0.f; unsigned pw[2][8];
#pragma unroll
            for (int kb = 0; kb < 2; ++kb)
#pragma unroll
                for (int r = 0; r < 16; r += 2) { const float e0 = fast_exp2(sc[kb][r] - mrun), e1 = fast_exp2(sc[kb][r + 1] - mrun); pw[kb][r >> 1] = pk2(e0, e1); ls += e0 + e1; }
            lrun += ls;
#pragma unroll
            for (int kb = 0; kb < 2; ++kb)
#pragma unroll
                for (int s2 = 0; s2 < 2; ++s2) {
                    const bf16x8 pf = __builtin_bit_cast(bf16x8, (u32x4){pw[kb][4 * s2 + 0], pw[kb][4 * s2 + 1], pw[kb][4 * s2 + 2], pw[kb][4 * s2 + 3]});
#pragma unroll
                    for (int db = 0; db < 2; ++db) { const int i = 4 * kb + 2 * s2 + db;
                        const bf16x8 vf = (bf16x8){vlo[i][0], vlo[i][1], vlo[i][2], vlo[i][3], vhi[i][0], vhi[i][1], vhi[i][2], vhi[i][3]};
                        if (db == 0) o0 = __builtin_amdgcn_mfma_f32_32x32x16_bf16(vf, pf, o0, 0, 0, 0); else o1 = __builtin_amdgcn_mfma_f32_32x32x16_bf16(vf, pf, o1, 0, 0, 0); } }
          }
        }
        if (pre) { LAS unsigned char* nk = lds + ((st + 1) & 1) * MLA_KBUF; LAS unsigned char* nv = lds + ((st + 1) & 1) * MLA_VBUF;
#pragma unroll
            for (int i = 0; i < 3; ++i) *(LAS u32x4*)(nk + kdst[i]) = sk[i];
#pragma unroll
            for (int i = 0; i < 2; ++i) *(LAS u32x4*)(nv + vdst[i]) = sv[i]; }
        __syncthreads();
    }
    lrun += shflx(lrun, 32, lane);
    const float inv = 1.0f / lrun;
    bf16_t* yo = (bf16_t*)(p.ws + WS_YCAT) + (rowb + q0 + r32) * 1024 + h * 64;
#pragma unroll
    for (int g = 0; g < 4; ++g) { u32x2 w0, w1; w0.x = pk2(o0[4 * g] * inv, o0[4 * g + 1] * inv); w0.y = pk2(o0[4 * g + 2] * inv, o0[4 * g + 3] * inv);
        w1.x = pk2(o1[4 * g] * inv, o1[4 * g + 1] * inv); w1.y = pk2(o1[4 * g + 2] * inv, o1[4 * g + 3] * inv);
        *(u32x2*)(yo + 8 * g + 4 * hi) = w0; *(u32x2*)(yo + 32 + 8 * g + 4 * hi) = w1; }
}

constexpr int XA_KB = 32768, XA_BUF = 65536;
__device__ __forceinline__ void xattn_range(const Params& p, LAS unsigned char* lds, int u0, int nu, int tid, unsigned long long* tacc = nullptr) {
    const int lane = tid & 63, wid = __builtin_amdgcn_readfirstlane(tid >> 6), fr = lane & 15, fq = lane >> 4;
    const bf16_t* XQ = (const bf16_t*)(p.ws + WS_XQ); const bf16_t* KM = (const bf16_t*)(p.ws + WS_KM); const bf16_t* VMT = (const bf16_t*)(p.ws + WS_VMT); bf16_t* OX = (bf16_t*)(p.ws + WS_OX);
    const int kpos0 = 8 * wid + (lane >> 5);
    const int vrow = 32 * wid + (lane >> 3), vslot = (lane & 7) ^ (vrow & 7);
    const int vsrc = vrow * 256 + vslot * 8;
    const int nstep = nu * 4;
#define XA_DMA(step) do { const int un_ = u0 + ((step) >> 2), t_ = (step) & 3, z_ = un_ >> 4; \
        const bf16_t* kp_ = KM + ((size_t)((z_ >> 2) * 256 + 64 * t_)) * 1024 + (z_ & 3) * 256; const bf16_t* vp_ = VMT + (size_t)z_ * 65536 + 64 * t_ + vsrc; \
        LAS unsigned char* nb_ = lds + ((step) & 1) * XA_BUF + wid * 4096; \
        _Pragma("unroll") for (int i_ = 0; i_ < 4; ++i_) { const int pos_ = kpos0 + 2 * i_; const int key_ = (pos_ & 32) + 8 * ((pos_ >> 2) & 3) + 4 * ((pos_ >> 4) & 1) + (pos_ & 3); \
            __builtin_amdgcn_global_load_lds((const unsigned*)(kp_ + key_ * 1024 + (((lane & 31) ^ (pos_ & 15)) << 3)), (LAS unsigned*)(nb_ + i_ * 1024), 16, 0, 0); \
            __builtin_amdgcn_global_load_lds((const unsigned*)(vp_ + i_ * 8 * 256), (LAS unsigned*)(nb_ + XA_KB + i_ * 1024), 16, 0, 0); } } while (0)
    XA_DMA(0);
    bf16x8 qf[8]; f32x4 oacc[16]; float mrun = -1.0e30f, lrun = 0.f;
    { const int z = u0 >> 4; const size_t qrow = (size_t)(z >> 2) * 2048 + (u0 & 15) * 128 + wid * 16 + fr;
#pragma unroll
      for (int ks = 0; ks < 8; ++ks) qf[ks] = *(const bf16x8*)(XQ + qrow * 1024 + (z & 3) * 256 + 32 * ks + 8 * fq); }
    __syncthreads();
    for (int step = 0; step < nstep; ++step) {
        const int t = step & 3, un = u0 + (step >> 2), z = un >> 4, b = z >> 2, h = z & 3;
        const size_t qrow = (size_t)b * 2048 + (un & 15) * 128 + wid * 16 + fr;
        if (t == 0) {
#pragma unroll
            for (int db = 0; db < 16; ++db) oacc[db] = (f32x4){0.f, 0.f, 0.f, 0.f};
            mrun = -1.0e30f; lrun = 0.f; }
        if (step + 1 < nstep) XA_DMA(step + 1);
        { const LAS unsigned char* kb = lds + (step & 1) * XA_BUF; const LAS unsigned char* vb = kb + XA_KB;
          f32x4 sacc[4]; bf16x8 kfa[8], kfb[8];
#define XA_LDK(dst, kvb) do { _Pragma("unroll") for (int ks = 0; ks < 8; ++ks) dst[ks] = *(const LAS bf16x8*)(kb + (16 * (kvb) + fr) * 512 + (((4 * ks + fq) ^ fr) << 4)); } while (0)
#define XA_QK(src, kvb) do { f32x4 a_ = {0.f, 0.f, 0.f, 0.f}; _Pragma("unroll") for (int ks = 0; ks < 8; ++ks) a_ = __builtin_amdgcn_mfma_f32_16x16x32_bf16(src[ks], qf[ks], a_, 0, 0, 0); sacc[kvb] = a_; } while (0)
          XA_LDK(kfa, 0); XA_LDK(kfb, 1); __builtin_amdgcn_sched_barrier(0);
          XA_QK(kfa, 0); XA_LDK(kfa, 2); __builtin_amdgcn_sched_barrier(0);
          XA_QK(kfb, 1); XA_LDK(kfb, 3); __builtin_amdgcn_sched_barrier(0);
          XA_QK(kfa, 2); __builtin_amdgcn_sched_barrier(0);
          XA_QK(kfb, 3);
#undef XA_LDK
#undef XA_QK
          float mx = fmaxf(fmaxf(sacc[0][0], sacc[0][1]), fmaxf(sacc[0][2], sacc[0][3]));
#pragma unroll
          for (int kvb = 1; kvb < 4; ++kvb) { mx = fmaxf(fmaxf(mx, sacc[kvb][0]), sacc[kvb][1]); mx = fmaxf(fmaxf(mx, sacc[kvb][2]), sacc[kvb][3]); }
          mx = fmaxf(mx, shflx(mx, 16, fr + 16 * fq)); mx = fmaxf(mx, shflx(mx, 32, fr + 16 * fq));
          if (__any(mx > mrun + 8.0f)) { const float mnew = fmaxf(mrun, mx), alpha = fast_exp2(mrun - mnew); mrun = mnew; lrun *= alpha;
#pragma unroll
              for (int db = 0; db < 16; ++db) oacc[db] = oacc[db] * alpha; }
          float ls = 0.f; u32x4 pw[2];
#pragma unroll
          for (int s2 = 0; s2 < 2; ++s2) { unsigned w[4];
#pragma unroll
              for (int hh = 0; hh < 2; ++hh)
#pragma unroll
                  for (int jj = 0; jj < 2; ++jj) { const float e0 = fast_exp2(sacc[2 * s2 + hh][2 * jj] - mrun), e1 = fast_exp2(sacc[2 * s2 + hh][2 * jj + 1] - mrun); w[2 * hh + jj] = pk2(e0, e1); ls += e0 + e1; }
              pw[s2] = (u32x4){w[0], w[1], w[2], w[3]}; }
          lrun += ls;
          { bf16x8 vfa[8], vfb[8];
#define XA_LDV(dst, s2, d0) do { _Pragma("unroll") for (int i = 0; i < 8; ++i) dst[i] = *(const LAS bf16x8*)(vb + (16 * ((d0) + i) + fr) * 128 + (((4 * (s2) + fq) ^ (fr & 7)) << 4)); } while (0)
#define XA_PV(src, s2, d0) do { const bf16x8 pf_ = __builtin_bit_cast(bf16x8, pw[s2]); _Pragma("unroll") for (int i = 0; i < 8; ++i) oacc[(d0) + i] = __builtin_amdgcn_mfma_f32_16x16x32_bf16(src[i], pf_, oacc[(d0) + i], 0, 0, 0); } while (0)
            XA_LDV(vfa, 0, 0); XA_LDV(vfb, 0, 8); __builtin_amdgcn_sched_barrier(0);
            XA_PV(vfa, 0, 0); XA_LDV(vfa, 1, 0); __builtin_amdgcn_sched_barrier(0);
            XA_PV(vfb, 0, 8); XA_LDV(vfb, 1, 8); __builtin_amdgcn_sched_barrier(0);
            XA_PV(vfa, 1, 0); __builtin_amdgcn_sched_barrier(0);
            XA_PV(vfb, 1, 8);
#undef XA_LDV
#undef XA_PV
          } }
        if (t == 3) { float lt = lrun; lt += shflx(lt, 16, lane); lt += shflx(lt, 32, lane); const float inv = 1.0f / lt;
            int t3; asm volatile("v_mbcnt_lo_u32_b32 %0, -1, 0\n\tv_mbcnt_hi_u32_b32 %0, -1, %0" : "=v"(t3)); t3 += wid << 6;
            const size_t qrow3 = (size_t)b * 2048 + (un & 15) * 128 + (t3 >> 6) * 16 + (t3 & 15);
            bf16_t* orow = OX + qrow3 * 1024 + h * 256 + 4 * ((t3 >> 4) & 3);
#pragma unroll
            for (int db = 0; db < 16; ++db) { const f32x4 v = oacc[db] * inv; u32x2 w; w.x = pk2(v[0], v[1]); w.y = pk2(v[2], v[3]); *(u32x2*)(orow + 16 * db) = w; }
            if (step + 1 < nstep) { const int un2 = un + 1, z2 = un2 >> 4; const size_t qr2 = (size_t)(z2 >> 2) * 2048 + (un2 & 15) * 128 + wid * 16 + fr;
#pragma unroll
                for (int ks = 0; ks < 8; ++ks) qf[ks] = *(const bf16x8*)(XQ + qr2 * 1024 + (z2 & 3) * 256 + 32 * ks + 8 * fq); } }
#if PROBE_XA
        const unsigned long long tb0_ = __builtin_amdgcn_s_memrealtime();
#endif
        __syncthreads();
#if PROBE_XA
        if (tacc) *tacc += __builtin_amdgcn_s_memrealtime() - tb0_;
#endif
    }
#undef XA_DMA
}

__device__ __forceinline__ void conv_unit(const Params& p, LAS unsigned char* lds, int unit, int tid) {
    const int lane = tid & 63, wid = tid >> 6, c = tid;
    const int b = unit >> 5, t0 = (unit & 31) * 64;
    LAS float* cl = (LAS float*)lds;
    LAS float* wl = (LAS float*)(lds + 65536);
    const __amdgpu_buffer_rsrc_t wr_ = __builtin_amdgcn_make_buffer_rsrc((void*)p.w_dw, 0, 31 * 512 * 4, 0x00020000);
#pragma unroll
    for (int j = 0; j < 31; ++j) wl[j * 512 + c] = __uint_as_float(__builtin_amdgcn_raw_buffer_load_b32(wr_, c * 4, j * 2048, 0));
    const __amdgpu_buffer_rsrc_t zr = __builtin_amdgcn_make_buffer_rsrc((void*)(p.ws + WS_Z), 0, (int)((size_t)NTOK * 512 * 2), 0x00020000);
    float z[94];
#define CV_BATCH(i0, n) do { unsigned short raw_[n]; \
        _Pragma("unroll") for (int i_ = 0; i_ < (n); ++i_) { const int t_ = t0 - 30 + (i0) + i_; const int tc_ = t_ < 0 ? 0 : t_; raw_[i_] = __builtin_amdgcn_raw_buffer_load_b16(zr, c * 2, (b * SEQ + tc_) * 1024, 0); } \
        __builtin_amdgcn_sched_barrier(0); \
        _Pragma("unroll") for (int i_ = 0; i_ < (n); ++i_) { const int t_ = t0 - 30 + (i0) + i_; z[(i0) + i_] = t_ < 0 ? 0.f : bf2f(raw_[i_]); } \
        __builtin_amdgcn_sched_barrier(0); } while (0)
    CV_BATCH(0, 32); CV_BATCH(32, 32); CV_BATCH(64, 30);
#undef CV_BATCH
    const float bias = p.b_dw[c];
    const f32x4 g0 = *(const f32x4*)(p.g_cln + lane * 8), g1 = *(const f32x4*)(p.g_cln + lane * 8 + 4), b0 = *(const f32x4*)(p.b_cln + lane * 8), b1 = *(const f32x4*)(p.b_cln + lane * 8 + 4);
#pragma unroll
    for (int ps = 0; ps < 2; ++ps) {
        float acc[32];
#pragma unroll
        for (int o = 0; o < 32; ++o) acc[o] = bias;
#pragma unroll
        for (int j = 0; j < 31; ++j) { const float wj = wl[j * 512 + c];
#pragma unroll
            for (int o = 0; o < 32; ++o) acc[o] += wj * z[32 * ps + o + j]; }
#pragma unroll
        for (int o = 0; o < 32; ++o) cl[o * 512 + c] = acc[o];
        __syncthreads();
#pragma unroll
        for (int oo = 0; oo < 4; ++oo) { const int o = wid * 4 + oo; const LAS float* r = cl + o * 512 + lane * 8;
            const f32x4 v0 = *(const LAS f32x4*)r, v1 = *(const LAS f32x4*)(r + 4);
            float s = (v0[0] + v0[1]) + (v0[2] + v0[3]) + (v1[0] + v1[1]) + (v1[2] + v1[3]); s = wave_sum(s, lane); const float mu = s * (1.0f / 512.0f);
            const f32x4 d0 = v0 - mu, d1 = v1 - mu; float q = (d0[0] * d0[0] + d0[1] * d0[1]) + (d0[2] * d0[2] + d0[3] * d0[3]) + (d1[0] * d1[0] + d1[1] * d1[1]) + (d1[2] * d1[2] + d1[3] * d1[3]);
            q = wave_sum(q, lane); const float rstd = 1.0f / sqrtf(q * (1.0f / 512.0f) + EPS);
            float y[8];
#pragma unroll
            for (int j = 0; j < 4; ++j) { const float a0 = d0[j] * rstd * g0[j] + b0[j], a1 = d1[j] * rstd * g1[j] + b1[j]; y[j] = a0 * sigmoidf_(a0); y[4 + j] = a1 * sigmoidf_(a1); }
            u32x4 wv; wv.x = pk2(y[0], y[1]); wv.y = pk2(y[2], y[3]); wv.z = pk2(y[4], y[5]); wv.w = pk2(y[6], y[7]);
            *(u32x4*)((bf16_t*)(p.ws + WS_YCAT) + ((size_t)b * SEQ + t0 + 32 * ps + o) * 1024 + 512 + lane * 8) = wv; }
        __syncthreads();
    }
}

constexpr int R1_LD = 2064;
constexpr int R1_LG = 2 * 32 * R1_LD;
__device__ __forceinline__ void router1_stage_weights(const Params& p, LAS unsigned char* lds, int tid) {
    const u32x4* W = (const u32x4*)(p.ws + WS_WR);
#pragma unroll 4
    for (int i = tid; i < 64 * 128; i += 512) { const int row = i >> 7, c = i & 127; *(LAS u32x4*)(lds + row * R1_LD + c * 16) = W[i]; }
    __syncthreads();
}
__device__ __forceinline__ void router1_unit(const Params& p, LAS unsigned char* lds, int unit, int tid) {
    const int lane = tid & 63, wid = tid >> 6, r = lane & 15, q = lane >> 4;
    LAS float* lg = (LAS float*)(lds + R1_LG) + wid * 512;
    LAS int* hist = (LAS int*)(lds + R1_LG + 16384);
    if (tid < 32) hist[tid] = 0;
    __syncthreads();
    const int tok0 = unit * RT_TOK + wid * 16;
    const bf16_t* xr = (const bf16_t*)(p.ws + WS_X2B) + (size_t)(tok0 + r) * 1024 + 8 * q;
    const LAS unsigned char* wh0 = lds + r * R1_LD + 16 * q;
    u32x4 xw[32];
#pragma unroll
    for (int ks = 0; ks < 32; ++ks) xw[ks] = *(const u32x4*)(xr + 32 * ks);
    f32x4 acc0 = {0.f, 0.f, 0.f, 0.f}, acc1 = {0.f, 0.f, 0.f, 0.f}; float ssq = 0.f;
#pragma unroll
    for (int ks = 0; ks < 32; ++ks) {
        const u32x4 w = xw[ks];
        { const float a0 = __uint_as_float(w.x << 16), a1 = __uint_as_float(w.x & 0xffff0000u), a2 = __uint_as_float(w.y << 16), a3 = __uint_as_float(w.y & 0xffff0000u);
          const float a4 = __uint_as_float(w.z << 16), a5 = __uint_as_float(w.z & 0xffff0000u), a6 = __uint_as_float(w.w << 16), a7 = __uint_as_float(w.w & 0xffff0000u);
          ssq += (a0 * a0 + a1 * a1) + (a2 * a2 + a3 * a3) + (a4 * a4 + a5 * a5) + (a6 * a6 + a7 * a7); }
        const bf16x8 ah = __builtin_bit_cast(bf16x8, w);
        const bf16x8 bh0 = *(const LAS bf16x8*)(wh0 + 64 * ks), bh1 = *(const LAS bf16x8*)(wh0 + 16 * R1_LD + 64 * ks);
        const bf16x8 bl0 = *(const LAS bf16x8*)(wh0 + 32 * R1_LD + 64 * ks), bl1 = *(const LAS bf16x8*)(wh0 + 48 * R1_LD + 64 * ks);
        acc0 = __builtin_amdgcn_mfma_f32_16x16x32_bf16(ah, bh0, acc0, 0, 0, 0); acc1 = __builtin_amdgcn_mfma_f32_16x16x32_bf16(ah, bh1, acc1, 0, 0, 0);
        acc0 = __builtin_amdgcn_mfma_f32_16x16x32_bf16(ah, bl0, acc0, 0, 0, 0); acc1 = __builtin_amdgcn_mfma_f32_16x16x32_bf16(ah, bl1, acc1, 0, 0, 0);
    }
    ssq += shflx(ssq, 16, lane); ssq += shflx(ssq, 32, lane);
    const float rstd_r = 1.0f / sqrtf(ssq * (1.0f / 1024.0f) + EPS);
    if (lane < 16) ((float*)(p.ws + WS_RSTD_X2))[tok0 + lane] = rstd_r;
    const float be0 = p.b_router[r], be1 = p.b_router[16 + r];
#pragma unroll
    for (int j = 0; j < 4; ++j) { const float rs = shfli(rstd_r, 4 * q + j); lg[(4 * q + j) * 32 + r] = acc0[j] * rs + be0; lg[(4 * q + j) * 32 + 16 + r] = acc1[j] * rs + be1; }
    asm volatile("s_waitcnt lgkmcnt(0)" ::: "memory");
    if (lane < 16) { const int tk = tok0 + lane; unsigned used = 0u; float tv[4]; int ti[4];
#pragma unroll
        for (int k = 0; k < 4; ++k) { float best = -3.0e38f; int bi = 0;
            for (int j = 0; j < 32; ++j) { const float v = lg[lane * 32 + j]; if (!((used >> j) & 1u) && v > best) { best = v; bi = j; } }
            used |= 1u << bi; tv[k] = best; ti[k] = bi; }
        const float e1 = __expf(tv[1] - tv[0]), e2 = __expf(tv[2] - tv[0]), e3 = __expf(tv[3] - tv[0]); const float inv = 1.0f / (1.0f + e1 + e2 + e3);
        int* oi = (int*)(p.ws + WS_TOPI) + (size_t)tk * 4; float* og = (float*)(p.ws + WS_TOPG) + (size_t)tk * 4;
        oi[0] = ti[0]; oi[1] = ti[1]; oi[2] = ti[2]; oi[3] = ti[3]; og[0] = inv; og[1] = e1 * inv; og[2] = e2 * inv; og[3] = e3 * inv;
#pragma unroll
        for (int k = 0; k < 4; ++k) atomicAdd((int*)&hist[ti[k]], 1); }
    __syncthreads();
    if (tid < 32) ((int*)(p.ws + WS_HIST))[unit * 32 + tid] = hist[tid];
    __syncthreads();
}
__device__ __forceinline__ void router2_unit(const Params& p, LAS unsigned char* lds, int unit, int tid) {
    const int lane = tid & 63, wid = tid >> 6;
    LAS int* cnt = (LAS int*)lds;
    LAS int* base = cnt + 32;
    LAS int* pst = cnt + 64;
    LAS int* part = cnt + 128;
    LAS int* wcnt = cnt + 128 + 1024;
    const int* H = (const int*)(p.ws + WS_HIST);
    { const int e = tid & 31, pt = tid >> 5; int tot = 0, bs = 0;
#pragma unroll 4
      for (int j = 0; j < 16; ++j) { const int bq = pt * 16 + j; const int v = H[bq * 32 + e]; tot += v; bs += (bq < unit) ? v : 0; }
      part[pt * 64 + e] = tot; part[pt * 64 + 32 + e] = bs; }
    const int my_e = ((const int*)(p.ws + WS_TOPI))[(size_t)unit * RT_TOK * 4 + tid];
    int my_rank = 0;
#pragma unroll 4
    for (int e = 0; e < 32; ++e) { const unsigned long long m = __ballot(my_e == e); if (my_e == e) my_rank = __popcll(m & ((1ull << lane) - 1ull)); if (lane == 0) wcnt[wid * 32 + e] = __popcll(m); }
    __syncthreads();
    if (tid < 32) { int tot = 0, bs = 0;
#pragma unroll
        for (int pt = 0; pt < 16; ++pt) { tot += part[pt * 64 + tid]; bs += part[pt * 64 + 32 + tid]; }
        cnt[tid] = tot; base[tid] = bs; }
    __syncthreads();
    if (tid == 0) { int sacc = 0; for (int e = 0; e < 32; ++e) { pst[e] = sacc; sacc += (cnt[e] + 255) & ~255; } pst[32] = sacc; }
    __syncthreads();
    { int woff = 0;
#pragma unroll
      for (int w = 0; w < 8; ++w) woff += (w < wid) ? wcnt[w * 32 + my_e] : 0;
      const int d = pst[my_e] + base[my_e] + woff + my_rank; const int tok = unit * RT_TOK + (tid >> 2);
      ((int*)(p.ws + WS_SLOT_TOK))[d] = tok; ((float*)(p.ws + WS_SLOT_GATE))[d] = ((const float*)(p.ws + WS_TOPG))[(size_t)unit * RT_TOK * 4 + tid];
      ((int*)(p.ws + WS_INV))[(size_t)unit * RT_TOK * 4 + tid] = d; ((float*)(p.ws + WS_SLOT_RS))[d] = ((const float*)(p.ws + WS_RSTD_X2))[tok]; }
    if (unit < 32) { const int e = unit, s0 = pst[e] + cnt[e], s1 = pst[e + 1];
        for (int s = s0 + tid; s < s1; s += 512) { ((int*)(p.ws + WS_SLOT_TOK))[s] = 0; ((float*)(p.ws + WS_SLOT_GATE))[s] = 0.f; ((float*)(p.ws + WS_SLOT_RS))[s] = 0.f; } }
    if (unit == 32) { int* te = (int*)(p.ws + WS_TILE_E); const int nt = pst[32] >> 8;
        for (int t = tid; t < NTILE_MAX; t += 512) { int e = 31; for (int k = 31; k >= 0; --k) if (t * 256 < pst[k + 1]) e = k; te[t] = e; }
        if (tid == 0) te[NTILE_MAX] = nt; }
    __syncthreads();
}

struct FinalRows { u32x2 x[4]; unsigned y[4][4]; };
__device__ __forceinline__ void final_load(const Params& p, int tok, int i0, int i1, int i2, int i3, FinalRows& r, int lane) {
    const u32x2* x2 = (const u32x2*)((const bf16_t*)(p.ws + WS_X2B) + (size_t)tok * 1024); const unsigned char* YB = p.ws + WS_YB;
    const unsigned* y0 = (const unsigned*)(YB + (size_t)i0 * 1024); const unsigned* y1 = (const unsigned*)(YB + (size_t)i1 * 1024); const unsigned* y2 = (const unsigned*)(YB + (size_t)i2 * 1024); const unsigned* y3 = (const unsigned*)(YB + (size_t)i3 * 1024);
#pragma unroll
    for (int j = 0; j < 4; ++j) { r.x[j] = x2[lane + 64 * j]; r.y[0][j] = y0[lane + 64 * j]; r.y[1][j] = y1[lane + 64 * j]; r.y[2][j] = y2[lane + 64 * j]; r.y[3][j] = y3[lane + 64 * j]; }
}
__device__ __forceinline__ void final_stage(const Params& p, int gw, int ngw, int lane) {
    if (gw >= NTOK) return;
    const int* INV = (const int*)(p.ws + WS_INV);
    FinalRows cur, nxt; int tok = gw;
    { const int* iv = INV + (size_t)tok * 4; final_load(p, tok, iv[0], iv[1], iv[2], iv[3], cur, lane); }
    int n0 = 0, n1 = 0, n2 = 0, n3 = 0;
    if (tok + ngw < NTOK) { const int* iv = INV + (size_t)(tok + ngw) * 4; n0 = iv[0]; n1 = iv[1]; n2 = iv[2]; n3 = iv[3]; }
    const f32x4 g0 = ((const f32x4*)p.g_final)[lane], g1 = ((const f32x4*)p.g_final)[lane + 64], g2 = ((const f32x4*)p.g_final)[lane + 128], g3 = ((const f32x4*)p.g_final)[lane + 192];
    for (; tok < NTOK; tok += ngw) {
        const int tn = tok + ngw;
        if (tn < NTOK) { final_load(p, tn, n0, n1, n2, n3, nxt, lane);
            if (tn + ngw < NTOK) { const int* iv = INV + (size_t)(tn + ngw) * 4; n0 = iv[0]; n1 = iv[1]; n2 = iv[2]; n3 = iv[3]; } }
        f32x4 v[4];
#pragma unroll
        for (int j = 0; j < 4; ++j) { const u32x2 w = cur.x[j]; v[j][0] = __uint_as_float(w.x << 16); v[j][1] = __uint_as_float(w.x & 0xffff0000u); v[j][2] = __uint_as_float(w.y << 16); v[j][3] = __uint_as_float(w.y & 0xffff0000u); }
#pragma unroll
        for (int k = 0; k < 4; ++k)
#pragma unroll
            for (int j = 0; j < 4; ++j) { const int w = (int)cur.y[k][j]; const f32x2 lo = __builtin_amdgcn_cvt_pk_f32_fp8(w, false), hi = __builtin_amdgcn_cvt_pk_f32_fp8(w, true);
                v[j][0] += lo[0] * Y8_INV; v[j][1] += lo[1] * Y8_INV; v[j][2] += hi[0] * Y8_INV; v[j][3] += hi[1] * Y8_INV; }
        float s = 0.f;
#pragma unroll
        for (int j = 0; j < 4; ++j) s += (v[j][0] * v[j][0] + v[j][1] * v[j][1]) + (v[j][2] * v[j][2] + v[j][3] * v[j][3]);
        s = wave_sum(s, lane); const float rstd = 1.0f / sqrtf(s * (1.0f / 1024.0f) + EPS);
        f32x4* xr = (f32x4*)(p.out + (size_t)tok * 1024);
        xr[lane] = v[0] * rstd * g0; xr[lane + 64] = v[1] * rstd * g1; xr[lane + 128] = v[2] * rstd * g2; xr[lane + 192] = v[3] * rstd * g3;
        cur = nxt;
    }
}

#define XB_TMO      128
#define XB_XCNT(j)  (256  + 64 * (j))
#define XB_XSUB(j)  (1280 + 64 * (j))
#define XB_XGEN(j)  (2304 + 64 * (j))
#define XB_TOP      3328
#define XB_TOPGEN   3392
#define XCD_BAR_WORDS 3456
constexpr int CW_MLAQ = 4096;
#define XB_SPIN_CAP (1u << 18)
__device__ __forceinline__ unsigned xb_ld(unsigned* p)              { return __hip_atomic_load(p, __ATOMIC_RELAXED, __HIP_MEMORY_SCOPE_AGENT); }
__device__ __forceinline__ unsigned xb_add(unsigned* p, unsigned v) { return __hip_atomic_fetch_add(p, v, __ATOMIC_RELAXED, __HIP_MEMORY_SCOPE_AGENT); }
__device__ __forceinline__ unsigned xb_xcc_id() { return (unsigned)__builtin_amdgcn_s_getreg((3 << 11) | 20) & 0xFu; }
#define XB_SPIN(cond, bar) do { unsigned _sp = 0; while (cond) { __builtin_amdgcn_s_sleep(1); \
    if ((++_sp & 255u) == 0u) { if (xb_ld(&(bar)[XB_TMO])) break; if (_sp > XB_SPIN_CAP) { atomicAdd(&(bar)[XB_TMO], 1u); break; } } } } while (0)
struct XcdBarrier { unsigned* bar; unsigned x; volatile LAS unsigned* st; };
__device__ __forceinline__ XcdBarrier xcd_barrier_post(unsigned* bar, volatile LAS unsigned* st, bool leader) {
    XcdBarrier b; b.bar = bar; b.x = xb_xcc_id(); b.st = st;
    if (leader) (void)xb_add(&bar[XB_XCNT(b.x)], 1u);
    return b;
}
__device__ __forceinline__ void xcd_barrier_complete(unsigned* bar, unsigned x, unsigned& nloc, unsigned& nx) {
    const unsigned G = gridDim.x * gridDim.y * gridDim.z;
    unsigned sum, cnt, mine, sp = 0u;
    for (;;) {
        sum = 0u; cnt = 0u; mine = 0u;
#pragma unroll
        for (unsigned j = 0; j < 16; ++j) { const unsigned c = xb_ld(&bar[XB_XCNT(j)]); sum += c; cnt += (c > 0u) ? 1u : 0u; mine = (j == x) ? c : mine; }
        if (sum == G) break;
        __builtin_amdgcn_s_sleep(1);
        if ((++sp & 255u) == 0u) { if (xb_ld(&bar[XB_TMO])) break; if (sp > XB_SPIN_CAP) { atomicAdd(&bar[XB_TMO], 1u); break; } }
    }
    nloc = mine > 0u ? mine : 1u; nx = cnt > 0u ? cnt : 1u;
}
__device__ __forceinline__ void xcd_barrier(const XcdBarrier& b, bool leader) {
    asm volatile("s_waitcnt vmcnt(0)" ::: "memory");
    __syncthreads();
    if (leader) {
        unsigned* bar = b.bar;
        __builtin_amdgcn_s_waitcnt(0);
        unsigned nloc = b.st[0], nx = b.st[1];
        if (nloc == 0u) { xcd_barrier_complete(bar, b.x, nloc, nx); b.st[0] = nloc; b.st[1] = nx; }
        const unsigned old = xb_add(&bar[XB_XSUB(b.x)], 1u);
        const unsigned gen = old / nloc;
        if (old + 1u == (gen + 1u) * nloc) {
            __builtin_amdgcn_fence(__ATOMIC_RELEASE, "agent");
            asm volatile("s_waitcnt vmcnt(0)" ::: "memory");
            const unsigned og = xb_add(&bar[XB_TOP], 1u);
            const unsigned tg = og / nx;
            if (og + 1u == (tg + 1u) * nx) xb_add(&bar[XB_TOPGEN], 1u);
            else XB_SPIN(xb_ld(&bar[XB_TOPGEN]) == tg, bar);
            __builtin_amdgcn_fence(__ATOMIC_ACQUIRE, "agent");
            xb_add(&bar[XB_XGEN(b.x)], 1u);
            asm volatile("s_waitcnt vmcnt(0)" ::: "memory");
        } else {
            XB_SPIN(xb_ld(&bar[XB_XGEN(b.x)]) == gen, bar);
            __builtin_amdgcn_fence(__ATOMIC_ACQUIRE, "agent");
            asm volatile("s_waitcnt vmcnt(0)" ::: "memory");
        }
    }
    __syncthreads();
}

constexpr int EPI_LDS = 131072;
constexpr int LDS_BYTES = 155648;

#ifndef USE_CG_SYNC
#define USE_CG_SYNC 0
#endif
#if USE_CG_SYNC
#define GRID_SYNC_() grid.sync()
#else
#define GRID_SYNC_() xcd_barrier(xbar, wave_s_ == 0 && __builtin_amdgcn_mbcnt_hi(~0u, __builtin_amdgcn_mbcnt_lo(~0u, 0u)) == 0u)
#endif
#if PROBE_MASK || PROBE_EPI || PROBE_XA || PROBE_SUB
#define GRID_SYNC() do { GRID_SYNC_(); const unsigned long long tn_ = __builtin_amdgcn_s_memrealtime(); if ((PROBE_MASK >> ph_) & 1) tacc_ += tn_ - tprev_; tprev_ = tn_; ++ph_; } while (0)
#else
#define GRID_SYNC() GRID_SYNC_()
#endif
constexpr int XB_LDS = 155520;

__device__ __forceinline__ void mla_order(int vb, int r, int& unit) {
    const int bh = vb >> 1, s = vb & 1; const int qb = (r == 0) ? s : (r == 1) ? 7 - s : (r == 2) ? 3 - s : 4 + s; unit = bh * 8 + qb;
}

#define GAS __attribute__((address_space(1)))
#define FROM_W(f, T, k) p_.f = (T*)(GAS T*)(w_[k])
__device__ __forceinline__ void params_from_words(Params& p_, const unsigned long long (&w_)[29]) {
    FROM_W(x, const float, 0); FROM_W(mem, const float, 1); FROM_W(pos, const int, 2);
    FROM_W(g_mix, const float, 3); FROM_W(w_in, const float, 4); FROM_W(g_q, const float, 5); FROM_W(w_uq, const float, 6); FROM_W(g_kv, const float, 7); FROM_W(w_ukv, const float, 8); FROM_W(w_dw, const float, 9); FROM_W(b_dw, const float, 10);
    FROM_W(g_cln, const float, 11); FROM_W(b_cln, const float, 12); FROM_W(w_out, const float, 13); FROM_W(g_xattn, const float, 14); FROM_W(g_mem, const float, 15); FROM_W(w_xq, const float, 16); FROM_W(w_xkv, const float, 17); FROM_W(w_xo, const float, 18);
    FROM_W(g_ffn, const float, 19); FROM_W(w_router, const float, 20); FROM_W(b_router, const float, 21); FROM_W(w_up, const float, 22); FROM_W(b_up, const float, 23); FROM_W(w_down, const float, 24); FROM_W(b_down, const float, 25); FROM_W(g_final, const float, 26);
    FROM_W(out, float, 27); FROM_W(ws, unsigned char, 28);
}
static_assert(sizeof(Params) == 29 * 8, "Params = 29 pointers");
typedef const __attribute__((address_space(4))) Params* CParams;
#define PHASE_BEGIN() CParams pp_ = (CParams)__builtin_amdgcn_kernarg_segment_ptr(); asm volatile("" : "+s"(pp_)); Params p; { const __attribute__((address_space(4))) unsigned long long* q_ = (const __attribute__((address_space(4))) unsigned long long*)pp_; unsigned long long w_[29]; _Pragma("unroll") for (int k_ = 0; k_ < 29; ++k_) w_[k_] = q_[k_]; params_from_words(p, w_); } unsigned char* ws = p.ws; int tid; asm volatile("v_mbcnt_lo_u32_b32 %0, -1, 0\n\tv_mbcnt_hi_u32_b32 %0, -1, %0" : "=v"(tid)); tid += wave_s_ << 6; const int lane = tid & 63; (void)lane; (void)ws;

__global__ void __launch_bounds__(512) mega_kernel(Params p_unused) {
    extern __shared__ __attribute__((aligned(16))) unsigned char lds_raw[];
#if USE_CG_SYNC
    cg::grid_group grid = cg::this_grid();
#endif
    LAS unsigned char* lds = (LAS unsigned char*)lds_raw;
    const int wave_s_ = __builtin_amdgcn_readfirstlane(threadIdx.x >> 6);
    if (threadIdx.x < 2) ((volatile LAS unsigned*)(lds + XB_LDS))[threadIdx.x] = 0u;
    __syncthreads();
    const XcdBarrier xbar = xcd_barrier_post((unsigned*)(((CParams)__builtin_amdgcn_kernarg_segment_ptr())->ws + WS_CTL), (volatile LAS unsigned*)(lds + XB_LDS), threadIdx.x == 0); (void)xbar;
    const int G = gridDim.x, bx = blockIdx.x;
    const int vb = (G % 8 == 0) ? (bx % 8) * (G / 8) + bx / 8 : bx;

#if PROBE_MASK || PROBE_EPI || PROBE_XA || PROBE_SUB
    unsigned long long tprev_ = __builtin_amdgcn_s_memrealtime(), tacc_ = 0; int ph_ = 0;
#endif
#if PROBE_SUB
    { PHASE_BEGIN(); prep_stage(p, lds, vb, G, tid, tacc_); }
#else
    { unsigned long long dummy_ = 0; PHASE_BEGIN(); prep_stage(p, lds, vb, G, tid, dummy_); }
#endif
    GRID_SYNC();
    { PHASE_BEGIN();
      { PvPlain P{(const bf16_t*)(ws + WS_XB), (const bf16_t*)(ws + WS_WT_IN), 1024, 1024, 1024}; pg8::SchedPlain S; S.o.init(128, 6, G, bx);
        EpiIn E{(bf16_t*)(ws + WS_U), (bf16_t*)(ws + WS_Z), (const float*)(ws + WS_RSTD_X), (float*)(ws + WS_SSQ_Q), (float*)(ws + WS_SSQ_KV), (const float*)(ws + WS_ROPE), (bf16_t*)(ws + WS_KB)};
        pg8::gemm_phase<true, false, false>(lds, lds + EPI_LDS, P, S, E, tid); }
 }
    GRID_SYNC();
    { PHASE_BEGIN();
      SUB_T0(4);
      { PvPlain P{(const bf16_t*)(ws + WS_U), (const bf16_t*)(ws + WS_WT_UQ), ULD, 256, 256}; pg8::SchedPlain S; S.o.init(128, 3, G, bx);
        EpiQ E{(bf16_t*)(ws + WS_Q), (const float*)(ws + WS_SSQ_Q), (const float*)(ws + WS_ROPE)};
        pg8::gemm_phase<false, false, false>(lds, lds + EPI_LDS, P, S, E, tid); }
      { PvPlain P{(const bf16_t*)(ws + WS_MEMB), (const bf16_t*)(ws + WS_WT_XKV), 1024, 1024, 1024}; pg8::SchedPlain S; S.o.init(16, 8, G, (bx + 128) % G);
        EpiKVMem E{(bf16_t*)(ws + WS_KM), (bf16_t*)(ws + WS_VMT), (const float*)(ws + WS_RSTD_MEM)};
        pg8::gemm_phase<false, false, false>(lds, lds + EPI_LDS, P, S, E, tid); }
      SUB_T1(4, tacc_);
      SUB_T0(5);
      { PvPlain P{(const bf16_t*)(ws + WS_U) + 256, (const bf16_t*)(ws + WS_WT_UKV), ULD, 128, 128}; pg8::SchedPlain S; S.o.init(128, 4, G, (bx + 128) % G);
        EpiKV E{(bf16_t*)(ws + WS_KB), (bf16_t*)(ws + WS_VB), (const float*)(ws + WS_SSQ_KV)};
        pg8::gemm_phase<true, false, false>(lds, lds + EPI_LDS, P, S, E, tid); }
      SUB_T1(5, tacc_);
      SUB_T0(6);
      { int tid2; asm volatile("v_mbcnt_lo_u32_b32 %0, -1, 0\n\tv_mbcnt_hi_u32_b32 %0, -1, %0" : "=v"(tid2)); tid2 += wave_s_ << 6; for (int i = vb; i < 512; i += G) conv_unit(p, lds, i, tid2); }
      SUB_T1(6, tacc_); }
    GRID_SYNC();
    { PHASE_BEGIN();
      if (G == 256) {
        const int xq_ = bx & 7, ix_ = bx >> 3;
        if ((ix_ % 3) == 0) moe_weights_stage(p, lds, xq_ * 11 + ix_ / 3, 88, tid);
        else { unsigned* qh = (unsigned*)(ws + WS_CTL) + CW_MLAQ + 64 * xq_; LAS int* nxt_ = (LAS int*)(lds + 98304);
          for (;;) { if (tid == 0) *nxt_ = (int)atomicAdd(qh, 1u);
            __syncthreads(); const int il = *nxt_; __syncthreads();
            if (il >= 128) break;
            const int bh = xq_ * 16 + (il >> 3), qb = 7 - (il & 7); mla_unit(p, lds, bh * 8 + qb, tid); } } }
      else { if (vb == 0) { } moe_weights_stage(p, lds, vb, G, tid); for (int i = vb; i < 1024; i += G) mla_unit(p, lds, i, tid); } }
    GRID_SYNC();
    { PHASE_BEGIN();
      PvPlain P{(const bf16_t*)(ws + WS_YCAT), (const bf16_t*)(ws + WS_WT_OUT), 1024, 1024, 1024}; pg8::SchedPlain S; S.o.init(128, 4, G, bx);
      EpiResid E{(const bf16_t*)(ws + WS_XB), (bf16_t*)(ws + WS_X1B), (float*)(ws + WS_SSQ_X1), nullptr};
      pg8::gemm_phase<true, false, false>(lds, lds + EPI_LDS, P, S, E, tid); }
    GRID_SYNC();
    { PHASE_BEGIN();
      PvPlain P{(const bf16_t*)(ws + WS_X1B), (const bf16_t*)(ws + WS_WT_XQ), 1024, 1024, 1024}; pg8::SchedPlain S; S.o.init(128, 4, G, bx);
      EpiScale16 E{(bf16_t*)(ws + WS_XQ), 1024, (const float*)(ws + WS_SSQ_X1), C2_X};
      pg8::gemm_phase<true, false, false>(lds, lds + EPI_LDS, P, S, E, tid); }
    GRID_SYNC();
    { PHASE_BEGIN();
#if PROBE_XA
      if (G == 256) xattn_range(p, lds, vb * 4, 4, tid, &tacc_);
#else
      if (G == 256) xattn_range(p, lds, vb * 4, 4, tid);
#endif
      else { for (int i = vb; i < 1024; i += G) xattn_range(p, lds, i, 1, tid); } }
    GRID_SYNC();
    { PHASE_BEGIN();
      PvPlain P{(const bf16_t*)(ws + WS_OX), (const bf16_t*)(ws + WS_WT_XO), 1024, 1024, 1024}; pg8::SchedPlain S; S.o.init(128, 4, G, bx);
      EpiResid E{(const bf16_t*)(ws + WS_X1B), (bf16_t*)(ws + WS_X2B), nullptr, ws + WS_X2F};
      pg8::gemm_phase<true, false, false>(lds, lds + EPI_LDS, P, S, E, tid); }
    GRID_SYNC();
    { PHASE_BEGIN(); if (vb < RT_UNITS) router1_stage_weights(p, lds, tid); for (int i = vb; i < RT_UNITS; i += G) router1_unit(p, lds, i, tid); }
    GRID_SYNC();
    { PHASE_BEGIN(); for (int i = vb; i < RT_UNITS; i += G) router2_unit(p, lds, i, tid); }
    GRID_SYNC();
    { PHASE_BEGIN(); const int* te = (const int*)(ws + WS_TILE_E); const int nt = te[NTILE_MAX];
      PvUpG P{(const bf16_t*)(ws + WS_X2F), (const bf16_t*)(ws + WS_WT_UP), te, (const int*)(ws + WS_SLOT_TOK), 512, 512, 512}; pg8::SchedPlain S; S.o.init(nt, 8, G, bx);
      EpiSwiglu E{(bf16_t*)(ws + WS_ACT), (const float*)(ws + WS_SLOT_RS), te, p.b_up};
#if PROBE_EPI
      pg8::gemm_phase<true, true, true>(lds, lds + EPI_LDS, P, S, E, tid, &tacc_);
#else
      pg8::gemm_phase<true, true, true>(lds, lds + EPI_LDS, P, S, E, tid);
#endif
    }
    GRID_SYNC();
    { PHASE_BEGIN(); const int* te = (const int*)(ws + WS_TILE_E); const int nt = te[NTILE_MAX];
      PvExp P{(const bf16_t*)(ws + WS_ACT), (const bf16_t*)(ws + WS_WT_DOWN), te, 512, 512, 512, 1024}; pg8::SchedPlain S; S.o.init(nt, 4, G, bx);
      EpiDown E{ws + WS_YB, (const float*)(ws + WS_SLOT_GATE), te, p.b_down};
      pg8::gemm_phase<true, false, true>(lds, lds + EPI_LDS, P, S, E, tid); }
    GRID_SYNC();
    { PHASE_BEGIN(); const int gw = vb * 8 + (tid >> 6), ngw = G * 8; final_stage(p, gw, ngw, lane); }
#if PROBE_MASK || PROBE_EPI || PROBE_XA || PROBE_SUB
    { const unsigned long long tn_ = __builtin_amdgcn_s_memrealtime(); if ((PROBE_MASK >> ph_) & 1) tacc_ += tn_ - tprev_;
      const unsigned long long t0_ = __builtin_amdgcn_s_memrealtime(); while (__builtin_amdgcn_s_memrealtime() - t0_ < 4ull * tacc_) __builtin_amdgcn_s_sleep(8); }
#endif
}

extern "C" void kernel_launch(void* const* d_in, const int* in_sizes, int n_in, void* d_out, int out_size, void* d_ws, size_t ws_size, hipStream_t stream) {
    static int grid = 0;
    if (grid == 0) {
        if (n_in != 27 || ws_size < WS_END) { fprintf(stderr, "kernel_launch: unexpected inputs (n_in %d, ws %zu)\n", n_in, ws_size); grid = -1; return; }
        int dev = 0, cus = 0, per_cu = 0;
        (void)hipGetDevice(&dev); (void)hipDeviceGetAttribute(&cus, hipDeviceAttributeMultiprocessorCount, dev);
        (void)hipFuncSetAttribute((const void*)mega_kernel, hipFuncAttributeMaxDynamicSharedMemorySize, LDS_BYTES);
        (void)hipOccupancyMaxActiveBlocksPerMultiprocessor(&per_cu, (const void*)mega_kernel, 512, LDS_BYTES);
        if (per_cu < 1) { fprintf(stderr, "kernel_launch: occupancy query says %d blocks per CU\n", per_cu); per_cu = 1; }
        if (per_cu > 1) per_cu = 1;
        grid = cus * per_cu;
        (void)hipGetLastError();
    }
    if (grid < 0) return;
    (void)hipMemsetAsync((char*)d_ws + WS_CTL, 0, 32768, stream);
    Params p{};
    p.x = (const float*)d_in[0]; p.mem = (const float*)d_in[1]; p.pos = (const int*)d_in[2];
    p.g_mix = (const float*)d_in[3]; p.w_in = (const float*)d_in[4]; p.g_q = (const float*)d_in[5]; p.w_uq = (const float*)d_in[6]; p.g_kv = (const float*)d_in[7]; p.w_ukv = (const float*)d_in[8];
    p.w_dw = (const float*)d_in[9]; p.b_dw = (const float*)d_in[10]; p.g_cln = (const float*)d_in[11]; p.b_cln = (const float*)d_in[12]; p.w_out = (const float*)d_in[13];
    p.g_xattn = (const float*)d_in[14]; p.g_mem = (const float*)d_in[15]; p.w_xq = (const float*)d_in[16]; p.w_xkv = (const float*)d_in[17]; p.w_xo = (const float*)d_in[18];
    p.g_ffn = (const float*)d_in[19]; p.w_router = (const float*)d_in[20]; p.b_router = (const float*)d_in[21]; p.w_up = (const float*)d_in[22]; p.b_up = (const float*)d_in[23];
    p.w_down = (const float*)d_in[24]; p.b_down = (const float*)d_in[25]; p.g_final = (const float*)d_in[26];
    p.out = (float*)d_out; p.ws = (unsigned char*)d_ws;
    void* args[] = {&p};
    hipError_t e = hipLaunchCooperativeKernel((const void*)mega_kernel, dim3(grid), dim3(512), args, LDS_BYTES, stream);
    if (e != hipSuccess) fprintf(stderr, "cooperative launch failed: %s (grid %d)\n", hipGetErrorString(e), grid);
}
```

```cpp
#include <hip/hip_runtime.h>
#include <stdint.h>
#include <stdio.h>
#include <hip/hip_cooperative_groups.h>
namespace cg = cooperative_groups;

#ifndef PROBE_MASK
#define PROBE_MASK 0
#endif
#ifndef PROBE_EPI
#define PROBE_EPI 0
#endif
#ifndef PROBE_XA
#define PROBE_XA 0
#endif
#ifndef PROBE_SUB
#define PROBE_SUB 0
#endif
#ifndef FP8_OUT
#define FP8_OUT 0
#endif
#ifndef FP8_XQ
#define FP8_XQ 1
#endif
#ifndef FP8_XO
#define FP8_XO 1
#endif
#ifndef FP8_MEM
#define FP8_MEM 1
#endif
#ifndef GROUP_BAR
#define GROUP_BAR 1
#endif
#if PROBE_SUB
#define SUB_T0(id) unsigned long long ts_##id = __builtin_amdgcn_s_memrealtime()
#define SUB_T1(id, acc) do { if (PROBE_SUB == id) { __syncthreads(); (acc) += __builtin_amdgcn_s_memrealtime() - ts_##id; } } while (0)
#else
#define SUB_T0(id)
#define SUB_T1(id, acc)
#endif
#define LAS __attribute__((address_space(3)))
typedef unsigned short bf16_t;
typedef short bf16x8 __attribute__((ext_vector_type(8)));
typedef short s16x4 __attribute__((ext_vector_type(4)));
typedef float f32x2 __attribute__((ext_vector_type(2)));
typedef float f32x4 __attribute__((ext_vector_type(4)));
typedef float f32x16 __attribute__((ext_vector_type(16)));
typedef unsigned u32x2 __attribute__((ext_vector_type(2)));
typedef unsigned u32x4 __attribute__((ext_vector_type(4)));

constexpr int BATCH = 16, SEQ = 2048, NTOK = BATCH * SEQ, DM = 1024;
constexpr int INC = 1440, INP = 1536, ULD = 512;
constexpr int HEADS = 8, QKD = 96, VD = 64;
constexpr int CCH = 512, CW = 31;
constexpr int MEML = 256, NMEM = BATCH * MEML;
constexpr int XH = 4, XD = 256;
constexpr int NE = 32, TOPK = 4;
constexpr int NSLOT = NTOK * TOPK + NE * 256;
constexpr int NTILE_MAX = NSLOT / 256;
constexpr float EPS = 1e-5f;
constexpr float C2_MLA = 0.14724444602590306f;
constexpr float C2_X = 0.09016844005556021f;
constexpr int RT_TOK = 128, RT_UNITS = NTOK / RT_TOK;

constexpr size_t MiB = 1u << 20;
constexpr size_t WS_CTL = 0;
constexpr size_t WS_RSTD_X = 1 * MiB;
constexpr size_t WS_RSTD_Q = WS_RSTD_X + 128 * 1024;
constexpr size_t WS_RSTD_KV = WS_RSTD_Q + 128 * 1024;
constexpr size_t WS_RSTD_X1 = WS_RSTD_KV + 128 * 1024;
constexpr size_t WS_RSTD_X2 = WS_RSTD_X1 + 128 * 1024;
constexpr size_t WS_RSTD_MEM = WS_RSTD_X2 + 128 * 1024;
constexpr size_t WS_ROPE = 2 * MiB;
constexpr size_t WS_TOPI = 6 * MiB;
constexpr size_t WS_TOPG = WS_TOPI + 512 * 1024;
constexpr size_t WS_INV = WS_TOPG + 512 * 1024;
constexpr size_t WS_SLOT_TOK = WS_INV + 512 * 1024;
constexpr size_t WS_SLOT_GATE = WS_SLOT_TOK + 1 * MiB;
constexpr size_t WS_SLOT_RS = 15 * MiB + 256 * 1024;
constexpr size_t WS_HIST = WS_SLOT_GATE + 1 * MiB;
constexpr size_t WS_TILE_E = WS_HIST + 64 * 1024;
constexpr size_t WS_SSQ_Q = 10 * MiB;
constexpr size_t WS_SSQ_KV = 10 * MiB + 512 * 1024;
constexpr size_t WS_SSQ_X1 = 11 * MiB;
constexpr size_t WS_SSQ_X2 = 13 * MiB;
constexpr size_t WS_WR = 15 * MiB;
constexpr size_t WS_WT_IN = 16 * MiB;
constexpr size_t WS_WT_UQ = 19 * MiB;
constexpr size_t WS_WT_UKV = WS_WT_UQ + 512 * 1024;
constexpr size_t WS_WT_OUT = 20 * MiB;
constexpr size_t WS_WT_XQ = 22 * MiB;
constexpr size_t WS_WT_XKV = 24 * MiB;
constexpr size_t WS_WT_XO = 28 * MiB;
constexpr size_t WS_WT_UP = 32 * MiB;
constexpr size_t WS_WT_DOWN = 160 * MiB;
constexpr size_t WS_X2B = 224 * MiB;
constexpr size_t WS_XB = WS_X2B;
constexpr size_t WS_ACT = 288 * MiB;
constexpr size_t WS_X2F = 432 * MiB;
constexpr size_t WS_U = 288 * MiB;
constexpr size_t WS_Z = 320 * MiB;
constexpr size_t WS_Q = 384 * MiB;
constexpr size_t WS_KB = 432 * MiB;
constexpr size_t WS_VB = 480 * MiB;
constexpr size_t WS_YCAT = 512 * MiB;
constexpr size_t WS_YB = 560 * MiB;
constexpr size_t WS_XG = WS_YB;
constexpr size_t WS_X1B = 576 * MiB;
constexpr size_t WS_XQ = 640 * MiB;
constexpr size_t WS_P = 704 * MiB;
constexpr size_t WS_X1F = 704 * MiB;
constexpr size_t WS_OX = 768 * MiB;
constexpr size_t WS_MEMB = 832 * MiB;
constexpr size_t WS_KM = 840 * MiB;
constexpr size_t WS_VMT = 848 * MiB;
constexpr size_t WS_END = 856 * MiB;

struct Params {
    const float* x; const float* mem; const int* pos;
    const float *g_mix, *w_in, *g_q, *w_uq, *g_kv, *w_ukv, *w_dw, *b_dw, *g_cln, *b_cln, *w_out, *g_xattn, *g_mem, *w_xq, *w_xkv, *w_xo, *g_ffn, *w_router, *b_router, *w_up, *b_up, *w_down, *b_down, *g_final;
    float* out; unsigned char* ws;
};

__device__ __forceinline__ float bf2f(bf16_t b) { return __uint_as_float((unsigned)b << 16); }
__device__ __forceinline__ unsigned f2bf(float f) { unsigned u = __float_as_uint(f); return (u + 0x7fffu + ((u >> 16) & 1u)) >> 16; }
typedef __bf16 bf16x2_t __attribute__((ext_vector_type(2)));
__device__ __forceinline__ unsigned pk2(float lo, float hi) { const f32x2 v = {lo, hi}; const bf16x2_t b = __builtin_convertvector(v, bf16x2_t); return __builtin_bit_cast(unsigned, b); }
__device__ __forceinline__ unsigned pk4_fp8(float a, float b, float c, float d) { int w = __builtin_amdgcn_cvt_pk_fp8_f32(a, b, 0, false); w = __builtin_amdgcn_cvt_pk_fp8_f32(c, d, w, true); return (unsigned)w; }
constexpr float W8_SCALE = 32.0f, W8_INV = 1.0f / 32.0f;
constexpr float A8_SCALE = 32.0f, A8_INV = 1.0f / 32.0f;
__device__ __forceinline__ float shflx(float v, int m, int lane) { return __int_as_float(__builtin_amdgcn_ds_bpermute((lane ^ m) << 2, __float_as_int(v))); }
__device__ __forceinline__ float shfli(float v, int src) { return __int_as_float(__builtin_amdgcn_ds_bpermute(src << 2, __float_as_int(v))); }
template <int CTRL> __device__ __forceinline__ float dpp_f(float v) { return __int_as_float(__builtin_amdgcn_update_dpp(0, __float_as_int(v), CTRL, 0xF, 0xF, false)); }
__device__ __forceinline__ float xsum16(float v) { const auto r = __builtin_amdgcn_permlane16_swap(__float_as_uint(v), __float_as_uint(v), false, false); return __uint_as_float(r[0]) + __uint_as_float(r[1]); }
__device__ __forceinline__ float xsum32(float v) { const auto r = __builtin_amdgcn_permlane32_swap(__float_as_uint(v), __float_as_uint(v), false, false); return __uint_as_float(r[0]) + __uint_as_float(r[1]); }
__device__ __forceinline__ float xmax16(float v) { const auto r = __builtin_amdgcn_permlane16_swap(__float_as_uint(v), __float_as_uint(v), false, false); return fmaxf(__uint_as_float(r[0]), __uint_as_float(r[1])); }
__device__ __forceinline__ float xmax32(float v) { const auto r = __builtin_amdgcn_permlane32_swap(__float_as_uint(v), __float_as_uint(v), false, false); return fmaxf(__uint_as_float(r[0]), __uint_as_float(r[1])); }
__device__ __forceinline__ float wave_sum(float v, int lane) { (void)lane;
    v += dpp_f<0x128>(v); v += dpp_f<0x124>(v); v += dpp_f<0x122>(v); v += dpp_f<0x121>(v);
    return xsum32(xsum16(v));
}
__device__ __forceinline__ int perm32(int rho) { const int n = rho >> 4, i = rho & 15; return 8 * (i >> 2) + 4 * n + (i & 3); }
__device__ __forceinline__ float fast_exp2(float x) { return __builtin_amdgcn_exp2f(x); }
__device__ __forceinline__ float sigmoidf_(float x) { return __builtin_amdgcn_rcpf(1.0f + __builtin_amdgcn_exp2f(x * -1.4426950408889634f)); }

struct TrDesc { const float* W; const float* g; bf16_t* WT; int N, K, mode, k0, n0, kperm; };
__device__ __forceinline__ void tr_load(const TrDesc& d, float (&v)[40], int lane) {
    const float* src = d.W + (size_t)(d.k0 + 8 * (lane >> 3)) * d.N + d.n0 + 4 * (lane & 7);
    if (d.kperm) { const int kp = d.k0 + 8 * (lane >> 3); src = d.W + (size_t)((kp & ~255) + 16 * ((kp >> 2) & 15) + 4 * ((kp >> 6) & 3)) * d.N + d.n0 + 4 * (lane & 7); }
#pragma unroll
    for (int i = 0; i < 8; ++i) { const f32x4 t = __builtin_nontemporal_load((const f32x4*)(src + (size_t)(d.kperm ? (i & 3) + 16 * (i >> 2) : i) * d.N)); v[4 * i] = t[0]; v[4 * i + 1] = t[1]; v[4 * i + 2] = t[2]; v[4 * i + 3] = t[3]; }
    f32x4 g0 = {1.f, 1.f, 1.f, 1.f}, g1 = {1.f, 1.f, 1.f, 1.f};
    if (d.g) { g0 = *(const f32x4*)(d.g + d.k0 + 8 * (lane >> 3)); g1 = *(const f32x4*)(d.g + d.k0 + 8 * (lane >> 3) + 4); }
    v[32] = g0[0]; v[33] = g0[1]; v[34] = g0[2]; v[35] = g0[3]; v[36] = g1[0]; v[37] = g1[1]; v[38] = g1[2]; v[39] = g1[3];
}
__device__ __forceinline__ void tr_store(const TrDesc& d, const float (&v)[40], int lane) {
    const int r8 = lane >> 3, c = lane & 7;
    float g[8];
#pragma unroll
    for (int i = 0; i < 8; ++i) g[i] = (d.mode >= 4) ? v[32 + i] * W8_SCALE : v[32 + i];
#pragma unroll
    for (int e = 0; e < 4; ++e) { const int nn = d.n0 + 4 * c + e; int row = nn;
        if (d.mode == 1 || d.mode == 4) row = (((nn & 1023) >> 7) << 8) + ((nn >> 10) << 7) + (nn & 127);
        if (d.mode == 2 && nn >= 416) { const int cc = (nn - 416) & 511, isg = (nn - 416) >> 9; row = 512 + ((cc >> 7) << 8) + (isg << 7) + (cc & 127); }
        float t[8];
#pragma unroll
        for (int i = 0; i < 8; ++i) t[i] = v[4 * i + e] * g[i];
        if (d.mode >= 4) { u32x2 o8; o8.x = pk4_fp8(t[0], t[1], t[2], t[3]); o8.y = pk4_fp8(t[4], t[5], t[6], t[7]);
            *(u32x2*)((unsigned char*)d.WT + (size_t)row * d.K + d.k0 + 8 * r8) = o8; }
        else { u32x4 o; o.x = pk2(t[0], t[1]); o.y = pk2(t[2], t[3]); o.z = pk2(t[4], t[5]); o.w = pk2(t[6], t[7]); *(u32x4*)(d.WT + (size_t)row * d.K + d.k0 + 8 * r8) = o; } }
}
template <bool F8> __device__ __forceinline__ void rows_bf16_rstd(const float* X, bf16_t* O, float* rstd, int nrows, int gw, int ngw, int lane) {
    if (gw >= nrows) return;
    const int last = gw + ((nrows - 1 - gw) / ngw) * ngw;
    f32x4 ra[4], rb[4], rc[4], rd[4];
#define RW_LD(v, m_) do { const int i_ = (m_); const f32x4* s_ = (const f32x4*)(X + (size_t)(i_ < nrows ? i_ : last) * 1024); _Pragma("unroll") for (int j = 0; j < 4; ++j) v[j] = __builtin_nontemporal_load(s_ + lane + 64 * j); } while (0)
#define RW_ST(v, m_) do { const int i_ = (m_); if (i_ < nrows) { float s = 0.f; \
        _Pragma("unroll") for (int j = 0; j < 4; ++j) s += (v[j].x * v[j].x + v[j].y * v[j].y) + (v[j].z * v[j].z + v[j].w * v[j].w); \
        s = wave_sum(s, lane); if (lane == 0) rstd[i_] = 1.0f / sqrtf(s * (1.0f / 1024.0f) + EPS); \
        _Pragma("unroll") for (int j = 0; j < 4; ++j) { if constexpr (F8) { ((unsigned*)((unsigned char*)O + (size_t)i_ * 1024))[lane + 64 * j] = pk4_fp8(v[j].x, v[j].y, v[j].z, v[j].w); } \
            else { u32x2 w; w.x = pk2(v[j].x, v[j].y); w.y = pk2(v[j].z, v[j].w); ((u32x2*)(O + (size_t)i_ * 1024))[lane + 64 * j] = w; } } } } while (0)
    RW_LD(ra, gw); RW_LD(rb, gw + ngw); RW_LD(rc, gw + 2 * ngw);
    for (int m = gw; m < nrows; m += 4 * ngw) {
        RW_LD(rd, m + 3 * ngw); RW_ST(ra, m);
        RW_LD(ra, m + 4 * ngw); RW_ST(rb, m + ngw);
        RW_LD(rb, m + 5 * ngw); RW_ST(rc, m + 2 * ngw);
        RW_LD(rc, m + 6 * ngw); RW_ST(rd, m + 3 * ngw);
    }
#undef RW_LD
#undef RW_ST
}
__device__ __forceinline__ void sincos_acc(double a, float& s, float& c) {
    const double TWO_PI = 6.283185307179586476925;
    const double n = rint(a * (1.0 / TWO_PI)); const double r = a - n * TWO_PI;
    const double h = 0.5 * r, h2 = h * h;
    const double sh = h * (1.0 + h2 * (-1.0 / 6.0 + h2 * (1.0 / 120.0 + h2 * (-1.0 / 5040.0 + h2 * (1.0 / 362880.0 + h2 * (-1.0 / 39916800.0 + h2 * (1.0 / 6227020800.0 + h2 * (-1.0 / 1307674368000.0 + h2 * (1.0 / 355687428096000.0)))))))));
    const double ch = 1.0 + h2 * (-0.5 + h2 * (1.0 / 24.0 + h2 * (-1.0 / 720.0 + h2 * (1.0 / 40320.0 + h2 * (-1.0 / 3628800.0 + h2 * (1.0 / 479001600.0 + h2 * (-1.0 / 87178291200.0 + h2 * (1.0 / 20922789888000.0 + h2 * (-1.0 / 6402373705728000.0)))))))));
    s = (float)(2.0 * sh * ch); c = (float)(ch * ch - sh * sh);
}
__device__ __forceinline__ double rope_inv(int i) {
    const double t[16] = {1.0, 0.5623413251903491, 0.31622776601683794, 0.1778279410038923, 0.1, 0.05623413251903491, 0.03162277660168379, 0.01778279410038923,
                          0.01, 0.005623413251903491, 0.0031622776601683794, 0.0017782794100389228, 0.001, 0.0005623413251903491, 0.00031622776601683794, 0.00017782794100389227};
    double r = t[0];
#pragma unroll
    for (int k = 1; k < 16; ++k) r = (i == k) ? t[k] : r;
    return r;
}

__device__ __forceinline__ void prep_stage(const Params& p, LAS unsigned char* lds, int vblk, int nblk, int tid, unsigned long long& tsub) {
    const int lane = tid & 63, wid = __builtin_amdgcn_readfirstlane(tid >> 6);
    const int gw = vblk * 8 + wid, ngw = nblk * 8;
    unsigned char* ws = p.ws;
    constexpr int I_IN = 16 * 45, I_UQ = 4 * 24, I_UKV = 2 * 32, I_SQ = 16 * 32, I_XKV = 16 * 64;
    constexpr int NITEMS = I_IN + I_UQ + I_UKV + 3 * I_SQ + I_XKV;
    auto get_desc = [&](int it) -> TrDesc {
        TrDesc d; int r = it; int item;
        d.kperm = 0;
        if (r < I_IN) { d.W = p.w_in; d.N = INC; d.K = 1024; d.g = p.g_mix; d.WT = (bf16_t*)(ws + WS_WT_IN); d.mode = 2; item = r; }
        else if ((r -= I_IN) < I_UQ) { d.W = p.w_uq; d.N = 768; d.K = 256; d.g = p.g_q; d.WT = (bf16_t*)(ws + WS_WT_UQ); d.mode = 0; item = r; }
        else if ((r -= I_UQ) < I_UKV) { d.W = p.w_ukv; d.N = 1024; d.K = 128; d.g = p.g_kv; d.WT = (bf16_t*)(ws + WS_WT_UKV); d.mode = 0; item = r; }
        else if ((r -= I_UKV) < I_SQ) { d.W = p.w_out; d.N = 1024; d.K = 1024; d.g = nullptr; d.WT = (bf16_t*)(ws + WS_WT_OUT); d.mode = FP8_OUT ? 5 : 0; item = r; }
        else if ((r -= I_SQ) < I_SQ) { d.W = p.w_xq; d.N = 1024; d.K = 1024; d.g = p.g_xattn; d.WT = (bf16_t*)(ws + WS_WT_XQ); d.mode = FP8_XQ ? 5 : 0; item = r; }
        else if ((r -= I_SQ) < I_SQ) { d.W = p.w_xo; d.N = 1024; d.K = 1024; d.g = nullptr; d.WT = (bf16_t*)(ws + WS_WT_XO); d.mode = FP8_XO ? 5 : 0; d.kperm = FP8_XO; item = r; }
        else { r -= I_SQ; d.W = p.w_xkv; d.N = 2048; d.K = 1024; d.g = p.g_mem; d.WT = (bf16_t*)(ws + WS_WT_XKV); d.mode = FP8_MEM ? 5 : 0; item = r; }
        const int nblk = d.N / 32; d.k0 = 64 * (item / nblk); d.n0 = 32 * (item % nblk); return d; };
    SUB_T0(1);
    if (gw < NITEMS) {
        const int last = gw + ((NITEMS - 1 - gw) / ngw) * ngw;
        float v0[40], v1[40], v2[40], v3[40];
#define TR_LD(v, it_) do { const int i_ = (it_); const TrDesc d_ = get_desc(i_ < NITEMS ? i_ : last); tr_load(d_, v, lane); } while (0)
#define TR_ST(v, it_) do { const int i_ = (it_); if (i_ < NITEMS) { const TrDesc d_ = get_desc(i_); tr_store(d_, v, lane); } } while (0)
        TR_LD(v0, gw); TR_LD(v1, gw + ngw); TR_LD(v2, gw + 2 * ngw);
        for (int it = gw; it < NITEMS; it += 4 * ngw) {
            TR_LD(v3, it + 3 * ngw); TR_ST(v0, it);
            TR_LD(v0, it + 4 * ngw); TR_ST(v1, it + ngw);
            TR_LD(v1, it + 5 * ngw); TR_ST(v2, it + 2 * ngw);
            TR_LD(v2, it + 6 * ngw); TR_ST(v3, it + 3 * ngw);
        }
    }
    SUB_T1(1, tsub);
    SUB_T0(2);
    rows_bf16_rstd<false>(p.x, (bf16_t*)(ws + WS_XB), (float*)(ws + WS_RSTD_X), NTOK, gw, ngw, lane);
    rows_bf16_rstd<FP8_MEM != 0>(p.mem, (bf16_t*)(ws + WS_MEMB), (float*)(ws + WS_RSTD_MEM), NMEM, gw, ngw, lane);
    SUB_T1(2, tsub);
    SUB_T0(3);
    const int gt = vblk * 512 + tid, ngt = nblk * 512;
    for (int i = gt; i < NTOK * 16; i += ngt) { const int row = i >> 4, f = i & 15; float s, c; sincos_acc((double)p.pos[row] * rope_inv(f), s, c);
        float* rt = (float*)(ws + WS_ROPE) + (size_t)row * 32; rt[f] = c; rt[16 + f] = s; }
    for (int i = gt; i < 1024 * 32; i += ngt) { const int k = i >> 5, e = i & 31; const float v = p.g_ffn[k] * p.w_router[i]; const unsigned hb = f2bf(v); const float lo = v - __uint_as_float(hb << 16);
        ((bf16_t*)(ws + WS_WR))[e * 1024 + k] = (bf16_t)hb; ((bf16_t*)(ws + WS_WR))[32768 + e * 1024 + k] = (bf16_t)f2bf(lo); }
    for (int i = gt; i < 96 * 1024 / 8; i += ngt) ((u32x4*)((bf16_t*)(ws + WS_WT_IN) + (size_t)416 * 1024))[i] = (u32x4){0u, 0u, 0u, 0u};
    SUB_T1(3, tsub);
}

__device__ __forceinline__ void moe_weights_stage(const Params& p, LAS unsigned char* lds, int ci, int nconv, int tid, int j0 = 0) {
    const int lane = tid & 63, wid = __builtin_amdgcn_readfirstlane(tid >> 6); const int ngw = nconv * 8, gw = ci * 8 + wid + j0 * ngw;
    unsigned char* ws = p.ws;
    constexpr int I_UP1 = 16 * 64, I_DN1 = 16 * 32, NITEMS = NE * (I_UP1 + I_DN1);
    auto get_desc = [&](int it) -> TrDesc {
        TrDesc d; int r = it; int item;
        if (r < NE * I_UP1) { const int e = r / I_UP1; d.W = p.w_up + (size_t)e * 1024 * 2048; d.N = 2048; d.K = 1024; d.g = p.g_ffn; d.WT = (bf16_t*)(ws + WS_WT_UP + (size_t)e * 2048 * 1024); d.mode = 4; item = r % I_UP1; }
        else { r -= NE * I_UP1; const int e = r / I_DN1; d.W = p.w_down + (size_t)e * 1024 * 1024; d.N = 1024; d.K = 1024; d.g = nullptr; d.WT = (bf16_t*)(ws + WS_WT_DOWN + (size_t)e * 1024 * 1024); d.mode = 5; item = r % I_DN1; }
        const int nblk = d.N / 32; d.k0 = 64 * (item / nblk); d.n0 = 32 * (item % nblk); d.kperm = 0; return d; };
    if (gw < NITEMS) {
        const int last = gw + ((NITEMS - 1 - gw) / ngw) * ngw;
        float v0[40], v1[40], v2[40], v3[40];
        TR_LD(v0, gw); TR_LD(v1, gw + ngw); TR_LD(v2, gw + 2 * ngw);
        for (int it = gw; it < NITEMS; it += 4 * ngw) {
            TR_LD(v3, it + 3 * ngw); TR_ST(v0, it);
            TR_LD(v0, it + 4 * ngw); TR_ST(v1, it + ngw);
            TR_LD(v1, it + 5 * ngw); TR_ST(v2, it + 2 * ngw);
            TR_LD(v2, it + 6 * ngw); TR_ST(v3, it + 3 * ngw);
        }
    }
}
#undef TR_LD
#undef TR_ST

struct Unit { int pm, pn, z; };
typedef f32x4 Acc[2][2][4][2];

template <bool PERM, class Prov, class Epi>
__device__ __forceinline__ void gemm_unit_naive(const Prov& P, const Epi& E, const Unit& u, LAS unsigned char* lds, int tid) {
    const int wid = tid >> 6, lane = tid & 63, wr = wid >> 2, wc = wid & 3, fr = lane & 15, fq = lane >> 4;
    const bf16_t* ap[2][4]; const bf16_t* bp[2][2];
#pragma unroll
    for (int ai = 0; ai < 2; ++ai)
#pragma unroll
        for (int m = 0; m < 4; ++m) ap[ai][m] = P.a_row(u, 128 * ai + 64 * wr + 16 * m + fr) + 8 * fq;
#pragma unroll
    for (int bj = 0; bj < 2; ++bj)
#pragma unroll
        for (int n = 0; n < 2; ++n) { const int rho = 16 * n + fr; bp[bj][n] = P.b_row(u, 128 * bj + 32 * wc + (PERM ? perm32(rho) : rho)) + 8 * fq; }
    Acc acc;
#pragma unroll
    for (int a = 0; a < 2; ++a)
#pragma unroll
        for (int b = 0; b < 2; ++b)
#pragma unroll
            for (int m = 0; m < 4; ++m)
#pragma unroll
                for (int n = 0; n < 2; ++n) acc[a][b][m][n] = (f32x4){0.f, 0.f, 0.f, 0.f};
    const int K = P.K;
#pragma unroll 1
    for (int k0 = 0; k0 < K; k0 += 32) {
        bf16x8 a[2][4], b[2][2];
#pragma unroll
        for (int ai = 0; ai < 2; ++ai)
#pragma unroll
            for (int m = 0; m < 4; ++m) a[ai][m] = *(const bf16x8*)(ap[ai][m] + k0);
#pragma unroll
        for (int bj = 0; bj < 2; ++bj)
#pragma unroll
            for (int n = 0; n < 2; ++n) b[bj][n] = *(const bf16x8*)(bp[bj][n] + k0);
#pragma unroll
        for (int ai = 0; ai < 2; ++ai)
#pragma unroll
            for (int bj = 0; bj < 2; ++bj)
#pragma unroll
                for (int m = 0; m < 4; ++m)
#pragma unroll
                    for (int n = 0; n < 2; ++n) acc[ai][bj][m][n] = __builtin_amdgcn_mfma_f32_16x16x32_bf16(b[bj][n], a[ai][m], acc[ai][bj][m][n], 0, 0, 0);
    }
    E(acc, u, wr, wc, fr, fq, lds, (const LAS float*)lds);
}

struct ProvPlain { const bf16_t* A; int lda; const bf16_t* Bt; int ldb; int K;
    __device__ __forceinline__ const bf16_t* a_row(const Unit& u, int r) const { return A + (size_t)(u.pm * 256 + r) * lda; }
    __device__ __forceinline__ const bf16_t* b_row(const Unit& u, int r) const { return Bt + (size_t)(u.pn * 256 + r) * ldb; } };
struct ProvXS { const bf16_t* XQ; const bf16_t* KM; int K;
    __device__ __forceinline__ const bf16_t* a_row(const Unit& u, int r) const { return XQ + (size_t)((u.z >> 2) * 2048 + u.pm * 256 + r) * 1024 + (u.z & 3) * 256; }
    __device__ __forceinline__ const bf16_t* b_row(const Unit& u, int r) const { return KM + (size_t)((u.z >> 2) * 256 + r) * 1024 + (u.z & 3) * 256; } };
struct ProvXPV { const bf16_t* Pm; const bf16_t* VMT; int K;
    __device__ __forceinline__ const bf16_t* a_row(const Unit& u, int r) const { return Pm + ((size_t)u.z * 2048 + u.pm * 256 + r) * 256; }
    __device__ __forceinline__ const bf16_t* b_row(const Unit& u, int r) const { return VMT + ((size_t)u.z * 256 + r) * 256; } };
struct ProvUp { const bf16_t* X2B; const int* slot_tok; const int* tile_e; const bf16_t* WT; int K;
    __device__ __forceinline__ const bf16_t* a_row(const Unit& u, int r) const { return X2B + (size_t)slot_tok[u.pm * 256 + r] * 1024; }
    __device__ __forceinline__ const bf16_t* b_row(const Unit& u, int r) const { return WT + ((size_t)tile_e[u.pm] * 2048 + u.pn * 256 + r) * 1024; } };
struct ProvDown { const bf16_t* ACT; const int* tile_e; const bf16_t* WT; int K;
    __device__ __forceinline__ const bf16_t* a_row(const Unit& u, int r) const { return ACT + (size_t)(u.pm * 256 + r) * 1024; }
    __device__ __forceinline__ const bf16_t* b_row(const Unit& u, int r) const { return WT + ((size_t)tile_e[u.pm] * 1024 + u.pn * 256 + r) * 1024; } };

__device__ __forceinline__ void tab_dma(const void* gbase, unsigned voff, LAS void* t64) {
    const unsigned la = (unsigned)__builtin_amdgcn_readfirstlane((int)(unsigned)(__UINTPTR_TYPE__)t64);
    const unsigned long long gb = (unsigned long long)gbase; const unsigned lo = (unsigned)__builtin_amdgcn_readfirstlane((int)(unsigned)gb), hi = (unsigned)__builtin_amdgcn_readfirstlane((int)(unsigned)(gb >> 32));
    const unsigned long long gbs = ((unsigned long long)hi << 32) | lo;
    asm volatile("s_mov_b32 m0, %0\n\ts_nop 0\n\tglobal_load_lds_dword %1, %2" :: "s"(la), "v"(voff), "s"(gbs) : "m0", "memory"); }
__device__ __forceinline__ void tab_dma16(const void* gbase, unsigned voff, LAS void* t64) {
    const unsigned la = (unsigned)__builtin_amdgcn_readfirstlane((int)(unsigned)(__UINTPTR_TYPE__)t64);
    const unsigned long long gb = (unsigned long long)gbase; const unsigned lo = (unsigned)__builtin_amdgcn_readfirstlane((int)(unsigned)gb), hi = (unsigned)__builtin_amdgcn_readfirstlane((int)(unsigned)(gb >> 32));
    const unsigned long long gbs = ((unsigned long long)hi << 32) | lo;
    asm volatile("s_mov_b32 m0, %0\n\ts_nop 0\n\tglobal_load_lds_dwordx4 %1, %2" :: "s"(la), "v"(voff), "s"(gbs) : "m0", "memory"); }
#define EPI_BAR() do { asm volatile("s_waitcnt lgkmcnt(0)" ::: "memory"); __builtin_amdgcn_s_barrier(); asm volatile("" ::: "memory"); } while (0)
#define EPI_ARGS Acc& acc, const Unit& u, int wr, int wc, int fr, int fq, LAS unsigned char* lds, const LAS float* tab
#define EPI_NOPF __device__ __forceinline__ void prefetch(const Unit&, LAS float*, int, LAS unsigned char*) const {}
#define FOR_AI_M _Pragma("unroll") for (int ai = 0; ai < 2; ++ai) _Pragma("unroll") for (int m = 0; m < 4; ++m)
#define FOR_BJ _Pragma("unroll") for (int bj = 0; bj < 2; ++bj)
struct EpiIn { bf16_t* U; bf16_t* Z; const float* rs; float* ssq_q; float* ssq_kv; const float* rope; bf16_t* KB;
    __device__ __forceinline__ void prefetch(const Unit& u, LAS float* t, int tid, LAS unsigned char*) const { tab_dma(rs + u.pm * 256, (unsigned)tid * 4u, t + 64 * __builtin_amdgcn_readfirstlane(tid >> 6)); }
    __device__ __forceinline__ void operator()(EPI_ARGS) const {
        if (u.pn >= 2) {
            FOR_AI_M { const int row = u.pm * 256 + 128 * ai + 64 * wr + 16 * m + fr; const float s = tab[128 * ai + 64 * wr + 16 * m + fr]; f32x4 o[2];
#pragma unroll
                for (int n = 0; n < 2; ++n) { const f32x4 av = acc[ai][0][m][n] * s, gv = acc[ai][1][m][n] * s; const f32x4 t = gv * (-1.4426950408889634f); f32x4 ex;
#pragma unroll
                    for (int j = 0; j < 4; ++j) ex[j] = __builtin_amdgcn_exp2f(t[j]);
                    ex = ex + 1.0f; f32x4 rc;
#pragma unroll
                    for (int j = 0; j < 4; ++j) rc[j] = __builtin_amdgcn_rcpf(ex[j]);
                    o[n] = av * rc; }
                u32x4 w; w.x = pk2(o[0][0], o[0][1]); w.y = pk2(o[0][2], o[0][3]); w.z = pk2(o[1][0], o[1][1]); w.w = pk2(o[1][2], o[1][3]);
                *(u32x4*)(Z + (size_t)row * 512 + (u.pn - 2) * 128 + 32 * wc + 8 * fq) = w; }
            return; }
        FOR_AI_M { const int row = u.pm * 256 + 128 * ai + 64 * wr + 16 * m + fr; const float s = tab[128 * ai + 64 * wr + 16 * m + fr]; bf16_t* rowp = U + (size_t)row * ULD + u.pn * 256 + 32 * wc + 8 * fq;
            float q0 = 0.f, q1 = 0.f;
            FOR_BJ { const f32x4 v0 = acc[ai][bj][m][0] * s, v1 = acc[ai][bj][m][1] * s; u32x4 w; w.x = pk2(v0[0], v0[1]); w.y = pk2(v0[2], v0[3]); w.z = pk2(v1[0], v1[1]); w.w = pk2(v1[2], v1[3]);
                *(u32x4*)(rowp + 128 * bj) = w;
                const float qq = (v0[0] * v0[0] + v0[1] * v0[1]) + (v0[2] * v0[2] + v0[3] * v0[3]) + (v1[0] * v1[0] + v1[1] * v1[1]) + (v1[2] * v1[2] + v1[3] * v1[3]);
                if (bj == 0) q0 = qq; else q1 = qq; }
            if (u.pn == 0) { float q = q0 + q1; q = xsum32(xsum16(q)); if (fq == 0) ssq_q[(size_t)row * 4 + wc] = q; }
            if (u.pn == 1) { float q = q0; q = xsum32(xsum16(q)); if (fq == 0) ssq_kv[(size_t)row * 4 + wc] = q;
                if (wc == 0) {
                    const int i0 = 8 * (fq & 1); const f32x4 c0 = *(const f32x4*)(rope + (size_t)row * 32 + i0), c1 = *(const f32x4*)(rope + (size_t)row * 32 + i0 + 4);
                    const f32x4 s0 = *(const f32x4*)(rope + (size_t)row * 32 + 16 + i0), s1 = *(const f32x4*)(rope + (size_t)row * 32 + 16 + i0 + 4);
                    const f32x4 v0 = acc[ai][1][m][0] * s, v1 = acc[ai][1][m][1] * s; f32x4 p0, p1;
#pragma unroll
                    for (int j = 0; j < 4; ++j) { p0[j] = shflx(v0[j], 32, fr + 16 * fq); p1[j] = shflx(v1[j], 32, fr + 16 * fq); }
                    f32x4 o0, o1;
                    if (fq < 2) { o0 = v0 * c0 - p0 * s0; o1 = v1 * c1 - p1 * s1; } else { o0 = p0 * s0 + v0 * c0; o1 = p1 * s1 + v1 * c1; }
                    u32x4 w; w.x = pk2(o0[0], o0[1]); w.y = pk2(o0[2], o0[3]); w.z = pk2(o1[0], o1[1]); w.w = pk2(o1[2], o1[3]);
                    bf16_t* kb = KB + (size_t)row * 768 + 64 + 8 * fq;
#pragma unroll
                    for (int h = 0; h < 8; ++h) *(u32x4*)(kb + h * 96) = w; } } } } };
struct EpiScale16 { bf16_t* O; int ldc; const float* ssq; float mul;
    __device__ __forceinline__ void prefetch(const Unit& u, LAS float* tb, int tid, LAS unsigned char* traw) const { const f32x4* sp = (const f32x4*)(ssq + (size_t)(u.pm * 256 + tid) * 16); const f32x4 t = (sp[0] + sp[1]) + (sp[2] + sp[3]);
        tb[tid] = mul / sqrtf(((t[0] + t[1]) + (t[2] + t[3])) * (1.0f / 1024.0f) + EPS); }
    __device__ __forceinline__ void operator()(EPI_ARGS) const {
        FOR_AI_M { const int row = u.pm * 256 + 128 * ai + 64 * wr + 16 * m + fr;
            const float s = tab[128 * ai + 64 * wr + 16 * m + fr]; bf16_t* rowp = O + (size_t)row * ldc + u.pn * 256 + 32 * wc + 8 * fq;
            FOR_BJ { const f32x4 v0 = acc[ai][bj][m][0] * s, v1 = acc[ai][bj][m][1] * s; u32x4 w; w.x = pk2(v0[0], v0[1]); w.y = pk2(v0[2], v0[3]); w.z = pk2(v1[0], v1[1]); w.w = pk2(v1[2], v1[3]);
                *(u32x4*)(rowp + 128 * bj) = w; } } } };
struct EpiQ { bf16_t* Q; const float* ssq; const float* rope;
    __device__ __forceinline__ void prefetch(const Unit& u, LAS float*, int tid, LAS unsigned char* traw) const { tab_dma16(ssq + (size_t)u.pm * 256 * 4, (unsigned)tid * 16u, traw + 1024 * __builtin_amdgcn_readfirstlane(tid >> 6)); }
    __device__ __forceinline__ void operator()(EPI_ARGS) const {
        const LAS unsigned char* raw = lds + 12288 + ((tab - (const LAS float*)(lds + 4096)) >> 9) * 4096;
        f32x4 csa[2][4], sna[2][4];
        FOR_AI_M { const int row = u.pm * 256 + 128 * ai + 64 * wr + 16 * m + fr; csa[ai][m] = *(const f32x4*)(rope + (size_t)row * 32 + 4 * fq); sna[ai][m] = *(const f32x4*)(rope + (size_t)row * 32 + 16 + 4 * fq); }
        FOR_AI_M { const int row = u.pm * 256 + 128 * ai + 64 * wr + 16 * m + fr; const f32x4 t = *(const LAS f32x4*)(raw + (128 * ai + 64 * wr + 16 * m + fr) * 16);
            const float s = C2_MLA * __builtin_amdgcn_rsqf(((t[0] + t[1]) + (t[2] + t[3])) * (1.0f / 256.0f) + EPS);
            const f32x4 cs = csa[ai][m], sn = sna[ai][m];
            FOR_BJ { const int colg = u.pn * 256 + 128 * bj + 32 * wc; f32x4 v0 = acc[ai][bj][m][0] * s, v1 = acc[ai][bj][m][1] * s;
                if (((colg >> 5) % 3) == 2) { const f32x4 r0 = v0 * cs - v1 * sn, r1 = v0 * sn + v1 * cs; v0 = r0; v1 = r1; }
                u32x2 w0, w1; w0.x = pk2(v0[0], v0[1]); w0.y = pk2(v0[2], v0[3]); w1.x = pk2(v1[0], v1[1]); w1.y = pk2(v1[2], v1[3]);
                const auto sx = __builtin_amdgcn_permlane16_swap(w0.x, w1.x, false, false), sy = __builtin_amdgcn_permlane16_swap(w0.y, w1.y, false, false);
                u32x4 w; w.x = sx[0]; w.y = sy[0]; w.z = sx[1]; w.w = sy[1];
                *(u32x4*)(Q + (size_t)row * 768 + colg + 4 * fq + ((fq & 1) ? 12 : 0)) = w; } } } };
struct EpiKV { bf16_t* KB; bf16_t* VB; const float* ssq;
    __device__ __forceinline__ void prefetch(const Unit& u, LAS float*, int tid, LAS unsigned char* traw) const { tab_dma16(ssq + (size_t)u.pm * 256 * 4, (unsigned)tid * 16u, traw + 1024 * __builtin_amdgcn_readfirstlane(tid >> 6)); }
    __device__ __forceinline__ void operator()(EPI_ARGS) const {
        const LAS unsigned char* raw = lds + 12288 + ((tab - (const LAS float*)(lds + 4096)) >> 9) * 4096;
        FOR_AI_M { const int row = u.pm * 256 + 128 * ai + 64 * wr + 16 * m + fr; const f32x4 t = *(const LAS f32x4*)(raw + (128 * ai + 64 * wr + 16 * m + fr) * 16);
            const float s = __builtin_amdgcn_rsqf(((t[0] + t[1]) + (t[2] + t[3])) * (1.0f / 128.0f) + EPS);
            FOR_BJ { const int h = 2 * u.pn + bj, cl = 32 * wc + 8 * fq; const f32x4 v0 = acc[ai][bj][m][0] * s, v1 = acc[ai][bj][m][1] * s;
                u32x4 w; w.x = pk2(v0[0], v0[1]); w.y = pk2(v0[2], v0[3]); w.z = pk2(v1[0], v1[1]); w.w = pk2(v1[2], v1[3]);
                if (wc < 2) *(u32x4*)(KB + (size_t)row * 768 + h * 96 + cl) = w; else *(u32x4*)(VB + (size_t)row * 512 + h * 64 + cl - 64) = w; } } } };
struct EpiResid { const bf16_t* base; bf16_t* ob; float* ssq; unsigned char* o8; float sc;
    EPI_NOPF
    __device__ __forceinline__ void operator()(EPI_ARGS) const {
        u32x4 bwa[2][4][2];
        FOR_AI_M { const int row = u.pm * 256 + 128 * ai + 64 * wr + 16 * m + fr;
            FOR_BJ { const size_t off = (size_t)row * 1024 + u.pn * 256 + 128 * bj + 32 * wc + 8 * fq; bwa[ai][m][bj] = *(const u32x4*)(base + off); } }
        FOR_AI_M { const int row = u.pm * 256 + 128 * ai + 64 * wr + 16 * m + fr; float q = 0.f; u32x2 w8[2];
            FOR_BJ { const size_t off = (size_t)row * 1024 + u.pn * 256 + 128 * bj + 32 * wc + 8 * fq;
                const u32x4 bw = bwa[ai][m][bj];
                f32x4 v0, v1; v0[0] = __uint_as_float(bw.x << 16); v0[1] = __uint_as_float(bw.x & 0xffff0000u); v0[2] = __uint_as_float(bw.y << 16); v0[3] = __uint_as_float(bw.y & 0xffff0000u);
                v1[0] = __uint_as_float(bw.z << 16); v1[1] = __uint_as_float(bw.z & 0xffff0000u); v1[2] = __uint_as_float(bw.w << 16); v1[3] = __uint_as_float(bw.w & 0xffff0000u);
                v0 = v0 + acc[ai][bj][m][0] * sc; v1 = v1 + acc[ai][bj][m][1] * sc;
                u32x4 w; w.x = pk2(v0[0], v0[1]); w.y = pk2(v0[2], v0[3]); w.z = pk2(v1[0], v1[1]); w.w = pk2(v1[2], v1[3]); *(u32x4*)(ob + off) = w;
                if (o8) { w8[bj].x = pk4_fp8(v0[0], v0[1], v0[2], v0[3]); w8[bj].y = pk4_fp8(v1[0], v1[1], v1[2], v1[3]); }
                q += (v0[0] * v0[0] + v0[1] * v0[1]) + (v0[2] * v0[2] + v0[3] * v0[3]) + (v1[0] * v1[0] + v1[1] * v1[1]) + (v1[2] * v1[2] + v1[3] * v1[3]); }
            if (o8) {
                const auto sx = __builtin_amdgcn_permlane16_swap(w8[0].x, w8[1].x, false, false), sy = __builtin_amdgcn_permlane16_swap(w8[0].y, w8[1].y, false, false);
                u32x4 w; w.x = sx[0]; w.y = sy[0]; w.z = sx[1]; w.w = sy[1];
                *(u32x4*)(o8 + (size_t)row * 1024 + u.pn * 256 + 32 * wc + ((fq & 1) ? 128 + 8 * (fq - 1) : 8 * fq)) = w; }
            if (ssq) { q = xsum32(xsum16(q)); if (fq == 0) ssq[(size_t)row * 16 + u.pn * 4 + wc] = q; } } } };
struct EpiKVMem { bf16_t* KM; bf16_t* VMT; const float* rs; float sc;
    __device__ __forceinline__ void prefetch(const Unit& u, LAS float* t, int tid, LAS unsigned char*) const { tab_dma(rs + u.pm * 256, (unsigned)tid * 4u, t + 64 * __builtin_amdgcn_readfirstlane(tid >> 6)); }
    __device__ __forceinline__ void operator()(EPI_ARGS) const {
        FOR_AI_M { const int row = u.pm * 256 + 128 * ai + 64 * wr + 16 * m + fr; const float s = tab[128 * ai + 64 * wr + 16 * m + fr] * sc;
            FOR_BJ {
#pragma unroll
                for (int n = 0; n < 2; ++n) { const int col = u.pn * 256 + 128 * bj + 32 * wc + 16 * n + 4 * fq; const f32x4 v = acc[ai][bj][m][n] * s;
                    u32x2 w; w.x = pk2(v[0], v[1]); w.y = pk2(v[2], v[3]); *(u32x2*)(KM + (size_t)row * 1024 + col) = w; } } } } };
struct EpiVT { bf16_t* VMT; const float* rs; float sc;
    __device__ __forceinline__ void prefetch(const Unit& u, LAS float* t, int tid, LAS unsigned char*) const { tab_dma(rs + (u.pm >> 2) * 256, (unsigned)tid * 4u, t + 64 * __builtin_amdgcn_readfirstlane(tid >> 6)); }
    __device__ __forceinline__ void operator()(EPI_ARGS) const {
        FOR_AI_M { const int r = 128 * ai + 64 * wr + 16 * m + fr; bf16_t* rowp = VMT + (size_t)u.pm * 65536 + (size_t)r * 256 + 32 * wc + 8 * fq;
            FOR_BJ { const f32x4 s0 = *(const LAS f32x4*)(tab + 128 * bj + 32 * wc + 8 * fq), s1 = *(const LAS f32x4*)(tab + 128 * bj + 32 * wc + 8 * fq + 4);
                const f32x4 v0 = acc[ai][bj][m][0] * (s0 * sc), v1 = acc[ai][bj][m][1] * (s1 * sc); u32x4 w; w.x = pk2(v0[0], v0[1]); w.y = pk2(v0[2], v0[3]); w.z = pk2(v1[0], v1[1]); w.w = pk2(v1[2], v1[3]);
                *(u32x4*)(rowp + 128 * bj) = w; } } } };
struct EpiSoftmaxP { bf16_t* Pm;
    EPI_NOPF
    __device__ __forceinline__ void operator()(EPI_ARGS) const {
        LAS float* red = (LAS float*)lds; float rmax[2][4];
        FOR_AI_M { float mx = -3.0e38f;
            FOR_BJ {
#pragma unroll
                for (int n = 0; n < 2; ++n)
#pragma unroll
                    for (int j = 0; j < 4; ++j) mx = fmaxf(mx, acc[ai][bj][m][n][j]); }
            mx = xmax32(xmax16(mx));
            if (fq == 0) red[(128 * ai + 64 * wr + 16 * m + fr) * 4 + wc] = mx; }
        EPI_BAR();
        FOR_AI_M { const f32x4 t = *(const LAS f32x4*)(red + (128 * ai + 64 * wr + 16 * m + fr) * 4); rmax[ai][m] = fmaxf(fmaxf(t[0], t[1]), fmaxf(t[2], t[3])); }
        EPI_BAR();
        FOR_AI_M { float s = 0.f;
            FOR_BJ {
#pragma unroll
                for (int n = 0; n < 2; ++n)
#pragma unroll
                    for (int j = 0; j < 4; ++j) { const float e = fast_exp2(acc[ai][bj][m][n][j] - rmax[ai][m]); acc[ai][bj][m][n][j] = e; s += e; } }
            s = xsum32(xsum16(s));
            if (fq == 0) red[(128 * ai + 64 * wr + 16 * m + fr) * 4 + wc] = s; }
        EPI_BAR();
        FOR_AI_M { const int r = 128 * ai + 64 * wr + 16 * m + fr; const f32x4 t = *(const LAS f32x4*)(red + r * 4); const float inv = 1.0f / ((t[0] + t[1]) + (t[2] + t[3]));
            bf16_t* rowp = Pm + ((size_t)u.z * 2048 + u.pm * 256 + r) * 256 + 32 * wc + 8 * fq;
            FOR_BJ { const f32x4 v0 = acc[ai][bj][m][0] * inv, v1 = acc[ai][bj][m][1] * inv; u32x4 w; w.x = pk2(v0[0], v0[1]); w.y = pk2(v0[2], v0[3]); w.z = pk2(v1[0], v1[1]); w.w = pk2(v1[2], v1[3]);
                *(u32x4*)(rowp + 128 * bj) = w; } }
        EPI_BAR();
    } };
struct EpiOX { bf16_t* OX;
    EPI_NOPF
    __device__ __forceinline__ void operator()(EPI_ARGS) const {
        FOR_AI_M { const int r = 128 * ai + 64 * wr + 16 * m + fr; bf16_t* rowp = OX + (size_t)((u.z >> 2) * 2048 + u.pm * 256 + r) * 1024 + (u.z & 3) * 256 + 32 * wc + 8 * fq;
            FOR_BJ { const f32x4 v0 = acc[ai][bj][m][0], v1 = acc[ai][bj][m][1]; u32x4 w; w.x = pk2(v0[0], v0[1]); w.y = pk2(v0[2], v0[3]); w.z = pk2(v1[0], v1[1]); w.w = pk2(v1[2], v1[3]);
                *(u32x4*)(rowp + 128 * bj) = w; } } } };
struct EpiSwiglu { bf16_t* ACT; const float* slot_rs; const LAS int* tile_e; const float* b_up;
    __device__ __forceinline__ void prefetch(const Unit& u, LAS float* t, int tid, LAS unsigned char*) const { const int e = __builtin_amdgcn_readfirstlane(tile_e[u.pm]); const int w = __builtin_amdgcn_readfirstlane(tid >> 6);
        tab_dma(slot_rs + u.pm * 256, (unsigned)tid * 4u, t + 64 * w);
        tab_dma(b_up + (size_t)e * 2048 + u.pn * 128, (unsigned)(((tid >> 7) << 10) + (tid & 127)) * 4u, t + 256 + 64 * w); }
    __device__ __forceinline__ void operator()(EPI_ARGS) const {
        const int cl = 32 * wc + 8 * fq;
        f32x4 bgv[2], blv[2]; bgv[0] = *(const LAS f32x4*)(tab + 256 + cl); bgv[1] = *(const LAS f32x4*)(tab + 256 + cl + 4); blv[0] = *(const LAS f32x4*)(tab + 384 + cl) + 1.0f; blv[1] = *(const LAS f32x4*)(tab + 384 + cl + 4) + 1.0f;
        FOR_AI_M { const int rl = 128 * ai + 64 * wr + 16 * m + fr; const int slot = u.pm * 256 + rl; const float s = tab[rl] * W8_INV;
            f32x4 o[2];
#pragma unroll
            for (int n = 0; n < 2; ++n) { f32x4 g = acc[ai][0][m][n] * s + bgv[n], l = acc[ai][1][m][n] * s + blv[n];
                g = __builtin_elementwise_min(g, (f32x4){7.f, 7.f, 7.f, 7.f}); l = __builtin_elementwise_min(__builtin_elementwise_max(l, (f32x4){-6.f, -6.f, -6.f, -6.f}), (f32x4){8.f, 8.f, 8.f, 8.f});
                const f32x4 t = g * (-1.702f * 1.4426950408889634f); f32x4 ex;
#pragma unroll
                for (int j = 0; j < 4; ++j) ex[j] = __builtin_amdgcn_exp2f(t[j]);
                ex = ex + 1.0f; f32x4 rc;
#pragma unroll
                for (int j = 0; j < 4; ++j) rc[j] = __builtin_amdgcn_rcpf(ex[j]);
                o[n] = (g * rc) * l; }
            u32x2 w; w.x = pk4_fp8(o[0][0], o[0][1], o[0][2], o[0][3]); w.y = pk4_fp8(o[1][0], o[1][1], o[1][2], o[1][3]);
            *(u32x2*)((unsigned char*)ACT + (size_t)slot * 1024 + u.pn * 128 + cl) = w; } } };
constexpr float Y8_SCALE = 32.0f, Y8_INV = 1.0f / 32.0f;
struct EpiDown { unsigned char* YB; const float* gate; const LAS int* tile_e; const float* b_down;
    __device__ __forceinline__ void prefetch(const Unit& u, LAS float* t, int tid, LAS unsigned char*) const { const int e = __builtin_amdgcn_readfirstlane(tile_e[u.pm]); const int w = __builtin_amdgcn_readfirstlane(tid >> 6);
        tab_dma(gate + u.pm * 256, (unsigned)tid * 4u, t + 64 * w);
        tab_dma(b_down + (size_t)e * 1024 + u.pn * 256, (unsigned)tid * 4u, t + 256 + 64 * w); }
    __device__ __forceinline__ void operator()(EPI_ARGS) const {
        const int c0 = 64 * wc + 16 * fq;
        FOR_AI_M { const int rl = 128 * ai + 64 * wr + 16 * m + fr; const int slot = u.pm * 256 + rl; const float g = tab[rl] * Y8_SCALE; const float g8 = g * W8_INV;
            u32x4 w;
            FOR_BJ { const f32x4 b0 = *(const LAS f32x4*)(tab + 256 + c0 + 8 * bj), b1 = *(const LAS f32x4*)(tab + 256 + c0 + 8 * bj + 4);
                const f32x4 v0 = acc[ai][bj][m][0] * g8 + b0 * g, v1 = acc[ai][bj][m][1] * g8 + b1 * g;
                const unsigned lo = pk4_fp8(v0[0], v0[1], v0[2], v0[3]), hi = pk4_fp8(v1[0], v1[1], v1[2], v1[3]);
                if (bj == 0) { w.x = lo; w.y = hi; } else { w.z = lo; w.w = hi; } }
            *(u32x4*)(YB + (size_t)slot * 1024 + u.pn * 256 + c0) = w; } } };

namespace pg8 {
typedef int v4i_t __attribute__((ext_vector_type(4)));
typedef int v8i_t __attribute__((ext_vector_type(8)));
constexpr int BK = 64, HALF = 128, HTB = HALF * BK * 2, STAGE_BYTES = 8 * HTB;
__device__ __forceinline__ int lds_byte(int r, int c) { const int st = (r >> 4) * 2 + (c >> 5), rr = r & 15, cc = c & 31, ob = rr * 64 + cc * 2; return st * 1024 + (ob ^ (((ob >> 9) & 1) << 5)); }
__device__ __forceinline__ void stage_rc(int b, int& R, int& C) { const int st = b / 1024, sb = b % 1024, swz = sb ^ (((sb >> 9) & 1) << 5); R = (st >> 1) * 16 + swz / 64; C = (st & 1) * 32 + (swz % 64) / 2; }

template <int PERM, bool GATHER, bool FP8, class Prov, class Sched, class Epi>
__device__ __forceinline__ void gemm_phase(LAS unsigned char* lds, LAS unsigned char* lds_epi, const Prov& P, const Sched& S, const Epi& E, int tid, unsigned long long* tepi = nullptr) {
    const int wid = __builtin_amdgcn_readfirstlane(tid >> 6), lane = tid & 63, wr = wid >> 2, wc = wid & 3, fr = lane & 15, fq = lane >> 4;
    const int K = P.K, nt = K / BK;
    unsigned voffA[2], voffB[2], voffG[2][2]; int Rg[2]; unsigned Cg[2];
#pragma unroll
    for (int i = 0; i < 2; ++i) { int R, C; stage_rc(tid * 16 + i * 8192, R, C); const int Rb = PERM == 2 ? (64 * ((R >> 5) & 3) + 16 * ((R & 15) >> 2) + 8 * (R >> 7) + 4 * ((R >> 4) & 1) + (R & 3)) : PERM == 1 ? ((R & ~31) + perm32(R & 31)) : R;
        voffA[i] = (unsigned)(R * P.lda + C) * 2u; voffB[i] = (unsigned)(Rb * P.ldb + C) * 2u; Rg[i] = R; Cg[i] = (unsigned)C * 2u; }
    LAS int* rtab = (LAS int*)(lds_epi + 8192);
    const unsigned kstep = (unsigned)(BK * 2);
    const unsigned hstepA = GATHER ? 0u : (unsigned)(HALF * P.lda * 2), hstepB = (unsigned)((PERM == 2 ? 8 : HALF) * P.ldb * 2);
    const __amdgpu_buffer_rsrc_t rsA = __builtin_amdgcn_make_buffer_rsrc((void*)P.a_root(), 0, -1, 0x00020000), rsB = __builtin_amdgcn_make_buffer_rsrc((void*)P.b_root(), 0, -1, 0x00020000);
#define PG8_AOFF(u_) ((unsigned)((const char*)P.a_base(u_) - (const char*)P.a_root()))
#define PG8_BOFF(u_) ((unsigned)((const char*)P.b_base(u_) - (const char*)P.b_root()))
    const unsigned ldsw = (unsigned)wid * 1024u;
    const int aoff = lds_byte(wr * 64 + fr, fq * 8), boff = lds_byte(wc * 32 + fr, fq * 8);
#define PG8_SA(b, h) (((b) * 2 + (h)) * HTB)
#define PG8_SB(b, h) ((4 + (b) * 2 + (h)) * HTB)
#define PG8_STAGE(bufoff, rs, soff, voff) do { _Pragma("unroll") for (int _i = 0; _i < 2; ++_i) \
        __builtin_amdgcn_raw_ptr_buffer_load_lds(rs, (LAS void*)(lds + (bufoff) + ldsw + _i * 8192), 16, (int)(voff)[_i], (int)(soff), 0, 0); } while (0)
#define PG8_STAGE_A(bufoff, soff, h) do { if constexpr (GATHER) { PG8_STAGE(bufoff, rsA, soff, voffG[h]); } else { PG8_STAGE(bufoff, rsA, (soff) + (h) * hstepA, voffA); } } while (0)
#define PG8_STAGE_B(bufoff, soff) PG8_STAGE(bufoff, rsB, soff, voffB)
#define PG8_LDA(dst, b, h) do { _Pragma("unroll") for (int m = 0; m < 4; ++m) { const v4i_t l0_ = *(const LAS v4i_t*)(lds + PG8_SA(b, h) + aoff + m * 2048), l1_ = *(const LAS v4i_t*)(lds + PG8_SA(b, h) + aoff + m * 2048 + 1024); dst[m] = __builtin_shufflevector(l0_, l1_, 0, 1, 2, 3, 4, 5, 6, 7); } } while (0)
#define PG8_LDB(dst, b, h) do { _Pragma("unroll") for (int n = 0; n < 2; ++n) { const v4i_t l0_ = *(const LAS v4i_t*)(lds + PG8_SB(b, h) + boff + n * 2048), l1_ = *(const LAS v4i_t*)(lds + PG8_SB(b, h) + boff + n * 2048 + 1024); dst[n] = __builtin_shufflevector(l0_, l1_, 0, 1, 2, 3, 4, 5, 6, 7); } } while (0)
#define PG8_MMA(ai, bj, At, Bt) do { __builtin_amdgcn_s_setprio(1); _Pragma("unroll") for (int m = 0; m < 4; ++m) _Pragma("unroll") for (int n = 0; n < 2; ++n) { if constexpr (FP8) { \
            acc[ai][bj][m][n] = __builtin_amdgcn_mfma_scale_f32_16x16x128_f8f6f4(Bt[n], At[m], acc[ai][bj][m][n], 0, 0, 0, 0x7f7f7f7f, 0, 0x7f7f7f7f); } \
        else { acc[ai][bj][m][n] = __builtin_amdgcn_mfma_f32_16x16x32_bf16(__builtin_bit_cast(bf16x8, __builtin_shufflevector(Bt[n], Bt[n], 0, 1, 2, 3)), __builtin_bit_cast(bf16x8, __builtin_shufflevector(At[m], At[m], 0, 1, 2, 3)), acc[ai][bj][m][n], 0, 0, 0); \
               acc[ai][bj][m][n] = __builtin_amdgcn_mfma_f32_16x16x32_bf16(__builtin_bit_cast(bf16x8, __builtin_shufflevector(Bt[n], Bt[n], 4, 5, 6, 7)), __builtin_bit_cast(bf16x8, __builtin_shufflevector(At[m], At[m], 4, 5, 6, 7)), acc[ai][bj][m][n], 0, 0, 0); } } \
        __builtin_amdgcn_s_setprio(0); } while (0)
#define PG8_WAIT_V(n) asm volatile("s_waitcnt vmcnt(" #n ")" ::: "memory")
#define PG8_WAIT_L(n) asm volatile("s_waitcnt lgkmcnt(" #n ")" ::: "memory")
#define PG8_BAR __builtin_amdgcn_s_barrier()
#define PG8_SCHED __builtin_amdgcn_sched_barrier(0)
    Unit cur, nxt; int ui = 0;
    if (!S.next(0, cur)) return;
    Acc acc;
#pragma unroll
    for (int a = 0; a < 2; ++a)
#pragma unroll
        for (int b = 0; b < 2; ++b)
#pragma unroll
            for (int m = 0; m < 4; ++m)
#pragma unroll
                for (int n = 0; n < 2; ++n) acc[a][b][m][n] = (f32x4){0.f, 0.f, 0.f, 0.f};
    v8i_t At[4], B0[2], B1[2];
    unsigned cA = PG8_AOFF(cur), cB = PG8_BOFF(cur);
    if constexpr (GATHER) {
#pragma unroll
        for (int h = 0; h < 2; ++h)
#pragma unroll
            for (int i = 0; i < 2; ++i) voffG[h][i] = (unsigned)P.row_tok(cur, h * HALF + Rg[i]) * (unsigned)(P.lda * 2) + Cg[i];
    }
    PG8_STAGE_B(PG8_SB(0, 0), cB); PG8_STAGE_B(PG8_SB(0, 1), cB + hstepB); PG8_STAGE_A(PG8_SA(0, 0), cA, 0); PG8_STAGE_A(PG8_SA(0, 1), cA, 1);
    if (wr == 1) PG8_BAR;
    PG8_WAIT_V(2); PG8_BAR;
    PG8_STAGE_B(PG8_SB(1, 0), cB + kstep); PG8_STAGE_A(PG8_SA(1, 0), cA + kstep, 0); PG8_STAGE_B(PG8_SB(1, 1), cB + hstepB + kstep);
    PG8_WAIT_V(6); PG8_BAR;
    for (;;) {
        const bool has_next = S.next(ui + 1, nxt);
        const unsigned nA = has_next ? PG8_AOFF(nxt) : cA, nB = has_next ? PG8_BOFF(nxt) : cB;
        if constexpr (GATHER) { if (has_next && wr == 0) { int tg_; asm volatile("v_mbcnt_lo_u32_b32 %0, -1, 0\n\tv_mbcnt_hi_u32_b32 %0, -1, %0" : "=v"(tg_)); tg_ += wid << 6; P.rows_dma(nxt, rtab, tg_); } }
        if (wr == 0) { int tp_; asm volatile("v_mbcnt_lo_u32_b32 %0, -1, 0\n\tv_mbcnt_hi_u32_b32 %0, -1, %0" : "=v"(tp_)); tp_ += wid << 6; E.prefetch(cur, (LAS float*)(lds_epi + 4096) + (ui & 1) * 512, tp_, lds_epi + 12288 + (ui & 1) * 4096); }
        for (int t = 0; t < nt; t += 2) {
            const bool last = (t == nt - 2);
            const unsigned a1 = cA + (unsigned)(t + 1) * kstep;
            const unsigned a2 = last ? nA : cA + (unsigned)(t + 2) * kstep, b2 = last ? nB : cB + (unsigned)(t + 2) * kstep;
            const unsigned a3 = a2 + kstep, b3 = b2 + kstep;
            PG8_LDB(B0, 0, 0); PG8_LDB(B1, 0, 1); PG8_SCHED; PG8_LDA(At, 0, 0); PG8_STAGE_A(PG8_SA(1, 1), a1, 1);
            if constexpr (GATHER) { if (last && has_next) {
#pragma unroll
                for (int h = 0; h < 2; ++h)
#pragma unroll
                    for (int i = 0; i < 2; ++i) voffG[h][i] = (unsigned)rtab[h * HALF + Rg[i]] * (unsigned)(P.lda * 2) + Cg[i]; } }
            PG8_WAIT_V(8); PG8_WAIT_L(0); PG8_BAR; PG8_MMA(0, 0, At, B0); PG8_MMA(0, 1, At, B1); PG8_BAR; PG8_SCHED;
            PG8_LDA(At, 0, 1); PG8_STAGE_B(PG8_SB(0, 0), b2); PG8_STAGE_B(PG8_SB(0, 1), b2 + hstepB); PG8_STAGE_A(PG8_SA(0, 0), a2, 0);
            PG8_WAIT_V(8); PG8_WAIT_L(0); PG8_BAR; PG8_MMA(1, 0, At, B0); PG8_MMA(1, 1, At, B1); PG8_BAR; PG8_SCHED;
            PG8_LDB(B0, 1, 0); PG8_LDB(B1, 1, 1); PG8_SCHED; PG8_LDA(At, 1, 0); PG8_STAGE_A(PG8_SA(0, 1), a2, 1);
            PG8_WAIT_V(8); PG8_WAIT_L(0); PG8_BAR; PG8_MMA(0, 0, At, B0); PG8_MMA(0, 1, At, B1); PG8_BAR; PG8_SCHED;
            PG8_LDA(At, 1, 1); PG8_STAGE_B(PG8_SB(1, 0), b3); PG8_STAGE_B(PG8_SB(1, 1), b3 + hstepB); PG8_STAGE_A(PG8_SA(1, 0), a3, 0);
            PG8_WAIT_V(8); PG8_WAIT_L(0); PG8_BAR; PG8_MMA(1, 0, At, B0); PG8_MMA(1, 1, At, B1); PG8_BAR; PG8_SCHED;
        }
#if PROBE_EPI
        const unsigned long long te0_ = __builtin_amdgcn_s_memrealtime();
#endif
        if (wr == 0) PG8_BAR;
        { int le_; asm volatile("v_mbcnt_lo_u32_b32 %0, -1, 0\n\tv_mbcnt_hi_u32_b32 %0, -1, %0" : "=v"(le_)); const int fr_ = le_ & 15, fq_ = le_ >> 4;
          E(acc, cur, wr, wc, fr_, fq_, lds_epi, (const LAS float*)(lds_epi + 4096) + (ui & 1) * 512); }
#if PROBE_EPI
        if (tepi) { asm volatile("s_waitcnt vmcnt(8)" ::: "memory"); *tepi += __builtin_amdgcn_s_memrealtime() - te0_; }
#endif
        if (!has_next) break;
#pragma unroll
        for (int a = 0; a < 2; ++a)
#pragma unroll
            for (int b = 0; b < 2; ++b)
#pragma unroll
                for (int m = 0; m < 4; ++m)
#pragma unroll
                    for (int n = 0; n < 2; ++n) acc[a][b][m][n] = (f32x4){0.f, 0.f, 0.f, 0.f};
        cur = nxt; cA = nA; cB = nB; ++ui;
        if (wr == 1) PG8_BAR;
    }
    PG8_WAIT_V(0);
    PG8_BAR;
#undef PG8_SA
#undef PG8_SB
#undef PG8_STAGE
#undef PG8_STAGE_A
#undef PG8_STAGE_B
#undef PG8_AOFF
#undef PG8_BOFF
#undef PG8_LDA
#undef PG8_LDB
#undef PG8_MMA
#undef PG8_WAIT_V
#undef PG8_WAIT_L
#undef PG8_BAR
#undef PG8_SCHED
}
struct Order { int nM, nN, nwg, G, c, wgm;
    __device__ __forceinline__ void init(int nM_, int nN_, int G_, int c_, int wgm_ = 8) { nM = nM_; nN = nN_; nwg = nM * nN; G = G_; c = c_; wgm = wgm_; }
    __device__ __forceinline__ bool next(int i, int& pm, int& pn) const {
        const long L = (long)i * G + c; if (L >= nwg) return false;
        int wgid = (int)L; { const int q = nwg / 8, r = nwg % 8, xcd = wgid % 8, off = wgid / 8; wgid = (xcd < r ? xcd * (q + 1) : r * (q + 1) + (xcd - r) * q) + off; }
        const int nig = wgm * nN, gid = wgid / nig, fm = gid * wgm, gsz = (nM - fm) < wgm ? (nM - fm) : wgm;
        pm = fm + ((wgid % nig) % gsz); pn = (wgid % nig) / gsz; return true; } };
struct SchedPair { int pm0, pn; __device__ __forceinline__ bool next(int i, Unit& u) const { if (i >= 2) return false; u.pm = pm0 + i; u.pn = pn; u.z = 0; return true; } };
struct SchedPlain { Order o; __device__ __forceinline__ bool next(int i, Unit& u) const { u.z = 0; return o.next(i, u.pm, u.pn); } };
struct SchedBatch8 { Order o; __device__ __forceinline__ bool next(int i, Unit& u) const { int pm, pn; if (!o.next(i, pm, pn)) return false; u.z = pm >> 3; u.pm = pm & 7; u.pn = 0; return true; } };
}

struct PvUpG { const bf16_t* X; const bf16_t* WT; const LAS int* tile_e; const int* slot_tok; int lda, ldb, K;
    __device__ __forceinline__ const bf16_t* a_root() const { return X; }
    __device__ __forceinline__ const bf16_t* b_root() const { return WT; }
    __device__ __forceinline__ const bf16_t* a_base(const Unit&) const { return X; }
    __device__ __forceinline__ const bf16_t* b_base(const Unit& u) const { return WT + ((size_t)__builtin_amdgcn_readfirstlane(tile_e[u.pm]) * 2048 + u.pn * 256) * ldb; }
    __device__ __forceinline__ int row_tok(const Unit& u, int r) const { return slot_tok[u.pm * 256 + r]; }
    __device__ __forceinline__ void rows_dma(const Unit& u, LAS int* rt, int tid) const { tab_dma(slot_tok + u.pm * 256, (unsigned)tid * 4u, rt + 64 * __builtin_amdgcn_readfirstlane(tid >> 6)); } };
struct PvPlain { const bf16_t* A; const bf16_t* Bt; int lda, ldb, K;
    __device__ __forceinline__ const bf16_t* a_root() const { return A; }
    __device__ __forceinline__ const bf16_t* b_root() const { return Bt; }
    __device__ __forceinline__ const bf16_t* a_base(const Unit& u) const { return A + (size_t)u.pm * 256 * lda; }
    __device__ __forceinline__ const bf16_t* b_base(const Unit& u) const { return Bt + (size_t)u.pn * 256 * ldb; } };
struct PvVT { const bf16_t* W; const bf16_t* M; int lda, ldb, K;
    __device__ __forceinline__ const bf16_t* a_root() const { return W; }
    __device__ __forceinline__ const bf16_t* b_root() const { return M; }
    __device__ __forceinline__ const bf16_t* a_base(const Unit& u) const { return W + (size_t)(1024 + (u.pm & 3) * 256) * lda; }
    __device__ __forceinline__ const bf16_t* b_base(const Unit& u) const { return M + (size_t)(u.pm >> 2) * 256 * ldb; } };
struct PvXS { const bf16_t* XQ; const bf16_t* KM; int lda, ldb, K;
    __device__ __forceinline__ const bf16_t* a_base(const Unit& u) const { return XQ + (size_t)((u.z >> 2) * 2048 + u.pm * 256) * 1024 + (u.z & 3) * 256; }
    __device__ __forceinline__ const bf16_t* b_base(const Unit& u) const { return KM + (size_t)((u.z >> 2) * 256) * 1024 + (u.z & 3) * 256; } };
struct PvXPV { const bf16_t* Pm; const bf16_t* VMT; int lda, ldb, K;
    __device__ __forceinline__ const bf16_t* a_base(const Unit& u) const { return Pm + ((size_t)u.z * 2048 + u.pm * 256) * 256; }
    __device__ __forceinline__ const bf16_t* b_base(const Unit& u) const { return VMT + (size_t)u.z * 65536; } };
struct PvExp { const bf16_t* A; const bf16_t* WT; const LAS int* tile_e; int lda, ldb, K, nrow;
    __device__ __forceinline__ const bf16_t* a_root() const { return A; }
    __device__ __forceinline__ const bf16_t* b_root() const { return WT; }
    __device__ __forceinline__ const bf16_t* a_base(const Unit& u) const { return A + (size_t)u.pm * 256 * lda; }
    __device__ __forceinline__ const bf16_t* b_base(const Unit& u) const { return WT + ((size_t)__builtin_amdgcn_readfirstlane(tile_e[u.pm]) * nrow + u.pn * 256) * ldb; } };

#ifndef CV_PACE_N
#define CV_PACE_N 3
#endif
#ifndef CV_PACE_D
#define CV_PACE_D 4
#endif
constexpr int CV_NITEMS = NE * (16 * 64 + 16 * 32), CV_NGW = 2048, CV_PER_WAVE = CV_NITEMS / CV_NGW, CV_LDS = 82432, CV_SLOT = 8448;
struct CvItem { unsigned long long src, dst, g; unsigned pitch, n0, up; };
__device__ __forceinline__ CvItem cv_item(const Params& p, unsigned it) {
    CvItem d;
    if (it < 32768u) { const unsigned e = it >> 10, item = it & 1023u, kb = item >> 6, nb = item & 63u;
        d.src = (unsigned long long)p.w_up + ((unsigned long long)e << 23) + (unsigned long long)(kb * 64u * 8192u + nb * 128u); d.pitch = 8192u;
        d.dst = (unsigned long long)(p.ws + WS_WT_UP) + ((unsigned long long)e << 21) + kb * 64u; d.n0 = nb * 32u; d.up = 1u; d.g = (unsigned long long)(p.g_ffn + kb * 64u); }
    else { const unsigned r = it - 32768u, e = r >> 9, item = r & 511u, kb = item >> 5, nb = item & 31u;
        d.src = (unsigned long long)p.w_down + ((unsigned long long)e << 22) + (unsigned long long)(kb * 64u * 4096u + nb * 128u); d.pitch = 4096u;
        d.dst = (unsigned long long)(p.ws + WS_WT_DOWN) + ((unsigned long long)e << 20) + kb * 64u; d.n0 = nb * 32u; d.up = 0u; d.g = 0ull; }
    return d; }
__device__ __forceinline__ void cv_dma16(unsigned long long base, unsigned voff, unsigned ldsaddr) { asm volatile("s_mov_b32 m0, %0\n\ts_nop 0\n\tglobal_load_lds_dwordx4 %1, %2 nt" :: "s"(ldsaddr), "v"(voff), "s"(base) : "m0", "memory"); }
__device__ __forceinline__ void cv_dma4(unsigned long long base, unsigned voff, unsigned ldsaddr) { asm volatile("s_mov_b32 m0, %0\n\ts_nop 0\n\tglobal_load_lds_dword %1, %2" :: "s"(ldsaddr), "v"(voff), "s"(base) : "m0", "memory"); }
__device__ __forceinline__ void cv_issue(const Params& p, unsigned slot, int it, int lane) {
    const CvItem d = cv_item(p, (unsigned)it);
    const unsigned voff = (unsigned)(lane >> 3) * 8u * d.pitch + (unsigned)(lane & 7) * 16u;
#pragma unroll
    for (int i = 0; i < 8; ++i) cv_dma16(d.src + (unsigned long long)i * d.pitch, voff, slot + i * 1024);
    if (d.up) cv_dma4(d.g, (unsigned)lane * 4u, slot + 8192);
}
__device__ __forceinline__ void cv_process(const Params& p, const LAS unsigned char* slot, int it, int lane) {
    const CvItem d = cv_item(p, (unsigned)it);
    const unsigned r8 = (unsigned)lane >> 3, c = (unsigned)lane & 7u;
    f32x4 v[8];
#pragma unroll
    for (int i = 0; i < 8; ++i) v[i] = *(const LAS f32x4*)(slot + i * 1024 + lane * 16);
    f32x4 g0 = {W8_SCALE, W8_SCALE, W8_SCALE, W8_SCALE}, g1 = g0;
    if (d.up) { g0 = *(const LAS f32x4*)(slot + 8192 + 32 * r8) * W8_SCALE; g1 = *(const LAS f32x4*)(slot + 8192 + 32 * r8 + 16) * W8_SCALE; }
#pragma unroll
    for (int i = 0; i < 4; ++i) { v[i] = v[i] * g0[i]; v[4 + i] = v[4 + i] * g1[i]; }
#pragma unroll
    for (int e = 0; e < 4; ++e) { const unsigned nn = d.n0 + 4u * c + (unsigned)e; unsigned row = nn;
        if (d.up) row = (((nn & 1023u) >> 7) << 8) + ((nn >> 10) << 7) + (nn & 127u);
        u32x2 o8; o8.x = pk4_fp8(v[0][e], v[1][e], v[2][e], v[3][e]); o8.y = pk4_fp8(v[4][e], v[5][e], v[6][e], v[7][e]);
        const unsigned off = row * 1024u + 8u * r8;
        asm volatile("global_store_dwordx2 %0, %1, %2 nt" :: "v"(off), "v"(o8), "s"(d.dst) : "memory"); }
}

constexpr int MLA_KT = 12288, MLA_VT = 8192, MLA_KBUF = 2 * MLA_KT, MLA_VBUF = 2 * MLA_VT, MLA_V0 = 2 * MLA_KBUF;
typedef short v4i16_t __attribute__((ext_vector_type(4)));
__device__ __forceinline__ s16x4 lds_tr16(const LAS unsigned char* p) { return __builtin_bit_cast(s16x4, __builtin_amdgcn_ds_read_tr16_b64_v4i16((LAS v4i16_t*)p)); }
__device__ __forceinline__ void mla_unit(const Params& p, LAS unsigned char* lds, int unit, int tid, int cvgw, int& cvj, int& cvs, int& cvp) {
    const int lane = tid & 63, wid = __builtin_amdgcn_readfirstlane(tid >> 6), r32 = lane & 31, hi = lane >> 5;
    const int qb = unit & 7, h = (unit >> 3) & 7, b = unit >> 6;
    const bf16_t* Qg = (const bf16_t*)(p.ws + WS_Q); const bf16_t* Kg = (const bf16_t*)(p.ws + WS_KB); const bf16_t* Vg = (const bf16_t*)(p.ws + WS_VB);
    const size_t rowb = (size_t)b * SEQ;
    const int q0 = qb * 256 + wid * 32;
    int ksrc[3], kdst[3], vsrc[2], vdst[2];
    const bf16_t* Kbh = Kg + rowb * 768 + h * 96; const bf16_t* Vbh = Vg + rowb * 512 + h * 64;
#pragma unroll
    for (int i = 0; i < 3; ++i) { const int pk = tid + 512 * i, r = pk / 12, c = pk % 12; ksrc[i] = r * 768 + c * 8; kdst[i] = (r >> 6) * MLA_KT + c * 1024 + (r & 63) * 16; }
#pragma unroll
    for (int i = 0; i < 2; ++i) { const int pk = tid + 512 * i, r = pk >> 3, c = pk & 7; vsrc[i] = r * 512 + c * 8; vdst[i] = MLA_V0 + (r >> 6) * MLA_VT + (c >> 2) * 4096 + (r & 63) * 64 + (c & 3) * 16; }
    const int kfo = hi * 1024 + r32 * 16;
    const int vfo = MLA_V0 + ((lane >> 4) & 1) * 32 + (lane & 3) * 8 + (4 * hi + ((lane & 15) >> 2)) * 64;
    bf16x8 qf[6];
#pragma unroll
    for (int s = 0; s < 6; ++s) qf[s] = *(const bf16x8*)(Qg + (rowb + q0 + r32) * 768 + h * 96 + 16 * s + 8 * hi);
    const int ns_blk = 2 * qb + 2, nt_me = 4 * qb + (wid >> 1) + 1;
    u32x4 sk[3], sv[2];
#pragma unroll
    for (int i = 0; i < 3; ++i) sk[i] = *(const u32x4*)(Kbh + ksrc[i]);
#pragma unroll
    for (int i = 0; i < 2; ++i) sv[i] = *(const u32x4*)(Vbh + vsrc[i]);
#pragma unroll
    for (int i = 0; i < 3; ++i) *(LAS u32x4*)(lds + kdst[i]) = sk[i];
#pragma unroll
    for (int i = 0; i < 2; ++i) *(LAS u32x4*)(lds + vdst[i]) = sv[i];
    __syncthreads();
    float mrun = -1.0e30f, lrun = 0.f; f32x16 o0 = {}, o1 = {};
    for (int st = 0; st < ns_blk; ++st) {
        if (wid >= 4) __builtin_amdgcn_s_sleep(6);
        const bool pre = (st + 1 < ns_blk);
        if (pre) { const bf16_t* kn = Kbh + (size_t)(st + 1) * 128 * 768; const bf16_t* vn = Vbh + (size_t)(st + 1) * 128 * 512;
#pragma unroll
            for (int i = 0; i < 3; ++i) sk[i] = *(const u32x4*)(kn + ksrc[i]);
#pragma unroll
            for (int i = 0; i < 2; ++i) sv[i] = *(const u32x4*)(vn + vsrc[i]); }
#pragma unroll
        for (int tt = 0; tt < 2; ++tt) {
          const int t = 2 * st + tt;
          if (t < nt_me) {
            const LAS unsigned char* kb_ = lds + (st & 1) * MLA_KBUF + tt * MLA_KT + kfo; const LAS unsigned char* vb_ = lds + (st & 1) * MLA_VBUF + tt * MLA_VT + vfo;
            f32x16 sc[2]; bf16x8 kf[2][6]; s16x4 vlo[8], vhi[8];
#pragma unroll
            for (int kb = 0; kb < 2; ++kb)
#pragma unroll
                for (int s = 0; s < 6; ++s) kf[kb][s] = *(const LAS bf16x8*)(kb_ + s * 2048 + kb * 512);
            __builtin_amdgcn_sched_barrier(0);
#pragma unroll
            for (int kb = 0; kb < 2; ++kb) { f32x16 a = {};
#pragma unroll
                for (int s = 0; s < 6; ++s) a = __builtin_amdgcn_mfma_f32_32x32x16_bf16(kf[kb][s], qf[s], a, 0, 0, 0);
                sc[kb] = a; }
            __builtin_amdgcn_sched_barrier(0);
#pragma unroll
            for (int i = 0; i < 8; ++i) { const LAS unsigned char* vr = vb_ + (i & 1) * 4096 + (i >> 2) * 2048 + ((i >> 1) & 1) * 1024; vlo[i] = lds_tr16(vr); vhi[i] = lds_tr16(vr + 512); }
            __builtin_amdgcn_sched_barrier(0);
            float mx = fmaxf(fmaxf(sc[0][0], sc[0][1]), sc[1][0]);
#pragma unroll
            for (int r = 2; r < 16; r += 2) mx = fmaxf(fmaxf(mx, sc[0][r]), sc[0][r + 1]);
#pragma unroll
            for (int r = 1; r < 15; r += 2) mx = fmaxf(fmaxf(mx, sc[1][r]), sc[1][r + 1]);
            mx = fmaxf(mx, sc[1][15]);
            mx = xmax32(mx);
            if (__any(mx > mrun + 8.0f)) { const float mnew = fmaxf(mrun, mx), alpha = fast_exp2(mrun - mnew); mrun = mnew; lrun *= alpha;
#pragma unroll
                for (int r = 0; r < 16; ++r) { o0[r] *= alpha; o1[r] *= alpha; } }
            float ls = 0.f; unsigned pw[2][8];
#pragma unroll
            for (int kb = 0; kb < 2; ++kb)
#pragma unroll
                for (int r = 0; r < 16; r += 2) { const float e0 = fast_exp2(sc[kb][r] - mrun), e1 = fast_exp2(sc[kb][r + 1] - mrun); pw[kb][r >> 1] = pk2(e0, e1); ls += e0 + e1; }
            lrun += ls;
#pragma unroll
            for (int kb = 0; kb < 2; ++kb)
#pragma unroll
                for (int s2 = 0; s2 < 2; ++s2) {
                    const bf16x8 pf = __builtin_bit_cast(bf16x8, (u32x4){pw[kb][4 * s2 + 0], pw[kb][4 * s2 + 1], pw[kb][4 * s2 + 2], pw[kb][4 * s2 + 3]});
#pragma unroll
                    for (int db = 0; db < 2; ++db) { const int i = 4 * kb + 2 * s2 + db;
                        const bf16x8 vf = (bf16x8){vlo[i][0], vlo[i][1], vlo[i][2], vlo[i][3], vhi[i][0], vhi[i][1], vhi[i][2], vhi[i][3]};
                        if (db == 0) o0 = __builtin_amdgcn_mfma_f32_32x32x16_bf16(vf, pf, o0, 0, 0, 0); else o1 = __builtin_amdgcn_mfma_f32_32x32x16_bf16(vf, pf, o1, 0, 0, 0); } }
          }
        }
        if (pre) { LAS unsigned char* nk = lds + ((st + 1) & 1) * MLA_KBUF; LAS unsigned char* nv = lds + ((st + 1) & 1) * MLA_VBUF;
#pragma unroll
            for (int i = 0; i < 3; ++i) *(LAS u32x4*)(nk + kdst[i]) = sk[i];
#pragma unroll
            for (int i = 0; i < 2; ++i) *(LAS u32x4*)(nv + vdst[i]) = sv[i]; }
        if (cvgw >= 0) {
            __builtin_amdgcn_sched_barrier(0);
            const unsigned slot_ = (unsigned)__builtin_amdgcn_readfirstlane((int)(unsigned)(__UINTPTR_TYPE__)(lds + CV_LDS)) + (unsigned)wid * CV_SLOT;
            if (cvp) { asm volatile("s_waitcnt vmcnt(0)" ::: "memory");
                int l_; asm volatile("v_mbcnt_lo_u32_b32 %0, -1, 0\n\tv_mbcnt_hi_u32_b32 %0, -1, %0" : "=v"(l_)); cv_process(p, lds + CV_LDS + wid * CV_SLOT, cvgw + cvj * CV_NGW, l_); ++cvj; cvp = 0;
                asm volatile("s_waitcnt lgkmcnt(0)" ::: "memory"); }
            if (cvj < CV_PER_WAVE && (cvs % CV_PACE_D) < CV_PACE_N) { int l_; asm volatile("v_mbcnt_lo_u32_b32 %0, -1, 0\n\tv_mbcnt_hi_u32_b32 %0, -1, %0" : "=v"(l_)); cv_issue(p, slot_, cvgw + cvj * CV_NGW, l_); cvp = 1; }
            ++cvs; __builtin_amdgcn_sched_barrier(0); }
        __syncthreads();
    }
    lrun = xsum32(lrun);
#if FP8_OUT
    const float inv = A8_SCALE / lrun;
    unsigned char* yo = p.ws + WS_YCAT + (rowb + q0 + r32) * 1024 + h * 64;
#pragma unroll
    for (int g = 0; g < 4; ++g) { *(unsigned*)(yo + 8 * g + 4 * hi) = pk4_fp8(o0[4 * g] * inv, o0[4 * g + 1] * inv, o0[4 * g + 2] * inv, o0[4 * g + 3] * inv);
        *(unsigned*)(yo + 32 + 8 * g + 4 * hi) = pk4_fp8(o1[4 * g] * inv, o1[4 * g + 1] * inv, o1[4 * g + 2] * inv, o1[4 * g + 3] * inv); }
#else
    const float inv = 1.0f / lrun;
    bf16_t* yo = (bf16_t*)(p.ws + WS_YCAT) + (rowb + q0 + r32) * 1024 + h * 64;
#pragma unroll
    for (int a = 0; a < 2; ++a) {
        u32x2 A0, B0, A1, B1; const int g = 2 * a;
        A0.x = pk2(o0[4 * g] * inv, o0[4 * g + 1] * inv); A0.y = pk2(o0[4 * g + 2] * inv, o0[4 * g + 3] * inv); B0.x = pk2(o0[4 * g + 4] * inv, o0[4 * g + 5] * inv); B0.y = pk2(o0[4 * g + 6] * inv, o0[4 * g + 7] * inv);
        A1.x = pk2(o1[4 * g] * inv, o1[4 * g + 1] * inv); A1.y = pk2(o1[4 * g + 2] * inv, o1[4 * g + 3] * inv); B1.x = pk2(o1[4 * g + 4] * inv, o1[4 * g + 5] * inv); B1.y = pk2(o1[4 * g + 6] * inv, o1[4 * g + 7] * inv);
        const auto s0x = __builtin_amdgcn_permlane32_swap(A0.x, B0.x, false, false), s0y = __builtin_amdgcn_permlane32_swap(A0.y, B0.y, false, false);
        const auto s1x = __builtin_amdgcn_permlane32_swap(A1.x, B1.x, false, false), s1y = __builtin_amdgcn_permlane32_swap(A1.y, B1.y, false, false);
        u32x4 w0, w1; w0.x = s0x[0]; w0.y = s0y[0]; w0.z = s0x[1]; w0.w = s0y[1]; w1.x = s1x[0]; w1.y = s1y[0]; w1.z = s1x[1]; w1.w = s1y[1];
        *(u32x4*)(yo + 16 * a + 8 * hi) = w0; *(u32x4*)(yo + 32 + 16 * a + 8 * hi) = w1; }
#endif
}

constexpr int XA_KB = 32768, XA_BUF = 65536;
__device__ __forceinline__ void xattn_range(const Params& p, LAS unsigned char* lds, int u0, int nu, int tid, unsigned long long* tacc = nullptr) {
    const int lane = tid & 63, wid = __builtin_amdgcn_readfirstlane(tid >> 6), fr = lane & 15, fq = lane >> 4;
    const bf16_t* XQ = (const bf16_t*)(p.ws + WS_XQ); const bf16_t* KM = (const bf16_t*)(p.ws + WS_KM); const bf16_t* VMT = (const bf16_t*)(p.ws + WS_VMT); bf16_t* OX = (bf16_t*)(p.ws + WS_OX);
    const int kpos0 = 8 * wid + (lane >> 5);
    const int vrow = 32 * wid + (lane >> 3), vslot = (lane & 7) ^ (vrow & 7);
    const int vsrc = vrow * 256 + vslot * 8;
    const int nstep = nu * 4;
#define XA_DMA(step) do { const int un_ = u0 + ((step) >> 2), t_ = (step) & 3, z_ = un_ >> 4; \
        const bf16_t* kp_ = KM + ((size_t)((z_ >> 2) * 256 + 64 * t_)) * 1024 + (z_ & 3) * 256; const bf16_t* vp_ = VMT + (size_t)z_ * 65536 + 64 * t_ + vsrc; \
        LAS unsigned char* nb_ = lds + ((step) & 1) * XA_BUF + wid * 4096; \
        _Pragma("unroll") for (int i_ = 0; i_ < 4; ++i_) { const int pos_ = kpos0 + 2 * i_; const int key_ = (pos_ & 32) + 8 * ((pos_ >> 2) & 3) + 4 * ((pos_ >> 4) & 1) + (pos_ & 3); \
            __builtin_amdgcn_global_load_lds((const unsigned*)(kp_ + key_ * 1024 + (((lane & 31) ^ (pos_ & 15)) << 3)), (LAS unsigned*)(nb_ + i_ * 1024), 16, 0, 0); \
            __builtin_amdgcn_global_load_lds((const unsigned*)(vp_ + i_ * 8 * 256), (LAS unsigned*)(nb_ + XA_KB + i_ * 1024), 16, 0, 0); } } while (0)
    XA_DMA(0);
    bf16x8 qf[8]; f32x4 oacc[16]; float mrun = -1.0e30f, lrun = 0.f;
    { const int z = u0 >> 4; const size_t qrow = (size_t)(z >> 2) * 2048 + (u0 & 15) * 128 + wid * 16 + fr;
#pragma unroll
      for (int ks = 0; ks < 8; ++ks) qf[ks] = *(const bf16x8*)(XQ + qrow * 1024 + (z & 3) * 256 + 32 * ks + 8 * fq); }
    __syncthreads();
    for (int step = 0; step < nstep; ++step) {
        const int t = step & 3, un = u0 + (step >> 2), z = un >> 4, b = z >> 2, h = z & 3;
        const size_t qrow = (size_t)b * 2048 + (un & 15) * 128 + wid * 16 + fr;
        if (t == 0) {
#pragma unroll
            for (int db = 0; db < 16; ++db) oacc[db] = (f32x4){0.f, 0.f, 0.f, 0.f};
            mrun = -1.0e30f; lrun = 0.f; }
        if (step + 1 < nstep) XA_DMA(step + 1);
        { const LAS unsigned char* kb = lds + (step & 1) * XA_BUF; const LAS unsigned char* vb = kb + XA_KB;
          f32x4 sacc[4]; bf16x8 kfa[8], kfb[8];
#define XA_LDK(dst, kvb) do { _Pragma("unroll") for (int ks = 0; ks < 8; ++ks) dst[ks] = *(const LAS bf16x8*)(kb + (16 * (kvb) + fr) * 512 + (((4 * ks + fq) ^ fr) << 4)); } while (0)
#define XA_QK(src, kvb) do { f32x4 a_ = {0.f, 0.f, 0.f, 0.f}; _Pragma("unroll") for (int ks = 0; ks < 8; ++ks) a_ = __builtin_amdgcn_mfma_f32_16x16x32_bf16(src[ks], qf[ks], a_, 0, 0, 0); sacc[kvb] = a_; } while (0)
          XA_LDK(kfa, 0); XA_LDK(kfb, 1); __builtin_amdgcn_sched_barrier(0);
          XA_QK(kfa, 0); XA_LDK(kfa, 2); __builtin_amdgcn_sched_barrier(0);
          XA_QK(kfb, 1); XA_LDK(kfb, 3); __builtin_amdgcn_sched_barrier(0);
          XA_QK(kfa, 2); __builtin_amdgcn_sched_barrier(0);
          XA_QK(kfb, 3);
          if (t == 3 && step + 1 < nstep) {
              __builtin_amdgcn_sched_barrier(0);
              const int un2 = un + 1, z2 = un2 >> 4; const size_t qr2 = (size_t)(z2 >> 2) * 2048 + (un2 & 15) * 128 + wid * 16 + fr;
#pragma unroll
              for (int ks = 0; ks < 8; ++ks) qf[ks] = *(const bf16x8*)(XQ + qr2 * 1024 + (z2 & 3) * 256 + 32 * ks + 8 * fq);
              __builtin_amdgcn_sched_barrier(0); }
#undef XA_LDK
#undef XA_QK
          float mx = fmaxf(fmaxf(sacc[0][0], sacc[0][1]), fmaxf(sacc[0][2], sacc[0][3]));
#pragma unroll
          for (int kvb = 1; kvb < 4; ++kvb) { mx = fmaxf(fmaxf(mx, sacc[kvb][0]), sacc[kvb][1]); mx = fmaxf(fmaxf(mx, sacc[kvb][2]), sacc[kvb][3]); }
          mx = xmax32(xmax16(mx));
          if (__any(mx > mrun + 8.0f)) { const float mnew = fmaxf(mrun, mx), alpha = fast_exp2(mrun - mnew); mrun = mnew; lrun *= alpha;
#pragma unroll
              for (int db = 0; db < 16; ++db) oacc[db] = oacc[db] * alpha; }
          float ls = 0.f; u32x4 pw[2];
#pragma unroll
          for (int s2 = 0; s2 < 2; ++s2) { unsigned w[4];
#pragma unroll
              for (int hh = 0; hh < 2; ++hh)
#pragma unroll
                  for (int jj = 0; jj < 2; ++jj) { const float e0 = fast_exp2(sacc[2 * s2 + hh][2 * jj] - mrun), e1 = fast_exp2(sacc[2 * s2 + hh][2 * jj + 1] - mrun); w[2 * hh + jj] = pk2(e0, e1); ls += e0 + e1; }
              pw[s2] = (u32x4){w[0], w[1], w[2], w[3]}; }
          lrun += ls;
          { bf16x8 vfa[8], vfb[8];
#define XA_LDV(dst, s2, d0) do { _Pragma("unroll") for (int i = 0; i < 8; ++i) dst[i] = *(const LAS bf16x8*)(vb + (16 * ((d0) + i) + fr) * 128 + (((4 * (s2) + fq) ^ (fr & 7)) << 4)); } while (0)
#define XA_PV(src, s2, d0) do { const bf16x8 pf_ = __builtin_bit_cast(bf16x8, pw[s2]); _Pragma("unroll") for (int i = 0; i < 8; ++i) oacc[(d0) + i] = __builtin_amdgcn_mfma_f32_16x16x32_bf16(src[i], pf_, oacc[(d0) + i], 0, 0, 0); } while (0)
            XA_LDV(vfa, 0, 0); XA_LDV(vfb, 0, 8); __builtin_amdgcn_sched_barrier(0);
            XA_PV(vfa, 0, 0); XA_LDV(vfa, 1, 0); __builtin_amdgcn_sched_barrier(0);
            XA_PV(vfb, 0, 8); XA_LDV(vfb, 1, 8); __builtin_amdgcn_sched_barrier(0);
            XA_PV(vfa, 1, 0); __builtin_amdgcn_sched_barrier(0);
            XA_PV(vfb, 1, 8);
#undef XA_LDV
#undef XA_PV
          } }
        if (t == 3) { float lt = lrun; lt = xsum32(xsum16(lt)); const float inv = 1.0f / lt;
            int t3; asm volatile("v_mbcnt_lo_u32_b32 %0, -1, 0\n\tv_mbcnt_hi_u32_b32 %0, -1, %0" : "=v"(t3)); t3 += wid << 6;
            const size_t qrow3 = (size_t)b * 2048 + (un & 15) * 128 + (t3 >> 6) * 16 + (t3 & 15);
#if FP8_XO
            unsigned char* orow = (unsigned char*)OX + qrow3 * 1024 + h * 256 + 64 * ((t3 >> 4) & 3);
#else
            bf16_t* orow = OX + qrow3 * 1024 + h * 256 + 4 * ((t3 >> 4) & 3);
#endif
#pragma unroll
#if FP8_XO
            for (int g4 = 0; g4 < 4; ++g4) { u32x4 w;
#pragma unroll
                for (int q4 = 0; q4 < 4; ++q4) { const f32x4 v = oacc[4 * g4 + q4] * (inv * A8_SCALE); w[q4] = pk4_fp8(v[0], v[1], v[2], v[3]); }
                *(u32x4*)(orow + 16 * g4) = w; }
#else
            for (int db = 0; db < 16; ++db) { const f32x4 v = oacc[db] * inv; u32x2 w; w.x = pk2(v[0], v[1]); w.y = pk2(v[2], v[3]); *(u32x2*)(orow + 16 * db) = w; }
#endif
 }
#if PROBE_XA
        const unsigned long long tb0_ = __builtin_amdgcn_s_memrealtime();
#endif
        __syncthreads();
#if PROBE_XA
        if (tacc) *tacc += __builtin_amdgcn_s_memrealtime() - tb0_;
#endif
    }
#undef XA_DMA
}

__device__ __forceinline__ void conv_unit(const Params& p, LAS unsigned char* lds, int unit, int tid) {
    const int lane = tid & 63, wid = tid >> 6, c = tid;
    const int b = unit >> 5, t0 = (unit & 31) * 64;
    LAS float* cl = (LAS float*)lds;
    LAS float* wl = (LAS float*)(lds + 65536);
    const __amdgpu_buffer_rsrc_t wr_ = __builtin_amdgcn_make_buffer_rsrc((void*)p.w_dw, 0, 31 * 512 * 4, 0x00020000);
#pragma unroll
    for (int j = 0; j < 31; ++j) wl[j * 512 + c] = __uint_as_float(__builtin_amdgcn_raw_buffer_load_b32(wr_, c * 4, j * 2048, 0));
    const __amdgpu_buffer_rsrc_t zr = __builtin_amdgcn_make_buffer_rsrc((void*)(p.ws + WS_Z), 0, (int)((size_t)NTOK * 512 * 2), 0x00020000);
    f32x2 Z[47];
#define CV_BATCH(i0, n) do { unsigned short raw_[n]; \
        _Pragma("unroll") for (int i_ = 0; i_ < (n); ++i_) { const int t_ = t0 - 30 + (i0) + i_; const int tc_ = t_ < 0 ? 0 : t_; raw_[i_] = __builtin_amdgcn_raw_buffer_load_b16(zr, c * 2, (b * SEQ + tc_) * 1024, 2); } \
        __builtin_amdgcn_sched_barrier(0); \
        _Pragma("unroll") for (int i_ = 0; i_ < (n); ++i_) { const int t_ = t0 - 30 + (i0) + i_; Z[((i0) + i_) >> 1][((i0) + i_) & 1] = t_ < 0 ? 0.f : bf2f(raw_[i_]); } \
        __builtin_amdgcn_sched_barrier(0); } while (0)
    CV_BATCH(0, 32); CV_BATCH(32, 32); CV_BATCH(64, 30);
#undef CV_BATCH
    const float bias = p.b_dw[c];
    const f32x4 g0 = *(const f32x4*)(p.g_cln + lane * 8), g1 = *(const f32x4*)(p.g_cln + lane * 8 + 4), b0 = *(const f32x4*)(p.b_cln + lane * 8), b1 = *(const f32x4*)(p.b_cln + lane * 8 + 4);
#pragma unroll
    for (int ps = 0; ps < 2; ++ps) {
        f32x2 pe[16], po[17];
#pragma unroll
        for (int i = 0; i < 16; ++i) pe[i] = (f32x2){bias, bias};
#pragma unroll
        for (int i = 0; i < 17; ++i) po[i] = (f32x2){0.f, 0.f};
#pragma unroll
        for (int j = 0; j < 31; ++j) { const float wj = wl[j * 512 + c];
            const f32x2 w2 = {wj, wj};
            if ((j & 1) == 0) {
#pragma unroll
                for (int i = 0; i < 16; ++i) pe[i] = __builtin_elementwise_fma(w2, Z[(32 * ps + 2 * i + j) >> 1], pe[i]); }
            else {
#pragma unroll
                for (int i = 0; i < 17; ++i) { const int zi = 32 * ps + (2 * i - 1) + j; if (zi + 1 < 94) po[i] = __builtin_elementwise_fma(w2, Z[zi >> 1], po[i]); } } }
#pragma unroll
        for (int o = 0; o < 32; ++o) cl[o * 512 + c] = (o & 1) ? pe[o >> 1][1] + po[(o + 1) >> 1][0] : pe[o >> 1][0] + po[o >> 1][1];
        __syncthreads();
#pragma unroll
        for (int oo = 0; oo < 4; ++oo) { const int o = wid * 4 + oo; const LAS float* r = cl + o * 512 + lane * 8;
            const f32x4 v0 = *(const LAS f32x4*)r, v1 = *(const LAS f32x4*)(r + 4);
            float s = (v0[0] + v0[1]) + (v0[2] + v0[3]) + (v1[0] + v1[1]) + (v1[2] + v1[3]); s = wave_sum(s, lane); const float mu = s * (1.0f / 512.0f);
            const f32x4 d0 = v0 - mu, d1 = v1 - mu; float q = (d0[0] * d0[0] + d0[1] * d0[1]) + (d0[2] * d0[2] + d0[3] * d0[3]) + (d1[0] * d1[0] + d1[1] * d1[1]) + (d1[2] * d1[2] + d1[3] * d1[3]);
            q = wave_sum(q, lane); const float rstd = __builtin_amdgcn_rsqf(q * (1.0f / 512.0f) + EPS);
            float y[8];
#pragma unroll
            for (int j = 0; j < 4; ++j) { const float a0 = d0[j] * rstd * g0[j] + b0[j], a1 = d1[j] * rstd * g1[j] + b1[j]; y[j] = a0 * sigmoidf_(a0); y[4 + j] = a1 * sigmoidf_(a1); }
#if FP8_OUT
            u32x2 wv; wv.x = pk4_fp8(y[0] * A8_SCALE, y[1] * A8_SCALE, y[2] * A8_SCALE, y[3] * A8_SCALE); wv.y = pk4_fp8(y[4] * A8_SCALE, y[5] * A8_SCALE, y[6] * A8_SCALE, y[7] * A8_SCALE);
            *(u32x2*)(p.ws + WS_YCAT + ((size_t)b * SEQ + t0 + 32 * ps + o) * 1024 + 512 + lane * 8) = wv; }
#else
            u32x4 wv; wv.x = pk2(y[0], y[1]); wv.y = pk2(y[2], y[3]); wv.z = pk2(y[4], y[5]); wv.w = pk2(y[6], y[7]);
            *(u32x4*)((bf16_t*)(p.ws + WS_YCAT) + ((size_t)b * SEQ + t0 + 32 * ps + o) * 1024 + 512 + lane * 8) = wv; }
#endif
        __syncthreads();
    }
}

constexpr int R1_LD = 2064;
constexpr int R1_LG = 2 * 32 * R1_LD;
__device__ __forceinline__ void router1_stage_weights(const Params& p, LAS unsigned char* lds, int tid) {
    const u32x4* W = (const u32x4*)(p.ws + WS_WR);
#pragma unroll 4
    for (int i = tid; i < 64 * 128; i += 512) { const int row = i >> 7, c = i & 127; *(LAS u32x4*)(lds + row * R1_LD + c * 16) = W[i]; }
    __syncthreads();
}
__device__ __forceinline__ void router1_unit(const Params& p, LAS unsigned char* lds, int unit, int tid) {
    const int lane = tid & 63, wid = tid >> 6, r = lane & 15, q = lane >> 4;
    LAS float* lg = (LAS float*)(lds + R1_LG) + wid * 512;
    LAS int* hist = (LAS int*)(lds + R1_LG + 16384);
    if (tid < 32) hist[tid] = 0;
    __syncthreads();
    const int tok0 = unit * RT_TOK + wid * 16;
    const bf16_t* xr = (const bf16_t*)(p.ws + WS_X2B) + (size_t)(tok0 + r) * 1024 + 8 * q;
    const LAS unsigned char* wh0 = lds + r * R1_LD + 16 * q;
    u32x4 xw[32];
#pragma unroll
    for (int ks = 0; ks < 32; ++ks) xw[ks] = *(const u32x4*)(xr + 32 * ks);
    f32x4 acc0 = {0.f, 0.f, 0.f, 0.f}, acc1 = {0.f, 0.f, 0.f, 0.f}; float ssq = 0.f;
#pragma unroll
    for (int ks = 0; ks < 32; ++ks) {
        const u32x4 w = xw[ks];
        { const float a0 = __uint_as_float(w.x << 16), a1 = __uint_as_float(w.x & 0xffff0000u), a2 = __uint_as_float(w.y << 16), a3 = __uint_as_float(w.y & 0xffff0000u);
          const float a4 = __uint_as_float(w.z << 16), a5 = __uint_as_float(w.z & 0xffff0000u), a6 = __uint_as_float(w.w << 16), a7 = __uint_as_float(w.w & 0xffff0000u);
          ssq += (a0 * a0 + a1 * a1) + (a2 * a2 + a3 * a3) + (a4 * a4 + a5 * a5) + (a6 * a6 + a7 * a7); }
        const bf16x8 ah = __builtin_bit_cast(bf16x8, w);
        const bf16x8 bh0 = *(const LAS bf16x8*)(wh0 + 64 * ks), bh1 = *(const LAS bf16x8*)(wh0 + 16 * R1_LD + 64 * ks);
        const bf16x8 bl0 = *(const LAS bf16x8*)(wh0 + 32 * R1_LD + 64 * ks), bl1 = *(const LAS bf16x8*)(wh0 + 48 * R1_LD + 64 * ks);
        acc0 = __builtin_amdgcn_mfma_f32_16x16x32_bf16(ah, bh0, acc0, 0, 0, 0); acc1 = __builtin_amdgcn_mfma_f32_16x16x32_bf16(ah, bh1, acc1, 0, 0, 0);
        acc0 = __builtin_amdgcn_mfma_f32_16x16x32_bf16(ah, bl0, acc0, 0, 0, 0); acc1 = __builtin_amdgcn_mfma_f32_16x16x32_bf16(ah, bl1, acc1, 0, 0, 0);
    }
    ssq = xsum32(xsum16(ssq));
    const float rstd_r = 1.0f / sqrtf(ssq * (1.0f / 1024.0f) + EPS);
    if (lane < 16) ((float*)(p.ws + WS_RSTD_X2))[tok0 + lane] = rstd_r;
    const float be0 = p.b_router[r], be1 = p.b_router[16 + r];
#pragma unroll
    for (int j = 0; j < 4; ++j) { const float rs = shfli(rstd_r, 4 * q + j); lg[(4 * q + j) * 32 + r] = acc0[j] * rs + be0; lg[(4 * q + j) * 32 + 16 + r] = acc1[j] * rs + be1; }
    asm volatile("s_waitcnt lgkmcnt(0)" ::: "memory");
    if (lane < 16) { const int tk = tok0 + lane; unsigned used = 0u; float tv[4]; int ti[4];
#pragma unroll
        for (int k = 0; k < 4; ++k) { float best = -3.0e38f; int bi = 0;
            for (int j = 0; j < 32; ++j) { const float v = lg[lane * 32 + j]; if (!((used >> j) & 1u) && v > best) { best = v; bi = j; } }
            used |= 1u << bi; tv[k] = best; ti[k] = bi; }
        const float e1 = __expf(tv[1] - tv[0]), e2 = __expf(tv[2] - tv[0]), e3 = __expf(tv[3] - tv[0]); const float inv = 1.0f / (1.0f + e1 + e2 + e3);
        int* oi = (int*)(p.ws + WS_TOPI) + (size_t)tk * 4; float* og = (float*)(p.ws + WS_TOPG) + (size_t)tk * 4;
        oi[0] = ti[0]; oi[1] = ti[1]; oi[2] = ti[2]; oi[3] = ti[3]; og[0] = inv; og[1] = e1 * inv; og[2] = e2 * inv; og[3] = e3 * inv;
#pragma unroll
        for (int k = 0; k < 4; ++k) atomicAdd((int*)&hist[ti[k]], 1); }
    __syncthreads();
    if (tid < 32) ((int*)(p.ws + WS_HIST))[unit * 32 + tid] = hist[tid];
    __syncthreads();
}
__device__ __forceinline__ void router2_unit(const Params& p, LAS unsigned char* lds, int unit, int tid) {
    const int lane = tid & 63, wid = tid >> 6;
    LAS int* cnt = (LAS int*)lds;
    LAS int* base = cnt + 32;
    LAS int* pst = cnt + 64;
    LAS int* part = cnt + 128;
    LAS int* wcnt = cnt + 128 + 1024;
    const int* H = (const int*)(p.ws + WS_HIST);
    { const int e = tid & 31, pt = tid >> 5; int tot = 0, bs = 0;
#pragma unroll 4
      for (int j = 0; j < 16; ++j) { const int bq = pt * 16 + j; const int v = H[bq * 32 + e]; tot += v; bs += (bq < unit) ? v : 0; }
      part[pt * 64 + e] = tot; part[pt * 64 + 32 + e] = bs; }
    const int my_e = ((const int*)(p.ws + WS_TOPI))[(size_t)unit * RT_TOK * 4 + tid];
    int my_rank = 0;
#pragma unroll 4
    for (int e = 0; e < 32; ++e) { const unsigned long long m = __ballot(my_e == e); if (my_e == e) my_rank = __popcll(m & ((1ull << lane) - 1ull)); if (lane == 0) wcnt[wid * 32 + e] = __popcll(m); }
    __syncthreads();
    if (tid < 32) { int tot = 0, bs = 0;
#pragma unroll
        for (int pt = 0; pt < 16; ++pt) { tot += part[pt * 64 + tid]; bs += part[pt * 64 + 32 + tid]; }
        cnt[tid] = tot; base[tid] = bs; }
    __syncthreads();
    if (tid == 0) { int sacc = 0; for (int e = 0; e < 32; ++e) { pst[e] = sacc; sacc += (cnt[e] + 255) & ~255; } pst[32] = sacc; }
    __syncthreads();
    { int woff = 0;
#pragma unroll
      for (int w = 0; w < 8; ++w) woff += (w < wid) ? wcnt[w * 32 + my_e] : 0;
      const int d = pst[my_e] + base[my_e] + woff + my_rank; const int tok = unit * RT_TOK + (tid >> 2);
      ((int*)(p.ws + WS_SLOT_TOK))[d] = tok; ((float*)(p.ws + WS_SLOT_GATE))[d] = ((const float*)(p.ws + WS_TOPG))[(size_t)unit * RT_TOK * 4 + tid];
      ((int*)(p.ws + WS_INV))[(size_t)unit * RT_TOK * 4 + tid] = d; ((float*)(p.ws + WS_SLOT_RS))[d] = ((const float*)(p.ws + WS_RSTD_X2))[tok]; }
    if (unit < 32) { const int e = unit, s0 = pst[e] + cnt[e], s1 = pst[e + 1];
        for (int s = s0 + tid; s < s1; s += 512) { ((int*)(p.ws + WS_SLOT_TOK))[s] = 0; ((float*)(p.ws + WS_SLOT_GATE))[s] = 0.f; ((float*)(p.ws + WS_SLOT_RS))[s] = 0.f; } }
    if (unit == 32) { int* te = (int*)(p.ws + WS_TILE_E); const int nt = pst[32] >> 8;
        for (int t = tid; t < NTILE_MAX; t += 512) { int e = 31; for (int k = 31; k >= 0; --k) if (t * 256 < pst[k + 1]) e = k; te[t] = e; }
        if (tid == 0) te[NTILE_MAX] = nt; }
    __syncthreads();
}

struct FinalRows { u32x2 x[4]; unsigned y[4][4]; };
__device__ __forceinline__ void final_load(const Params& p, int tok, int i0, int i1, int i2, int i3, FinalRows& r, int lane) {
    const u32x2* x2 = (const u32x2*)((const bf16_t*)(p.ws + WS_X2B) + (size_t)tok * 1024); const unsigned char* YB = p.ws + WS_YB;
    const unsigned* y0 = (const unsigned*)(YB + (size_t)i0 * 1024); const unsigned* y1 = (const unsigned*)(YB + (size_t)i1 * 1024); const unsigned* y2 = (const unsigned*)(YB + (size_t)i2 * 1024); const unsigned* y3 = (const unsigned*)(YB + (size_t)i3 * 1024);
#pragma unroll
    for (int j = 0; j < 4; ++j) { r.x[j] = __builtin_nontemporal_load(x2 + lane + 64 * j); r.y[0][j] = __builtin_nontemporal_load(y0 + lane + 64 * j); r.y[1][j] = __builtin_nontemporal_load(y1 + lane + 64 * j);
        r.y[2][j] = __builtin_nontemporal_load(y2 + lane + 64 * j); r.y[3][j] = __builtin_nontemporal_load(y3 + lane + 64 * j); }
}
__device__ __forceinline__ void final_stage(const Params& p, int gw, int ngw, int lane) {
    if (gw >= NTOK) return;
    const int* INV = (const int*)(p.ws + WS_INV);
    FinalRows cur, nxt; int tok = gw;
    { const int* iv = INV + (size_t)tok * 4; final_load(p, tok, iv[0], iv[1], iv[2], iv[3], cur, lane); }
    int n0 = 0, n1 = 0, n2 = 0, n3 = 0;
    if (tok + ngw < NTOK) { const int* iv = INV + (size_t)(tok + ngw) * 4; n0 = iv[0]; n1 = iv[1]; n2 = iv[2]; n3 = iv[3]; }
    const f32x4 g0 = ((const f32x4*)p.g_final)[lane], g1 = ((const f32x4*)p.g_final)[lane + 64], g2 = ((const f32x4*)p.g_final)[lane + 128], g3 = ((const f32x4*)p.g_final)[lane + 192];
    for (; tok < NTOK; tok += ngw) {
        const int tn = tok + ngw;
        if (tn < NTOK) { final_load(p, tn, n0, n1, n2, n3, nxt, lane);
            if (tn + ngw < NTOK) { const int* iv = INV + (size_t)(tn + ngw) * 4; n0 = iv[0]; n1 = iv[1]; n2 = iv[2]; n3 = iv[3]; } }
        f32x4 v[4];
#pragma unroll
        for (int j = 0; j < 4; ++j) { const u32x2 w = cur.x[j]; v[j][0] = __uint_as_float(w.x << 16); v[j][1] = __uint_as_float(w.x & 0xffff0000u); v[j][2] = __uint_as_float(w.y << 16); v[j][3] = __uint_as_float(w.y & 0xffff0000u); }
#pragma unroll
        for (int k = 0; k < 4; ++k)
#pragma unroll
            for (int j = 0; j < 4; ++j) { const int w = (int)cur.y[k][j]; const f32x2 lo = __builtin_amdgcn_cvt_pk_f32_fp8(w, false), hi = __builtin_amdgcn_cvt_pk_f32_fp8(w, true);
                v[j][0] += lo[0] * Y8_INV; v[j][1] += lo[1] * Y8_INV; v[j][2] += hi[0] * Y8_INV; v[j][3] += hi[1] * Y8_INV; }
        float s = 0.f;
#pragma unroll
        for (int j = 0; j < 4; ++j) s += (v[j][0] * v[j][0] + v[j][1] * v[j][1]) + (v[j][2] * v[j][2] + v[j][3] * v[j][3]);
        s = wave_sum(s, lane); const float rstd = __builtin_amdgcn_rsqf(s * (1.0f / 1024.0f) + EPS);
        f32x4* xr = (f32x4*)(p.out + (size_t)tok * 1024);
        __builtin_nontemporal_store(v[0] * rstd * g0, xr + lane); __builtin_nontemporal_store(v[1] * rstd * g1, xr + lane + 64); __builtin_nontemporal_store(v[2] * rstd * g2, xr + lane + 128); __builtin_nontemporal_store(v[3] * rstd * g3, xr + lane + 192);
        cur = nxt;
    }
}

#define XB_TMO      128
#define XB_XCNT(j)  (256  + 64 * (j))
#define XB_XSUB(j)  (1280 + 64 * (j))
#define XB_XGEN(j)  (2304 + 64 * (j))
#define XB_TOP      3328
#define XB_TOPGEN   3392
#define XCD_BAR_WORDS 3456
constexpr int CW_MLAQ = 4096;
#define XB_SPIN_CAP (1u << 18)
__device__ __forceinline__ unsigned xb_ld(unsigned* p)              { return __hip_atomic_load(p, __ATOMIC_RELAXED, __HIP_MEMORY_SCOPE_AGENT); }
__device__ __forceinline__ unsigned xb_add(unsigned* p, unsigned v) { return __hip_atomic_fetch_add(p, v, __ATOMIC_RELAXED, __HIP_MEMORY_SCOPE_AGENT); }
__device__ __forceinline__ unsigned xb_xcc_id() { return (unsigned)__builtin_amdgcn_s_getreg((3 << 11) | 20) & 0xFu; }
#define XB_SPIN(cond, bar) do { unsigned _sp = 0; while (cond) { __builtin_amdgcn_s_sleep(1); \
    if ((++_sp & 255u) == 0u) { if (xb_ld(&(bar)[XB_TMO])) break; if (_sp > XB_SPIN_CAP) { atomicAdd(&(bar)[XB_TMO], 1u); break; } } } } while (0)
struct XcdBarrier { unsigned* bar; unsigned x; volatile LAS unsigned* st; };
__device__ __forceinline__ XcdBarrier xcd_barrier_post(unsigned* bar, volatile LAS unsigned* st, bool leader) {
    XcdBarrier b; b.bar = bar; b.x = xb_xcc_id(); b.st = st;
    if (leader) (void)xb_add(&bar[XB_XCNT(b.x)], 1u);
    return b;
}
__device__ __forceinline__ void xcd_barrier_complete(unsigned* bar, unsigned x, unsigned& nloc, unsigned& nx) {
    const unsigned G = gridDim.x * gridDim.y * gridDim.z;
    unsigned sum, cnt, mine, sp = 0u;
    for (;;) {
        sum = 0u; cnt = 0u; mine = 0u;
#pragma unroll
        for (unsigned j = 0; j < 16; ++j) { const unsigned c = xb_ld(&bar[XB_XCNT(j)]); sum += c; cnt += (c > 0u) ? 1u : 0u; mine = (j == x) ? c : mine; }
        if (sum == G) break;
        __builtin_amdgcn_s_sleep(1);
        if ((++sp & 255u) == 0u) { if (xb_ld(&bar[XB_TMO])) break; if (sp > XB_SPIN_CAP) { atomicAdd(&bar[XB_TMO], 1u); break; } }
    }
    nloc = mine > 0u ? mine : 1u; nx = cnt > 0u ? cnt : 1u;
}
__device__ __forceinline__ void xcd_barrier(const XcdBarrier& b, bool leader) {
    asm volatile("s_waitcnt vmcnt(0)" ::: "memory");
    __syncthreads();
    if (leader) {
        unsigned* bar = b.bar;
        __builtin_amdgcn_s_waitcnt(0);
        unsigned nloc = b.st[0], nx = b.st[1];
        if (nloc == 0u) { xcd_barrier_complete(bar, b.x, nloc, nx); b.st[0] = nloc; b.st[1] = nx; }
        const unsigned old = xb_add(&bar[XB_XSUB(b.x)], 1u);
        const unsigned gen = old / nloc;
        if (old + 1u == (gen + 1u) * nloc) {
            __builtin_amdgcn_fence(__ATOMIC_RELEASE, "agent");
            asm volatile("s_waitcnt vmcnt(0)" ::: "memory");
            const unsigned og = xb_add(&bar[XB_TOP], 1u);
            const unsigned tg = og / nx;
            if (og + 1u != (tg + 1u) * nx) XB_SPIN(xb_ld(&bar[XB_TOP]) < (tg + 1u) * nx, bar);
            __builtin_amdgcn_fence(__ATOMIC_ACQUIRE, "agent");
            xb_add(&bar[XB_XGEN(b.x)], 1u);
            asm volatile("s_waitcnt vmcnt(0)" ::: "memory");
        } else {
            XB_SPIN(xb_ld(&bar[XB_XGEN(b.x)]) == gen, bar);
            __builtin_amdgcn_fence(__ATOMIC_ACQUIRE, "agent");
            asm volatile("s_waitcnt vmcnt(0)" ::: "memory");
        }
    }
    __syncthreads();
}

constexpr int CW_GRP = 4608;
constexpr int CW_SLAB = 6016;
constexpr int CW_XCC = 5632;
__device__ __forceinline__ void group_barrier(unsigned* bar, int grp, unsigned target, bool leader, int m0, int m1, int m2, int m3) {
    asm volatile("s_waitcnt vmcnt(0)" ::: "memory");
    __syncthreads();
    if (leader) {
        unsigned* cnt = bar + CW_GRP + 16 * grp;
        const unsigned i0 = bar[CW_XCC + m0], i1 = bar[CW_XCC + m1], i2 = bar[CW_XCC + m2], i3 = bar[CW_XCC + m3];
        const bool same = (i0 != 0u) && (i0 == i1) && (i0 == i2) && (i0 == i3);
        if (!same) { __builtin_amdgcn_fence(__ATOMIC_RELEASE, "agent"); asm volatile("s_waitcnt vmcnt(0)" ::: "memory"); }
        (void)xb_add(cnt, 1u);
        XB_SPIN(xb_ld(cnt) < target, bar);
        { __builtin_amdgcn_fence(__ATOMIC_ACQUIRE, "agent"); asm volatile("s_waitcnt vmcnt(0)" ::: "memory"); }
    }
    __syncthreads();
}

constexpr int EPI_LDS = 131072;
constexpr int LDS_BYTES = 155648;

#ifndef USE_CG_SYNC
#define USE_CG_SYNC 0
#endif
#if USE_CG_SYNC
#define GRID_SYNC_() grid.sync()
#else
#define GRID_SYNC_() xcd_barrier(xbar, wave_s_ == 0 && __builtin_amdgcn_mbcnt_hi(~0u, __builtin_amdgcn_mbcnt_lo(~0u, 0u)) == 0u)
#endif
#define LOCAL_SYNC_() do { asm volatile("s_waitcnt vmcnt(0)" ::: "memory"); __syncthreads(); } while (0)
#if PROBE_MASK || PROBE_EPI || PROBE_XA || PROBE_SUB
#define SEAM_SYNC(local) do { if (local) LOCAL_SYNC_(); else GRID_SYNC_(); const unsigned long long tn_ = __builtin_amdgcn_s_memrealtime(); if ((PROBE_MASK >> ph_) & 1) tacc_ += tn_ - tprev_; tprev_ = tn_; ++ph_; } while (0)
#define GRID_SYNC() do { GRID_SYNC_(); const unsigned long long tn_ = __builtin_amdgcn_s_memrealtime(); if ((PROBE_MASK >> ph_) & 1) tacc_ += tn_ - tprev_; tprev_ = tn_; ++ph_; } while (0)
#else
#define SEAM_SYNC(local) do { if (local) LOCAL_SYNC_(); else GRID_SYNC_(); } while (0)
#define GRID_SYNC() GRID_SYNC_()
#endif
constexpr int XB_LDS = 155520;

__device__ __forceinline__ void mla_order(int vb, int r, int& unit) {
    const int bh = vb >> 1, s = vb & 1; const int qb = (r == 0) ? s : (r == 1) ? 7 - s : (r == 2) ? 3 - s : 4 + s; unit = bh * 8 + qb;
}

#define GAS __attribute__((address_space(1)))
#define FROM_W(f, T, k) p_.f = (T*)(GAS T*)(w_[k])
__device__ __forceinline__ void params_from_words(Params& p_, const unsigned long long (&w_)[29]) {
    FROM_W(x, const float, 0); FROM_W(mem, const float, 1); FROM_W(pos, const int, 2);
    FROM_W(g_mix, const float, 3); FROM_W(w_in, const float, 4); FROM_W(g_q, const float, 5); FROM_W(w_uq, const float, 6); FROM_W(g_kv, const float, 7); FROM_W(w_ukv, const float, 8); FROM_W(w_dw, const float, 9); FROM_W(b_dw, const float, 10);
    FROM_W(g_cln, const float, 11); FROM_W(b_cln, const float, 12); FROM_W(w_out, const float, 13); FROM_W(g_xattn, const float, 14); FROM_W(g_mem, const float, 15); FROM_W(w_xq, const float, 16); FROM_W(w_xkv, const float, 17); FROM_W(w_xo, const float, 18);
    FROM_W(g_ffn, const float, 19); FROM_W(w_router, const float, 20); FROM_W(b_router, const float, 21); FROM_W(w_up, const float, 22); FROM_W(b_up, const float, 23); FROM_W(w_down, const float, 24); FROM_W(b_down, const float, 25); FROM_W(g_final, const float, 26);
    FROM_W(out, float, 27); FROM_W(ws, unsigned char, 28);
}
static_assert(sizeof(Params) == 29 * 8, "Params = 29 pointers");
typedef const __attribute__((address_space(4))) Params* CParams;
#define PHASE_BEGIN() CParams pp_ = (CParams)__builtin_amdgcn_kernarg_segment_ptr(); asm volatile("" : "+s"(pp_)); Params p; { const __attribute__((address_space(4))) unsigned long long* q_ = (const __attribute__((address_space(4))) unsigned long long*)pp_; unsigned long long w_[29]; _Pragma("unroll") for (int k_ = 0; k_ < 29; ++k_) w_[k_] = q_[k_]; params_from_words(p, w_); } unsigned char* ws = p.ws; int tid; asm volatile("v_mbcnt_lo_u32_b32 %0, -1, 0\n\tv_mbcnt_hi_u32_b32 %0, -1, %0" : "=v"(tid)); tid += wave_s_ << 6; const int lane = tid & 63; (void)lane; (void)ws;

__global__ void __launch_bounds__(512) mega_kernel(Params p_unused) {
    extern __shared__ __attribute__((aligned(16))) unsigned char lds_raw[];
#if USE_CG_SYNC
    cg::grid_group grid = cg::this_grid();
#endif
    LAS unsigned char* lds = (LAS unsigned char*)lds_raw;
    const int wave_s_ = __builtin_amdgcn_readfirstlane(threadIdx.x >> 6);
    if (threadIdx.x < 2) ((volatile LAS unsigned*)(lds + XB_LDS))[threadIdx.x] = 0u;
    __syncthreads();
    const XcdBarrier xbar = xcd_barrier_post((unsigned*)(((CParams)__builtin_amdgcn_kernarg_segment_ptr())->ws + WS_CTL), (volatile LAS unsigned*)(lds + XB_LDS), threadIdx.x == 0); (void)xbar;
    const int G = gridDim.x, bx = blockIdx.x;
    const int vb = (G % 8 == 0) ? (bx % 8) * (G / 8) + bx / 8 : bx;
    if (threadIdx.x == 0 && G == 256) ((unsigned*)(((CParams)__builtin_amdgcn_kernarg_segment_ptr())->ws + WS_CTL))[CW_XCC + vb] = xb_xcc_id() + 1u;

#if PROBE_MASK || PROBE_EPI || PROBE_XA || PROBE_SUB
    unsigned long long tprev_ = __builtin_amdgcn_s_memrealtime(), tacc_ = 0; int ph_ = 0;
#endif
#if PROBE_SUB
    { PHASE_BEGIN(); prep_stage(p, lds, vb, G, tid, tacc_); }
#else
    { unsigned long long dummy_ = 0; PHASE_BEGIN(); prep_stage(p, lds, vb, G, tid, dummy_); }
#endif
    GRID_SYNC();
    { PHASE_BEGIN();
      { PvPlain P{(const bf16_t*)(ws + WS_XB), (const bf16_t*)(ws + WS_WT_IN), 1024, 1024, 1024}; pg8::SchedPlain S; S.o.init(128, 6, G, bx);
        EpiIn E{(bf16_t*)(ws + WS_U), (bf16_t*)(ws + WS_Z), (const float*)(ws + WS_RSTD_X), (float*)(ws + WS_SSQ_Q), (float*)(ws + WS_SSQ_KV), (const float*)(ws + WS_ROPE), (bf16_t*)(ws + WS_KB)};
        pg8::gemm_phase<true, false, false>(lds, lds + EPI_LDS, P, S, E, tid); }
 }
    GRID_SYNC();
    { PHASE_BEGIN();
      SUB_T0(4);
      { PvPlain P{(const bf16_t*)(ws + WS_U), (const bf16_t*)(ws + WS_WT_UQ), ULD, 256, 256}; pg8::SchedPlain S; S.o.init(128, 3, G, bx);
        EpiQ E{(bf16_t*)(ws + WS_Q), (const float*)(ws + WS_SSQ_Q), (const float*)(ws + WS_ROPE)};
        { int tq_; asm volatile("v_mbcnt_lo_u32_b32 %0, -1, 0\n\tv_mbcnt_hi_u32_b32 %0, -1, %0" : "=v"(tq_)); tq_ += wave_s_ << 6; pg8::gemm_phase<false, false, false>(lds, lds + EPI_LDS, P, S, E, tq_); } }
      constexpr int KM_ = FP8_MEM ? 512 : 1024;
      { PvPlain P{(const bf16_t*)(ws + WS_MEMB), (const bf16_t*)(ws + WS_WT_XKV), KM_, KM_, KM_}; pg8::SchedPlain S; S.o.init(16, 4, G, (bx + 128) % G);
        EpiKVMem E{(bf16_t*)(ws + WS_KM), (bf16_t*)(ws + WS_VMT), (const float*)(ws + WS_RSTD_MEM), FP8_MEM ? W8_INV : 1.0f};
        { int tq_; asm volatile("v_mbcnt_lo_u32_b32 %0, -1, 0\n\tv_mbcnt_hi_u32_b32 %0, -1, %0" : "=v"(tq_)); tq_ += wave_s_ << 6; pg8::gemm_phase<false, false, FP8_MEM != 0>(lds, lds + EPI_LDS, P, S, E, tq_); } }
      { PvVT P{(const bf16_t*)(ws + WS_WT_XKV), (const bf16_t*)(ws + WS_MEMB), KM_, KM_, KM_}; pg8::SchedPlain S; S.o.init(64, 1, G, (bx + 64) % G);
        EpiVT E{(bf16_t*)(ws + WS_VMT), (const float*)(ws + WS_RSTD_MEM), FP8_MEM ? W8_INV : 1.0f};
        { int tq_; asm volatile("v_mbcnt_lo_u32_b32 %0, -1, 0\n\tv_mbcnt_hi_u32_b32 %0, -1, %0" : "=v"(tq_)); tq_ += wave_s_ << 6; pg8::gemm_phase<true, false, FP8_MEM != 0>(lds, lds + EPI_LDS, P, S, E, tq_); } }
      SUB_T1(4, tacc_);
      SUB_T0(5);
      { PvPlain P{(const bf16_t*)(ws + WS_U) + 256, (const bf16_t*)(ws + WS_WT_UKV), ULD, 128, 128}; pg8::SchedPlain S; S.o.init(128, 4, G, (bx + 128) % G);
        EpiKV E{(bf16_t*)(ws + WS_KB), (bf16_t*)(ws + WS_VB), (const float*)(ws + WS_SSQ_KV)};
        pg8::gemm_phase<true, false, false>(lds, lds + EPI_LDS, P, S, E, tid); }
      SUB_T1(5, tacc_);
      SUB_T0(6);
      { int tid2; asm volatile("v_mbcnt_lo_u32_b32 %0, -1, 0\n\tv_mbcnt_hi_u32_b32 %0, -1, %0" : "=v"(tid2)); tid2 += wave_s_ << 6; for (int i = vb; i < 512; i += G) conv_unit(p, lds, i, tid2); }
      SUB_T1(6, tacc_); }
    GRID_SYNC();
    bool uni3 = false; int cv_left = CV_PER_WAVE;
    { PHASE_BEGIN();
      if (G == 256) {
        const int xq_ = bx & 7; const int wid_ = __builtin_amdgcn_readfirstlane(tid >> 6);
        unsigned* qh = (unsigned*)(ws + WS_CTL) + CW_MLAQ + 64 * xq_; LAS int* nxt_ = (LAS int*)(lds + 81920);
        int cvj = 0, cvs = 0, cvp = 0; const int cvgw = bx * 8 + wid_;
        { volatile LAS unsigned* fl_ = (volatile LAS unsigned*)(lds + XB_LDS + 16);
          if (wid_ == 0) { const unsigned* ids_ = (const unsigned*)(ws + WS_CTL) + CW_XCC; bool ok_ = true;
#pragma unroll
            for (int k_ = 0; k_ < 4; ++k_) { const int i_ = lane * 4 + k_; const unsigned id_ = ids_[i_], rf_ = ids_[i_ & ~31]; ok_ = ok_ && (id_ != 0u) && (id_ == rf_); }
            const bool all_ = __builtin_amdgcn_ballot_w64(ok_) == ~0ull; if (lane == 0) *fl_ = all_ ? 1u : 0u; }
          __syncthreads(); uni3 = (*fl_ != 0u); __syncthreads(); }
        unsigned* slabc = (unsigned*)(ws + WS_CTL) + CW_SLAB;
        int prev_slab = -1;
        for (;;) { if (tid == 0) *nxt_ = (int)atomicAdd(qh, 1u);
          asm volatile("s_waitcnt vmcnt(0)" ::: "memory");
          __syncthreads();
          if (uni3 && prev_slab >= 0 && tid == 0) (void)xb_add(slabc + 16 * prev_slab, 1u);
          const int il = *nxt_; __syncthreads();
          if (il >= 128) break;
          const int bh = xq_ * 16 + (il & 15), qb = 7 - (il >> 4);        mla_unit(p, lds, bh * 8 + qb, tid, cvgw, cvj, cvs, cvp);
          prev_slab = (bh >> 3) * 4 + (qb >> 1); }
        if (cvp) { asm volatile("s_waitcnt vmcnt(0)" ::: "memory"); cv_process(p, lds + CV_LDS + wid_ * CV_SLOT, cvgw + cvj * CV_NGW, lane); ++cvj; }
        cv_left = cvj; }
      else { int cvj = 0, cvs = 0, cvp = 0; moe_weights_stage(p, lds, vb, G, tid); for (int i = vb; i < 1024; i += G) mla_unit(p, lds, i, tid, -1, cvj, cvs, cvp); } }
    if (uni3) { if (wave_s_ == 0 && __builtin_amdgcn_mbcnt_hi(~0u, __builtin_amdgcn_mbcnt_lo(~0u, 0u)) == 0u) { unsigned* bar_ = (unsigned*)(((CParams)__builtin_amdgcn_kernarg_segment_ptr())->ws + WS_CTL);
          unsigned* c_ = bar_ + CW_SLAB + 16 * (((vb >> 4) * 4) + (vb & 3)); XB_SPIN(xb_ld(c_) < 16u, bar_);
          __builtin_amdgcn_fence(__ATOMIC_ACQUIRE, "agent"); asm volatile("s_waitcnt vmcnt(0)" ::: "memory"); }
        asm volatile("s_waitcnt vmcnt(0)" ::: "memory"); __syncthreads(); }
    else GRID_SYNC_();
#if PROBE_MASK || PROBE_EPI || PROBE_XA || PROBE_SUB
    { const unsigned long long tn_ = __builtin_amdgcn_s_memrealtime(); if ((PROBE_MASK >> ph_) & 1) tacc_ += tn_ - tprev_; tprev_ = tn_; ++ph_; }
#endif
#define GROUP_SEAM(k_) do { if (G == 256 && GROUP_BAR) { const int z_ = vb >> 2; const int v0_ = ((z_ >> 2) * 4) * 4 + (vb & 3); group_barrier((unsigned*)(((CParams)__builtin_amdgcn_kernarg_segment_ptr())->ws + WS_CTL), (z_ >> 2) * 4 + (vb & 3), 4u * (k_), wave_s_ == 0 && __builtin_amdgcn_mbcnt_hi(~0u, __builtin_amdgcn_mbcnt_lo(~0u, 0u)) == 0u, v0_, v0_ + 4, v0_ + 8, v0_ + 12); } else GRID_SYNC_(); } while (0)
#if PROBE_MASK || PROBE_EPI || PROBE_XA || PROBE_SUB
#define GROUP_SYNC(k_) do { GROUP_SEAM(k_); const unsigned long long tn_ = __builtin_amdgcn_s_memrealtime(); if ((PROBE_MASK >> ph_) & 1) tacc_ += tn_ - tprev_; tprev_ = tn_; ++ph_; } while (0)
#else
#define GROUP_SYNC(k_) GROUP_SEAM(k_)
#endif
    { PHASE_BEGIN();
      constexpr int KO = FP8_OUT ? 512 : 1024;
      PvPlain P{(const bf16_t*)(ws + WS_YCAT), (const bf16_t*)(ws + WS_WT_OUT), KO, KO, KO};
      EpiResid E{(const bf16_t*)(ws + WS_XB), (bf16_t*)(ws + WS_X1B), (float*)(ws + WS_SSQ_X1), FP8_XQ ? ws + WS_X1F : nullptr, FP8_OUT ? W8_INV * A8_INV : 1.0f};
      if (G == 256) { const int z_ = vb >> 2; pg8::SchedPair S{(z_ >> 2) * 8 + 2 * (vb & 3), z_ & 3};
        pg8::gemm_phase<true, false, FP8_OUT != 0>(lds, lds + EPI_LDS, P, S, E, tid); }
      else { pg8::SchedPlain S; S.o.init(128, 4, G, bx); pg8::gemm_phase<true, false, FP8_OUT != 0>(lds, lds + EPI_LDS, P, S, E, tid); } }
    GROUP_SYNC(1);
    { PHASE_BEGIN();
      constexpr int KQ = FP8_XQ ? 512 : 1024;
      PvPlain P{(const bf16_t*)(ws + (FP8_XQ ? WS_X1F : WS_X1B)), (const bf16_t*)(ws + WS_WT_XQ), KQ, KQ, KQ};
      EpiScale16 E{(bf16_t*)(ws + WS_XQ), 1024, (const float*)(ws + WS_SSQ_X1), FP8_XQ ? C2_X * W8_INV : C2_X};
      if (G == 256) {
        const int z_ = vb >> 2; pg8::SchedPair S{(z_ >> 2) * 8 + 2 * (vb & 3), z_ & 3};
        pg8::gemm_phase<true, false, FP8_XQ != 0>(lds, lds + EPI_LDS, P, S, E, tid); }
      else { pg8::SchedPlain S; S.o.init(128, 4, G, bx); pg8::gemm_phase<true, false, FP8_XQ != 0>(lds, lds + EPI_LDS, P, S, E, tid); } }
    SEAM_SYNC(G == 256);
    { PHASE_BEGIN();
#if PROBE_XA
      if (G == 256) xattn_range(p, lds, vb * 4, 4, tid, &tacc_);
#else
      if (G == 256) xattn_range(p, lds, vb * 4, 4, tid);
#endif
      else { for (int i = vb; i < 1024; i += G) xattn_range(p, lds, i, 1, tid); } }
    GROUP_SYNC(2);
    { PHASE_BEGIN();
      constexpr int KX = FP8_XO ? 512 : 1024;
      PvPlain P{(const bf16_t*)(ws + WS_OX), (const bf16_t*)(ws + WS_WT_XO), KX, KX, KX};
      EpiResid E{(const bf16_t*)(ws + WS_X1B), (bf16_t*)(ws + WS_X2B), nullptr, ws + WS_X2F, FP8_XO ? W8_INV * A8_INV : 1.0f};
      if (G == 256) { const int z_ = vb >> 2; pg8::SchedPair S{(z_ >> 2) * 8 + 2 * (vb & 3), z_ & 3};
        pg8::gemm_phase<true, false, FP8_XO != 0>(lds, lds + EPI_LDS, P, S, E, tid); }
      else { pg8::SchedPlain S; S.o.init(128, 4, G, bx); pg8::gemm_phase<true, false, FP8_XO != 0>(lds, lds + EPI_LDS, P, S, E, tid); } }
    GROUP_SYNC(3);
    { PHASE_BEGIN();
      if (G == 256) { const int z_ = vb >> 2; router1_stage_weights(p, lds, tid); router1_unit(p, lds, (z_ >> 2) * 16 + 4 * (vb & 3) + (z_ & 3), tid); }
      else { if (vb < RT_UNITS) router1_stage_weights(p, lds, tid); for (int i = vb; i < RT_UNITS; i += G) router1_unit(p, lds, i, tid); }
      if (G == 256 && cv_left < CV_PER_WAVE) moe_weights_stage(p, lds, bx, G, tid, cv_left); }
    GRID_SYNC();
    { PHASE_BEGIN(); for (int i = vb; i < RT_UNITS; i += G) router2_unit(p, lds, i, tid); }
    GRID_SYNC();
    { PHASE_BEGIN(); const int* te = (const int*)(ws + WS_TILE_E); const int nt = te[NTILE_MAX];
      LAS int* tl = (LAS int*)(lds + EPI_LDS + 9216); for (int i = tid; i < NTILE_MAX; i += 512) tl[i] = te[i];
      __syncthreads();
      PvUpG P{(const bf16_t*)(ws + WS_X2F), (const bf16_t*)(ws + WS_WT_UP), tl, (const int*)(ws + WS_SLOT_TOK), 512, 512, 512}; pg8::SchedPlain S; S.o.init(nt, 8, G, bx, 4);
      EpiSwiglu E{(bf16_t*)(ws + WS_ACT), (const float*)(ws + WS_SLOT_RS), tl, p.b_up};
#if PROBE_EPI == 1
      pg8::gemm_phase<true, true, true>(lds, lds + EPI_LDS, P, S, E, tid, &tacc_);
#else
      pg8::gemm_phase<true, true, true>(lds, lds + EPI_LDS, P, S, E, tid);
#endif
    }
    GRID_SYNC();
    { PHASE_BEGIN(); const int* te = (const int*)(ws + WS_TILE_E); const int nt = te[NTILE_MAX];
      LAS int* tl = (LAS int*)(lds + EPI_LDS + 9216); for (int i = tid; i < NTILE_MAX; i += 512) tl[i] = te[i];
      __syncthreads();
      PvExp P{(const bf16_t*)(ws + WS_ACT), (const bf16_t*)(ws + WS_WT_DOWN), tl, 512, 512, 512, 1024}; pg8::SchedPlain S; S.o.init(nt, 4, G, bx, (nt + 7) / 8);
      EpiDown E{ws + WS_YB, (const float*)(ws + WS_SLOT_GATE), tl, p.b_down};
#if PROBE_EPI == 2
      pg8::gemm_phase<2, false, true>(lds, lds + EPI_LDS, P, S, E, tid, &tacc_); }
#else
      pg8::gemm_phase<2, false, true>(lds, lds + EPI_LDS, P, S, E, tid); }
#endif
    GRID_SYNC();
    { PHASE_BEGIN(); const int gw = vb * 8 + (tid >> 6), ngw = G * 8; final_stage(p, gw, ngw, lane); }
#if PROBE_MASK || PROBE_EPI || PROBE_XA || PROBE_SUB
    { const unsigned long long tn_ = __builtin_amdgcn_s_memrealtime(); if ((PROBE_MASK >> ph_) & 1) tacc_ += tn_ - tprev_;
      const unsigned long long t0_ = __builtin_amdgcn_s_memrealtime(); while (__builtin_amdgcn_s_memrealtime() - t0_ < 4ull * tacc_) __builtin_amdgcn_s_sleep(8); }
#endif
}

extern "C" void kernel_launch(void* const* d_in, const int* in_sizes, int n_in, void* d_out, int out_size, void* d_ws, size_t ws_size, hipStream_t stream) {
    static int grid = 0;
    if (grid == 0) {
        if (n_in != 27 || ws_size < WS_END) { fprintf(stderr, "kernel_launch: unexpected inputs (n_in %d, ws %zu)\n", n_in, ws_size); grid = -1; return; }
        int dev = 0, cus = 0, per_cu = 0;
        (void)hipGetDevice(&dev); (void)hipDeviceGetAttribute(&cus, hipDeviceAttributeMultiprocessorCount, dev);
        (void)hipFuncSetAttribute((const void*)mega_kernel, hipFuncAttributeMaxDynamicSharedMemorySize, LDS_BYTES);
        (void)hipOccupancyMaxActiveBlocksPerMultiprocessor(&per_cu, (const void*)mega_kernel, 512, LDS_BYTES);
        if (per_cu < 1) { fprintf(stderr, "kernel_launch: occupancy query says %d blocks per CU\n", per_cu); per_cu = 1; }
        if (per_cu > 1) per_cu = 1;
        grid = cus * per_cu;
        (void)hipGetLastError();
    }
    if (grid < 0) return;
    (void)hipMemsetAsync((char*)d_ws + WS_CTL, 0, 32768, stream);
    Params p{};
    p.x = (const float*)d_in[0]; p.mem = (const float*)d_in[1]; p.pos = (const int*)d_in[2];
    p.g_mix = (const float*)d_in[3]; p.w_in = (const float*)d_in[4]; p.g_q = (const float*)d_in[5]; p.w_uq = (const float*)d_in[6]; p.g_kv = (const float*)d_in[7]; p.w_ukv = (const float*)d_in[8];
    p.w_dw = (const float*)d_in[9]; p.b_dw = (const float*)d_in[10]; p.g_cln = (const float*)d_in[11]; p.b_cln = (const float*)d_in[12]; p.w_out = (const float*)d_in[13];
    p.g_xattn = (const float*)d_in[14]; p.g_mem = (const float*)d_in[15]; p.w_xq = (const float*)d_in[16]; p.w_xkv = (const float*)d_in[17]; p.w_xo = (const float*)d_in[18];
    p.g_ffn = (const float*)d_in[19]; p.w_router = (const float*)d_in[20]; p.b_router = (const float*)d_in[21]; p.w_up = (const float*)d_in[22]; p.b_up = (const float*)d_in[23];
    p.w_down = (const float*)d_in[24]; p.b_down = (const float*)d_in[25]; p.g_final = (const float*)d_in[26];
    p.out = (float*)d_out; p.ws = (unsigned char*)d_ws;
    void* args[] = {&p};
    hipError_t e = hipLaunchCooperativeKernel((const void*)mega_kernel, dim3(grid), dim3(512), args, LDS_BYTES, stream);
    if (e != hipSuccess) fprintf(stderr, "cooperative launch failed: %s (grid %d)\n", hipGetErrorString(e), grid);
}
```
